# Optimizing an MI355X kernel written in HIP

```python
import math
import jax, jax.numpy as jnp
from jax import lax
import numpy as np

D_MODEL = 2048
BATCH = 2
SEQ = 8192
DEPTH = 2

F32 = jnp.float32
EPS = 1e-6
GRID_W = 64

S5_WIDTH = D_MODEL // 2
S5_GROUP = 16
S5_GROUPS = S5_WIDTH // S5_GROUP
S5_STATE = 64
DT_MIN = 1e-3
DT_MAX = 1e-1

HEAD_DIM = 128
N_Q_HEADS = (D_MODEL // 2) // HEAD_DIM
N_KV_HEADS = max(1, N_Q_HEADS // 4)
GQA_GROUP = N_Q_HEADS // N_KV_HEADS
ATTN_WIDTH = N_Q_HEADS * HEAD_DIM
ROPE_THETA = 10000.0
BLOCK_Q = 128

IN_A = S5_WIDTH
IN_Q = ATTN_WIDTH
IN_KV = N_KV_HEADS * HEAD_DIM
EVEN_IN = IN_A + IN_Q + 2 * IN_KV
EVEN_OUT = S5_WIDTH + ATTN_WIDTH

SGU_CHUNK = 128
SGU_GROUPS = 8
SGU_WIDTH = 2 * D_MODEL
SGU_GROUP_W = SGU_WIDTH // SGU_GROUPS

PEER_HEADS = 8
PEER_NKEYS = 128
PEER_EXPERTS = PEER_NKEYS * PEER_NKEYS
PEER_TOPK = 16
PEER_DKEY = 256
PEER_BLOCK = 128

N_EVEN = (DEPTH + 1) // 2
N_ODD = DEPTH // 2

kernel_name = "hybrid_s5_gqa_sgu_peer_encoder"


def rms_norm(x, g):
    x32 = x.astype(F32)
    y = x32 * lax.rsqrt(jnp.mean(x32 * x32, axis=-1, keepdims=True) + EPS)
    return (y * g.astype(F32)).astype(x.dtype)


def ada_rms_norm(x, g, shift, scale):
    return rms_norm(x, g) * (1 + scale[:, None, :]) + shift[:, None, :]


def axial_rope(seq_len):
    rows = seq_len // GRID_W
    row = jnp.repeat(jnp.arange(rows, dtype=F32), GRID_W)
    col = jnp.tile(jnp.arange(GRID_W, dtype=F32), rows)
    n_pair_axis = HEAD_DIM // 4
    inv_freq = ROPE_THETA ** (-jnp.arange(n_pair_axis, dtype=F32) / n_pair_axis)
    ang = jnp.concatenate([row[:, None] * inv_freq, col[:, None] * inv_freq], axis=-1)
    return jnp.cos(ang), jnp.sin(ang)


def apply_rope(x, cos, sin):
    x32 = x.astype(F32).reshape(x.shape[:-1] + (HEAD_DIM // 2, 2))
    x1, x2 = x32[..., 0], x32[..., 1]
    c = cos[None, :, None, :]
    s = sin[None, :, None, :]
    out = jnp.stack([x1 * c - x2 * s, x1 * s + x2 * c], axis=-1).reshape(x.shape)
    return out.astype(x.dtype)


def block_attention(q, k, v):
    bsz, hkv, grp, s_len, dh = q.shape
    nb = s_len // BLOCK_Q
    qb = q.reshape(bsz, hkv, grp, nb, BLOCK_Q, dh).transpose(3, 0, 1, 2, 4, 5)
    scale = dh ** -0.5

    def one_block(qblk):
        s = jnp.einsum('bhgqd,bhkd->bhgqk', qblk, k, preferred_element_type=F32) * scale
        p = jax.nn.softmax(s, axis=-1)
        return jnp.einsum('bhgqk,bhkd->bhgqd', p.astype(v.dtype), v)

    o = lax.map(one_block, qb)
    return o.transpose(1, 0, 4, 2, 3, 5).reshape(bsz, s_len, hkv * grp * dh)


def _ssm_combine(e1, e2):
    a1r, a1i, b1r, b1i = e1
    a2r, a2i, b2r, b2i = e2
    return (a2r * a1r - a2i * a1i,
            a2r * a1i + a2i * a1r,
            a2r * b1r - a2i * b1i + b2r,
            a2r * b1i + a2i * b1r + b2i)


def s5_mixer(u, lam_re, lam_im, log_dt, b_re, b_im, c_re, c_im, d_skip, glu_w, glu_b):
    bsz, s_len, n_g, _ = u.shape
    u32 = u.astype(F32)
    y = d_skip.astype(F32) * u32
    for direction in range(2):
        lr = jnp.minimum(lam_re[direction].astype(F32), -1e-4)
        li = lam_im[direction].astype(F32)
        dt = jnp.exp(log_dt[direction].astype(F32))[:, None]
        mag = jnp.exp(lr * dt)
        ab_re = mag * jnp.cos(li * dt)
        ab_im = mag * jnp.sin(li * dt)
        den = lr * lr + li * li
        nr = ab_re - 1.0
        coef_re = (nr * lr + ab_im * li) / den
        coef_im = (ab_im * lr - nr * li) / den
        br = b_re[direction].astype(F32)
        bi = b_im[direction].astype(F32)
        bb_re = coef_re[..., None] * br - coef_im[..., None] * bi
        bb_im = coef_re[..., None] * bi + coef_im[..., None] * br
        x_re = jnp.einsum('bsgh,gph->bsgp', u32, bb_re)
        x_im = jnp.einsum('bsgh,gph->bsgp', u32, bb_im)
        a_re = jnp.broadcast_to(ab_re[None, None], (1, s_len) + ab_re.shape)
        a_im = jnp.broadcast_to(ab_im[None, None], (1, s_len) + ab_im.shape)
        _, _, h_re, h_im = lax.associative_scan(
            _ssm_combine, (a_re, a_im, x_re, x_im), reverse=(direction == 1), axis=1)
        y = y + jnp.einsum('bsgp,ghp->bsgh', h_re, c_re[direction].astype(F32)) \
              - jnp.einsum('bsgp,ghp->bsgh', h_im, c_im[direction].astype(F32))
    y = jax.nn.gelu(y)
    gate = jax.nn.sigmoid(jnp.einsum('bsgh,ghk->bsgk', y, glu_w.astype(F32)) + glu_b.astype(F32))
    return (y * gate).astype(u.dtype)


def even_mixer(h, w_in, w_out, lam_re, lam_im, log_dt, b_re, b_im, c_re, c_im, d_skip,
               glu_w, glu_b, q_g, k_g, cos, sin):
    bsz, s_len, _ = h.shape
    z = h @ w_in
    ua, q, k, v = jnp.split(z, [IN_A, IN_A + IN_Q, IN_A + IN_Q + IN_KV], axis=-1)
    a_out = s5_mixer(ua.reshape(bsz, s_len, S5_GROUPS, S5_GROUP), lam_re, lam_im, log_dt,
                     b_re, b_im, c_re, c_im, d_skip, glu_w, glu_b).reshape(bsz, s_len, S5_WIDTH)
    q = apply_rope(rms_norm(q.reshape(bsz, s_len, N_Q_HEADS, HEAD_DIM), q_g), cos, sin)
    k = apply_rope(rms_norm(k.reshape(bsz, s_len, N_KV_HEADS, HEAD_DIM), k_g), cos, sin)
    v = v.reshape(bsz, s_len, N_KV_HEADS, HEAD_DIM)
    q = q.reshape(bsz, s_len, N_KV_HEADS, GQA_GROUP, HEAD_DIM).transpose(0, 2, 3, 1, 4)
    b_out = block_attention(q, k.transpose(0, 2, 1, 3), v.transpose(0, 2, 1, 3))
    return jnp.concatenate([a_out, b_out], axis=-1) @ w_out


def odd_mixer(h, w_in, w_out, ln_g, w_s, b_s):
    bsz, s_len, _ = h.shape
    z = jax.nn.gelu(h @ w_in)
    u, v = jnp.split(z, 2, axis=-1)
    v32 = v.reshape(bsz, s_len // SGU_CHUNK, SGU_CHUNK, SGU_GROUPS, SGU_GROUP_W).astype(F32)
    mu = jnp.mean(v32, axis=-1, keepdims=True)
    var = jnp.mean(jnp.square(v32 - mu), axis=-1, keepdims=True)
    vn = ((v32 - mu) * lax.rsqrt(var + EPS) * ln_g.astype(F32)).astype(h.dtype)
    s = jnp.einsum('gij,bnjgc->bnigc', w_s, vn) + b_s.T[None, None, :, :, None]
    return (u * s.reshape(bsz, s_len, SGU_WIDTH)) @ w_out


def peer(h, w_q, sub_k1, sub_k2, u_tab, v_tab):
    bsz, s_len, d = h.shape
    t = bsz * s_len
    ht = h.reshape(t, d)
    q = (ht @ w_q).reshape(t, PEER_HEADS, 2, PEER_DKEY // 2)
    s1 = jnp.einsum('thd,kd->thk', q[:, :, 0], sub_k1, preferred_element_type=F32)
    s2 = jnp.einsum('thd,kd->thk', q[:, :, 1], sub_k2, preferred_element_type=F32)
    v1, i1 = lax.top_k(s1, PEER_TOPK)
    v2, i2 = lax.top_k(s2, PEER_TOPK)
    cand = (v1[..., :, None] + v2[..., None, :]).reshape(t, PEER_HEADS, PEER_TOPK * PEER_TOPK)
    sc, ci = lax.top_k(cand, PEER_TOPK)
    r1 = jnp.take_along_axis(i1, ci // PEER_TOPK, axis=-1)
    r2 = jnp.take_along_axis(i2, ci % PEER_TOPK, axis=-1)
    eidx = r1 * PEER_NKEYS + r2
    gates = jax.nn.softmax(sc, axis=-1)
    nb = t // PEER_BLOCK
    xb = ht.reshape(nb, PEER_BLOCK, d)
    ib = eidx.reshape(nb, PEER_BLOCK, PEER_HEADS * PEER_TOPK)
    gb = gates.reshape(nb, PEER_BLOCK, PEER_HEADS * PEER_TOPK)

    def one_block(args):
        xblk, iblk, gblk = args
        act = jnp.einsum('td,tkd->tk', xblk, u_tab[iblk], preferred_element_type=F32)
        w = (jax.nn.gelu(act) * gblk).astype(xblk.dtype)
        return jnp.einsum('tk,tkd->td', w, v_tab[iblk])

    out = lax.map(one_block, (xb, ib, gb))
    return out.reshape(bsz, s_len, d)


def setup_inputs(seed: int = 0) -> dict:
    key = jax.random.key(seed)
    k = jax.random.split(key, 32)

    def nrm(i, shape, std):
        return jax.random.normal(k[i], shape, F32) * std

    D = D_MODEL
    G, P, H = S5_GROUPS, S5_STATE, S5_GROUP
    lam_im_base = jnp.pi * jnp.arange(P, dtype=F32)
    return {
        "x": nrm(0, (BATCH, SEQ, D), 1.0),
        "c": nrm(1, (BATCH, D), 1.0),
        "ada_w": nrm(2, (DEPTH, D, 6 * D), 0.5 * D ** -0.5),
        "ada_b": nrm(3, (DEPTH, 6 * D), 0.01),
        "norm_g": 1.0 + nrm(4, (DEPTH, 2, D), 0.01),
        "even_w_in": nrm(5, (N_EVEN, D, EVEN_IN), D ** -0.5),
        "even_w_out": nrm(6, (N_EVEN, EVEN_OUT, D), EVEN_OUT ** -0.5),
        "s5_lam_re": -0.5 + nrm(7, (N_EVEN, 2, G, P), 0.01),
        "s5_lam_im": lam_im_base + nrm(8, (N_EVEN, 2, G, P), 0.01),
        "s5_log_dt": jax.random.uniform(k[9], (N_EVEN, 2, G), F32,
                                        minval=math.log(DT_MIN), maxval=math.log(DT_MAX)),
        "s5_b_re": nrm(10, (N_EVEN, 2, G, P, H), (2 * H) ** -0.5),
        "s5_b_im": nrm(11, (N_EVEN, 2, G, P, H), (2 * H) ** -0.5),
        "s5_c_re": nrm(12, (N_EVEN, 2, G, H, P), 0.5 ** 0.5),
        "s5_c_im": nrm(13, (N_EVEN, 2, G, H, P), 0.5 ** 0.5),
        "s5_d": nrm(14, (N_EVEN, G, H), 1.0),
        "s5_glu_w": nrm(15, (N_EVEN, G, H, H), H ** -0.5),
        "s5_glu_b": nrm(16, (N_EVEN, G, H), 0.01),
        "q_norm_g": 1.0 + nrm(17, (N_EVEN, HEAD_DIM), 0.01),
        "k_norm_g": 1.0 + nrm(18, (N_EVEN, HEAD_DIM), 0.01),
        "odd_w_in": nrm(19, (N_ODD, D, 2 * SGU_WIDTH), D ** -0.5),
        "odd_w_out": nrm(20, (N_ODD, SGU_WIDTH, D), SGU_WIDTH ** -0.5),
        "sgu_ln_g": 1.0 + nrm(21, (N_ODD, SGU_GROUPS, SGU_GROUP_W), 0.01),
        "sgu_w": nrm(22, (N_ODD, SGU_GROUPS, SGU_CHUNK, SGU_CHUNK), 0.5 * SGU_CHUNK ** -0.5),
        "sgu_b": 1.0 + nrm(23, (N_ODD, SGU_GROUPS, SGU_CHUNK), 0.01),
        "peer_w_q": nrm(24, (DEPTH, D, PEER_HEADS * PEER_DKEY), D ** -0.5),
        "peer_k1": nrm(25, (DEPTH, PEER_NKEYS, PEER_DKEY // 2), (PEER_DKEY // 2) ** -0.5),
        "peer_k2": nrm(26, (DEPTH, PEER_NKEYS, PEER_DKEY // 2), (PEER_DKEY // 2) ** -0.5),
        "peer_u": nrm(27, (DEPTH, PEER_EXPERTS, D), D ** -0.5),
        "peer_v": nrm(28, (DEPTH, PEER_EXPERTS, D), 1.0),
        "final_g": 1.0 + nrm(29, (D,), 0.01),
    }


def reference(x, c, ada_w, ada_b, norm_g, even_w_in, even_w_out, s5_lam_re, s5_lam_im,
              s5_log_dt, s5_b_re, s5_b_im, s5_c_re, s5_c_im, s5_d, s5_glu_w, s5_glu_b,
              q_norm_g, k_norm_g, odd_w_in, odd_w_out, sgu_ln_g, sgu_w, sgu_b,
              peer_w_q, peer_k1, peer_k2, peer_u, peer_v, final_g):
    s_len = x.shape[1]
    cos, sin = axial_rope(s_len)
    c_act = jax.nn.silu(c)
    for layer in range(DEPTH):
        mod = c_act @ ada_w[layer] + ada_b[layer]
        sh1, sc1, g1, sh2, sc2, g2 = jnp.split(mod, 6, axis=-1)
        h = ada_rms_norm(x, norm_g[layer, 0], sh1, sc1)
        i = layer // 2
        if layer % 2 == 0:
            m = even_mixer(h, even_w_in[i], even_w_out[i], s5_lam_re[i], s5_lam_im[i],
                           s5_log_dt[i], s5_b_re[i], s5_b_im[i], s5_c_re[i], s5_c_im[i],
                           s5_d[i], s5_glu_w[i], s5_glu_b[i], q_norm_g[i], k_norm_g[i], cos, sin)
        else:
            m = odd_mixer(h, odd_w_in[i], odd_w_out[i], sgu_ln_g[i], sgu_w[i], sgu_b[i])
        x = x + g1[:, None, :] * m
        h = ada_rms_norm(x, norm_g[layer, 1], sh2, sc2)
        x = x + g2[:, None, :] * peer(h, peer_w_q[layer], peer_k1[layer], peer_k2[layer],
                                      peer_u[layer], peer_v[layer])
    return rms_norm(x, final_g)
```

```cpp
#include <hip/hip_runtime.h>
#include <hip/hip_cooperative_groups.h>
#include <hip/hip_bf16.h>
#include <cstdio>
#include <cstdint>
namespace cg = cooperative_groups;

__device__ __forceinline__ int lane_id_v() { int l; asm volatile("v_mbcnt_lo_u32_b32 %0, -1, 0\n\tv_mbcnt_hi_u32_b32 %0, -1, %0" : "=v"(l)); return l; }

namespace pg8 {
#define PG8_LAS __attribute__((address_space(3)))
typedef unsigned short bf16_t;
typedef short bf16x8 __attribute__((ext_vector_type(8)));
typedef float f32x4 __attribute__((ext_vector_type(4)));
typedef unsigned u32x4 __attribute__((ext_vector_type(4)));
constexpr int BM = 256, BK = 64, HALF = 128, HTB = HALF * BK * 2  , STAGE_BYTES = 8 * HTB, NXCD = 8, WGM = 8;

__host__ __device__ __forceinline__ int lds_byte(int r, int c) { const int st = (r >> 4) * 2 + (c >> 5), rr = r & 15, cc = c & 31, ob = rr * 64 + cc * 2; return st * 1024 + (ob ^ (((ob >> 9) & 1) << 5)); }
__host__ __device__ __forceinline__ void stage_rc(int b, int& R, int& C) { const int st = b / 1024, sb = b % 1024, swz = sb ^ (((sb >> 9) & 1) << 5); R = (st >> 1) * 16 + swz / 64; C = (st & 1) * 32 + (swz % 64) / 2; }
__host__ __device__ __forceinline__ int perm32(int rho) { const int n = rho >> 4, i = rho & 15; return 8 * (i >> 2) + 4 * n + (i & 3); }

struct Unit { int pm, pn, pb; };
struct Gemm { const bf16_t* A; const bf16_t* Bt; int M, N, K; int lda, ldb; size_t bsA, bsB; };

struct StaticOrder {
    int nM, nN, nwg, G, c, pbs;
    __host__ __device__ void init(int M, int N, int G_, int c_) { nM = M / BM; nN = N / BM; nwg = nM * nN; G = G_; c = c_; pbs = -1; }
    __host__ __device__ bool next(int i, Unit& u) const {
        const long L = (long)i * G + c; if (L >= nwg) return false;
        int wgid = (int)L; { const int q = nwg / NXCD, r = nwg % NXCD, xcd = wgid % NXCD, off = wgid / NXCD; wgid = (xcd < r ? xcd * (q + 1) : r * (q + 1) + (xcd - r) * q) + off; }
        const int nig = WGM * nN, gid = wgid / nig, fm = gid * WGM, gsz = (nM - fm) < WGM ? (nM - fm) : WGM;
        u.pm = fm + ((wgid % nig) % gsz); u.pn = (wgid % nig) / gsz; u.pb = pbs >= 0 ? (u.pm >> pbs) : 0; return true;
    }
    __device__ __forceinline__ void a_ready(const Unit&) const {}
    __device__ __forceinline__ void done(const Unit&) const {}
};

__device__ __forceinline__ unsigned cvt_pk_bf16(float lo, float hi) { unsigned r; asm volatile("v_cvt_pk_bf16_f32 %0, %1, %2" : "=v"(r) : "v"(lo), "v"(hi)); return r; }
typedef float f32x2 __attribute__((ext_vector_type(2)));

typedef int i32x8 __attribute__((ext_vector_type(8)));
typedef int i32x4v __attribute__((ext_vector_type(4)));
__device__ __forceinline__ void pg8_mfma_f8(f32x4& c, const i32x8& a, const i32x8& b, int sc) {
    asm("s_nop 1\n\tv_mfma_f32_16x16x128_f8f6f4 %0, %1, %2, %0" : "+v"(c) : "v"(a), "v"(b)); (void)sc; }
__device__ __forceinline__ void pg8_mfma_f8_drain(f32x4 (&acc)[2][2][4][2]) {
#pragma unroll
    for (int a = 0; a < 2; ++a)
#pragma unroll
        for (int b = 0; b < 2; ++b) {
            if (a == 0 && b == 0) asm volatile("s_nop 15\n\ts_nop 15" : "+v"(acc[a][b][0][0]), "+v"(acc[a][b][0][1]), "+v"(acc[a][b][1][0]), "+v"(acc[a][b][1][1]), "+v"(acc[a][b][2][0]), "+v"(acc[a][b][2][1]), "+v"(acc[a][b][3][0]), "+v"(acc[a][b][3][1]));
            else asm volatile("" : "+v"(acc[a][b][0][0]), "+v"(acc[a][b][0][1]), "+v"(acc[a][b][1][0]), "+v"(acc[a][b][1][1]), "+v"(acc[a][b][2][0]), "+v"(acc[a][b][2][1]), "+v"(acc[a][b][3][0]), "+v"(acc[a][b][3][1])); }
}
__device__ __forceinline__ i32x8 pg8_cat(bf16x8 a, bf16x8 b) { return __builtin_shufflevector(__builtin_bit_cast(i32x4v, a), __builtin_bit_cast(i32x4v, b), 0, 1, 2, 3, 4, 5, 6, 7); }
template <class Epi, class Sched, bool ALIGN_EPI = false, bool SP2 = false, bool F8 = false>
__device__ __forceinline__ void gemm_phase(PG8_LAS unsigned char* lds, const Gemm g, const Sched& S, const Epi& E) {
    int tid_o = threadIdx.x; asm volatile("" : "+v"(tid_o)); const int tid = tid_o, wid = __builtin_amdgcn_readfirstlane(tid >> 6), lane = tid & 63, wr = wid >> 2, wc = wid & 3, fr = lane & 15, fq = lane >> 4;
    const int K = g.K, nt = K / BK;
    unsigned voffA[2], voffB[2];
#pragma unroll
    for (int i = 0; i < 2; ++i) { int R, C; stage_rc(tid * 16 + i * 8192, R, C); const int Rb = Epi::PERM ? ((R & ~31) + perm32(R & 31)) : R;
        voffA[i] = (unsigned)(R * g.lda + C) * 2u; voffB[i] = (unsigned)(Rb * g.ldb + C) * 2u; }
    const size_t kstep = (size_t)(BK * 2);
    const size_t hstepA = (size_t)HALF * g.lda * 2, hstepB = (size_t)HALF * g.ldb * 2;
    const size_t tstepA = 2 * hstepA, tstepB = 2 * hstepB;
    const unsigned ldsw = (unsigned)wid * 1024u;
    const int aoff = lds_byte(wr * 64 + fr, fq * 8), boff = lds_byte(wc * 32 + fr, fq * 8);
#define PG8_SA(b, h) (((b) * 2 + (h)) * HTB)
#define PG8_SB(b, h) ((4 + (b) * 2 + (h)) * HTB)
#define PG8_STAGE(bufoff, gbase, voff) do { _Pragma("unroll") for (int _i = 0; _i < 2; ++_i) \
        __builtin_amdgcn_global_load_lds((const unsigned*)((const char*)(gbase) + (voff)[_i]), (PG8_LAS unsigned*)(lds + (bufoff) + ldsw + _i * 8192), 16, 0, 0); } while (0)
#define PG8_LDA(dst, b, h) do { _Pragma("unroll") for (int m = 0; m < 4; ++m) { dst[m].lo = *(const PG8_LAS i32x4v*)(lds + PG8_SA(b, h) + aoff + m * 2048); dst[m].hi = *(const PG8_LAS i32x4v*)(lds + PG8_SA(b, h) + aoff + m * 2048 + 1024); } } while (0)
#define PG8_LDB(dst, b, h) do { _Pragma("unroll") for (int n = 0; n < 2; ++n) { dst[n].lo = *(const PG8_LAS i32x4v*)(lds + PG8_SB(b, h) + boff + n * 2048); dst[n].hi = *(const PG8_LAS i32x4v*)(lds + PG8_SB(b, h) + boff + n * 2048 + 1024); } } while (0)
#define PG8_MMA(ai, bj, At, Bt) do { __builtin_amdgcn_s_setprio(1); \
        if constexpr (F8) { _Pragma("unroll") for (int m = 0; m < 4; ++m) _Pragma("unroll") for (int n = 0; n < 2; ++n) pg8_mfma_f8(acc[ai][bj][m][n], Bt[n], At[m], f8scale); } \
        else { _Pragma("unroll") for (int m = 0; m < 4; ++m) _Pragma("unroll") for (int n = 0; n < 2; ++n) { \
            const i32x4v b_lo = Bt[n].lo, b_hi = Bt[n].hi, a_lo = At[m].lo, a_hi = At[m].hi;     \
            acc[ai][bj][m][n] = __builtin_amdgcn_mfma_f32_16x16x32_bf16(__builtin_bit_cast(bf16x8, b_lo), __builtin_bit_cast(bf16x8, a_lo), acc[ai][bj][m][n], 0, 0, 0); \
            acc[ai][bj][m][n] = __builtin_amdgcn_mfma_f32_16x16x32_bf16(__builtin_bit_cast(bf16x8, b_hi), __builtin_bit_cast(bf16x8, a_hi), acc[ai][bj][m][n], 0, 0, 0); } } \
        __builtin_amdgcn_s_setprio(0); } while (0)
#define PG8_WAIT_V(n) asm volatile("s_waitcnt vmcnt(" #n ")" ::: "memory")
#define PG8_WAIT_L(n) asm volatile("s_waitcnt lgkmcnt(" #n ")" ::: "memory")
#define PG8_BAR __builtin_amdgcn_s_barrier()
#define PG8_SCHED __builtin_amdgcn_sched_barrier(0)
    Unit cur, nxt; int ui = 0;
    if (!S.next(0, cur)) return;
    f32x4 acc[2][2][4][2];
#pragma unroll
    for (int a = 0; a < 2; ++a)
#pragma unroll
        for (int b = 0; b < 2; ++b)
#pragma unroll
            for (int m = 0; m < 4; ++m)
#pragma unroll
                for (int n = 0; n < 2; ++n) acc[a][b][m][n] = (f32x4){0.f, 0.f, 0.f, 0.f};
    int f8scale = 0x7f7f7f7f; asm volatile("" : "+v"(f8scale));
    i32x8 At[4], B0[2], B1[2];
    const char* cA = (const char*)(g.A + (size_t)cur.pb * g.bsA) + (size_t)cur.pm * tstepA; const char* cB = (const char*)(g.Bt + (size_t)cur.pb * g.bsB) + (size_t)cur.pn * tstepB;
    S.a_ready(cur);
    if constexpr (SP2) {
        PG8_STAGE(PG8_SB(0, 0), cB, voffB); PG8_STAGE(PG8_SB(0, 1), cB + hstepB, voffB); PG8_STAGE(PG8_SA(0, 0), cA, voffA); PG8_STAGE(PG8_SA(0, 1), cA + hstepA, voffA);
        if (wr == 1) PG8_BAR;
        PG8_WAIT_V(2); PG8_BAR;
        PG8_STAGE(PG8_SB(1, 0), cB + kstep, voffB); PG8_STAGE(PG8_SA(1, 0), cA + kstep, voffA); PG8_STAGE(PG8_SB(1, 1), cB + hstepB + kstep, voffB);
        PG8_WAIT_V(6); PG8_BAR;
    } else {
        PG8_STAGE(PG8_SB(0, 0), cB, voffB); PG8_STAGE(PG8_SA(0, 0), cA, voffA); PG8_STAGE(PG8_SB(0, 1), cB + hstepB, voffB); PG8_STAGE(PG8_SA(0, 1), cA + hstepA, voffA);
        if (wr == 1) PG8_BAR;
        PG8_WAIT_V(4); PG8_BAR;
        PG8_STAGE(PG8_SB(1, 0), cB + kstep, voffB); PG8_STAGE(PG8_SA(1, 0), cA + kstep, voffA); PG8_STAGE(PG8_SB(1, 1), cB + hstepB + kstep, voffB);
        PG8_WAIT_V(6); PG8_BAR;
    }
    for (;;) {
        const bool has_next = S.next(ui + 1, nxt);
        const char* nA = has_next ? (const char*)(g.A + (size_t)nxt.pb * g.bsA) + (size_t)nxt.pm * tstepA : cA; const char* nB = has_next ? (const char*)(g.Bt + (size_t)nxt.pb * g.bsB) + (size_t)nxt.pn * tstepB : cB;
        for (int t = 0; t < nt; t += 2) {
            const bool last = (t == nt - 2);
            const char* a1 = cA + (size_t)(t + 1) * kstep;
            const char* a2 = last ? nA : cA + (size_t)(t + 2) * kstep; const char* b2 = last ? nB : cB + (size_t)(t + 2) * kstep;
            const char* a3 = a2 + kstep; const char* b3 = b2 + kstep;
            if (last && has_next) S.a_ready(nxt);
            if constexpr (SP2) {
            PG8_LDB(B0, 0, 0); PG8_LDB(B1, 0, 1); PG8_SCHED; PG8_LDA(At, 0, 0); PG8_STAGE(PG8_SA(1, 1), a1 + hstepA, voffA);
            PG8_WAIT_V(8); PG8_WAIT_L(0); PG8_BAR; PG8_MMA(0, 0, At, B0); PG8_MMA(0, 1, At, B1); PG8_BAR; PG8_SCHED;
            PG8_LDA(At, 0, 1); PG8_STAGE(PG8_SB(0, 0), b2, voffB); PG8_STAGE(PG8_SB(0, 1), b2 + hstepB, voffB); PG8_STAGE(PG8_SA(0, 0), a2, voffA);
            PG8_WAIT_V(8); PG8_WAIT_L(0); PG8_BAR; PG8_MMA(1, 0, At, B0); PG8_MMA(1, 1, At, B1); PG8_BAR; PG8_SCHED;
            PG8_LDB(B0, 1, 0); PG8_LDB(B1, 1, 1); PG8_SCHED; PG8_LDA(At, 1, 0); PG8_STAGE(PG8_SA(0, 1), a2 + hstepA, voffA);
            PG8_WAIT_V(8); PG8_WAIT_L(0); PG8_BAR; PG8_MMA(0, 0, At, B0); PG8_MMA(0, 1, At, B1); PG8_BAR; PG8_SCHED;
            PG8_LDA(At, 1, 1); PG8_STAGE(PG8_SB(1, 0), b3, voffB); PG8_STAGE(PG8_SB(1, 1), b3 + hstepB, voffB); PG8_STAGE(PG8_SA(1, 0), a3, voffA);
            PG8_WAIT_V(8); PG8_WAIT_L(0); PG8_BAR; PG8_MMA(1, 0, At, B0); PG8_MMA(1, 1, At, B1); PG8_BAR; PG8_SCHED;
            } else {
            PG8_LDB(B0, 0, 0); PG8_SCHED; PG8_LDA(At, 0, 0); PG8_STAGE(PG8_SA(1, 1), a1 + hstepA, voffA);
            PG8_WAIT_L(8); PG8_BAR; PG8_WAIT_L(0); PG8_MMA(0, 0, At, B0); PG8_BAR; PG8_SCHED;
            PG8_LDB(B1, 0, 1); PG8_STAGE(PG8_SB(0, 0), b2, voffB);
            PG8_BAR; PG8_WAIT_L(0); PG8_MMA(0, 1, At, B1); PG8_BAR;
            PG8_LDA(At, 0, 1); PG8_STAGE(PG8_SA(0, 0), a2, voffA);
            PG8_BAR; PG8_WAIT_L(0); PG8_MMA(1, 0, At, B0); PG8_BAR; PG8_SCHED;
            PG8_STAGE(PG8_SB(0, 1), b2 + hstepB, voffB);
            PG8_WAIT_V(6); PG8_BAR; PG8_MMA(1, 1, At, B1); PG8_BAR;
            PG8_LDB(B0, 1, 0); PG8_SCHED; PG8_LDA(At, 1, 0); PG8_STAGE(PG8_SA(0, 1), a2 + hstepA, voffA);
            PG8_WAIT_L(8); PG8_BAR; PG8_WAIT_L(0); PG8_MMA(0, 0, At, B0); PG8_BAR; PG8_SCHED;
            PG8_LDB(B1, 1, 1); PG8_STAGE(PG8_SB(1, 0), b3, voffB);
            PG8_BAR; PG8_WAIT_L(0); PG8_MMA(0, 1, At, B1); PG8_BAR;
            PG8_LDA(At, 1, 1); PG8_STAGE(PG8_SA(1, 0), a3, voffA);
            PG8_BAR; PG8_WAIT_L(0); PG8_MMA(1, 0, At, B0); PG8_BAR; PG8_SCHED;
            PG8_STAGE(PG8_SB(1, 1), b3 + hstepB, voffB);
            PG8_WAIT_V(6); PG8_BAR; PG8_MMA(1, 1, At, B1); PG8_BAR;
            }
        }
        if constexpr (ALIGN_EPI) { if (wr == 0) PG8_BAR; }
        if constexpr (F8) pg8_mfma_f8_drain(acc);
        if constexpr (!Epi::AFTER_DRAIN) { E(acc, cur, wr, wc, fr, fq); S.done(cur); }
        if (!has_next) break;
#pragma unroll
        for (int a = 0; a < 2; ++a)
#pragma unroll
            for (int b = 0; b < 2; ++b)
#pragma unroll
                for (int m = 0; m < 4; ++m)
#pragma unroll
                    for (int n = 0; n < 2; ++n) acc[a][b][m][n] = (f32x4){0.f, 0.f, 0.f, 0.f};
        cur = nxt; cA = nA; cB = nB; ++ui;
        if constexpr (ALIGN_EPI) { if (wr == 1) PG8_BAR; }
    }
    PG8_WAIT_V(0);
    if constexpr (!ALIGN_EPI) { if (wr == 0) PG8_BAR; }
    PG8_BAR;
    if constexpr (Epi::AFTER_DRAIN) { E.fused(acc, cur, wr, wc, fr, fq, lds, wid, lane); S.done(cur); }
#undef PG8_SA
#undef PG8_SB
#undef PG8_STAGE
#undef PG8_LDA
#undef PG8_LDB
#undef PG8_MMA
#undef PG8_WAIT_V
#undef PG8_WAIT_L
#undef PG8_BAR
#undef PG8_SCHED
}
}
namespace attn {
using bf16 = __hip_bfloat16;
constexpr int   D = 128, NW = 8, QBLK = 32, KVBLK = 64;
constexpr float SCALE = 0.088388347648318440f;
constexpr float THR = 8.f;
constexpr int SDEPTH = 2;
constexpr int LDQ = 1024, LDK = 256, LDO = 2048;
constexpr size_t SHM_V = KVBLK * D * 2, SHM_K = KVBLK * D * 2, SHM_ATTN = 2 * SHM_V + 2 * SHM_K + NW * 64 * 4;
using bf16x8 = __attribute__((ext_vector_type(8))) short;
using s16x4  = __attribute__((ext_vector_type(4))) short;
using f32x16 = __attribute__((ext_vector_type(16))) float;
using f32x8  = __attribute__((ext_vector_type(8))) float;
using u32x4  = __attribute__((ext_vector_type(4))) unsigned;
#define KSWZ(row, colB) ((row) * 256 + ((colB) ^ (((row) & 7) << 4)))
#define SBAR() __builtin_amdgcn_sched_barrier(0)
__device__ __forceinline__ int crow(int r, int hi) { return (r & 3) + 8 * (r >> 2) + 4 * hi; }
__device__ __forceinline__ unsigned cvtpk(float lo, float hi) {
  unsigned r; asm volatile("v_cvt_pk_bf16_f32 %0, %1, %2" : "=v"(r) : "v"(lo), "v"(hi)); return r;
}
template <typename TIn> struct Stage;
template <> struct Stage<bf16>  { using T = bf16x8;
  __device__ static __forceinline__ T ld8(const bf16* p) { return *reinterpret_cast<const bf16x8*>(p); }
  __device__ static __forceinline__ bf16x8 tobf(T x) { return x; } };
template <> struct Stage<float> { using T = f32x8;
  __device__ static __forceinline__ T ld8(const float* p) { return *reinterpret_cast<const f32x8*>(p); }
  __device__ static __forceinline__ bf16x8 tobf(T x) {
    u32x4 w = {cvtpk(x[0], x[1]), cvtpk(x[2], x[3]), cvtpk(x[4], x[5]), cvtpk(x[6], x[7])}; return *reinterpret_cast<bf16x8*>(&w); } };

__device__ __forceinline__ void partialSM(f32x16& p0, f32x16& p1, float& m_reg, float& mn, float& alpha) {
  constexpr float C = SCALE * 1.4426950408889634f;
  float pmax = p0[0]; for (int r = 1; r < 16; ++r) pmax = fmaxf(pmax, p0[r]); for (int r = 0; r < 16; ++r) pmax = fmaxf(pmax, p1[r]);
  { auto rr = __builtin_amdgcn_permlane32_swap(__float_as_uint(pmax), __float_as_uint(pmax), false, false);
    pmax = fmaxf(__uint_as_float(rr[0]), __uint_as_float(rr[1])); }
  if (__builtin_expect(__all(pmax - m_reg <= THR / SCALE), 1)) { mn = m_reg; alpha = 1.f; }
  else { mn = fmaxf(m_reg, pmax); alpha = __builtin_amdgcn_exp2f((m_reg - mn) * C); m_reg = mn; }
  float mnC = -mn * C;
  for (int r = 0; r < 16; ++r) p0[r] = fmaf(p0[r], C, mnC); for (int r = 0; r < 16; ++r) p1[r] = fmaf(p1[r], C, mnC);
  for (int r = 0; r < 16; ++r) p0[r] = __builtin_amdgcn_exp2f(p0[r]);
}
__device__ __forceinline__ void finishSM(f32x16& p0, f32x16& p1, float alpha, float& l_reg, bf16x8& pa0, bf16x8& pa1, bf16x8& pa2, bf16x8& pa3) {
  for (int r = 0; r < 16; ++r) p1[r] = __builtin_amdgcn_exp2f(p1[r]);
  float ps = 0; for (int r = 0; r < 16; ++r) ps += p0[r]; for (int r = 0; r < 16; ++r) ps += p1[r];
  { auto rr = __builtin_amdgcn_permlane32_swap(__float_as_uint(ps), __float_as_uint(ps), false, false);
    ps = __uint_as_float(rr[0]) + __uint_as_float(rr[1]); }
  l_reg = l_reg * alpha + ps;
#define PK4(P, BASE, OUT) do { unsigned a0 = cvtpk(P[BASE + 0], P[BASE + 1]), a1 = cvtpk(P[BASE + 2], P[BASE + 3]);   \
    unsigned b0 = cvtpk(P[BASE + 4], P[BASE + 5]), b1 = cvtpk(P[BASE + 6], P[BASE + 7]);                              \
    auto r0 = __builtin_amdgcn_permlane32_swap(a0, b0, false, false); auto r1 = __builtin_amdgcn_permlane32_swap(a1, b1, false, false); \
    u32x4 w = {r0[0], r1[0], r0[1], r1[1]}; OUT = *reinterpret_cast<bf16x8*>(&w); } while (0)
  PK4(p0, 0, pa0); PK4(p0, 8, pa1); PK4(p1, 0, pa2); PK4(p1, 8, pa3);
#undef PK4
}
__device__ __forceinline__ void qkt(f32x16& p0, f32x16& p1, const bf16* Ks, const bf16x8* qr, int r32, int hi) {
  p0 = f32x16{}; p1 = f32x16{};
  for (int d0 = 0; d0 < 8; ++d0) { int cb = (d0 * 16 + hi * 8) * 2;
    bf16x8 b0 = *reinterpret_cast<const bf16x8*>((const char*)Ks + KSWZ(r32, cb));
    bf16x8 b1 = *reinterpret_cast<const bf16x8*>((const char*)Ks + KSWZ(32 + r32, cb));
    p0 = __builtin_amdgcn_mfma_f32_32x32x16_bf16(b0, qr[d0], p0, 0, 0, 0);
    p1 = __builtin_amdgcn_mfma_f32_32x32x16_bf16(b1, qr[d0], p1, 0, 0, 0); }
}
__device__ __forceinline__ int v_st(int k, int c) { const int kk = (k & ~0xC) | ((k & 4) << 1) | ((k & 8) >> 1); return ((kk >> 3) * 4 + (c >> 5)) * 512 + ((kk & 7) * 32 + (c & 31)) * 2; }
__device__ __forceinline__ int v_rd_base(int lane) { return ((lane & 3) << 3) | (((lane >> 2) & 3) << 6) | (((lane >> 4) & 1) << 5) | (((lane >> 5) & 1) << 8); }
constexpr int v_rd_off(int d0, int ks, int half) { return d0 * 512 + ks * 4096 + half * 2048; }
template <int OFF> __device__ __forceinline__ s16x4 tr_read(int vb) {
  s16x4 r; asm volatile("ds_read_b64_tr_b16 %0, %1 offset:%2" : "=&v"(r) : "v"(vb), "i"(OFF) : "memory"); return r;
}
template <int D0> __device__ __forceinline__ void pv_one(f32x16& od, int vb, bf16x8 pa0, bf16x8 pa1, bf16x8 pa2, bf16x8 pa3) {
  const s16x4 l0 = tr_read<v_rd_off(D0, 0, 0)>(vb), h0 = tr_read<v_rd_off(D0, 0, 1)>(vb), l1 = tr_read<v_rd_off(D0, 1, 0)>(vb), h1 = tr_read<v_rd_off(D0, 1, 1)>(vb);
  const s16x4 l2 = tr_read<v_rd_off(D0, 2, 0)>(vb), h2 = tr_read<v_rd_off(D0, 2, 1)>(vb), l3 = tr_read<v_rd_off(D0, 3, 0)>(vb), h3 = tr_read<v_rd_off(D0, 3, 1)>(vb);
  asm volatile("s_waitcnt lgkmcnt(0)" ::: "memory"); SBAR();
#define PK(L, H) (bf16x8){L[0], L[1], L[2], L[3], H[0], H[1], H[2], H[3]}
  od = __builtin_amdgcn_mfma_f32_32x32x16_bf16(pa0, PK(l0, h0), od, 0, 0, 0);
  od = __builtin_amdgcn_mfma_f32_32x32x16_bf16(pa1, PK(l1, h1), od, 0, 0, 0);
  od = __builtin_amdgcn_mfma_f32_32x32x16_bf16(pa2, PK(l2, h2), od, 0, 0, 0);
  od = __builtin_amdgcn_mfma_f32_32x32x16_bf16(pa3, PK(l3, h3), od, 0, 0, 0);
#undef PK
}
__device__ __forceinline__ void pv_d0(f32x16* o, int vb, bf16x8 pa0, bf16x8 pa1, bf16x8 pa2, bf16x8 pa3) {
  pv_one<0>(o[0], vb, pa0, pa1, pa2, pa3); pv_one<1>(o[1], vb, pa0, pa1, pa2, pa3); pv_one<2>(o[2], vb, pa0, pa1, pa2, pa3); pv_one<3>(o[3], vb, pa0, pa1, pa2, pa3);
}

template <typename TQ>
__device__ __forceinline__ void attn_dense_body(const TQ* __restrict__ Qb, const bf16* __restrict__ Kh, const bf16* __restrict__ Vh,
                                                unsigned char* __restrict__ Ob, int seq, char* lds) {
  using St = Stage<bf16>; using SQ = Stage<TQ>;
  int tid_o = threadIdx.x; asm volatile("" : "+v"(tid_o)); const int tid = tid_o, wid = tid >> 6, lane = tid & 63, r32 = lane & 31, hi = lane >> 5;
  bf16* V_lds = (bf16*)lds; bf16* K_lds = (bf16*)(lds + 2 * SHM_V);
  float* ws = (float*)(lds + 2 * SHM_V + 2 * SHM_K) + wid * 64; float* li_l = ws; float* al_l = ws + 32;
  float m_reg = -1e30f, l_reg = 0; f32x16 o[4] = {}; bf16x8 qr[8];
  const TQ* Qw = Qb + (long)(wid * QBLK + r32) * LDQ + hi * 8;
#pragma unroll
  for (int d0 = 0; d0 < 8; ++d0) qr[d0] = SQ::tobf(SQ::ld8(Qw + d0 * 16));
  const int sr = tid >> 4, sc = (tid & 15) * 8, vst0 = v_st(sr, sc), vst1 = v_st(32 + sr, sc);
  const int vb0 = (int)(uintptr_t)V_lds + v_rd_base(lane);
  struct { typename St::T vs0, vs1, ks0, ks1; } sr_[SDEPTH];
#define SLOAD(i, k0) do { sr_[i].vs0 = St::ld8(&Vh[(long)((k0) + sr) * LDK + sc]); sr_[i].vs1 = St::ld8(&Vh[(long)((k0) + 32 + sr) * LDK + sc]); \
    sr_[i].ks0 = St::ld8(&Kh[(long)((k0) + sr) * LDK + sc]); sr_[i].ks1 = St::ld8(&Kh[(long)((k0) + 32 + sr) * LDK + sc]); } while (0)
#define SWRITE(b, i) do { *(bf16x8*)((char*)V_lds + (b) * SHM_V + vst0) = St::tobf(sr_[i].vs0);          \
    *(bf16x8*)((char*)V_lds + (b) * SHM_V + vst1) = St::tobf(sr_[i].vs1); int kc = sc * 2;               \
    *(bf16x8*)((char*)K_lds + (b) * SHM_K + KSWZ(sr, kc)) = St::tobf(sr_[i].ks0);                       \
    *(bf16x8*)((char*)K_lds + (b) * SHM_K + KSWZ(32 + sr, kc)) = St::tobf(sr_[i].ks1); } while (0)
#define SWAIT() do { if constexpr (SDEPTH == 2) asm volatile("s_waitcnt vmcnt(4)" ::: "memory"); else asm volatile("s_waitcnt vmcnt(0)" ::: "memory"); } while (0)
#define RESC(a) do { if (__any((a) < 1.f)) { if (hi == 0) al_l[r32] = (a); asm volatile("s_waitcnt lgkmcnt(0)" ::: "memory"); \
    for (int d = 0; d < 4; ++d) for (int r = 0; r < 16; ++r) o[d][r] *= al_l[crow(r, hi)]; } } while (0)
  f32x16 pA0, pA1, pB0, pB1; float mnA, mnB, alA, alB; bf16x8 pa0, pa1, pa2, pa3; const int NT = seq / KVBLK;
  constexpr int SE = 0, SO = SDEPTH - 1;
  SLOAD(SE, 0); asm volatile("s_waitcnt vmcnt(0)" ::: "memory"); SWRITE(0, SE); __syncthreads();
  qkt(pA0, pA1, K_lds, qr, r32, hi); partialSM(pA0, pA1, m_reg, mnA, alA);
  SLOAD(SO, KVBLK); if constexpr (SDEPTH == 2) { if (2 < NT) SLOAD(SE, 2 * KVBLK); }
  SWAIT(); SWRITE(1, SO); __syncthreads();
  for (int j = 1; j + 1 < NT; j += 2) {
    SBAR(); qkt(pB0, pB1, (bf16*)((char*)K_lds + SHM_K), qr, r32, hi);
    finishSM(pA0, pA1, alA, l_reg, pa0, pa1, pa2, pa3); SBAR();
    SLOAD(SO, (j + SDEPTH) * KVBLK); SBAR();
    pv_d0(o, vb0, pa0, pa1, pa2, pa3); partialSM(pB0, pB1, m_reg, mnB, alB);
    __syncthreads(); SWAIT(); SWRITE(0, SE);
    RESC(alB); __syncthreads();
    SBAR(); qkt(pA0, pA1, K_lds, qr, r32, hi);
    finishSM(pB0, pB1, alB, l_reg, pa0, pa1, pa2, pa3); SBAR();
    if (SDEPTH == 1 || j + 3 < NT) SLOAD(SE, (j + 1 + SDEPTH) * KVBLK); SBAR();
    pv_d0(o, vb0 + (int)SHM_V, pa0, pa1, pa2, pa3); partialSM(pA0, pA1, m_reg, mnA, alA);
    __syncthreads(); SWAIT(); SWRITE(1, SO);
    RESC(alA); __syncthreads();
  }
  SBAR(); qkt(pB0, pB1, (bf16*)((char*)K_lds + SHM_K), qr, r32, hi);
  finishSM(pA0, pA1, alA, l_reg, pa0, pa1, pa2, pa3); SBAR();
  pv_d0(o, vb0, pa0, pa1, pa2, pa3); partialSM(pB0, pB1, m_reg, mnB, alB);
  __syncthreads(); RESC(alB);
  finishSM(pB0, pB1, alB, l_reg, pa0, pa1, pa2, pa3); SBAR();
  pv_d0(o, vb0 + (int)SHM_V, pa0, pa1, pa2, pa3);
  if (hi == 0) li_l[r32] = l_reg; asm volatile("s_waitcnt lgkmcnt(0)" ::: "memory");
  float rli[16];
#pragma unroll
  for (int r = 0; r < 16; ++r) rli[r] = __builtin_amdgcn_rcpf(li_l[crow(r, hi)]);
  unsigned char* Ow = Ob + (long)(wid * QBLK) * LDO;
#pragma unroll
  for (int r = 0; r < 16; ++r) { int orow = crow(r, hi);
    for (int d0 = 0; d0 < 4; ++d0) Ow[(long)orow * LDO + d0 * 32 + r32] = (unsigned char)(__builtin_amdgcn_cvt_pk_fp8_f32(__builtin_amdgcn_fmed3f(o[d0][r] * rli[r] * 16.0f, -440.f, 440.f), 0.f, 0, false) & 0xff); }
#undef SLOAD
#undef SWRITE
#undef SWAIT
#undef RESC
}
#undef KSWZ
#undef SBAR
}

#define LAS __attribute__((address_space(3)))
typedef unsigned short bf16_t;
typedef short bf16x8 __attribute__((ext_vector_type(8)));
typedef float f32x4 __attribute__((ext_vector_type(4)));
typedef float f32x2 __attribute__((ext_vector_type(2)));
typedef float f32x16 __attribute__((ext_vector_type(16)));
typedef unsigned u32x4 __attribute__((ext_vector_type(4)));
typedef unsigned u32x2 __attribute__((ext_vector_type(2)));

constexpr int NTOK = 16384, DMODEL = 2048, SEQL = 8192;
constexpr size_t MiB = 1u << 20;
constexpr size_t WS_MOD = 0;
constexpr size_t WS_BAR = 512 * 1024;
constexpr size_t WS_S5A = 1 * MiB;
constexpr size_t WS_LNST = 296 * MiB;
constexpr size_t WS_ABT = 2 * MiB;
constexpr size_t WS_BIASQ = 2 * MiB + 64 * 1024;
constexpr size_t WS_ROWSQ = 336 * MiB;
constexpr size_t WS_BIASP = 340 * MiB;
constexpr size_t WS_WQF = 304 * MiB;
constexpr size_t WS_KEYS = 4 * MiB;
constexpr size_t WS_WSB = 5 * MiB;
constexpr size_t WS_WINE = 6 * MiB;
constexpr size_t WS_WOUTE = 16 * MiB;
constexpr size_t WS_WINO = 24 * MiB;
constexpr size_t WS_WOUTO = 56 * MiB;
constexpr size_t WS_WQ = 72 * MiB;
constexpr size_t WS_PU = 88 * MiB;
constexpr size_t WS_PV = 152 * MiB;
constexpr size_t WS_PSC = 5 * MiB + 512 * 1024;
constexpr int PEER_ROWB = 1536;
constexpr bool PEER_SLICE_U = true, PEER_SLICE_V = true;
typedef unsigned u32x6 __attribute__((ext_vector_type(6)));
typedef float f32x16 __attribute__((ext_vector_type(16)));
typedef float f32x32 __attribute__((ext_vector_type(32)));
typedef _Float16 h16x2 __attribute__((ext_vector_type(2)));
typedef _Float16 h16x32 __attribute__((ext_vector_type(32)));
constexpr size_t WS_WY = 216 * MiB;
constexpr size_t WS_WSUM = 232 * MiB;
constexpr size_t WS_H8 = 256 * MiB;
constexpr size_t WS_H = 344 * MiB;
constexpr size_t WS_XB = WS_H;
constexpr size_t WS_TMP = 408 * MiB;
constexpr size_t WS_AB = WS_TMP  , WS_Q = WS_TMP + 64 * MiB, WS_K = WS_TMP + 96 * MiB, WS_V = WS_TMP + 104 * MiB,
                 WS_SS = WS_TMP + 112 * MiB  , WS_CAT = WS_TMP + 176 * MiB;
constexpr size_t WS_Z = WS_TMP, WS_SG = WS_TMP + 256 * MiB;
constexpr size_t WS_QP = WS_TMP;
constexpr size_t WS_X8 = WS_TMP + 64 * MiB;
constexpr size_t WS_RSTD = WS_TMP + 64 * MiB;
constexpr size_t WS_EID = WS_TMP + 128 * MiB;
constexpr size_t WS_GATE = WS_TMP + 136 * MiB;
constexpr size_t WS_PW = WS_TMP + 144 * MiB;
constexpr size_t WS_PO = WS_TMP + 152 * MiB;
constexpr size_t WS_PACT = WS_TMP + 216 * MiB;
typedef unsigned u32x16 __attribute__((ext_vector_type(16)));
typedef __bf16 bf16x2v __attribute__((ext_vector_type(2)));
constexpr size_t WS_END = WS_TMP + 384 * MiB;
constexpr int LDS_BYTES = 147456;

struct P {
    const float *x, *c, *ada_w, *ada_b, *norm_g, *even_w_in, *even_w_out, *lam_re, *lam_im, *log_dt, *b_re, *b_im, *c_re, *c_im, *s5_d, *glu_w, *glu_b,
        *q_g, *k_g, *odd_w_in, *odd_w_out, *sgu_ln_g, *sgu_w, *sgu_b, *peer_wq, *peer_k1, *peer_k2, *peer_u, *peer_v, *final_g;
    float* out; unsigned char* ws;
};

__device__ __forceinline__ unsigned cvtpk(float lo, float hi) { unsigned r; asm("v_cvt_pk_bf16_f32 %0, %1, %2" : "=v"(r) : "v"(lo), "v"(hi)); return r; }
__device__ __forceinline__ unsigned pk_fp8x4(float a, float b, float c, float d) {
    a = __builtin_amdgcn_fmed3f(a, -440.f, 440.f); b = __builtin_amdgcn_fmed3f(b, -440.f, 440.f); c = __builtin_amdgcn_fmed3f(c, -440.f, 440.f); d = __builtin_amdgcn_fmed3f(d, -440.f, 440.f);
    int w = 0; w = __builtin_amdgcn_cvt_pk_fp8_f32(a, b, w, false); w = __builtin_amdgcn_cvt_pk_fp8_f32(c, d, w, true); return (unsigned)w; }
constexpr float F8_WS = 64.0f, F8_HS = 8.0f, F8_SGS = 8.0f, F8_CS = 16.0f, F8_XS = 8.0f;
__device__ __forceinline__ float bflo(unsigned w) { return __uint_as_float(w << 16); }
__device__ __forceinline__ float bfhi(unsigned w) { return __uint_as_float(w & 0xffff0000u); }
__device__ __forceinline__ float wave_sum(float v) {
    v += __uint_as_float(__builtin_amdgcn_update_dpp(0u, __float_as_uint(v), 0xB1, 0xF, 0xF, true));
    v += __uint_as_float(__builtin_amdgcn_update_dpp(0u, __float_as_uint(v), 0x4E, 0xF, 0xF, true));
    v += __uint_as_float(__builtin_amdgcn_update_dpp(0u, __float_as_uint(v), 0x141, 0xF, 0xF, true));
    v += __uint_as_float(__builtin_amdgcn_update_dpp(0u, __float_as_uint(v), 0x140, 0xF, 0xF, true));
    { const auto r = __builtin_amdgcn_permlane16_swap(__float_as_uint(v), __float_as_uint(v), false, false); v = __uint_as_float(r[0]) + __uint_as_float(r[1]); }
    { const auto r = __builtin_amdgcn_permlane32_swap(__float_as_uint(v), __float_as_uint(v), false, false); v = __uint_as_float(r[0]) + __uint_as_float(r[1]); }
    return v;
}
__device__ __forceinline__ float row16_sum(float v) {
    v += __uint_as_float(__builtin_amdgcn_update_dpp(0u, __float_as_uint(v), 0xB1, 0xF, 0xF, true));
    v += __uint_as_float(__builtin_amdgcn_update_dpp(0u, __float_as_uint(v), 0x4E, 0xF, 0xF, true));
    v += __uint_as_float(__builtin_amdgcn_update_dpp(0u, __float_as_uint(v), 0x141, 0xF, 0xF, true));
    v += __uint_as_float(__builtin_amdgcn_update_dpp(0u, __float_as_uint(v), 0x140, 0xF, 0xF, true));
    return v;
}
__device__ __forceinline__ float xrow_sum(float v) {
    { const auto r = __builtin_amdgcn_permlane16_swap(__float_as_uint(v), __float_as_uint(v), false, false); v = __uint_as_float(r[0]) + __uint_as_float(r[1]); }
    { const auto r = __builtin_amdgcn_permlane32_swap(__float_as_uint(v), __float_as_uint(v), false, false); v = __uint_as_float(r[0]) + __uint_as_float(r[1]); }
    return v;
}
__device__ __forceinline__ float sigmoid_f(float x) { return __builtin_amdgcn_rcpf(1.f + __expf(-x)); }
__device__ __forceinline__ float gelu_t(float x) { const float u = 0.7978845608028654f * (x + 0.044715f * x * x * x); return x * __builtin_amdgcn_rcpf(1.f + __expf(-2.f * u)); }
__device__ __forceinline__ void sincos_rad(float ang, float& sn, float& cs) {
    float rev = ang * 0.15915494309189535f; rev = rev - floorf(rev);
    sn = __builtin_amdgcn_sinf(rev); cs = __builtin_amdgcn_cosf(rev);
}
__device__ __forceinline__ float dot4(f32x4 a, f32x4 b) { return (a.x * b.x + a.y * b.y) + (a.z * b.z + a.w * b.w); }
#define LDS_WAIT() asm volatile("s_waitcnt lgkmcnt(0)" ::: "memory")

namespace pg8 {
constexpr int NTOK_ = 16384;
struct EpiEvenSplit {
    static constexpr bool PERM = true, AFTER_DRAIN = false;
    float ds; unsigned char* wsb;
    __device__ __forceinline__ void operator()(const f32x4 (&acc)[2][2][4][2], const Unit& u, int wr, int wc, int fr, int fq) const {
        { const int l_ = lane_id_v(); fr = l_ & 15; fq = l_ >> 4; }
        const int row0 = u.pm * BM + wr * 64 + fr; const int pn = u.pn;
        bf16_t* const UA = (bf16_t*)(wsb + WS_AB);
        if (pn < 4) {
#pragma unroll
            for (int ai = 0; ai < 2; ++ai)
#pragma unroll
                for (int m = 0; m < 4; ++m) { const int t = row0 + ai * HALF + m * 16;
#pragma unroll
                    for (int bj = 0; bj < 2; ++bj) { const int c = pn * 256 + bj * HALF + wc * 32 + 8 * fq; const f32x4 v0 = acc[ai][bj][m][0] * ds, v1 = acc[ai][bj][m][1] * ds;
                        u32x4 w; w.x = cvt_pk_bf16(v0[0], v0[1]); w.y = cvt_pk_bf16(v0[2], v0[3]); w.z = cvt_pk_bf16(v1[0], v1[1]); w.w = cvt_pk_bf16(v1[2], v1[3]);
                        *(u32x4*)(UA + ((size_t)(c >> 4) * 1024 + (t >> 4)) * 512 + (t & 15) * 16 + (c & 15)) = w; } }
            return;
        }
        bf16_t* base; int ldc, colt;
        if (pn < 8) { base = (bf16_t*)(wsb + WS_Q); ldc = 1024; colt = (pn - 4) * 256; } else { base = (bf16_t*)(wsb + (pn == 8 ? WS_K : WS_V)); ldc = 256; colt = 0; }
        const int col0 = colt + wc * 32 + 8 * fq;
#pragma unroll
        for (int ai = 0; ai < 2; ++ai)
#pragma unroll
            for (int m = 0; m < 4; ++m) { bf16_t* rowp = base + (size_t)(row0 + ai * HALF + m * 16) * ldc + col0;
#pragma unroll
                for (int bj = 0; bj < 2; ++bj) { const f32x4 v0 = acc[ai][bj][m][0] * ds, v1 = acc[ai][bj][m][1] * ds;
                    u32x4 w; w.x = cvt_pk_bf16(v0[0], v0[1]); w.y = cvt_pk_bf16(v0[2], v0[3]); w.z = cvt_pk_bf16(v1[0], v1[1]); w.w = cvt_pk_bf16(v1[2], v1[3]);
                    *(u32x4*)(rowp + bj * HALF) = w; } }
    }
};
template <int ACT> struct EpiBf16T {
    static constexpr bool PERM = true, AFTER_DRAIN = false;
    bf16_t* O; int ldc; float ds; float* lnst;
    __device__ __forceinline__ void operator()(const f32x4 (&acc)[2][2][4][2], const Unit& u, int wr, int wc, int fr, int fq) const {
        { const int l_ = lane_id_v(); fr = l_ & 15; fq = l_ >> 4; }
        const int row0 = u.pm * BM + wr * 64 + fr, col0 = u.pn * BM + wc * 32 + 8 * fq;
        const bool do_st = (ACT == 1) && lnst != nullptr && u.pn >= 16;
#pragma unroll
        for (int ai = 0; ai < 2; ++ai)
#pragma unroll
            for (int m = 0; m < 4; ++m) { const int trow = row0 + ai * HALF + m * 16;
                bf16_t* rowp = (ACT == 1) ? O + ((size_t)((trow >> 7) * 16 + (col0 >> 9)) * 128 + (trow & 127)) * 512 + (col0 & 511) : O + (size_t)trow * ldc + col0; float s1 = 0.f, s2 = 0.f;
#pragma unroll
                for (int bj = 0; bj < 2; ++bj) { f32x4 v0 = acc[ai][bj][m][0] * ds, v1 = acc[ai][bj][m][1] * ds;
                    if (ACT == 1) {
#pragma unroll
                        for (int e = 0; e < 4; ++e) { v0[e] = gelu_t(v0[e]); v1[e] = gelu_t(v1[e]); s1 += v0[e] + v1[e]; s2 += v0[e] * v0[e] + v1[e] * v1[e]; } }
                    u32x4 w; w.x = cvt_pk_bf16(v0[0], v0[1]); w.y = cvt_pk_bf16(v0[2], v0[3]); w.z = cvt_pk_bf16(v1[0], v1[1]); w.w = cvt_pk_bf16(v1[2], v1[3]);
                    *(u32x4*)(rowp + bj * HALF) = w; }
                if (ACT == 1) { if (do_st) {
                    s1 = xrow_sum(s1); s2 = xrow_sum(s2);
                    if (fq == 0) *(f32x2*)(lnst + ((size_t)((u.pn - 16) * 4 + wc) * NTOK_ + (row0 + ai * HALF + m * 16)) * 2) = (f32x2){s1, s2}; } }
            }
    }
};
struct EpiResid {
    static constexpr bool PERM = false, AFTER_DRAIN = false;
    const float* xin; float* xout; const float* gate; float ds;
    __device__ __forceinline__ void operator()(const f32x4 (&acc)[2][2][4][2], const Unit& u, int wr, int wc, int fr, int fq) const {
        { const int l_ = lane_id_v(); fr = l_ & 15; fq = l_ >> 4; }
        const int row0 = u.pm * BM + wr * 64 + fr, col0 = u.pn * BM + wc * 32 + 4 * fq;
        const float* gp = gate + (size_t)((u.pm * BM) >> 13) * 12288 + col0;
        f32x4 gv[2][2];
#pragma unroll
        for (int bj = 0; bj < 2; ++bj)
#pragma unroll
            for (int n = 0; n < 2; ++n) gv[bj][n] = *(const f32x4*)(gp + bj * HALF + n * 16) * ds;
#pragma unroll
        for (int ai = 0; ai < 2; ++ai)
#pragma unroll
            for (int m = 0; m < 4; ++m) { const size_t off = (size_t)(row0 + ai * HALF + m * 16) * 2048 + col0;
#pragma unroll
                for (int bj = 0; bj < 2; ++bj)
#pragma unroll
                    for (int n = 0; n < 2; ++n) { const f32x4 xi = *(const f32x4*)(xin + off + bj * HALF + n * 16);
                        *(f32x4*)(xout + off + bj * HALF + n * 16) = xi + gv[bj][n] * acc[ai][bj][m][n]; } }
    }
};
struct EpiF32B {
    static constexpr bool PERM = false, AFTER_DRAIN = false;
    float* C; int ldc; size_t bs;
    __device__ __forceinline__ void operator()(const f32x4 (&acc)[2][2][4][2], const Unit& u, int wr, int wc, int fr, int fq) const {
        { const int l_ = lane_id_v(); fr = l_ & 15; fq = l_ >> 4; }
        char* base = (char*)(C + (size_t)u.pb * bs + (size_t)(u.pm * BM) * ldc);
        const unsigned off0 = (unsigned)((wr * 64 + fr) * ldc + u.pn * BM + wc * 32 + 4 * fq) * 4u;
#pragma unroll
        for (int ai = 0; ai < 2; ++ai)
#pragma unroll
            for (int m = 0; m < 4; ++m) { const unsigned off = off0 + (unsigned)((ai * HALF + m * 16) * ldc) * 4u;
#pragma unroll
                for (int bj = 0; bj < 2; ++bj)
#pragma unroll
                    for (int n = 0; n < 2; ++n) *(f32x4*)(base + off + (bj * HALF + n * 16) * 4) = acc[ai][bj][m][n]; }
    }
};
struct EpiS5Glu {
    static constexpr bool PERM = false, AFTER_DRAIN = false;
    unsigned char* CAT; const PG8_LAS float* wl;
    __device__ __forceinline__ void operator()(const f32x4 (&acc)[2][2][4][2], const Unit& u, int wr, int wc, int fr, int fq) const {
        { const int l_ = lane_id_v(); fr = l_ & 15; fq = l_ >> 4; }
        const int g = u.pb;
#pragma unroll
        for (int ai = 0; ai < 2; ++ai)
#pragma unroll
            for (int m = 0; m < 4; ++m) {
                const int chunk = u.pm * BM + ai * HALF + wr * 64 + m * 16 + fr, token = chunk * 16 + wc * 4 + fq;
                float y[16];
#pragma unroll
                for (int bj = 0; bj < 2; ++bj)
#pragma unroll
                    for (int n = 0; n < 2; ++n)
#pragma unroll
                        for (int j = 0; j < 4; ++j) y[8 * bj + 4 * n + j] = gelu_t(acc[ai][bj][m][n][j]);
                f32x4 z[4];
#pragma unroll
                for (int kq = 0; kq < 4; ++kq) z[kq] = *(const PG8_LAS f32x4*)(wl + 256 + 4 * kq);
#pragma unroll
                for (int h = 0; h < 16; ++h)
#pragma unroll
                    for (int kq = 0; kq < 4; ++kq) z[kq] += *(const PG8_LAS f32x4*)(wl + h * 16 + 4 * kq) * y[h];
                float o[16];
#pragma unroll
                for (int k = 0; k < 16; ++k) o[k] = y[k] * sigmoid_f(z[k >> 2][k & 3]);
                u32x4 w; w.x = pk_fp8x4(o[0] * F8_CS, o[1] * F8_CS, o[2] * F8_CS, o[3] * F8_CS); w.y = pk_fp8x4(o[4] * F8_CS, o[5] * F8_CS, o[6] * F8_CS, o[7] * F8_CS);
                w.z = pk_fp8x4(o[8] * F8_CS, o[9] * F8_CS, o[10] * F8_CS, o[11] * F8_CS); w.w = pk_fp8x4(o[12] * F8_CS, o[13] * F8_CS, o[14] * F8_CS, o[15] * F8_CS);
                *(u32x4*)(CAT + (size_t)token * 2048 + g * 16) = w;
                asm volatile("" ::: "memory");
            }
    }
};
template <bool FIRST> struct EpiResidB {
    static constexpr bool PERM = false, AFTER_DRAIN = false;
    const float* xin; bf16_t* xb; const float* gate; float* rowsq; unsigned char* x8; float ds;
    __device__ __forceinline__ void operator()(const f32x4 (&acc)[2][2][4][2], const Unit& u, int wr, int wc, int fr, int fq) const {
        { const int l_ = lane_id_v(); fr = l_ & 15; fq = l_ >> 4; }
        const int row0 = u.pm * BM + wr * 64 + fr, col0 = u.pn * BM + wc * 32 + 4 * fq;
        const float* gp = gate + (size_t)((u.pm * BM) >> 13) * 12288 + col0; float* const rq = rowsq;
        f32x4 gv[2][2];
#pragma unroll
        for (int bj = 0; bj < 2; ++bj)
#pragma unroll
            for (int n = 0; n < 2; ++n) gv[bj][n] = *(const f32x4*)(gp + bj * HALF + n * 16) * ds;
#pragma unroll
        for (int ai = 0; ai < 2; ++ai) {
            f32x4 xi[4][2][2];
#pragma unroll
            for (int m = 0; m < 4; ++m) { const size_t off = (size_t)(row0 + ai * HALF + m * 16) * 2048 + col0;
#pragma unroll
                for (int bj = 0; bj < 2; ++bj)
#pragma unroll
                    for (int n = 0; n < 2; ++n) {
                        if (FIRST) xi[m][bj][n] = *(const f32x4*)(xin + off + bj * HALF + n * 16);
                        else { const u32x2 w = *(const u32x2*)(xb + off + bj * HALF + n * 16); xi[m][bj][n] = (f32x4){__uint_as_float(w.x << 16), __uint_as_float(w.x & 0xffff0000u), __uint_as_float(w.y << 16), __uint_as_float(w.y & 0xffff0000u)}; } } }
            asm volatile("" ::: "memory");
#pragma unroll
            for (int m = 0; m < 4; ++m) { const int row = row0 + ai * HALF + m * 16; const size_t off = (size_t)row * 2048 + col0; float ss = 0.f;
#pragma unroll
                for (int bj = 0; bj < 2; ++bj)
#pragma unroll
                    for (int n = 0; n < 2; ++n) { const f32x4 xo = xi[m][bj][n] + gv[bj][n] * acc[ai][bj][m][n]; ss += (xo[0] * xo[0] + xo[1] * xo[1]) + (xo[2] * xo[2] + xo[3] * xo[3]);
                        u32x2 o; o.x = cvt_pk_bf16(xo[0], xo[1]); o.y = cvt_pk_bf16(xo[2], xo[3]); *(u32x2*)(xb + off + bj * HALF + n * 16) = o;
                        *(unsigned*)(x8 + off + bj * HALF + n * 16) = pk_fp8x4(xo[0] * F8_XS, xo[1] * F8_XS, xo[2] * F8_XS, xo[3] * F8_XS); }
                ss = xrow_sum(ss);
                if (fq == 0) rq[(size_t)(u.pn * 4 + wc) * NTOK_ + row] = ss; }
        }
    }
};
struct EpiQ {
    static constexpr bool PERM = true, AFTER_DRAIN = false;
    bf16_t* O; const float* rowsq; const float* bias; float ds;
    __device__ __forceinline__ void operator()(const f32x4 (&acc)[2][2][4][2], const Unit& u, int wr, int wc, int fr, int fq) const {
        { const int l_ = lane_id_v(); fr = l_ & 15; fq = l_ >> 4; }
        const int row0 = u.pm * BM + wr * 64 + fr, col0 = u.pn * BM + wc * 32 + 8 * fq;
        const float* bp = bias + (size_t)((u.pm * BM) >> 13) * 2048 + col0;
        f32x4 bv[2][2];
#pragma unroll
        for (int bj = 0; bj < 2; ++bj)
#pragma unroll
            for (int n = 0; n < 2; ++n) bv[bj][n] = *(const f32x4*)(bp + bj * HALF + 4 * n);
        float rstd[2][4];
#pragma unroll
        for (int ai = 0; ai < 2; ++ai)
#pragma unroll
            for (int m = 0; m < 4; ++m) { const int row = row0 + ai * HALF + m * 16; float sq = 0.f;
#pragma unroll
                for (int t = 0; t < 8; ++t) sq += rowsq[(size_t)(fq * 8 + t) * NTOK_ + row];
                rstd[ai][m] = rsqrtf(xrow_sum(sq) * (1.0f / 2048.0f) + 1e-6f) * ds; }
#pragma unroll
        for (int ai = 0; ai < 2; ++ai)
#pragma unroll
            for (int m = 0; m < 4; ++m) { const int row = row0 + ai * HALF + m * 16; bf16_t* rowp = O + (size_t)row * 2048 + col0;
#pragma unroll
                for (int bj = 0; bj < 2; ++bj) { const f32x4 v0 = acc[ai][bj][m][0] * rstd[ai][m] + bv[bj][0], v1 = acc[ai][bj][m][1] * rstd[ai][m] + bv[bj][1];
                    u32x4 w; w.x = cvt_pk_bf16(v0[0], v0[1]); w.y = cvt_pk_bf16(v0[2], v0[3]); w.z = cvt_pk_bf16(v1[0], v1[1]); w.w = cvt_pk_bf16(v1[2], v1[3]);
                    *(u32x4*)(rowp + bj * HALF) = w; } }
    }
};
struct BatchOrder {
    int nM, nU, G, c;
    __device__ __forceinline__ bool next(int i, Unit& u) const { const int L = i * G + c; if (L >= nU) return false; u.pb = L / nM; u.pm = L % nM; u.pn = 0; return true; }
    __device__ __forceinline__ void a_ready(const Unit&) const {}
    __device__ __forceinline__ void done(const Unit&) const {}
};
}

__device__ __forceinline__ unsigned f2bf_rne(float f) { unsigned u = __builtin_bit_cast(unsigned, f); return (u + 0x7fffu + ((u >> 16) & 1u)) >> 16; }
__device__ __forceinline__ unsigned pk2(float lo, float hi) { return f2bf_rne(lo) | (f2bf_rne(hi) << 16); }
__device__ __forceinline__ void p0_transpose_item(const float* W, int K, int N, bf16_t* WT, LAS float* scr, int item, int lane) {
    const int nblk = N / 32, kb = item / nblk, nb = item % nblk, k0 = 64 * kb, n0 = 32 * nb;
#pragma unroll 8
    for (int i = 0; i < 32; ++i) { const int kk = 2 * i + (lane >> 5); scr[kk * 33 + (lane & 31)] = W[(size_t)(k0 + kk) * N + n0 + (lane & 31)]; }
    LDS_WAIT(); asm volatile("" ::: "memory");
    const int c = lane & 7;
#pragma unroll
    for (int j = 0; j < 4; ++j) { const int n = (lane >> 3) + 8 * j; const LAS float* s = scr + (8 * c) * 33 + n;
        u32x4 o; o.x = pk2(s[0 * 33], s[1 * 33]); o.y = pk2(s[2 * 33], s[3 * 33]); o.z = pk2(s[4 * 33], s[5 * 33]); o.w = pk2(s[6 * 33], s[7 * 33]);
        *(u32x4*)(WT + (size_t)(n0 + n) * K + k0 + 8 * c) = o; }
    LDS_WAIT(); asm volatile("" ::: "memory");
}

__device__ __forceinline__ void p0_transpose_item_f8(const float* W, int K, int N, unsigned char* WT, LAS float* scr, int item, int lane, float sc) {
    const int nblk = N / 32, kb = item / nblk, nb = item % nblk, k0 = 64 * kb, n0 = 32 * nb;
#pragma unroll 8
    for (int i = 0; i < 32; ++i) { const int kk = 2 * i + (lane >> 5); scr[kk * 33 + (lane & 31)] = W[(size_t)(k0 + kk) * N + n0 + (lane & 31)] * sc; }
    LDS_WAIT(); asm volatile("" ::: "memory");
    const int c = lane & 7;
#pragma unroll
    for (int j = 0; j < 4; ++j) { const int n = (lane >> 3) + 8 * j; const LAS float* s = scr + (8 * c) * 33 + n;
        u32x2 o; o.x = pk_fp8x4(s[0 * 33], s[1 * 33], s[2 * 33], s[3 * 33]); o.y = pk_fp8x4(s[4 * 33], s[5 * 33], s[6 * 33], s[7 * 33]);
        *(u32x2*)(WT + (size_t)(n0 + n) * K + k0 + 8 * c) = o; }
    LDS_WAIT(); asm volatile("" ::: "memory");
}

__device__ __forceinline__ void s5_gen_group(const P& p, LAS unsigned char* lds, int g, int tid) {
    LAS f32x2* pw = (LAS f32x2*)lds;
    LAS f32x2* Cc = (LAS f32x2*)(lds + 17408);
    LAS f32x2* Bb = (LAS f32x2*)(lds + 17408 + 16384);
    LAS float* Kt = (LAS float*)(lds + 17408 + 32768);
    LAS float* dsk = (LAS float*)(lds + 17408 + 65536);
    __syncthreads();
    if (tid < 128) {
        const int d = tid >> 6, pp = tid & 63, dgp = (d * 64 + g) * 64 + pp;
        const float lr = fminf(p.lam_re[dgp], -1e-4f), li = p.lam_im[dgp], dt = __expf(p.log_dt[d * 64 + g]);
        const float lrdt = lr * dt, ang = li * dt;
#pragma unroll 1
        for (int e = 0; e <= 16; ++e) { const float mag = __expf((float)e * lrdt); float sn, cs; sincos_rad((float)e * ang, sn, cs); pw[e * 128 + tid] = (f32x2){mag * cs, mag * sn}; }
        const f32x2 a1 = pw[128 + tid]; const float abr = a1.x, abi = a1.y;
        const float den = lr * lr + li * li, nr = abr - 1.0f;
        const float cre = (nr * lr + abi * li) / den, cim = (abi * lr - nr * li) / den;
        ((f32x2*)(p.ws + WS_S5A))[dgp] = pw[16 * 128 + tid];
#pragma unroll 4
        for (int h = 0; h < 16; ++h) { const float br = p.b_re[dgp * 16 + h], bi = p.b_im[dgp * 16 + h]; Bb[(d * 64 + pp) * 16 + h] = (f32x2){cre * br - cim * bi, cre * bi + cim * br}; }
    }
    for (int i = tid; i < 2048; i += 512) { const int d = i >> 10, h = (i >> 6) & 15, pp = i & 63; const size_t src = ((size_t)(d * 64 + g) * 16 + h) * 64 + pp; Cc[i] = (f32x2){p.c_re[src], p.c_im[src]}; }
    if (tid < 16) dsk[tid] = p.s5_d[g * 16 + tid];
    __syncthreads();
    {
        const int d = tid >> 8, tau = (tid >> 4) & 15, h = tid & 15; float acc[16];
#pragma unroll
        for (int hp = 0; hp < 16; ++hp) acc[hp] = 0.f;
#pragma unroll 2
        for (int pp = 0; pp < 64; ++pp) { const f32x2 c = Cc[(d * 16 + h) * 64 + pp], w = pw[tau * 128 + d * 64 + pp]; const float tx = c.x * w.x - c.y * w.y, ty = c.x * w.y + c.y * w.x;
#pragma unroll
            for (int hp = 0; hp < 16; ++hp) { const f32x2 bb = Bb[(d * 64 + pp) * 16 + hp]; acc[hp] += tx * bb.x - ty * bb.y; } }
#pragma unroll
        for (int hp = 0; hp < 16; ++hp) Kt[(d * 16 + tau) * 256 + h * 16 + hp] = acc[hp];
    }
    __syncthreads();
    bf16_t* Wy = (bf16_t*)(p.ws + WS_WY) + (size_t)g * 256 * 512;
#pragma unroll 1
    for (int idx = tid; idx < 256 * 256; idx += 512) {
        const int np = idx >> 8, k0 = (idx & 255) * 2;
        const int bj = (np >> 7) & 1, wc = (np >> 5) & 3, n = (np >> 4) & 1, fq = (np >> 2) & 3, j = np & 3, i = wc * 4 + fq, h = 8 * bj + 4 * n + j;
        float v[2];
#pragma unroll
        for (int kk = 0; kk < 2; ++kk) { const int k = k0 + kk;
            if (k < 256) { const int s = k >> 4, hp = k & 15;
                if (s < i) v[kk] = Kt[(i - s) * 256 + h * 16 + hp]; else if (s > i) v[kk] = Kt[(16 + (s - i)) * 256 + h * 16 + hp];
                else v[kk] = Kt[h * 16 + hp] + Kt[16 * 256 + h * 16 + hp] + (h == hp ? dsk[h] : 0.f);
            } else { const int kc = k - 256, d = kc >> 7, pp = (kc >> 1) & 63, ri = kc & 1, e = d ? 16 - i : i + 1;
                const f32x2 c = Cc[(d * 16 + h) * 64 + pp], w = pw[e * 128 + d * 64 + pp]; v[kk] = ri ? -(c.x * w.y + c.y * w.x) : (c.x * w.x - c.y * w.y); } }
        *(unsigned*)(Wy + (size_t)np * 512 + k0) = cvtpk(v[0], v[1]);
    }
    bf16_t* Wsum = (bf16_t*)(p.ws + WS_WSUM) + (size_t)g * 256 * 256;
#pragma unroll 1
    for (int idx = tid; idx < 256 * 128; idx += 512) {
        const int r = idx >> 7, k0 = (idx & 127) * 2, d = r >> 7, pp = (r >> 1) & 63, ri = r & 1;
        float v[2];
#pragma unroll
        for (int kk = 0; kk < 2; ++kk) { const int k = k0 + kk, s = k >> 4, hp = k & 15, e = d ? s : 15 - s;
            const f32x2 w = pw[e * 128 + d * 64 + pp], bb = Bb[(d * 64 + pp) * 16 + hp]; v[kk] = ri ? (w.x * bb.y + w.y * bb.x) : (w.x * bb.x - w.y * bb.y); }
        *(unsigned*)(Wsum + (size_t)r * 256 + k0) = cvtpk(v[0], v[1]);
    }
}

#ifndef PRO_DBL
#define PRO_DBL 0
#endif
#define PRO_REP(b) for (int _pr = 0; _pr < 1 + ((PRO_DBL >> (b)) & 1); ++_pr)
__device__ __forceinline__ void phase_prologue(const P& p, LAS unsigned char* lds, int tid, int lane, int wid) {
    unsigned char* ws = p.ws;
    LAS float* cact = (LAS float*)lds;
    LAS float* red = (LAS float*)(lds + 16384);
    for (int i = tid; i < 4096; i += 512) { const float cv = p.c[i]; cact[i] = cv * sigmoid_f(cv); }
    __syncthreads();
    float* mod = (float*)(ws + WS_MOD);
    PRO_REP(0) for (int item = blockIdx.x; item < 192; item += gridDim.x) {
        const int l = item / 96, cb = item % 96, cg4 = tid & 31, rl = tid >> 5;
        const float* W = p.ada_w + (size_t)l * 2048 * 12288 + cb * 128 + cg4 * 4;
        f32x4 a0 = {0.f, 0.f, 0.f, 0.f}, a1 = {0.f, 0.f, 0.f, 0.f};
#pragma unroll 8
        for (int r = rl; r < 2048; r += 16) { const f32x4 w = *(const f32x4*)(W + (size_t)r * 12288); const float c0 = cact[r], c1 = cact[2048 + r]; a0 += w * c0; a1 += w * c1; }
        *(LAS f32x4*)(red + (rl * 32 + cg4) * 8) = a0; *(LAS f32x4*)(red + (rl * 32 + cg4) * 8 + 4) = a1;
        __syncthreads();
        if (tid < 256) { const int col = tid & 127, b = tid >> 7; float s = 0.f;
#pragma unroll
            for (int r2 = 0; r2 < 16; ++r2) s += red[(r2 * 32 + (col >> 2)) * 8 + b * 4 + (col & 3)];
            s += p.ada_b[l * 12288 + cb * 128 + col]; mod[(l * 2 + b) * 12288 + cb * 128 + col] = s; }
        __syncthreads();
    }
    PRO_REP(1) {
        LAS float* scr = (LAS float*)(lds + 32768 + wid * 8448);
        const int gw = blockIdx.x * 8 + wid, ngw = gridDim.x * 8;
        constexpr int I0 = 32 * 80, I1 = 32 * 64, I2 = 32 * 256, I3 = 64 * 64, NIT = I0 + I1 + I2 + I3;
        for (int it = gw; it < NIT; it += ngw) {
            int r = it;
            if (r < I0) { p0_transpose_item_f8(p.even_w_in, 2048, 2560, ws + WS_WINE, scr, r, lane, F8_WS); continue; } r -= I0;
            if (r < I1) { p0_transpose_item_f8(p.even_w_out, 2048, 2048, ws + WS_WOUTE, scr, r, lane, F8_WS); continue; } r -= I1;
            if (r < I2) { p0_transpose_item_f8(p.odd_w_in, 2048, 8192, ws + WS_WINO, scr, r, lane, F8_WS); continue; } r -= I2;
            p0_transpose_item_f8(p.odd_w_out, 4096, 2048, ws + WS_WOUTO, scr, r, lane, F8_WS);
        }
    }
    const long gtid = (long)blockIdx.x * 512 + tid, ngt = (long)gridDim.x * 512;
    PRO_REP(2) {
        const int gw = blockIdx.x * 8 + wid, ngw = gridDim.x * 8;
        float* psc = (float*)(ws + WS_PSC);
        for (int row0 = 4 * gw; row0 < 4 * 16384; row0 += 4 * ngw) {
            f32x4 v[4][8]; float am[4]; const float* src[4]; unsigned char* dst[4];
#pragma unroll
            for (int rr = 0; rr < 4; ++rr) { const int row = row0 + rr; const bool tv = row >= 2 * 16384; const int r = tv ? row - 2 * 16384 : row;
                const bool sl = tv ? PEER_SLICE_V : PEER_SLICE_U;
                src[rr] = (tv ? p.peer_v : p.peer_u) + (size_t)r * 2048; dst[rr] = ws + (tv ? WS_PV : WS_PU) + (size_t)r * PEER_ROWB;
#pragma unroll
                for (int j = 0; j < 8; ++j) v[rr][j] = *(const f32x4*)(src[rr] + (sl ? 4 * (lane + 64 * j) : 16 * lane + 1024 * (j >> 2) + 4 * (j & 3))); }
#pragma unroll
            for (int rr = 0; rr < 4; ++rr) { am[rr] = 0.f;
#pragma unroll
                for (int j = 0; j < 8; ++j) am[rr] = fmaxf(am[rr], fmaxf(fmaxf(fabsf(v[rr][j].x), fabsf(v[rr][j].y)), fmaxf(fabsf(v[rr][j].z), fabsf(v[rr][j].w))));
#pragma unroll
                for (int o = 32; o > 0; o >>= 1) am[rr] = fmaxf(am[rr], __shfl_xor(am[rr], o)); }
#pragma unroll
            for (int rr = 0; rr < 4; ++rr) { const int row = row0 + rr;
                const float sc = am[rr] > 0.f ? 7.5f / am[rr] : 1.0f;
                if (lane == 0) psc[row] = am[rr] > 0.f ? am[rr] * (1.0f / 7.5f) : 1.0f;
                f32x16 ev, od;
#pragma unroll
                for (int j = 0; j < 8; ++j) { const f32x4 t = v[rr][j] * sc; ev[2 * j] = t.x; od[2 * j] = t.y; ev[2 * j + 1] = t.z; od[2 * j + 1] = t.w; }
                const u32x6 q = __builtin_amdgcn_cvt_scalef32_2xpk16_fp6_f32(ev, od, 1.0f);
                const bool tv = row >= 2 * 16384; const int r = tv ? row - 2 * 16384 : row;
                if (!(tv ? PEER_SLICE_V : PEER_SLICE_U)) {
                    *(u32x4*)(dst[rr] + 16 * lane) = (u32x4){q[0], q[1], q[2], q[3]};
                    *(u32x2*)(dst[rr] + 1024 + 8 * lane) = (u32x2){q[4], q[5]};
                } else {
                    unsigned char* sb = ws + (tv ? WS_PV : WS_PU) + (size_t)(r >> 14) * 16384 * PEER_ROWB + (size_t)(r & 16383) * 192 + 12 * (lane >> 2) + 4 * (lane & 3);
                    const unsigned pc[8] = {q[0] & 0xFFFFFFu, (q[0] >> 24) | ((q[1] & 0xFFFFu) << 8), (q[1] >> 16) | ((q[2] & 0xFFu) << 16), q[2] >> 8,
                                            q[3] & 0xFFFFFFu, (q[3] >> 24) | ((q[4] & 0xFFFFu) << 8), (q[4] >> 16) | ((q[5] & 0xFFu) << 16), q[5] >> 8};
                    const int i8 = 8 * (lane & 3);
#pragma unroll
                    for (int j = 0; j < 8; ++j) { const unsigned nx = __builtin_amdgcn_update_dpp(0u, pc[j], 0xF9, 0xF, 0xF, true);
                        const unsigned d = (pc[j] >> i8) | (nx << (24 - i8));
                        if ((lane & 3) < 3) *(unsigned*)(sb + (size_t)j * 16384 * 192) = d; }
                } }
        }
    }
    PRO_REP(3) for (int g = (int)gridDim.x - 1 - (int)blockIdx.x; g < 64; g += gridDim.x) s5_gen_group(p, lds, g, tid);
    for (long i = gtid; i < 65536; i += ngt) { const int layer = (int)(i >> 15), half = (int)(i >> 14) & 1, r = (int)(i & 16383);
        ((bf16_t*)(ws + WS_KEYS))[i] = (bf16_t)f2bf_rne((half ? p.peer_k2 : p.peer_k1)[layer * 16384 + r]); }
    for (long i = gtid; i < 131072; i += ngt) ((bf16_t*)(ws + WS_WSB))[i] = (bf16_t)f2bf_rne(p.sgu_w[i]);
}

template <bool OUT8>
__device__ __forceinline__ void phase_adaln(const float* xin, void* hout_, const float* g, const float* shift, const float* scale, int gw, int ngw, int lane) {
    for (int b = 0; b < 2; ++b) {
        f32x4 A[8], Bc[8];
#pragma unroll
        for (int j = 0; j < 8; ++j) { const int c = 8 * lane + 512 * (j >> 1) + 4 * (j & 1);
            const f32x4 gv = *(const f32x4*)(g + c), sc = *(const f32x4*)(scale + b * 12288 + c); A[j] = gv * (sc + 1.0f); Bc[j] = *(const f32x4*)(shift + b * 12288 + c); }
#pragma unroll 1
        for (int row0 = b * 8192 + gw; row0 < (b + 1) * 8192; row0 += 4 * ngw) {
            f32x4 v[4][8];
#pragma unroll
            for (int k = 0; k < 4; ++k) { const int row = row0 + k * ngw < (b + 1) * 8192 ? row0 + k * ngw : row0; const float* xr = xin + (size_t)row * 2048 + 8 * lane;
#pragma unroll
                for (int j = 0; j < 8; ++j) v[k][j] = *(const f32x4*)(xr + 512 * (j >> 1) + 4 * (j & 1)); }
#pragma unroll
            for (int k = 0; k < 4; ++k) { const int row = row0 + k * ngw < (b + 1) * 8192 ? row0 + k * ngw : row0; float ss = 0.f;
#pragma unroll
                for (int j = 0; j < 8; ++j) ss += dot4(v[k][j], v[k][j]);
                ss = wave_sum(ss); const float rstd = rsqrtf(ss * (1.0f / 2048.0f) + 1e-6f);
                bf16_t* hr = (bf16_t*)hout_ + (size_t)row * 2048 + 8 * lane; unsigned char* hr8 = (unsigned char*)hout_ + (size_t)row * 2048 + 8 * lane;
#pragma unroll
                for (int j = 0; j < 4; ++j) { const f32x4 y0 = v[k][2 * j] * rstd * A[2 * j] + Bc[2 * j], y1 = v[k][2 * j + 1] * rstd * A[2 * j + 1] + Bc[2 * j + 1];
                    if (OUT8) { u32x2 o; o.x = pk_fp8x4(y0.x * F8_HS, y0.y * F8_HS, y0.z * F8_HS, y0.w * F8_HS); o.y = pk_fp8x4(y1.x * F8_HS, y1.y * F8_HS, y1.z * F8_HS, y1.w * F8_HS); *(u32x2*)(hr8 + 512 * j) = o; }
                    else { u32x4 o; o.x = cvtpk(y0.x, y0.y); o.y = cvtpk(y0.z, y0.w); o.z = cvtpk(y1.x, y1.y); o.w = cvtpk(y1.z, y1.w);
                    *(u32x4*)(hr + 512 * j) = o; } } }
        }
    }
}

__device__ __forceinline__ void phase_fold_wq(const P& p, LAS unsigned char* lds, int tid, int lane, int wid) {
    unsigned char* ws = p.ws; const float* mod = (const float*)(ws + WS_MOD);
    for (long i = (long)blockIdx.x * 512 + tid; i < 2 * 2 * 2048; i += (long)gridDim.x * 512) { const int l = (int)(i >> 12), b = (int)(i >> 11) & 1, c = (int)(i & 2047);
        float* ab = (float*)(ws + WS_ABT) + (size_t)(l * 2 + b) * 4096;
        ab[c] = p.norm_g[(l * 2 + 1) * 2048 + c] * (1.0f + mod[(size_t)(l * 2 + b) * 12288 + 4 * 2048 + c]); ab[2048 + c] = mod[(size_t)(l * 2 + b) * 12288 + 3 * 2048 + c]; }
    LAS float* scr = (LAS float*)(lds + wid * 8448);
    const int gw = blockIdx.x * 8 + wid, ngw = gridDim.x * 8;
    for (int it = gw; it < 2 * 2048; it += ngw) {
        const int l = it >> 11, item = it & 2047, kb = item >> 6, nb = item & 63, k0 = 64 * kb, n0 = 32 * nb;
        const float* W = p.peer_wq + (size_t)l * 2048 * 2048;
#pragma unroll 8
        for (int i = 0; i < 32; ++i) { const int kk = 2 * i + (lane >> 5); scr[kk * 33 + (lane & 31)] = W[(size_t)(k0 + kk) * 2048 + n0 + (lane & 31)]; }
        LDS_WAIT(); asm volatile("" ::: "memory");
        const int c = lane & 7;
#pragma unroll
        for (int b = 0; b < 2; ++b) {
            const float* mb = mod + (size_t)(l * 2 + b) * 12288; const float* ng = p.norm_g + (l * 2 + 1) * 2048;
            float A[8];
#pragma unroll
            for (int t = 0; t < 8; ++t) A[t] = ng[k0 + 8 * c + t] * (1.0f + mb[4 * 2048 + k0 + 8 * c + t]);
            unsigned char* WT = ws + WS_WQF + (size_t)(l * 2 + b) * 2048 * 2048;
#pragma unroll
            for (int t = 0; t < 8; ++t) A[t] *= F8_WS;
#pragma unroll
            for (int j = 0; j < 4; ++j) { const int n = (lane >> 3) + 8 * j; const LAS float* s = scr + (8 * c) * 33 + n;
                u32x2 o; o.x = pk_fp8x4(s[0 * 33] * A[0], s[1 * 33] * A[1], s[2 * 33] * A[2], s[3 * 33] * A[3]); o.y = pk_fp8x4(s[4 * 33] * A[4], s[5 * 33] * A[5], s[6 * 33] * A[6], s[7 * 33] * A[7]);
                *(u32x2*)(WT + (size_t)(n0 + n) * 2048 + k0 + 8 * c) = o; }
            { const int n = lane & 31, kh = lane >> 5; float acc = 0.f;
#pragma unroll 8
              for (int t = 0; t < 32; ++t) acc += scr[(32 * kh + t) * 33 + n] * mb[3 * 2048 + k0 + 32 * kh + t];
              acc += __shfl_xor(acc, 32);
              if (lane < 32) ((float*)(ws + WS_BIASP))[((size_t)(l * 2 + b) * 32 + kb) * 2048 + n0 + n] = acc; }
        }
        LDS_WAIT(); asm volatile("" ::: "memory");
    }
}

__device__ __forceinline__ void phase_bias_reduce(const P& p, int tid) {
    for (long i = (long)blockIdx.x * 512 + tid; i < 2 * 2 * 2048; i += (long)gridDim.x * 512) { const int lb = (int)(i >> 11), n = (int)(i & 2047); float acc = 0.f;
#pragma unroll 8
        for (int kb = 0; kb < 32; ++kb) acc += ((const float*)(p.ws + WS_BIASP))[((size_t)lb * 32 + kb) * 2048 + n];
        ((float*)(p.ws + WS_BIASQ))[i] = acc; }
}
__device__ __forceinline__ void phase_qkprep(const P& p, int gw, int ngw, int lane) {
    bf16_t* Q = (bf16_t*)(p.ws + WS_Q); bf16_t* K = (bf16_t*)(p.ws + WS_K);
    const int sub = lane >> 4, ll = lane & 15;
    float inv[4], gq[8], gk[8];
#pragma unroll
    for (int e = 0; e < 4; ++e) inv[e] = __builtin_amdgcn_exp2f(-(float)((4 * ll + e) & 31) * 0.41524101186092029f);
#pragma unroll
    for (int e = 0; e < 8; ++e) { gq[e] = p.q_g[8 * ll + e]; gk[e] = p.k_g[8 * ll + e]; }
#pragma unroll 2
    for (int it = gw; it < NTOK * 10 / 4; it += ngw) {
        const int hr = 4 * it + sub, token = hr / 10, hh = hr - token * 10;
        u32x4* ptr = hh < 8 ? (u32x4*)(Q + (size_t)token * 1024 + hh * 128 + 8 * ll) : (u32x4*)(K + (size_t)token * 256 + (hh - 8) * 128 + 8 * ll);
        const u32x4 w = *ptr;
        float x[8] = {bflo(w.x), bfhi(w.x), bflo(w.y), bfhi(w.y), bflo(w.z), bfhi(w.z), bflo(w.w), bfhi(w.w)};
        float ss = 0.f;
#pragma unroll
        for (int e = 0; e < 8; ++e) ss += x[e] * x[e];
        ss = row16_sum(ss);
        const float r = rsqrtf(ss * (1.0f / 128.0f) + 1e-6f);
        const int s = token & 8191; const float pos = (float)(ll < 8 ? (s >> 6) : (s & 63));
        unsigned o[4];
#pragma unroll
        for (int e = 0; e < 4; ++e) { const float x1 = x[2 * e] * r * (hh < 8 ? gq[2 * e] : gk[2 * e]), x2 = x[2 * e + 1] * r * (hh < 8 ? gq[2 * e + 1] : gk[2 * e + 1]);
            float sn, cs; sincos_rad(pos * inv[e], sn, cs); o[e] = cvtpk(x1 * cs - x2 * sn, x1 * sn + x2 * cs); }
        *ptr = (u32x4){o[0], o[1], o[2], o[3]};
    }
}

__device__ __forceinline__ void phase_s5scan(const P& p, LAS unsigned char* lds, int lane, int wid) {
    const f32x2* A16 = (const f32x2*)(p.ws + WS_S5A);
    LAS f32x2* agg = (LAS f32x2*)lds;
    for (int item = blockIdx.x; item < 256; item += gridDim.x) {
        const int b = item >> 7, g = (item >> 1) & 63, d = item & 1;
        const f32x2 a = A16[(d * 64 + g) * 64 + lane];
        const float* S = (const float*)(p.ws + WS_SS) + ((size_t)g * 1024 + b * 512) * 256 + d * 128 + 2 * lane;
        bf16_t* HIN = (bf16_t*)(p.ws + WS_AB) + ((size_t)g * 1024 + b * 512) * 512 + 256 + d * 128 + 2 * lane;
        const int sA = 2 * wid + (d ? 1 : 0), sB = 2 * wid + (d ? 0 : 1), ordA = d ? 15 - sA : sA;
        float ar = 0.f, ai = 0.f, br = 0.f, bi = 0.f;
#pragma unroll 16
        for (int k = 0; k < 32; ++k) { const int o = d ? 31 - k : k; const f32x2 va = *(const f32x2*)(S + (size_t)(32 * sA + o) * 256), vb = *(const f32x2*)(S + (size_t)(32 * sB + o) * 256);
            const float nar = a.x * ar - a.y * ai + va.x, nai = a.x * ai + a.y * ar + va.y, nbr = a.x * br - a.y * bi + vb.x, nbi = a.x * bi + a.y * br + vb.y; ar = nar; ai = nai; br = nbr; bi = nbi; }
        __syncthreads();
        agg[ordA * 64 + lane] = (f32x2){ar, ai}; agg[(ordA + 1) * 64 + lane] = (f32x2){br, bi};
        __syncthreads();
        float pr = a.x, pi = a.y;
#pragma unroll
        for (int q = 0; q < 5; ++q) { const float nr = pr * pr - pi * pi, ni = 2.f * pr * pi; pr = nr; pi = ni; }
        float cr = 0.f, ci = 0.f;
        for (int s2 = 0; s2 < ordA; ++s2) { const f32x2 v = agg[s2 * 64 + lane]; const float nr = pr * cr - pi * ci + v.x, ni = pr * ci + pi * cr + v.y; cr = nr; ci = ni; }
        const float dr = pr * cr - pi * ci + ar, di = pr * ci + pi * cr + ai;
        ar = cr; ai = ci; br = dr; bi = di;
#pragma unroll 16
        for (int k = 0; k < 32; ++k) { const int o = d ? 31 - k : k; const size_t ca = (size_t)(32 * sA + o), cb = (size_t)(32 * sB + o);
            *(unsigned*)(HIN + ca * 512) = cvtpk(ar, ai); *(unsigned*)(HIN + cb * 512) = cvtpk(br, bi);
            const f32x2 va = *(const f32x2*)(S + ca * 256), vb = *(const f32x2*)(S + cb * 256);
            const float nar = a.x * ar - a.y * ai + va.x, nai = a.x * ai + a.y * ar + va.y, nbr = a.x * br - a.y * bi + vb.x, nbi = a.x * bi + a.y * br + vb.y; ar = nar; ai = nai; br = nbr; bi = nbi; }
    }
}

__device__ __forceinline__ void phase_attn(const P& p, char* lds) {
    const bf16_t* Q = (const bf16_t*)(p.ws + WS_Q); const bf16_t* K = (const bf16_t*)(p.ws + WS_K); const bf16_t* V = (const bf16_t*)(p.ws + WS_V);
    unsigned char* CAT = p.ws + WS_CAT;
    const int G = gridDim.x, bx = blockIdx.x, vcu = (G % 8 == 0) ? (bx % 8) * (G / 8) + bx / 8 : bx;
    for (int unit = vcu; unit < 512; unit += G) {
        const int bk = unit >> 7, rem = unit & 127, b = bk >> 1, kvh = bk & 1, h = kvh * 4 + (rem >> 5), qb = rem & 31;
        attn::attn_dense_body<attn::bf16>((const attn::bf16*)(Q + (size_t)(b * 8192 + qb * 256) * 1024 + h * 128),
                                          (const attn::bf16*)(K + (size_t)(b * 8192) * 256 + kvh * 128), (const attn::bf16*)(V + (size_t)(b * 8192) * 256 + kvh * 128),
                                          CAT + (size_t)(b * 8192 + qb * 256) * 2048 + 1024 + h * 128, 8192, lds);
        __syncthreads();
    }
}

constexpr int SGU_VS = 136;
constexpr int SGU_HB = 71680;
constexpr int SGU_VNT = 0, SGU_STG = 128 * SGU_VS * 2, SGU_STAT = 2 * 128 * SGU_VS * 2, SGU_BS = SGU_STAT + 1024;
static_assert(SGU_BS + 512 <= SGU_HB && 2 * SGU_HB <= LDS_BYTES - 64 && SGU_HB % 16 == 0, "SGU LDS map");
__device__ __forceinline__ void phase_sgu(const P& p, LAS unsigned char* lds, int tid, int lane, int wid) {
    const int hb = wid >> 2, w4 = wid & 3, t256 = tid & 255;
    LAS unsigned char* base = lds + hb * SGU_HB;
    LAS bf16_t* vnT = (LAS bf16_t*)(base + SGU_VNT);
    LAS bf16_t* stg = (LAS bf16_t*)(base + SGU_STG);
    LAS f32x2* stats = (LAS f32x2*)(base + SGU_STAT);
    LAS float* bs = (LAS float*)(base + SGU_BS);
    const bf16_t* Z = (const bf16_t*)(p.ws + WS_Z); unsigned char* SG = p.ws + WS_SG;
    const bf16_t* Wsb = (const bf16_t*)(p.ws + WS_WSB);
    const int fr = lane & 15, fq = lane >> 4, wi = w4 & 1, wc = w4 >> 1, i0 = 64 * wi, c0 = 64 * wc;
    for (int up = blockIdx.x; up < 512; up += gridDim.x) {
        const int unit = 2 * up + hb, n = unit >> 3, g = unit & 7;
        __syncthreads();
        if (t256 < 128) { const f32x2* part = (const f32x2*)(p.ws + WS_LNST) + (size_t)(2 * g * 4) * NTOK + (n * 128 + t256); float s1 = 0.f, s2 = 0.f;
#pragma unroll
            for (int q = 0; q < 8; ++q) { const f32x2 a2 = part[(size_t)q * NTOK]; s1 += a2.x; s2 += a2.y; }
            const float mean = s1 * (1.0f / 512.0f), var = fmaxf(s2 * (1.0f / 512.0f) - mean * mean, 0.f); stats[t256] = (f32x2){mean, rsqrtf(var + 1e-6f)};
            bs[t256] = p.sgu_b[g * 128 + t256]; }
        bf16x8 Af[4][4];
#pragma unroll
        for (int m = 0; m < 4; ++m)
#pragma unroll
            for (int ks = 0; ks < 4; ++ks) Af[m][ks] = *(const bf16x8*)(Wsb + (size_t)(g * 128 + i0 + 16 * m + fr) * 128 + 32 * ks + 8 * fq);
#pragma unroll 1
        for (int qt = 0; qt < 4; ++qt) {
            const int chb = g * 512 + qt * 128;
            __syncthreads();
            { u32x4 T[8];
#pragma unroll
              for (int q = 0; q < 8; ++q) { const int pc = t256 + 256 * q, j = pc >> 4, ch = (pc & 15) * 8; T[q] = *(const u32x4*)(Z + ((size_t)(n * 16 + 8 + g) * 128 + j) * 512 + qt * 128 + ch); }
#pragma unroll
              for (int q = 0; q < 8; ++q) { const int pc = t256 + 256 * q, j = pc >> 4, ch = (pc & 15) * 8; *(LAS u32x4*)(stg + j * SGU_VS + ch) = T[q]; } }
            __syncthreads();
#pragma unroll 1
            for (int slab = 0; slab < 2; ++slab) {
                const int cc = slab * 64 + lane; const float lng = p.sgu_ln_g[chb + cc];
                const int cl = cc & 63, rp = (cc & ~63) + ((cl >> 2) & 3) * 16 + (cl >> 4) * 4 + (cl & 3);
#pragma unroll
                for (int jg = 0; jg < 4; ++jg) {
                    const int j0 = 32 * w4 + 8 * jg; float y[8];
#pragma unroll
                    for (int k = 0; k < 8; ++k) { const float xv = bflo((unsigned)stg[(j0 + k) * SGU_VS + cc]); const f32x2 st = stats[j0 + k]; y[k] = (xv - st.x) * st.y * lng; }
                    u32x4 o; o.x = cvtpk(y[0], y[1]); o.y = cvtpk(y[2], y[3]); o.z = cvtpk(y[4], y[5]); o.w = cvtpk(y[6], y[7]);
                    *(LAS u32x4*)(vnT + rp * SGU_VS + j0) = o;
                }
            }
            __syncthreads();
#pragma unroll 1
            for (int np = 0; np < 2; ++np) {
                u32x4 U[4];
#pragma unroll
                for (int m = 0; m < 4; ++m) U[m] = *(const u32x4*)(Z + ((size_t)(n * 16 + g) * 128 + i0 + 16 * m + fr) * 512 + qt * 128 + c0 + 16 * fq + 8 * np);
                f32x4 acc[4][2];
#pragma unroll
                for (int m = 0; m < 4; ++m)
#pragma unroll
                    for (int nn = 0; nn < 2; ++nn) acc[m][nn] = (f32x4){0.f, 0.f, 0.f, 0.f};
#pragma unroll
                for (int ks = 0; ks < 4; ++ks) {
                    bf16x8 Bf[2];
#pragma unroll
                    for (int nn = 0; nn < 2; ++nn) Bf[nn] = *(const LAS bf16x8*)(vnT + (c0 + 16 * (2 * np + nn) + fr) * SGU_VS + 32 * ks + 8 * fq);
#pragma unroll
                    for (int m = 0; m < 4; ++m)
#pragma unroll
                        for (int nn = 0; nn < 2; ++nn) acc[m][nn] = __builtin_amdgcn_mfma_f32_16x16x32_bf16(Bf[nn], Af[m][ks], acc[m][nn], 0, 0, 0);
                }
#pragma unroll
                for (int m = 0; m < 4; ++m) { const int i = i0 + 16 * m + fr; const float bi = bs[i]; const size_t tok = (size_t)(n * 128 + i);
                    const int cch = chb + c0 + 16 * fq + 8 * np;
                    const u32x4 u0 = U[m];
                    const f32x4 s0 = acc[m][0] + bi, s1 = acc[m][1] + bi;
                    u32x2 o;
                    o.x = pk_fp8x4(bflo(u0.x) * s0.x * F8_SGS, bfhi(u0.x) * s0.y * F8_SGS, bflo(u0.y) * s0.z * F8_SGS, bfhi(u0.y) * s0.w * F8_SGS);
                    o.y = pk_fp8x4(bflo(u0.z) * s1.x * F8_SGS, bfhi(u0.z) * s1.y * F8_SGS, bflo(u0.w) * s1.z * F8_SGS, bfhi(u0.w) * s1.w * F8_SGS);
                    *(u32x2*)(SG + tok * 4096 + cch) = o; }
            }
        }
    }
}
#define XB_TMO      128
#define XB_XCNT(j)  (256  + 64 * (j))
#define XB_XSUB(j)  (1280 + 64 * (j))
#define XB_XGEN(j)  (2304 + 64 * (j))
#define XB_TOP      3328
#define XB_TOPGEN   3392
#define XCD_BAR_WORDS 3456
#define XB_SPIN_CAP (1u << 22)

__device__ __forceinline__ unsigned xb_ld(unsigned* p)              { return __hip_atomic_load(p, __ATOMIC_RELAXED, __HIP_MEMORY_SCOPE_AGENT); }
__device__ __forceinline__ unsigned xb_add(unsigned* p, unsigned v) { return __hip_atomic_fetch_add(p, v, __ATOMIC_RELAXED, __HIP_MEMORY_SCOPE_AGENT); }
__device__ __forceinline__ unsigned xb_xcc_id() { return (unsigned)__builtin_amdgcn_s_getreg((3 << 11) | 20) & 0xFu; }
#define XB_SPIN(cond, bar) do { unsigned _sp = 0; while (cond) { __builtin_amdgcn_s_sleep(1); \
    if ((++_sp & 255u) == 0u) { if (xb_ld(&(bar)[XB_TMO])) break; if (_sp > XB_SPIN_CAP) { atomicAdd(&(bar)[XB_TMO], 1u); break; } } } } while (0)

struct XcdBarrier {
    unsigned* bar; unsigned x;
    volatile LAS unsigned* st;
};

__device__ __forceinline__ XcdBarrier xcd_barrier_post(unsigned* bar, volatile LAS unsigned* st) {
    XcdBarrier b; b.bar = bar; b.x = xb_xcc_id(); b.st = st;
    if (threadIdx.x == 0) st[2] = xb_add(&bar[XB_XCNT(b.x)], 1u);
    return b;
}
__device__ __forceinline__ void xcd_barrier_complete(unsigned* bar, unsigned x, unsigned& nloc, unsigned& nx) {
    const unsigned G = gridDim.x * gridDim.y * gridDim.z;
    unsigned sum, cnt, mine, sp = 0u;
    for (;;) {
        sum = 0u; cnt = 0u; mine = 0u;
#pragma unroll
        for (unsigned j = 0; j < 16; ++j) { const unsigned c = xb_ld(&bar[XB_XCNT(j)]); sum += c; cnt += (c > 0u) ? 1u : 0u; mine = (j == x) ? c : mine; }
        if (sum == G) break;
        __builtin_amdgcn_s_sleep(1);
        if ((++sp & 255u) == 0u) { if (xb_ld(&bar[XB_TMO])) break; if (sp > XB_SPIN_CAP) { atomicAdd(&bar[XB_TMO], 1u); break; } }
    }
    nloc = mine > 0u ? mine : 1u; nx = cnt > 0u ? cnt : 1u;
}

__device__ __forceinline__ void xcd_barrier(const XcdBarrier& b) {
    asm volatile("s_waitcnt vmcnt(0)" ::: "memory");
    __syncthreads();
    if (threadIdx.x == 0) {
        unsigned* bar = b.bar;
        __builtin_amdgcn_s_waitcnt(0);
        unsigned nloc = b.st[0], nx = b.st[1];
        if (nloc == 0u) { xcd_barrier_complete(bar, b.x, nloc, nx); b.st[0] = nloc; b.st[1] = nx; }
        const unsigned old = xb_add(&bar[XB_XSUB(b.x)], 1u);
        const unsigned gen = old / nloc;
        if (old + 1u == (gen + 1u) * nloc) {
            __builtin_amdgcn_fence(__ATOMIC_RELEASE, "agent");
            asm volatile("s_waitcnt vmcnt(0)" ::: "memory");
            const unsigned og = xb_add(&bar[XB_TOP], 1u);
            const unsigned tg = og / nx;
            if (og + 1u == (tg + 1u) * nx) xb_add(&bar[XB_TOPGEN], 1u);
            else XB_SPIN(xb_ld(&bar[XB_TOPGEN]) == tg, bar);
            __builtin_amdgcn_fence(__ATOMIC_ACQUIRE, "agent");
            xb_add(&bar[XB_XGEN(b.x)], 1u);
            asm volatile("s_waitcnt vmcnt(0)" ::: "memory");
        } else {
            XB_SPIN(xb_ld(&bar[XB_XGEN(b.x)]) == gen, bar);
            __builtin_amdgcn_fence(__ATOMIC_ACQUIRE, "agent");
            asm volatile("s_waitcnt vmcnt(0)" ::: "memory");
        }
    }
    __syncthreads();
}

__device__ __forceinline__ void ce_desc(float& a, float& b) { const float mx = fmaxf(a, b), mn = fminf(a, b); a = mx; b = mn; }
__device__ __forceinline__ void bitonic_sort16_desc(float (&a)[16]) {
#pragma unroll
    for (int k = 2; k <= 16; k <<= 1)
#pragma unroll
        for (int j = k >> 1; j > 0; j >>= 1)
#pragma unroll
            for (int i = 0; i < 16; ++i) { const int l = i ^ j; if (l > i) { if ((i & k) == 0) ce_desc(a[i], a[l]); else ce_desc(a[l], a[i]); } }
}
__device__ __forceinline__ void merge_top16(float (&V)[16], const float (&S)[16]) {
#pragma unroll
    for (int i = 0; i < 16; ++i) V[i] = fmaxf(V[i], S[15 - i]);
#pragma unroll
    for (int j = 8; j > 0; j >>= 1)
#pragma unroll
        for (int i = 0; i < 16; ++i) { const int l = i ^ j; if (l > i) ce_desc(V[i], V[l]); }
}
__device__ __forceinline__ float with_payload(float v, unsigned mask, unsigned pay) { return __uint_as_float((__float_as_uint(v) & ~mask) | pay); }

__device__ __forceinline__ void peer_topk_half(const bf16_t* qrow, const bf16_t* keys, int r32, int hi, float (&V)[16]) {
    bf16x8 qf[8];
#pragma unroll
    for (int ks = 0; ks < 8; ++ks) qf[ks] = *(const bf16x8*)(qrow + 16 * ks + 8 * hi);
#pragma unroll
    for (int k = 0; k < 16; ++k) V[k] = -INFINITY;
#pragma unroll 1
    for (int t = 0; t < 4; ++t) {
        f32x16 s = (f32x16){0.f, 0.f, 0.f, 0.f, 0.f, 0.f, 0.f, 0.f, 0.f, 0.f, 0.f, 0.f, 0.f, 0.f, 0.f, 0.f};
#pragma unroll
        for (int ks = 0; ks < 8; ++ks) { const bf16x8 kf = *(const bf16x8*)(keys + (size_t)(t * 32 + r32) * 128 + 16 * ks + 8 * hi);
            s = __builtin_amdgcn_mfma_f32_32x32x16_bf16(kf, qf[ks], s, 0, 0, 0); }
        float S[16];
#pragma unroll
        for (int r = 0; r < 16; ++r) S[r] = with_payload(s[r], 0x7Fu, (unsigned)(t * 32 + (r & 3) + 8 * (r >> 2) + 4 * hi));
        bitonic_sort16_desc(S); merge_top16(V, S);
    }
    float PVv[16];
#pragma unroll
    for (int k = 0; k < 16; ++k) { const auto r = __builtin_amdgcn_permlane32_swap(__float_as_uint(V[k]), __float_as_uint(V[k]), false, false); PVv[k] = (hi ? __uint_as_float(r[0]) : __uint_as_float(r[1])); }
    merge_top16(V, PVv);
}

__device__ __forceinline__ void phase_peer_s1(const P& p, int layer, LAS unsigned char* lds, int lane, int wid) {
    LAS int* idxL = (LAS int*)(lds + 65536 + wid * 8192);
    const bf16_t* QP = (const bf16_t*)(p.ws + WS_QP);
    const bf16_t* keys = (const bf16_t*)(p.ws + WS_KEYS) + (size_t)layer * 2 * 16384;
    const float* rowsq = (const float*)(p.ws + WS_ROWSQ) + (size_t)layer * 32 * NTOK; float* RSTD = (float*)(p.ws + WS_RSTD);
    int* EID = (int*)(p.ws + WS_EID); float* GATE = (float*)(p.ws + WS_GATE);
    const int r32 = lane & 31, hi = lane >> 5, gw = blockIdx.x * 8 + wid, ngw = gridDim.x * 8;
#pragma unroll 1
    for (int tq = gw; tq < NTOK / 4; tq += ngw) {
        {
            const bf16_t* qrow = QP + (size_t)(4 * tq + (r32 >> 3)) * 2048 + (r32 & 7) * 256;
            float v1[16], v2[16];
            peer_topk_half(qrow, keys, r32, hi, v1);
            peer_topk_half(qrow + 128, keys + 16384, r32, hi, v2);
#pragma unroll
            for (int k = 0; k < 16; ++k) { idxL[k * 64 + lane] = (int)(__float_as_uint(v1[k]) & 0x7Fu); idxL[(16 + k) * 64 + lane] = (int)(__float_as_uint(v2[k]) & 0x7Fu); }
            float SC[16], S2[16];
#pragma unroll
            for (int b2 = 0; b2 < 16; ++b2) SC[b2] = with_payload(v1[0] + v2[b2], 0xFFu, (unsigned)b2);
#pragma unroll
            for (int a = 1; a <= 4; ++a) {
#pragma unroll
                for (int b2 = 0; b2 < 16; ++b2) S2[b2] = ((a + 1) * (b2 + 1) <= 16) ? with_payload(v1[a] + v2[b2], 0xFFu, (unsigned)(a * 16 + b2)) : -INFINITY;
                merge_top16(SC, S2); }
#pragma unroll
            for (int a = 5; a <= 7; ++a) { S2[2 * (a - 5)] = with_payload(v1[a] + v2[0], 0xFFu, (unsigned)(a * 16)); S2[2 * (a - 5) + 1] = with_payload(v1[a] + v2[1], 0xFFu, (unsigned)(a * 16 + 1)); }
#pragma unroll
            for (int a = 8; a <= 15; ++a) S2[6 + (a - 8)] = with_payload(v1[a] + v2[0], 0xFFu, (unsigned)(a * 16));
            S2[14] = -INFINITY; S2[15] = -INFINITY;
            bitonic_sort16_desc(S2); merge_top16(SC, S2);
            float e[16], sum = 0.f;
#pragma unroll
            for (int k = 0; k < 16; ++k) { e[k] = __expf(SC[k] - SC[0]); sum += e[k]; }
            const float inv = 1.0f / sum;
            if (hi == 0) {
                u32x4 iw[4]; f32x4 gv[4];
#pragma unroll
                for (int k = 0; k < 16; ++k) { const unsigned pay = __float_as_uint(SC[k]) & 0xFFu;
                    iw[k >> 2][k & 3] = (unsigned)(idxL[(pay >> 4) * 64 + lane] * 128 + idxL[(16 + (pay & 15)) * 64 + lane]); gv[k >> 2][k & 3] = e[k] * inv; }
                const size_t gbase = (size_t)(4 * tq + (r32 >> 3)) * 128 + (r32 & 7) * 16;
#pragma unroll
                for (int k4 = 0; k4 < 4; ++k4) { *(u32x4*)(EID + gbase + 4 * k4) = iw[k4]; *(f32x4*)(GATE + gbase + 4 * k4) = gv[k4]; } }
        }
        {
            const int token = 4 * tq + (lane >> 4), w = lane & 15;
            const float sq = row16_sum(rowsq[(size_t)w * NTOK + token] + rowsq[(size_t)(w + 16) * NTOK + token]);
            if (w == 0) RSTD[token] = rsqrtf(sq * (1.0f / 2048.0f) + 1e-6f); }
    }
}

__device__ __forceinline__ float dot2bf(unsigned a, unsigned b, float acc) { return __builtin_amdgcn_fdot2_f32_bf16(__builtin_bit_cast(bf16x2v, a), __builtin_bit_cast(bf16x2v, b), acc, false); }
__device__ __forceinline__ void peer_partition(const P& p, int myrank, int& part, int& rank, int& nwg) {
    unsigned* bar = (unsigned*)(p.ws + WS_BAR); const unsigned x = xb_xcc_id(); unsigned mine = 0u; bool ok = true;
#pragma unroll
    for (unsigned j = 0; j < 16; ++j) { const unsigned cj = xb_ld(&bar[XB_XCNT(j)]); ok = ok && ((j < 8u) ? (cj > 0u) : (cj == 0u)); mine = (j == x) ? cj : mine; }
    if (ok) { part = (int)x; rank = myrank; nwg = (int)mine; } else { part = (int)blockIdx.x & 7; rank = (int)blockIdx.x >> 3; nwg = (int)gridDim.x >> 3; }
    part = __builtin_amdgcn_readfirstlane(part); rank = __builtin_amdgcn_readfirstlane(rank); nwg = __builtin_amdgcn_readfirstlane(nwg);
}
__device__ __forceinline__ void phase_peer_u(const P& p, int layer, LAS unsigned char* lds, int lane, int wid, int myrank) {
    LAS unsigned char* wl = lds + wid * 16384;
    int part, rank, nwg; peer_partition(p, myrank, part, rank, nwg);
    const unsigned char* PUS = p.ws + WS_PU + (size_t)layer * 16384 * PEER_ROWB + (size_t)part * 16384 * 192;
    const int* EID = (const int*)(p.ws + WS_EID);
    const unsigned char* HB = p.ws + WS_XB + 512 * part;
    const float* RSTD = (const float*)(p.ws + WS_RSTD);
    const float* ABs = (const float*)(p.ws + WS_ABT) + (size_t)layer * 2 * 4096 + 256 * part + 4 * lane;
    float* PACT = (float*)(p.ws + WS_PACT) + (size_t)part * NTOK * 128;
    const int g = lane >> 3, s = lane & 7, nb = NTOK / 8, stride = nwg * 8;
    int tb = rank * 8 + wid;
    if (tb >= nb) return;
    int e0[8], e1[8]; u32x2 hs[8]; float rs[8]; f32x4 Av, Bv;
#define PB_LOAD(TB) { _Pragma("unroll") for (int j = 0; j < 8; ++j) { const size_t t = (size_t)(TB) * 8 + j; e0[j] = EID[t * 128 + lane]; e1[j] = EID[t * 128 + 64 + lane]; hs[j] = *(const u32x2*)(HB + t * 4096 + 8 * lane); rs[j] = RSTD[t]; } \
        Av = *(const f32x4*)(ABs + ((TB) >> 10) * 4096); Bv = *(const f32x4*)(ABs + ((TB) >> 10) * 4096 + 2048); }
#define PB_STORE(BUF) _Pragma("unroll") for (int j = 0; j < 8; ++j) { LAS int* il = (LAS int*)(wl + (BUF) * 8192); il[j * 128 + lane] = e0[j]; il[j * 128 + 64 + lane] = e1[j]; \
        u32x2 hw; hw.x = __builtin_bit_cast(unsigned, (h16x2){(_Float16)(bflo(hs[j].x) * rs[j] * Av.x + Bv.x), (_Float16)(bfhi(hs[j].x) * rs[j] * Av.y + Bv.y)}); hw.y = __builtin_bit_cast(unsigned, (h16x2){(_Float16)(bflo(hs[j].y) * rs[j] * Av.z + Bv.z), (_Float16)(bfhi(hs[j].y) * rs[j] * Av.w + Bv.w)}); \
        *(LAS u32x2*)(wl + (BUF) * 8192 + 4096 + j * 512 + 8 * lane) = hw; }
#define PR_LOAD(SLOT, ID) { const unsigned char* ur = PUS + (size_t)(ID) * 192 + 24 * s; R[SLOT][0] = *(const u32x2*)ur; R[SLOT][1] = *(const u32x2*)(ur + 8); R[SLOT][2] = *(const u32x2*)(ur + 16); }
    PB_LOAD(tb) PB_STORE(0)
    u32x2 R[8][3];
    { LAS int* il = (LAS int*)wl;
#pragma unroll
      for (int q = 0; q < 8; ++q) { const int id = il[8 * q + g]; PR_LOAD(q, id) } }
    int bi = 0;
#pragma unroll 1
    for (; tb < nb; tb += stride, bi ^= 1) {
        { const int tbn = tb + stride < nb ? tb + stride : tb; PB_LOAD(tbn) }
#pragma unroll 1
        for (int j = 0; j < 8; ++j) {
            if (j == 7) { PB_STORE(bi ^ 1) }
            LAS int* ids = (LAS int*)(wl + bi * 8192) + j * 128;
            LAS int* nid = (j < 7) ? ids + 128 : (LAS int*)(wl + (bi ^ 1) * 8192);
            LAS u32x4* hp = (LAS u32x4*)(wl + bi * 8192 + 4096 + j * 512 + s * 64);
            const u32x4 h0 = hp[0], h1 = hp[1], h2 = hp[2], h3 = hp[3];
            float acc[16];
#pragma unroll
            for (int it = 0; it < 16; ++it) {
                const int sl = it & 7;
                const h16x32 d = __builtin_amdgcn_cvt_scalef32_pk32_f16_fp6((u32x6){R[sl][0].x, R[sl][0].y, R[sl][1].x, R[sl][1].y, R[sl][2].x, R[sl][2].y}, 1.0f);
                { const int idn = (it < 8) ? ids[8 * (it + 8) + g] : nid[8 * (it - 8) + g]; PR_LOAD(sl, idn) }
                h16x2 a2 = (h16x2){(_Float16)0.f, (_Float16)0.f}, b2 = a2;
                const unsigned hw[16] = {h0.x, h0.y, h0.z, h0.w, h1.x, h1.y, h1.z, h1.w, h2.x, h2.y, h2.z, h2.w, h3.x, h3.y, h3.z, h3.w};
#pragma unroll
                for (int k = 0; k < 16; k += 2) { a2 = __builtin_elementwise_fma(__builtin_bit_cast(h16x2, hw[k]), (h16x2){d[2 * k], d[2 * k + 1]}, a2); b2 = __builtin_elementwise_fma(__builtin_bit_cast(h16x2, hw[k + 1]), (h16x2){d[2 * k + 2], d[2 * k + 3]}, b2); }
                const h16x2 s2 = a2 + b2; const float a0 = (float)s2.x, a1 = (float)s2.y;
                float v = a0 + a1;
                v += __uint_as_float(__builtin_amdgcn_update_dpp(0u, __float_as_uint(v), 0xB1, 0xF, 0xF, true));
                v += __uint_as_float(__builtin_amdgcn_update_dpp(0u, __float_as_uint(v), 0x4E, 0xF, 0xF, true));
                v += __uint_as_float(__builtin_amdgcn_update_dpp(0u, __float_as_uint(v), 0x141, 0xF, 0xF, true));
                acc[it] = v;
            }
            if (s == 0) { float* pa = PACT + ((size_t)tb * 8 + j) * 128 + g;
#pragma unroll
                for (int it = 0; it < 16; ++it) pa[8 * it] = acc[it]; }
        }
    }
#undef PB_LOAD
#undef PB_STORE
#undef PR_LOAD
}

__device__ __forceinline__ void phase_peer_w(const P& p, int layer, int tid) {
    const int* EID = (const int*)(p.ws + WS_EID); const float* GATE = (const float*)(p.ws + WS_GATE); const float* PACT = (const float*)(p.ws + WS_PACT); float* PW = (float*)(p.ws + WS_PW);
    const float* PSU = (const float*)(p.ws + WS_PSC) + layer * 16384; const float* PSV = PSU + 2 * 16384;
#pragma unroll 4
    for (int i = (int)blockIdx.x * 512 + tid; i < NTOK * 128; i += (int)gridDim.x * 512) {
        const int id = EID[i]; float a = 0.f;
#pragma unroll
        for (int x = 0; x < 8; ++x) a += PACT[(size_t)x * NTOK * 128 + i];
        PW[i] = gelu_t(a * PSU[id]) * GATE[i] * PSV[id];
    }
}

__device__ __forceinline__ void phase_peer_vs(const P& p, int layer, LAS unsigned char* lds, int lane, int wid, int myrank) {
    LAS unsigned char* wl = lds + wid * 16384;
    int part, rank, nwg; peer_partition(p, myrank, part, rank, nwg);
    const unsigned char* PVS = p.ws + WS_PV + (size_t)layer * 16384 * PEER_ROWB + (size_t)part * 16384 * 192;
    const int* EID = (const int*)(p.ws + WS_EID); const float* PW = (const float*)(p.ws + WS_PW);
    unsigned char* PO = p.ws + WS_PO + 512 * part;
    const int g = lane >> 3, s = lane & 7, nb = NTOK / 8, stride = nwg * 8;
    const bool b3 = (lane & 8) != 0;
    int tb = rank * 8 + wid;
    if (tb >= nb) return;
    int e0[8], e1[8]; float w0[8], w1[8];
#define PB_LOAD(TB) _Pragma("unroll") for (int j = 0; j < 8; ++j) { const size_t t = (size_t)(TB) * 8 + j; e0[j] = EID[t * 128 + lane]; e1[j] = EID[t * 128 + 64 + lane]; w0[j] = PW[t * 128 + lane]; w1[j] = PW[t * 128 + 64 + lane]; }
#define PB_STORE(BUF) _Pragma("unroll") for (int j = 0; j < 8; ++j) { LAS int* il = (LAS int*)(wl + (BUF) * 8192); LAS float* fl = (LAS float*)(wl + (BUF) * 8192 + 4096); il[j * 128 + lane] = e0[j]; il[j * 128 + 64 + lane] = e1[j]; fl[j * 128 + lane] = w0[j]; fl[j * 128 + 64 + lane] = w1[j]; }
#define PR_LOAD(SLOT, ID) { const unsigned char* vr = PVS + (size_t)(ID) * 192 + 24 * s; R[SLOT][0] = *(const u32x2*)vr; R[SLOT][1] = *(const u32x2*)(vr + 8); R[SLOT][2] = *(const u32x2*)(vr + 16); }
    PB_LOAD(tb) PB_STORE(0)
    u32x2 R[8][3];
    { LAS int* il = (LAS int*)wl;
#pragma unroll
      for (int q = 0; q < 8; ++q) { const int id = il[8 * q + g]; PR_LOAD(q, id) } }
    int bi = 0;
#pragma unroll 1
    for (; tb < nb; tb += stride, bi ^= 1) {
        { const int tbn = tb + stride < nb ? tb + stride : tb; PB_LOAD(tbn) }
#pragma unroll 1
        for (int j = 0; j < 8; ++j) {
            if (j == 7) { PB_STORE(bi ^ 1) }
            LAS int* ids = (LAS int*)(wl + bi * 8192) + j * 128;
            LAS int* nid = (j < 7) ? ids + 128 : (LAS int*)(wl + (bi ^ 1) * 8192);
            LAS float* wv = (LAS float*)(wl + bi * 8192 + 4096) + j * 128;
            h16x2 o2[16];
#pragma unroll
            for (int k = 0; k < 16; ++k) o2[k] = (h16x2){(_Float16)0.f, (_Float16)0.f};
#pragma unroll
            for (int it = 0; it < 16; ++it) {
                const int sl = it & 7;
                const h16x32 d = __builtin_amdgcn_cvt_scalef32_pk32_f16_fp6((u32x6){R[sl][0].x, R[sl][0].y, R[sl][1].x, R[sl][1].y, R[sl][2].x, R[sl][2].y}, 1.0f);
                { const int idn = (it < 8) ? ids[8 * (it + 8) + g] : nid[8 * (it - 8) + g]; PR_LOAD(sl, idn) }
                const _Float16 wh = (_Float16)wv[8 * it + g]; const h16x2 w2 = (h16x2){wh, wh};
#pragma unroll
                for (int k = 0; k < 16; ++k) o2[k] = __builtin_elementwise_fma(w2, (h16x2){d[2 * k], d[2 * k + 1]}, o2[k]);
            }
            h16x2 t8[8], t4[4]; float res[4];
#pragma unroll
            for (int k = 0; k < 8; ++k) { const auto r = __builtin_amdgcn_permlane32_swap(__builtin_bit_cast(unsigned, o2[k]), __builtin_bit_cast(unsigned, o2[8 + k]), false, false);
                unsigned ra = r[0], rb = r[1]; asm volatile("" : "+v"(ra), "+v"(rb)); t8[k] = __builtin_bit_cast(h16x2, ra) + __builtin_bit_cast(h16x2, rb); }
#pragma unroll
            for (int k = 0; k < 4; ++k) { const auto r = __builtin_amdgcn_permlane16_swap(__builtin_bit_cast(unsigned, t8[k]), __builtin_bit_cast(unsigned, t8[4 + k]), false, false);
                unsigned ra = r[0], rb = r[1]; asm volatile("" : "+v"(ra), "+v"(rb)); t4[k] = __builtin_bit_cast(h16x2, ra) + __builtin_bit_cast(h16x2, rb); }
#pragma unroll
            for (int k = 0; k < 2; ++k) { const unsigned lo = __builtin_bit_cast(unsigned, t4[k]), hi = __builtin_bit_cast(unsigned, t4[2 + k]); const unsigned mine = b3 ? hi : lo, send = b3 ? lo : hi;
                const h16x2 rr = __builtin_bit_cast(h16x2, mine) + __builtin_bit_cast(h16x2, (unsigned)__builtin_amdgcn_update_dpp(0u, send, 0x128, 0xF, 0xF, true));
                res[2 * k] = (float)rr.x; res[2 * k + 1] = (float)rr.y; }
            u32x2 ow; ow.x = cvtpk(res[0], res[1]); ow.y = cvtpk(res[2], res[3]);
            *(u32x2*)(PO + ((size_t)tb * 8 + j) * 4096 + 64 * s + 8 * g) = ow;
        }
    }
#undef PB_LOAD
#undef PB_STORE
#undef PR_LOAD
}

template <bool FINAL>
__device__ __forceinline__ void phase_peer_norm(const P& p, int layer, int lane, int wid) {
    bf16_t* XB = (bf16_t*)(p.ws + WS_XB);
    const bf16_t* PO = (const bf16_t*)(p.ws + WS_PO);
    const float* mod = (const float*)(p.ws + WS_MOD);
    float* X = p.out;
    const int gw = blockIdx.x * 8 + wid, ngw = gridDim.x * 8;
    u32x4 pw[4], xw[4];
#define PN_LOAD(T, PWV, XWV) { const bf16_t* por = PO + (size_t)(T) * 2048 + 16 * lane; const bf16_t* xbl = XB + (size_t)(T) * 2048 + 16 * lane; \
        _Pragma("unroll") for (int j = 0; j < 4; ++j) { PWV[j] = *(const u32x4*)(por + 1024 * (j >> 1) + 8 * (j & 1)); XWV[j] = *(const u32x4*)(xbl + 1024 * (j >> 1) + 8 * (j & 1)); } }
    if (gw < NTOK) PN_LOAD(gw, pw, xw)
#pragma unroll 1
    for (int token = gw; token < NTOK; token += ngw) {
        const int b = token >> 13;
        u32x4 pwn[4], xwn[4];
        { const int tn = token + ngw < NTOK ? token + ngw : token; PN_LOAD(tn, pwn, xwn) }
        float o[32];
#pragma unroll
        for (int j = 0; j < 4; ++j) { const u32x4 w = pw[j];
            o[8 * j + 0] = bflo(w.x); o[8 * j + 1] = bfhi(w.x); o[8 * j + 2] = bflo(w.y); o[8 * j + 3] = bfhi(w.y);
            o[8 * j + 4] = bflo(w.z); o[8 * j + 5] = bfhi(w.z); o[8 * j + 6] = bflo(w.w); o[8 * j + 7] = bfhi(w.w); }
        {
            const float* g2 = mod + (size_t)(layer * 2 + b) * 12288 + 5 * 2048 + 16 * lane;
            bf16_t* xbr = XB + (size_t)token * 2048 + 16 * lane; float* xr = X + (size_t)token * 2048 + 16 * lane;
            float xn[32], ss = 0.f;
#pragma unroll
            for (int jh = 0; jh < 2; ++jh) { const u32x4 w0 = xw[2 * jh], w1 = xw[2 * jh + 1];
                const float xi[16] = {bflo(w0.x), bfhi(w0.x), bflo(w0.y), bfhi(w0.y), bflo(w0.z), bfhi(w0.z), bflo(w0.w), bfhi(w0.w), bflo(w1.x), bfhi(w1.x), bflo(w1.y), bfhi(w1.y), bflo(w1.z), bfhi(w1.z), bflo(w1.w), bfhi(w1.w)};
#pragma unroll
                for (int q = 0; q < 4; ++q) { const f32x4 gg = *(const f32x4*)(g2 + 1024 * jh + 4 * q);
#pragma unroll
                    for (int e = 0; e < 4; ++e) { const float t = xi[4 * q + e] + gg[e] * o[16 * jh + 4 * q + e]; xn[16 * jh + 4 * q + e] = t; ss += t * t; } } }
            ss = wave_sum(ss); const float rstd = rsqrtf(ss * (1.0f / 2048.0f) + 1e-6f);
            if (FINAL) {
#pragma unroll
                for (int j = 0; j < 8; ++j) { const int off = 1024 * (j >> 2) + 4 * (j & 3); const f32x4 fg = *(const f32x4*)(p.final_g + 16 * lane + off);
                    f32x4 y;
#pragma unroll
                    for (int e = 0; e < 4; ++e) y[e] = xn[4 * j + e] * rstd * fg[e];
                    *(f32x4*)(xr + off) = y; }
            } else {
                const float* ng = p.norm_g + (size_t)((layer + 1) * 2 + 0) * 2048 + 16 * lane;
                const float* sh = mod + (size_t)((layer + 1) * 2 + b) * 12288 + 16 * lane; const float* sc = sh + 2048;
                unsigned char* hrow8 = p.ws + WS_H8 + (size_t)token * 2048 + 16 * lane;
#pragma unroll
                for (int jh = 0; jh < 2; ++jh) { float y[16];
#pragma unroll
                    for (int hq = 0; hq < 4; ++hq) { const int jj = 4 * jh + hq, off = 1024 * jh + 4 * hq; const f32x4 gv = *(const f32x4*)(ng + off), sv = *(const f32x4*)(sc + off), hv = *(const f32x4*)(sh + off);
                        f32x4 xo;
#pragma unroll
                        for (int e = 0; e < 4; ++e) { xo[e] = xn[4 * jj + e]; y[4 * hq + e] = (xo[e] * rstd * gv[e] * (1.0f + sv[e]) + hv[e]) * F8_HS; }
                        u32x2 xw; xw.x = cvtpk(xo[0], xo[1]); xw.y = cvtpk(xo[2], xo[3]); *(u32x2*)(xbr + off) = xw; }
                    u32x4 w; w.x = pk_fp8x4(y[0], y[1], y[2], y[3]); w.y = pk_fp8x4(y[4], y[5], y[6], y[7]); w.z = pk_fp8x4(y[8], y[9], y[10], y[11]); w.w = pk_fp8x4(y[12], y[13], y[14], y[15]);
                    *(u32x4*)(hrow8 + 1024 * jh) = w; }
            }
        }
#pragma unroll
        for (int j = 0; j < 4; ++j) { pw[j] = pwn[j]; xw[j] = xwn[j]; }
    }
#undef PN_LOAD
}

#ifndef PH_MASK
#define PH_MASK 0xFFFF
#endif
#define PH(b) if constexpr ((PH_MASK >> (b)) & 1)
#ifndef DBL_MASK
#define DBL_MASK 0
#endif
#define REP(b) for (int _r = 0; _r < 1 + ((DBL_MASK >> (b)) & 1); ++_r)
__device__ __forceinline__ int fresh_tid() { int t = threadIdx.x; asm volatile("" : "+v"(t)); return t; }
__device__ __forceinline__ P load_p() {
    typedef __attribute__((address_space(1))) float* gp;
    typedef const gp __attribute__((address_space(4)))* cq;
    cq q = (cq)__builtin_amdgcn_kernarg_segment_ptr(); asm volatile("" : "+s"(q));
    P r; float** d = (float**)&r;
#pragma unroll
    for (int i = 0; i < (int)(sizeof(P) / 8); ++i) d[i] = (float*)q[i];
    return r;
}
#define LP (load_p())
#define WSB (load_p().ws)
#define MODP ((const float*)(load_p().ws + WS_MOD))
#define HP ((bf16_t*)(load_p().ws + WS_H))
__global__ void __launch_bounds__(512, 2) mk_fwd(P p_arg) {
    extern __shared__ __attribute__((aligned(16))) unsigned char lds_raw[];
    LAS unsigned char* lds = (LAS unsigned char*)lds_raw;
    cg::grid_group grid = cg::this_grid();
    const int wid = __builtin_amdgcn_readfirstlane((int)threadIdx.x >> 6);
    const int gw = blockIdx.x * 8 + wid, ngw = gridDim.x * 8, G = gridDim.x;
    volatile LAS unsigned* xst = (volatile LAS unsigned*)(lds + LDS_BYTES - 64);
    if (threadIdx.x < 16) xst[threadIdx.x] = 0u;
    __syncthreads();
    const XcdBarrier xb = xcd_barrier_post((unsigned*)(load_p().ws + WS_BAR), xst);
#define TID (fresh_tid())
#define LANE (fresh_tid() & 63)

    REP(0) { PH(0) phase_prologue(LP, lds, TID, LANE, wid);
    grid.sync(); }
    REP(1) { PH(1) phase_adaln<true>(LP.x, WSB + WS_H8, LP.norm_g, MODP, MODP + 2048, gw, ngw, LANE);
    xcd_barrier(xb); }
    REP(2) { PH(2) {   pg8::Gemm g{(const bf16_t*)(WSB + WS_H8), (const bf16_t*)(WSB + WS_WINE), NTOK, 2560, 1024, 1024, 1024, 0, 0}; pg8::StaticOrder S; S.init(NTOK, 2560, G, (int)blockIdx.x);
        pg8::EpiEvenSplit E{1.0f / (F8_HS * F8_WS), WSB};
        pg8::gemm_phase<pg8::EpiEvenSplit, pg8::StaticOrder, true, true, true>(lds, g, S, E); }
    xcd_barrier(xb); }
    PH(3) { phase_qkprep(LP, gw, ngw, LANE); phase_fold_wq(LP, lds, TID, LANE, wid); __syncthreads(); }
    REP(4) { PH(4) {
        pg8::Gemm g{(const bf16_t*)(WSB + WS_AB), (const bf16_t*)(WSB + WS_WSUM), 1024, 256, 256, 512, 256, (size_t)1024 * 512, (size_t)256 * 256};
        pg8::BatchOrder S{4, 256, G, (int)blockIdx.x}; pg8::EpiF32B E{(float*)(WSB + WS_SS), 256, (size_t)1024 * 256};
        pg8::gemm_phase<pg8::EpiF32B, pg8::BatchOrder, false, false>(lds, g, S, E); }
    xcd_barrier(xb); }
    REP(5) { PH(5) { phase_s5scan(LP, lds, LANE, wid); phase_bias_reduce(LP, TID); }
    xcd_barrier(xb); }
    REP(13) { PH(13) {
        pg8::Gemm g{(const bf16_t*)(WSB + WS_AB), (const bf16_t*)(WSB + WS_WY), 1024, 256, 512, 512, 512, (size_t)1024 * 512, (size_t)256 * 512};
        LAS float* wl = (LAS float*)(lds + 131072);
        { const int un = (int)blockIdx.x;
            const int tid = TID; __syncthreads();
            if (tid < 256) wl[tid] = LP.glu_w[(un >> 2) * 256 + tid]; else if (tid < 272) wl[tid] = LP.glu_b[(un >> 2) * 16 + tid - 256];
            __syncthreads();
            pg8::BatchOrder S{4, un + 1, 256, un}; pg8::EpiS5Glu E{WSB + WS_CAT, wl};
            pg8::gemm_phase<pg8::EpiS5Glu, pg8::BatchOrder, false, false>(lds, g, S, E); }
        __syncthreads(); } }
    REP(6) { PH(6) phase_attn(LP, (char*)lds_raw);
    xcd_barrier(xb); }
    REP(7) { PH(7) {   pg8::Gemm g{(const bf16_t*)(WSB + WS_CAT), (const bf16_t*)(WSB + WS_WOUTE), NTOK, 2048, 1024, 1024, 1024, 0, 0}; pg8::StaticOrder S; S.init(NTOK, 2048, G, (int)blockIdx.x);
        pg8::EpiResidB<true> E{LP.x, (bf16_t*)(WSB + WS_XB), MODP + 2 * 2048, (float*)(WSB + WS_ROWSQ), WSB + WS_X8, 1.0f / (F8_CS * F8_WS)};
        pg8::gemm_phase<pg8::EpiResidB<true>, pg8::StaticOrder, true, true, true>(lds, g, S, E); }
    xcd_barrier(xb); }
    REP(8) { PH(8) {   pg8::Gemm g{(const bf16_t*)(WSB + WS_X8), (const bf16_t*)(WSB + WS_WQF), NTOK, 2048, 1024, 1024, 1024, 0, (size_t)2048 * 1024}; pg8::StaticOrder S; S.init(NTOK, 2048, G, (int)blockIdx.x); S.pbs = 5;
        pg8::EpiQ E{(bf16_t*)(WSB + WS_QP), (const float*)(WSB + WS_ROWSQ), (const float*)(WSB + WS_BIASQ), 1.0f / (F8_XS * F8_WS)};
        pg8::gemm_phase<pg8::EpiQ, pg8::StaticOrder, true, true, true>(lds, g, S, E); }
    xcd_barrier(xb); }
    REP(16) { PH(9) phase_peer_s1(LP, 0, lds, LANE, wid); }
    xcd_barrier(xb);
    REP(17) { PH(9) phase_peer_u(LP, 0, lds, LANE, wid, (int)xst[2]); }
    xcd_barrier(xb);
    REP(18) { PH(9) phase_peer_w(LP, 0, TID); }
    xcd_barrier(xb);
    REP(19) { PH(9) phase_peer_vs(LP, 0, lds, LANE, wid, (int)xst[2]); }
    xcd_barrier(xb);
    PH(9) phase_peer_norm<false>(LP, 0, LANE, wid);
    xcd_barrier(xb);
    REP(10) { PH(10) {   pg8::Gemm g{(const bf16_t*)(WSB + WS_H8), (const bf16_t*)(WSB + WS_WINO), NTOK, 8192, 1024, 1024, 1024, 0, 0}; pg8::StaticOrder S; S.init(NTOK, 8192, G, (int)blockIdx.x);
        pg8::EpiBf16T<1> E{(bf16_t*)(WSB + WS_Z), 8192, 1.0f / (F8_HS * F8_WS), (float*)(WSB + WS_LNST)};
        pg8::gemm_phase<pg8::EpiBf16T<1>, pg8::StaticOrder, true, true, true>(lds, g, S, E); }
    xcd_barrier(xb); }
    REP(11) { PH(11) phase_sgu(LP, lds, TID, LANE, wid);
    xcd_barrier(xb); }
    PH(12) {   pg8::Gemm g{(const bf16_t*)(WSB + WS_SG), (const bf16_t*)(WSB + WS_WOUTO), NTOK, 2048, 2048, 2048, 2048, 0, 0}; pg8::StaticOrder S; S.init(NTOK, 2048, G, (int)blockIdx.x);
        pg8::EpiResidB<false> E{nullptr, (bf16_t*)(WSB + WS_XB), MODP + 2 * 12288 + 2 * 2048, (float*)(WSB + WS_ROWSQ) + (size_t)32 * NTOK, WSB + WS_X8, 1.0f / (F8_SGS * F8_WS)};
        pg8::gemm_phase<pg8::EpiResidB<false>, pg8::StaticOrder, true, true, true>(lds, g, S, E); }
    xcd_barrier(xb);
    REP(8) { PH(8) {   pg8::Gemm g{(const bf16_t*)(WSB + WS_X8), (const bf16_t*)(WSB + WS_WQF) + (size_t)2 * 2048 * 1024, NTOK, 2048, 1024, 1024, 1024, 0, (size_t)2048 * 1024}; pg8::StaticOrder S; S.init(NTOK, 2048, G, (int)blockIdx.x); S.pbs = 5;
        pg8::EpiQ E{(bf16_t*)(WSB + WS_QP), (const float*)(WSB + WS_ROWSQ) + (size_t)32 * NTOK, (const float*)(WSB + WS_BIASQ) + 2 * 2048, 1.0f / (F8_XS * F8_WS)};
        pg8::gemm_phase<pg8::EpiQ, pg8::StaticOrder, true, true, true>(lds, g, S, E); }
    xcd_barrier(xb); }
    REP(16) { PH(9) phase_peer_s1(LP, 1, lds, LANE, wid); }
    xcd_barrier(xb);
    REP(17) { PH(9) phase_peer_u(LP, 1, lds, LANE, wid, (int)xst[2]); }
    xcd_barrier(xb);
    REP(18) { PH(9) phase_peer_w(LP, 1, TID); }
    xcd_barrier(xb);
    REP(19) { PH(9) phase_peer_vs(LP, 1, lds, LANE, wid, (int)xst[2]); }
    xcd_barrier(xb);
    PH(9) phase_peer_norm<true>(LP, 1, LANE, wid);
}

#undef LP
#undef WSB
#undef MODP
#undef HP
extern "C" void kernel_launch(void* const* d_in, const int* in_sizes, int n_in, void* d_out, int out_size, void* d_ws, size_t ws_size, hipStream_t stream) {
    static int grid = 0;
    if (grid == 0) {
        if (n_in != 30 || out_size != NTOK * DMODEL || ws_size < WS_END) { fprintf(stderr, "kernel_launch: unexpected shapes (n_in %d out %d ws %zu, need ws >= %zu)\n", n_in, out_size, ws_size, (size_t)WS_END); grid = -1; return; }
        int dev = 0, cus = 0, per_cu = 0;
        (void)hipGetDevice(&dev); (void)hipDeviceGetAttribute(&cus, hipDeviceAttributeMultiprocessorCount, dev);
        if (hipFuncSetAttribute((const void*)mk_fwd, hipFuncAttributeMaxDynamicSharedMemorySize, LDS_BYTES) != hipSuccess) { fprintf(stderr, "kernel_launch: hipFuncSetAttribute failed\n"); grid = -1; return; }
        if (hipOccupancyMaxActiveBlocksPerMultiprocessor(&per_cu, (const void*)mk_fwd, 512, LDS_BYTES) != hipSuccess || per_cu < 1) { fprintf(stderr, "kernel_launch: occupancy query says %d\n", per_cu); (void)hipGetLastError(); per_cu = 1; }
        grid = cus;
        if (grid > cus * per_cu) grid = cus * per_cu;
        if (grid != 256) { fprintf(stderr, "kernel_launch: this kernel is laid out for a 256-CU device (got %d workgroups)\n", grid); grid = -1; return; }
    }
    if (grid < 0) return;
    if (hipMemsetAsync((char*)d_ws + WS_BAR, 0, 16384, stream) != hipSuccess) { fprintf(stderr, "kernel_launch: hipMemsetAsync failed\n"); return; }
    P p{};
    const float** pf = (const float**)&p;
    for (int i = 0; i < 30; ++i) pf[i] = (const float*)d_in[i];
    p.out = (float*)d_out; p.ws = (unsigned char*)d_ws;
    void* args[] = {&p};
    hipError_t e = hipLaunchCooperativeKernel((const void*)mk_fwd, dim3(grid), dim3(512), args, LDS_BYTES, stream);
    if (e != hipSuccess) fprintf(stderr, "kernel_launch: cooperative launch failed: %s (grid %d)\n", hipGetErrorString(e), grid);
}
```

```cpp
#include <hip/hip_runtime.h>
#include <hip/hip_cooperative_groups.h>
#include <hip/hip_bf16.h>
#include <cstdio>
#include <cstdint>
namespace cg = cooperative_groups;

__device__ __forceinline__ int lane_id_v() { int l; asm volatile("v_mbcnt_lo_u32_b32 %0, -1, 0\n\tv_mbcnt_hi_u32_b32 %0, -1, %0" : "=v"(l)); return l; }

namespace pg8 {
#define PG8_LAS __attribute__((address_space(3)))
typedef unsigned short bf16_t;
typedef short bf16x8 __attribute__((ext_vector_type(8)));
typedef float f32x4 __attribute__((ext_vector_type(4)));
typedef unsigned u32x4 __attribute__((ext_vector_type(4)));
constexpr int BM = 256, BK = 64, HALF = 128, HTB = HALF * BK * 2  , STAGE_BYTES = 8 * HTB, NXCD = 8, WGM = 8;

__host__ __device__ __forceinline__ int lds_byte(int r, int c) { const int st = (r >> 4) * 2 + (c >> 5), rr = r & 15, cc = c & 31, ob = rr * 64 + cc * 2; return st * 1024 + (ob ^ (((ob >> 9) & 1) << 5)); }
__host__ __device__ __forceinline__ void stage_rc(int b, int& R, int& C) { const int st = b / 1024, sb = b % 1024, swz = sb ^ (((sb >> 9) & 1) << 5); R = (st >> 1) * 16 + swz / 64; C = (st & 1) * 32 + (swz % 64) / 2; }
__host__ __device__ __forceinline__ int perm32(int rho) { const int n = rho >> 4, i = rho & 15; return 8 * (i >> 2) + 4 * n + (i & 3); }

struct Unit { int pm, pn, pb; };
struct Gemm { const bf16_t* A; const bf16_t* Bt; int M, N, K; int lda, ldb; size_t bsA, bsB; };

struct StaticOrder {
    int nM, nN, nwg, G, c, pbs;
    __host__ __device__ void init(int M, int N, int G_, int c_) { nM = M / BM; nN = N / BM; nwg = nM * nN; G = G_; c = c_; pbs = -1; }
    __host__ __device__ bool next(int i, Unit& u) const {
        const long L = (long)i * G + c; if (L >= nwg) return false;
        int wgid = (int)L; { const int q = nwg / NXCD, r = nwg % NXCD, xcd = wgid % NXCD, off = wgid / NXCD; wgid = (xcd < r ? xcd * (q + 1) : r * (q + 1) + (xcd - r) * q) + off; }
        const int nig = WGM * nN, gid = wgid / nig, fm = gid * WGM, gsz = (nM - fm) < WGM ? (nM - fm) : WGM;
        u.pm = fm + ((wgid % nig) % gsz); u.pn = (wgid % nig) / gsz; u.pb = pbs >= 0 ? (u.pm >> pbs) : 0; return true;
    }
    __device__ __forceinline__ void a_ready(const Unit&) const {}
    __device__ __forceinline__ void done(const Unit&) const {}
};

__device__ __forceinline__ unsigned cvt_pk_bf16(float lo, float hi) { unsigned r; asm volatile("v_cvt_pk_bf16_f32 %0, %1, %2" : "=v"(r) : "v"(lo), "v"(hi)); return r; }
typedef float f32x2 __attribute__((ext_vector_type(2)));

typedef int i32x8 __attribute__((ext_vector_type(8)));
typedef int i32x4v __attribute__((ext_vector_type(4)));
__device__ __forceinline__ void pg8_mfma_f8(f32x4& c, const i32x8& a, const i32x8& b, int sc) {
    asm("s_nop 1\n\tv_mfma_f32_16x16x128_f8f6f4 %0, %1, %2, %0" : "+v"(c) : "v"(a), "v"(b)); (void)sc; }
__device__ __forceinline__ void pg8_mfma_f8_drain(f32x4 (&acc)[2][2][4][2]) {
#pragma unroll
    for (int a = 0; a < 2; ++a)
#pragma unroll
        for (int b = 0; b < 2; ++b) {
            if (a == 0 && b == 0) asm volatile("s_nop 15\n\ts_nop 15" : "+v"(acc[a][b][0][0]), "+v"(acc[a][b][0][1]), "+v"(acc[a][b][1][0]), "+v"(acc[a][b][1][1]), "+v"(acc[a][b][2][0]), "+v"(acc[a][b][2][1]), "+v"(acc[a][b][3][0]), "+v"(acc[a][b][3][1]));
            else asm volatile("" : "+v"(acc[a][b][0][0]), "+v"(acc[a][b][0][1]), "+v"(acc[a][b][1][0]), "+v"(acc[a][b][1][1]), "+v"(acc[a][b][2][0]), "+v"(acc[a][b][2][1]), "+v"(acc[a][b][3][0]), "+v"(acc[a][b][3][1])); }
}
__device__ __forceinline__ i32x8 pg8_cat(bf16x8 a, bf16x8 b) { return __builtin_shufflevector(__builtin_bit_cast(i32x4v, a), __builtin_bit_cast(i32x4v, b), 0, 1, 2, 3, 4, 5, 6, 7); }
template <class Epi, class Sched, bool ALIGN_EPI = false, bool SP2 = false, bool F8 = false>
__device__ __forceinline__ void gemm_phase(PG8_LAS unsigned char* lds, const Gemm g, const Sched& S, const Epi& E) {
    int tid_o = threadIdx.x; asm volatile("" : "+v"(tid_o)); const int tid = tid_o, wid = __builtin_amdgcn_readfirstlane(tid >> 6), lane = tid & 63, wr = wid >> 2, wc = wid & 3, fr = lane & 15, fq = lane >> 4;
    const int K = g.K, nt = K / BK;
    unsigned voffA[2], voffB[2];
#pragma unroll
    for (int i = 0; i < 2; ++i) { int R, C; stage_rc(tid * 16 + i * 8192, R, C); const int Rb = Epi::PERM ? ((R & ~31) + perm32(R & 31)) : R;
        voffA[i] = (unsigned)(R * g.lda + C) * 2u; voffB[i] = (unsigned)(Rb * g.ldb + C) * 2u; }
    const size_t kstep = (size_t)(BK * 2);
    const size_t hstepA = (size_t)HALF * g.lda * 2, hstepB = (size_t)HALF * g.ldb * 2;
    const size_t tstepA = 2 * hstepA, tstepB = 2 * hstepB;
    const unsigned ldsw = (unsigned)wid * 1024u;
    const int aoff = lds_byte(wr * 64 + fr, fq * 8), boff = lds_byte(wc * 32 + fr, fq * 8);
#define PG8_SA(b, h) (((b) * 2 + (h)) * HTB)
#define PG8_SB(b, h) ((4 + (b) * 2 + (h)) * HTB)
#define PG8_STAGE(bufoff, gbase, voff) do { _Pragma("unroll") for (int _i = 0; _i < 2; ++_i) \
        __builtin_amdgcn_global_load_lds((const unsigned*)((const char*)(gbase) + (voff)[_i]), (PG8_LAS unsigned*)(lds + (bufoff) + ldsw + _i * 8192), 16, 0, 0); } while (0)
#define PG8_LDA(dst, b, h) do { _Pragma("unroll") for (int m = 0; m < 4; ++m) { dst[m].lo = *(const PG8_LAS i32x4v*)(lds + PG8_SA(b, h) + aoff + m * 2048); dst[m].hi = *(const PG8_LAS i32x4v*)(lds + PG8_SA(b, h) + aoff + m * 2048 + 1024); } } while (0)
#define PG8_LDB(dst, b, h) do { _Pragma("unroll") for (int n = 0; n < 2; ++n) { dst[n].lo = *(const PG8_LAS i32x4v*)(lds + PG8_SB(b, h) + boff + n * 2048); dst[n].hi = *(const PG8_LAS i32x4v*)(lds + PG8_SB(b, h) + boff + n * 2048 + 1024); } } while (0)
#define PG8_MMA(ai, bj, At, Bt) do { __builtin_amdgcn_s_setprio(1); \
        if constexpr (F8) { _Pragma("unroll") for (int m = 0; m < 4; ++m) _Pragma("unroll") for (int n = 0; n < 2; ++n) pg8_mfma_f8(acc[ai][bj][m][n], Bt[n], At[m], f8scale); } \
        else { _Pragma("unroll") for (int m = 0; m < 4; ++m) _Pragma("unroll") for (int n = 0; n < 2; ++n) { \
            const i32x4v b_lo = Bt[n].lo, b_hi = Bt[n].hi, a_lo = At[m].lo, a_hi = At[m].hi;     \
            acc[ai][bj][m][n] = __builtin_amdgcn_mfma_f32_16x16x32_bf16(__builtin_bit_cast(bf16x8, b_lo), __builtin_bit_cast(bf16x8, a_lo), acc[ai][bj][m][n], 0, 0, 0); \
            acc[ai][bj][m][n] = __builtin_amdgcn_mfma_f32_16x16x32_bf16(__builtin_bit_cast(bf16x8, b_hi), __builtin_bit_cast(bf16x8, a_hi), acc[ai][bj][m][n], 0, 0, 0); } } \
        __builtin_amdgcn_s_setprio(0); } while (0)
#define PG8_WAIT_V(n) asm volatile("s_waitcnt vmcnt(" #n ")" ::: "memory")
#define PG8_WAIT_L(n) asm volatile("s_waitcnt lgkmcnt(" #n ")" ::: "memory")
#define PG8_BAR __builtin_amdgcn_s_barrier()
#define PG8_SCHED __builtin_amdgcn_sched_barrier(0)
    Unit cur, nxt; int ui = 0;
    if (!S.next(0, cur)) return;
    f32x4 acc[2][2][4][2];
#pragma unroll
    for (int a = 0; a < 2; ++a)
#pragma unroll
        for (int b = 0; b < 2; ++b)
#pragma unroll
            for (int m = 0; m < 4; ++m)
#pragma unroll
                for (int n = 0; n < 2; ++n) acc[a][b][m][n] = (f32x4){0.f, 0.f, 0.f, 0.f};
    int f8scale = 0x7f7f7f7f; asm volatile("" : "+v"(f8scale));
    i32x8 At[4], B0[2], B1[2];
    const char* cA = (const char*)(g.A + (size_t)cur.pb * g.bsA) + (size_t)cur.pm * tstepA; const char* cB = (const char*)(g.Bt + (size_t)cur.pb * g.bsB) + (size_t)cur.pn * tstepB;
    S.a_ready(cur);
    if constexpr (SP2) {
        PG8_STAGE(PG8_SB(0, 0), cB, voffB); PG8_STAGE(PG8_SB(0, 1), cB + hstepB, voffB); PG8_STAGE(PG8_SA(0, 0), cA, voffA); PG8_STAGE(PG8_SA(0, 1), cA + hstepA, voffA);
        if (wr == 1) PG8_BAR;
        PG8_WAIT_V(2); PG8_BAR;
        PG8_STAGE(PG8_SB(1, 0), cB + kstep, voffB); PG8_STAGE(PG8_SA(1, 0), cA + kstep, voffA); PG8_STAGE(PG8_SB(1, 1), cB + hstepB + kstep, voffB);
        PG8_WAIT_V(6); PG8_BAR;
    } else {
        PG8_STAGE(PG8_SB(0, 0), cB, voffB); PG8_STAGE(PG8_SA(0, 0), cA, voffA); PG8_STAGE(PG8_SB(0, 1), cB + hstepB, voffB); PG8_STAGE(PG8_SA(0, 1), cA + hstepA, voffA);
        if (wr == 1) PG8_BAR;
        PG8_WAIT_V(4); PG8_BAR;
        PG8_STAGE(PG8_SB(1, 0), cB + kstep, voffB); PG8_STAGE(PG8_SA(1, 0), cA + kstep, voffA); PG8_STAGE(PG8_SB(1, 1), cB + hstepB + kstep, voffB);
        PG8_WAIT_V(6); PG8_BAR;
    }
    for (;;) {
        const bool has_next = S.next(ui + 1, nxt);
        const char* nA = has_next ? (const char*)(g.A + (size_t)nxt.pb * g.bsA) + (size_t)nxt.pm * tstepA : cA; const char* nB = has_next ? (const char*)(g.Bt + (size_t)nxt.pb * g.bsB) + (size_t)nxt.pn * tstepB : cB;
        for (int t = 0; t < nt; t += 2) {
            const bool last = (t == nt - 2);
            const char* a1 = cA + (size_t)(t + 1) * kstep;
            const char* a2 = last ? nA : cA + (size_t)(t + 2) * kstep; const char* b2 = last ? nB : cB + (size_t)(t + 2) * kstep;
            const char* a3 = a2 + kstep; const char* b3 = b2 + kstep;
            if (last && has_next) S.a_ready(nxt);
            if constexpr (SP2) {
            PG8_LDB(B0, 0, 0); PG8_LDB(B1, 0, 1); PG8_SCHED; PG8_LDA(At, 0, 0); PG8_STAGE(PG8_SA(1, 1), a1 + hstepA, voffA);
            PG8_WAIT_V(8); PG8_WAIT_L(0); PG8_BAR; PG8_MMA(0, 0, At, B0); PG8_MMA(0, 1, At, B1); PG8_BAR; PG8_SCHED;
            PG8_LDA(At, 0, 1); PG8_STAGE(PG8_SB(0, 0), b2, voffB); PG8_STAGE(PG8_SB(0, 1), b2 + hstepB, voffB); PG8_STAGE(PG8_SA(0, 0), a2, voffA);
            PG8_WAIT_V(8); PG8_WAIT_L(0); PG8_BAR; PG8_MMA(1, 0, At, B0); PG8_MMA(1, 1, At, B1); PG8_BAR; PG8_SCHED;
            PG8_LDB(B0, 1, 0); PG8_LDB(B1, 1, 1); PG8_SCHED; PG8_LDA(At, 1, 0); PG8_STAGE(PG8_SA(0, 1), a2 + hstepA, voffA);
            PG8_WAIT_V(8); PG8_WAIT_L(0); PG8_BAR; PG8_MMA(0, 0, At, B0); PG8_MMA(0, 1, At, B1); PG8_BAR; PG8_SCHED;
            PG8_LDA(At, 1, 1); PG8_STAGE(PG8_SB(1, 0), b3, voffB); PG8_STAGE(PG8_SB(1, 1), b3 + hstepB, voffB); PG8_STAGE(PG8_SA(1, 0), a3, voffA);
            PG8_WAIT_V(8); PG8_WAIT_L(0); PG8_BAR; PG8_MMA(1, 0, At, B0); PG8_MMA(1, 1, At, B1); PG8_BAR; PG8_SCHED;
            } else {
            PG8_LDB(B0, 0, 0); PG8_SCHED; PG8_LDA(At, 0, 0); PG8_STAGE(PG8_SA(1, 1), a1 + hstepA, voffA);
            PG8_WAIT_L(8); PG8_BAR; PG8_WAIT_L(0); PG8_MMA(0, 0, At, B0); PG8_BAR; PG8_SCHED;
            PG8_LDB(B1, 0, 1); PG8_STAGE(PG8_SB(0, 0), b2, voffB);
            PG8_BAR; PG8_WAIT_L(0); PG8_MMA(0, 1, At, B1); PG8_BAR;
            PG8_LDA(At, 0, 1); PG8_STAGE(PG8_SA(0, 0), a2, voffA);
            PG8_BAR; PG8_WAIT_L(0); PG8_MMA(1, 0, At, B0); PG8_BAR; PG8_SCHED;
            PG8_STAGE(PG8_SB(0, 1), b2 + hstepB, voffB);
            PG8_WAIT_V(6); PG8_BAR; PG8_MMA(1, 1, At, B1); PG8_BAR;
            PG8_LDB(B0, 1, 0); PG8_SCHED; PG8_LDA(At, 1, 0); PG8_STAGE(PG8_SA(0, 1), a2 + hstepA, voffA);
            PG8_WAIT_L(8); PG8_BAR; PG8_WAIT_L(0); PG8_MMA(0, 0, At, B0); PG8_BAR; PG8_SCHED;
            PG8_LDB(B1, 1, 1); PG8_STAGE(PG8_SB(1, 0), b3, voffB);
            PG8_BAR; PG8_WAIT_L(0); PG8_MMA(0, 1, At, B1); PG8_BAR;
            PG8_LDA(At, 1, 1); PG8_STAGE(PG8_SA(1, 0), a3, voffA);
            PG8_BAR; PG8_WAIT_L(0); PG8_MMA(1, 0, At, B0); PG8_BAR; PG8_SCHED;
            PG8_STAGE(PG8_SB(1, 1), b3 + hstepB, voffB);
            PG8_WAIT_V(6); PG8_BAR; PG8_MMA(1, 1, At, B1); PG8_BAR;
            }
        }
        if constexpr (ALIGN_EPI) { if (wr == 0) PG8_BAR; }
        if constexpr (F8) pg8_mfma_f8_drain(acc);
        if constexpr (!Epi::AFTER_DRAIN) { E(acc, cur, wr, wc, fr, fq); S.done(cur); }
        if (!has_next) break;
#pragma unroll
        for (int a = 0; a < 2; ++a)
#pragma unroll
            for (int b = 0; b < 2; ++b)
#pragma unroll
                for (int m = 0; m < 4; ++m)
#pragma unroll
                    for (int n = 0; n < 2; ++n) acc[a][b][m][n] = (f32x4){0.f, 0.f, 0.f, 0.f};
        cur = nxt; cA = nA; cB = nB; ++ui;
        if constexpr (ALIGN_EPI) { if (wr == 1) PG8_BAR; }
    }
    PG8_WAIT_V(0);
    if constexpr (!ALIGN_EPI) { if (wr == 0) PG8_BAR; }
    PG8_BAR;
    if constexpr (Epi::AFTER_DRAIN) { E.fused(acc, cur, wr, wc, fr, fq, lds, wid, lane); S.done(cur); }
#undef PG8_SA
#undef PG8_SB
#undef PG8_STAGE
#undef PG8_LDA
#undef PG8_LDB
#undef PG8_MMA
#undef PG8_WAIT_V
#undef PG8_WAIT_L
#undef PG8_BAR
#undef PG8_SCHED
}
}
namespace attn {
using bf16 = __hip_bfloat16;
constexpr int   D = 128, NW = 8, QBLK = 32, KVBLK = 64;
constexpr float SCALE = 0.088388347648318440f;
constexpr float THR = 8.f;
constexpr int SDEPTH = 2;
constexpr int LDQ = 1024, LDK = 256, LDO = 2048;
constexpr size_t SHM_V = KVBLK * D * 2, SHM_K = KVBLK * D * 2, SHM_ATTN = 2 * SHM_V + 2 * SHM_K + NW * 64 * 4;
using bf16x8 = __attribute__((ext_vector_type(8))) short;
using s16x4  = __attribute__((ext_vector_type(4))) short;
using f32x16 = __attribute__((ext_vector_type(16))) float;
using f32x8  = __attribute__((ext_vector_type(8))) float;
using u32x4  = __attribute__((ext_vector_type(4))) unsigned;
#define KSWZ(row, colB) ((row) * 256 + ((colB) ^ (((row) & 7) << 4)))
#define SBAR() __builtin_amdgcn_sched_barrier(0)
__device__ __forceinline__ int crow(int r, int hi) { return (r & 3) + 8 * (r >> 2) + 4 * hi; }
__device__ __forceinline__ unsigned cvtpk(float lo, float hi) {
  unsigned r; asm volatile("v_cvt_pk_bf16_f32 %0, %1, %2" : "=v"(r) : "v"(lo), "v"(hi)); return r;
}
template <typename TIn> struct Stage;
template <> struct Stage<bf16>  { using T = bf16x8;
  __device__ static __forceinline__ T ld8(const bf16* p) { return *reinterpret_cast<const bf16x8*>(p); }
  __device__ static __forceinline__ bf16x8 tobf(T x) { return x; } };
template <> struct Stage<float> { using T = f32x8;
  __device__ static __forceinline__ T ld8(const float* p) { return *reinterpret_cast<const f32x8*>(p); }
  __device__ static __forceinline__ bf16x8 tobf(T x) {
    u32x4 w = {cvtpk(x[0], x[1]), cvtpk(x[2], x[3]), cvtpk(x[4], x[5]), cvtpk(x[6], x[7])}; return *reinterpret_cast<bf16x8*>(&w); } };

__device__ __forceinline__ void partialSM(f32x16& p0, f32x16& p1, float& m_reg, float& mn, float& alpha) {
  constexpr float C = SCALE * 1.4426950408889634f;
  float pmax = p0[0]; for (int r = 1; r < 16; ++r) pmax = fmaxf(pmax, p0[r]); for (int r = 0; r < 16; ++r) pmax = fmaxf(pmax, p1[r]);
  { auto rr = __builtin_amdgcn_permlane32_swap(__float_as_uint(pmax), __float_as_uint(pmax), false, false);
    pmax = fmaxf(__uint_as_float(rr[0]), __uint_as_float(rr[1])); }
  if (__builtin_expect(__all(pmax - m_reg <= THR / SCALE), 1)) { mn = m_reg; alpha = 1.f; }
  else { mn = fmaxf(m_reg, pmax); alpha = __builtin_amdgcn_exp2f((m_reg - mn) * C); m_reg = mn; }
  float mnC = -mn * C;
  for (int r = 0; r < 16; ++r) p0[r] = fmaf(p0[r], C, mnC); for (int r = 0; r < 16; ++r) p1[r] = fmaf(p1[r], C, mnC);
  for (int r = 0; r < 16; ++r) p0[r] = __builtin_amdgcn_exp2f(p0[r]);
}
__device__ __forceinline__ void finishSM(f32x16& p0, f32x16& p1, float alpha, float& l_reg, bf16x8& pa0, bf16x8& pa1, bf16x8& pa2, bf16x8& pa3) {
  for (int r = 0; r < 16; ++r) p1[r] = __builtin_amdgcn_exp2f(p1[r]);
  float ps = 0; for (int r = 0; r < 16; ++r) ps += p0[r]; for (int r = 0; r < 16; ++r) ps += p1[r];
  { auto rr = __builtin_amdgcn_permlane32_swap(__float_as_uint(ps), __float_as_uint(ps), false, false);
    ps = __uint_as_float(rr[0]) + __uint_as_float(rr[1]); }
  l_reg = l_reg * alpha + ps;
#define PK4(P, BASE, OUT) do { unsigned a0 = cvtpk(P[BASE + 0], P[BASE + 1]), a1 = cvtpk(P[BASE + 2], P[BASE + 3]);   \
    unsigned b0 = cvtpk(P[BASE + 4], P[BASE + 5]), b1 = cvtpk(P[BASE + 6], P[BASE + 7]);                              \
    auto r0 = __builtin_amdgcn_permlane32_swap(a0, b0, false, false); auto r1 = __builtin_amdgcn_permlane32_swap(a1, b1, false, false); \
    u32x4 w = {r0[0], r1[0], r0[1], r1[1]}; OUT = *reinterpret_cast<bf16x8*>(&w); } while (0)
  PK4(p0, 0, pa0); PK4(p0, 8, pa1); PK4(p1, 0, pa2); PK4(p1, 8, pa3);
#undef PK4
}
__device__ __forceinline__ void qkt(f32x16& p0, f32x16& p1, const bf16* Ks, const bf16x8* qr, int r32, int hi) {
  p0 = f32x16{}; p1 = f32x16{};
  for (int d0 = 0; d0 < 8; ++d0) { int cb = (d0 * 16 + hi * 8) * 2;
    bf16x8 b0 = *reinterpret_cast<const bf16x8*>((const char*)Ks + KSWZ(r32, cb));
    bf16x8 b1 = *reinterpret_cast<const bf16x8*>((const char*)Ks + KSWZ(32 + r32, cb));
    p0 = __builtin_amdgcn_mfma_f32_32x32x16_bf16(b0, qr[d0], p0, 0, 0, 0);
    p1 = __builtin_amdgcn_mfma_f32_32x32x16_bf16(b1, qr[d0], p1, 0, 0, 0); }
}
__device__ __forceinline__ int v_st(int k, int c) { const int kk = (k & ~0xC) | ((k & 4) << 1) | ((k & 8) >> 1); return ((kk >> 3) * 4 + (c >> 5)) * 512 + ((kk & 7) * 32 + (c & 31)) * 2; }
__device__ __forceinline__ int v_rd_base(int lane) { return ((lane & 3) << 3) | (((lane >> 2) & 3) << 6) | (((lane >> 4) & 1) << 5) | (((lane >> 5) & 1) << 8); }
constexpr int v_rd_off(int d0, int ks, int half) { return d0 * 512 + ks * 4096 + half * 2048; }
template <int OFF> __device__ __forceinline__ s16x4 tr_read(int vb) {
  s16x4 r; asm volatile("ds_read_b64_tr_b16 %0, %1 offset:%2" : "=&v"(r) : "v"(vb), "i"(OFF) : "memory"); return r;
}
template <int D0> __device__ __forceinline__ void pv_one(f32x16& od, int vb, bf16x8 pa0, bf16x8 pa1, bf16x8 pa2, bf16x8 pa3) {
  const s16x4 l0 = tr_read<v_rd_off(D0, 0, 0)>(vb), h0 = tr_read<v_rd_off(D0, 0, 1)>(vb), l1 = tr_read<v_rd_off(D0, 1, 0)>(vb), h1 = tr_read<v_rd_off(D0, 1, 1)>(vb);
  const s16x4 l2 = tr_read<v_rd_off(D0, 2, 0)>(vb), h2 = tr_read<v_rd_off(D0, 2, 1)>(vb), l3 = tr_read<v_rd_off(D0, 3, 0)>(vb), h3 = tr_read<v_rd_off(D0, 3, 1)>(vb);
  asm volatile("s_waitcnt lgkmcnt(0)" ::: "memory"); SBAR();
#define PK(L, H) (bf16x8){L[0], L[1], L[2], L[3], H[0], H[1], H[2], H[3]}
  od = __builtin_amdgcn_mfma_f32_32x32x16_bf16(pa0, PK(l0, h0), od, 0, 0, 0);
  od = __builtin_amdgcn_mfma_f32_32x32x16_bf16(pa1, PK(l1, h1), od, 0, 0, 0);
  od = __builtin_amdgcn_mfma_f32_32x32x16_bf16(pa2, PK(l2, h2), od, 0, 0, 0);
  od = __builtin_amdgcn_mfma_f32_32x32x16_bf16(pa3, PK(l3, h3), od, 0, 0, 0);
#undef PK
}
__device__ __forceinline__ void pv_d0(f32x16* o, int vb, bf16x8 pa0, bf16x8 pa1, bf16x8 pa2, bf16x8 pa3) {
  pv_one<0>(o[0], vb, pa0, pa1, pa2, pa3); pv_one<1>(o[1], vb, pa0, pa1, pa2, pa3); pv_one<2>(o[2], vb, pa0, pa1, pa2, pa3); pv_one<3>(o[3], vb, pa0, pa1, pa2, pa3);
}

template <typename TQ>
__device__ __forceinline__ void attn_dense_body(const TQ* __restrict__ Qb, const bf16* __restrict__ Kh, const bf16* __restrict__ Vh,
                                                unsigned char* __restrict__ Ob, int seq, char* lds) {
  using St = Stage<bf16>; using SQ = Stage<TQ>;
  int tid_o = threadIdx.x; asm volatile("" : "+v"(tid_o)); const int tid = tid_o, wid = tid >> 6, lane = tid & 63, r32 = lane & 31, hi = lane >> 5;
  bf16* V_lds = (bf16*)lds; bf16* K_lds = (bf16*)(lds + 2 * SHM_V);
  float* ws = (float*)(lds + 2 * SHM_V + 2 * SHM_K) + wid * 64; float* li_l = ws; float* al_l = ws + 32;
  float m_reg = -1e30f, l_reg = 0; f32x16 o[4] = {}; bf16x8 qr[8];
  const TQ* Qw = Qb + (long)(wid * QBLK + r32) * LDQ + hi * 8;
#pragma unroll
  for (int d0 = 0; d0 < 8; ++d0) qr[d0] = SQ::tobf(SQ::ld8(Qw + d0 * 16));
  const int sr = tid >> 4, sc = (tid & 15) * 8, vst0 = v_st(sr, sc), vst1 = v_st(32 + sr, sc);
  const int vb0 = (int)(uintptr_t)V_lds + v_rd_base(lane);
  struct { typename St::T vs0, vs1, ks0, ks1; } sr_[SDEPTH];
#define SLOAD(i, k0) do { sr_[i].vs0 = St::ld8(&Vh[(long)((k0) + sr) * LDK + sc]); sr_[i].vs1 = St::ld8(&Vh[(long)((k0) + 32 + sr) * LDK + sc]); \
    sr_[i].ks0 = St::ld8(&Kh[(long)((k0) + sr) * LDK + sc]); sr_[i].ks1 = St::ld8(&Kh[(long)((k0) + 32 + sr) * LDK + sc]); } while (0)
#define SWRITE(b, i) do { *(bf16x8*)((char*)V_lds + (b) * SHM_V + vst0) = St::tobf(sr_[i].vs0);          \
    *(bf16x8*)((char*)V_lds + (b) * SHM_V + vst1) = St::tobf(sr_[i].vs1); int kc = sc * 2;               \
    *(bf16x8*)((char*)K_lds + (b) * SHM_K + KSWZ(sr, kc)) = St::tobf(sr_[i].ks0);                       \
    *(bf16x8*)((char*)K_lds + (b) * SHM_K + KSWZ(32 + sr, kc)) = St::tobf(sr_[i].ks1); } while (0)
#define SWAIT() do { if constexpr (SDEPTH == 2) asm volatile("s_waitcnt vmcnt(4)" ::: "memory"); else asm volatile("s_waitcnt vmcnt(0)" ::: "memory"); } while (0)
#define RESC(a) do { if (__any((a) < 1.f)) { if (hi == 0) al_l[r32] = (a); asm volatile("s_waitcnt lgkmcnt(0)" ::: "memory"); \
    for (int d = 0; d < 4; ++d) for (int r = 0; r < 16; ++r) o[d][r] *= al_l[crow(r, hi)]; } } while (0)
  f32x16 pA0, pA1, pB0, pB1; float mnA, mnB, alA, alB; bf16x8 pa0, pa1, pa2, pa3; const int NT = seq / KVBLK;
  constexpr int SE = 0, SO = SDEPTH - 1;
  SLOAD(SE, 0); asm volatile("s_waitcnt vmcnt(0)" ::: "memory"); SWRITE(0, SE); __syncthreads();
  qkt(pA0, pA1, K_lds, qr, r32, hi); partialSM(pA0, pA1, m_reg, mnA, alA);
  SLOAD(SO, KVBLK); if constexpr (SDEPTH == 2) { if (2 < NT) SLOAD(SE, 2 * KVBLK); }
  SWAIT(); SWRITE(1, SO); __syncthreads();
  for (int j = 1; j + 1 < NT; j += 2) {
    SBAR(); qkt(pB0, pB1, (bf16*)((char*)K_lds + SHM_K), qr, r32, hi);
    finishSM(pA0, pA1, alA, l_reg, pa0, pa1, pa2, pa3); SBAR();
    SLOAD(SO, (j + SDEPTH) * KVBLK); SBAR();
    pv_d0(o, vb0, pa0, pa1, pa2, pa3); partialSM(pB0, pB1, m_reg, mnB, alB);
    __syncthreads(); SWAIT(); SWRITE(0, SE);
    RESC(alB); __syncthreads();
    SBAR(); qkt(pA0, pA1, K_lds, qr, r32, hi);
    finishSM(pB0, pB1, alB, l_reg, pa0, pa1, pa2, pa3); SBAR();
    if (SDEPTH == 1 || j + 3 < NT) SLOAD(SE, (j + 1 + SDEPTH) * KVBLK); SBAR();
    pv_d0(o, vb0 + (int)SHM_V, pa0, pa1, pa2, pa3); partialSM(pA0, pA1, m_reg, mnA, alA);
    __syncthreads(); SWAIT(); SWRITE(1, SO);
    RESC(alA); __syncthreads();
  }
  SBAR(); qkt(pB0, pB1, (bf16*)((char*)K_lds + SHM_K), qr, r32, hi);
  finishSM(pA0, pA1, alA, l_reg, pa0, pa1, pa2, pa3); SBAR();
  pv_d0(o, vb0, pa0, pa1, pa2, pa3); partialSM(pB0, pB1, m_reg, mnB, alB);
  __syncthreads(); RESC(alB);
  finishSM(pB0, pB1, alB, l_reg, pa0, pa1, pa2, pa3); SBAR();
  pv_d0(o, vb0 + (int)SHM_V, pa0, pa1, pa2, pa3);
  if (hi == 0) li_l[r32] = l_reg; asm volatile("s_waitcnt lgkmcnt(0)" ::: "memory");
  float rli[16];
#pragma unroll
  for (int r = 0; r < 16; ++r) rli[r] = __builtin_amdgcn_rcpf(li_l[crow(r, hi)]);
  unsigned char* Ow = Ob + (long)(wid * QBLK) * LDO;
#pragma unroll
  for (int r = 0; r < 16; ++r) { int orow = crow(r, hi);
    for (int d0 = 0; d0 < 4; ++d0) Ow[(long)orow * LDO + d0 * 32 + r32] = (unsigned char)(__builtin_amdgcn_cvt_pk_fp8_f32(__builtin_amdgcn_fmed3f(o[d0][r] * rli[r] * 16.0f, -440.f, 440.f), 0.f, 0, false) & 0xff); }
#undef SLOAD
#undef SWRITE
#undef SWAIT
#undef RESC
}
#undef KSWZ
#undef SBAR
}

#define LAS __attribute__((address_space(3)))
typedef unsigned short bf16_t;
typedef short bf16x8 __attribute__((ext_vector_type(8)));
typedef float f32x4 __attribute__((ext_vector_type(4)));
typedef float f32x2 __attribute__((ext_vector_type(2)));
typedef float f32x16 __attribute__((ext_vector_type(16)));
typedef unsigned u32x4 __attribute__((ext_vector_type(4)));
typedef unsigned u32x2 __attribute__((ext_vector_type(2)));

constexpr int NTOK = 16384, DMODEL = 2048, SEQL = 8192;
constexpr size_t MiB = 1u << 20;
constexpr size_t WS_MOD = 0;
constexpr size_t WS_BAR = 512 * 1024;
constexpr size_t WS_S5A = 1 * MiB;
constexpr size_t WS_LNST = 296 * MiB;
constexpr size_t WS_ABT = 2 * MiB;
constexpr size_t WS_BIASQ = 2 * MiB + 64 * 1024;
constexpr size_t WS_ROWSQ = 336 * MiB;
constexpr size_t WS_BIASP = 340 * MiB;
constexpr size_t WS_WQF = 304 * MiB;
constexpr size_t WS_KEYS = 4 * MiB;
constexpr size_t WS_WSB = 5 * MiB;
constexpr size_t WS_WINE = 6 * MiB;
constexpr size_t WS_WOUTE = 16 * MiB;
constexpr size_t WS_WINO = 24 * MiB;
constexpr size_t WS_WOUTO = 56 * MiB;
constexpr size_t WS_WQ = 72 * MiB;
constexpr size_t WS_PU = 88 * MiB;
constexpr size_t WS_PV = 152 * MiB;
constexpr size_t WS_PSC = 5 * MiB + 512 * 1024;
constexpr int PEER_ROWB = 1536;
constexpr bool PEER_SLICE_U = true, PEER_SLICE_V = true;
typedef unsigned u32x6 __attribute__((ext_vector_type(6)));
typedef float f32x16 __attribute__((ext_vector_type(16)));
typedef float f32x32 __attribute__((ext_vector_type(32)));
typedef _Float16 h16x2 __attribute__((ext_vector_type(2)));
typedef _Float16 h16x32 __attribute__((ext_vector_type(32)));
constexpr size_t WS_WY = 216 * MiB;
constexpr size_t WS_WSUM = 232 * MiB;
constexpr size_t WS_H8 = 256 * MiB;
constexpr size_t WS_H = 344 * MiB;
constexpr size_t WS_XB = WS_H;
constexpr size_t WS_TMP = 408 * MiB;
constexpr size_t WS_AB = WS_TMP  , WS_Q = WS_TMP + 64 * MiB, WS_K = WS_TMP + 96 * MiB, WS_V = WS_TMP + 104 * MiB,
                 WS_SS = WS_TMP + 112 * MiB  , WS_CAT = WS_TMP + 176 * MiB;
constexpr size_t WS_Z = WS_TMP, WS_SG = WS_TMP + 256 * MiB;
constexpr size_t WS_QP = WS_TMP;
constexpr size_t WS_X8 = WS_TMP + 64 * MiB;
constexpr size_t WS_RSTD = WS_TMP + 64 * MiB;
constexpr size_t WS_EID = WS_TMP + 128 * MiB;
constexpr size_t WS_GATE = WS_TMP + 136 * MiB;
constexpr size_t WS_PW = WS_TMP + 144 * MiB;
constexpr size_t WS_PO = WS_TMP + 152 * MiB;
constexpr size_t WS_PACT = WS_TMP + 216 * MiB;
typedef unsigned u32x16 __attribute__((ext_vector_type(16)));
typedef __bf16 bf16x2v __attribute__((ext_vector_type(2)));
constexpr size_t WS_END = WS_TMP + 384 * MiB;
constexpr int LDS_BYTES = 147456;

struct P {
    const float *x, *c, *ada_w, *ada_b, *norm_g, *even_w_in, *even_w_out, *lam_re, *lam_im, *log_dt, *b_re, *b_im, *c_re, *c_im, *s5_d, *glu_w, *glu_b,
        *q_g, *k_g, *odd_w_in, *odd_w_out, *sgu_ln_g, *sgu_w, *sgu_b, *peer_wq, *peer_k1, *peer_k2, *peer_u, *peer_v, *final_g;
    float* out; unsigned char* ws;
};

__device__ __forceinline__ unsigned cvtpk(float lo, float hi) { unsigned r; asm("v_cvt_pk_bf16_f32 %0, %1, %2" : "=v"(r) : "v"(lo), "v"(hi)); return r; }
__device__ __forceinline__ unsigned pk_fp8x4(float a, float b, float c, float d) {
    a = __builtin_amdgcn_fmed3f(a, -440.f, 440.f); b = __builtin_amdgcn_fmed3f(b, -440.f, 440.f); c = __builtin_amdgcn_fmed3f(c, -440.f, 440.f); d = __builtin_amdgcn_fmed3f(d, -440.f, 440.f);
    int w = 0; w = __builtin_amdgcn_cvt_pk_fp8_f32(a, b, w, false); w = __builtin_amdgcn_cvt_pk_fp8_f32(c, d, w, true); return (unsigned)w; }
constexpr float F8_WS = 64.0f, F8_HS = 8.0f, F8_SGS = 8.0f, F8_CS = 16.0f, F8_XS = 8.0f;
__device__ __forceinline__ float bflo(unsigned w) { return __uint_as_float(w << 16); }
__device__ __forceinline__ float bfhi(unsigned w) { return __uint_as_float(w & 0xffff0000u); }
__device__ __forceinline__ float wave_sum(float v) {
    v += __uint_as_float(__builtin_amdgcn_update_dpp(0u, __float_as_uint(v), 0xB1, 0xF, 0xF, true));
    v += __uint_as_float(__builtin_amdgcn_update_dpp(0u, __float_as_uint(v), 0x4E, 0xF, 0xF, true));
    v += __uint_as_float(__builtin_amdgcn_update_dpp(0u, __float_as_uint(v), 0x141, 0xF, 0xF, true));
    v += __uint_as_float(__builtin_amdgcn_update_dpp(0u, __float_as_uint(v), 0x140, 0xF, 0xF, true));
    { const auto r = __builtin_amdgcn_permlane16_swap(__float_as_uint(v), __float_as_uint(v), false, false); v = __uint_as_float(r[0]) + __uint_as_float(r[1]); }
    { const auto r = __builtin_amdgcn_permlane32_swap(__float_as_uint(v), __float_as_uint(v), false, false); v = __uint_as_float(r[0]) + __uint_as_float(r[1]); }
    return v;
}
__device__ __forceinline__ float row16_sum(float v) {
    v += __uint_as_float(__builtin_amdgcn_update_dpp(0u, __float_as_uint(v), 0xB1, 0xF, 0xF, true));
    v += __uint_as_float(__builtin_amdgcn_update_dpp(0u, __float_as_uint(v), 0x4E, 0xF, 0xF, true));
    v += __uint_as_float(__builtin_amdgcn_update_dpp(0u, __float_as_uint(v), 0x141, 0xF, 0xF, true));
    v += __uint_as_float(__builtin_amdgcn_update_dpp(0u, __float_as_uint(v), 0x140, 0xF, 0xF, true));
    return v;
}
__device__ __forceinline__ float xrow_sum(float v) {
    { const auto r = __builtin_amdgcn_permlane16_swap(__float_as_uint(v), __float_as_uint(v), false, false); v = __uint_as_float(r[0]) + __uint_as_float(r[1]); }
    { const auto r = __builtin_amdgcn_permlane32_swap(__float_as_uint(v), __float_as_uint(v), false, false); v = __uint_as_float(r[0]) + __uint_as_float(r[1]); }
    return v;
}
__device__ __forceinline__ float sigmoid_f(float x) { return __builtin_amdgcn_rcpf(1.f + __expf(-x)); }
__device__ __forceinline__ float gelu_t(float x) { const float u = 0.7978845608028654f * (x + 0.044715f * x * x * x); return x * __builtin_amdgcn_rcpf(1.f + __expf(-2.f * u)); }
__device__ __forceinline__ void sincos_rad(float ang, float& sn, float& cs) {
    float rev = ang * 0.15915494309189535f; rev = rev - floorf(rev);
    sn = __builtin_amdgcn_sinf(rev); cs = __builtin_amdgcn_cosf(rev);
}
__device__ __forceinline__ float dot4(f32x4 a, f32x4 b) { return (a.x * b.x + a.y * b.y) + (a.z * b.z + a.w * b.w); }
#define LDS_WAIT() asm volatile("s_waitcnt lgkmcnt(0)" ::: "memory")

namespace pg8 {
constexpr int NTOK_ = 16384;
struct EpiEvenSplit {
    static constexpr bool PERM = true, AFTER_DRAIN = false;
    float ds; unsigned char* wsb;
    __device__ __forceinline__ void operator()(const f32x4 (&acc)[2][2][4][2], const Unit& u, int wr, int wc, int fr, int fq) const {
        { const int l_ = lane_id_v(); fr = l_ & 15; fq = l_ >> 4; }
        const int row0 = u.pm * BM + wr * 64 + fr; const int pn = u.pn;
        bf16_t* const UA = (bf16_t*)(wsb + WS_AB);
        if (pn < 4) {
#pragma unroll
            for (int ai = 0; ai < 2; ++ai)
#pragma unroll
                for (int m = 0; m < 4; ++m) { const int t = row0 + ai * HALF + m * 16;
#pragma unroll
                    for (int bj = 0; bj < 2; ++bj) { const int c = pn * 256 + bj * HALF + wc * 32 + 8 * fq; const f32x4 v0 = acc[ai][bj][m][0] * ds, v1 = acc[ai][bj][m][1] * ds;
                        u32x4 w; w.x = cvt_pk_bf16(v0[0], v0[1]); w.y = cvt_pk_bf16(v0[2], v0[3]); w.z = cvt_pk_bf16(v1[0], v1[1]); w.w = cvt_pk_bf16(v1[2], v1[3]);
                        *(u32x4*)(UA + ((size_t)(c >> 4) * 1024 + (t >> 4)) * 512 + (t & 15) * 16 + (c & 15)) = w; } }
            return;
        }
        bf16_t* base; int ldc, colt;
        if (pn < 8) { base = (bf16_t*)(wsb + WS_Q); ldc = 1024; colt = (pn - 4) * 256; } else { base = (bf16_t*)(wsb + (pn == 8 ? WS_K : WS_V)); ldc = 256; colt = 0; }
        const int col0 = colt + wc * 32 + 8 * fq;
#pragma unroll
        for (int ai = 0; ai < 2; ++ai)
#pragma unroll
            for (int m = 0; m < 4; ++m) { bf16_t* rowp = base + (size_t)(row0 + ai * HALF + m * 16) * ldc + col0;
#pragma unroll
                for (int bj = 0; bj < 2; ++bj) { const f32x4 v0 = acc[ai][bj][m][0] * ds, v1 = acc[ai][bj][m][1] * ds;
                    u32x4 w; w.x = cvt_pk_bf16(v0[0], v0[1]); w.y = cvt_pk_bf16(v0[2], v0[3]); w.z = cvt_pk_bf16(v1[0], v1[1]); w.w = cvt_pk_bf16(v1[2], v1[3]);
                    *(u32x4*)(rowp + bj * HALF) = w; } }
    }
};
template <int ACT> struct EpiBf16T {
    static constexpr bool PERM = true, AFTER_DRAIN = false;
    bf16_t* O; int ldc; float ds; float* lnst;
    __device__ __forceinline__ void operator()(const f32x4 (&acc)[2][2][4][2], const Unit& u, int wr, int wc, int fr, int fq) const {
        { const int l_ = lane_id_v(); fr = l_ & 15; fq = l_ >> 4; }
        const int row0 = u.pm * BM + wr * 64 + fr, col0 = u.pn * BM + wc * 32 + 8 * fq;
        const bool do_st = (ACT == 1) && lnst != nullptr && u.pn >= 16;
#pragma unroll
        for (int ai = 0; ai < 2; ++ai)
#pragma unroll
            for (int m = 0; m < 4; ++m) { const int trow = row0 + ai * HALF + m * 16;
                bf16_t* rowp = (ACT == 1) ? O + ((size_t)((trow >> 7) * 16 + (col0 >> 9)) * 128 + (trow & 127)) * 512 + (col0 & 511) : O + (size_t)trow * ldc + col0; float s1 = 0.f, s2 = 0.f;
#pragma unroll
                for (int bj = 0; bj < 2; ++bj) { f32x4 v0 = acc[ai][bj][m][0] * ds, v1 = acc[ai][bj][m][1] * ds;
                    if (ACT == 1) {
#pragma unroll
                        for (int e = 0; e < 4; ++e) { v0[e] = gelu_t(v0[e]); v1[e] = gelu_t(v1[e]); s1 += v0[e] + v1[e]; s2 += v0[e] * v0[e] + v1[e] * v1[e]; } }
                    u32x4 w; w.x = cvt_pk_bf16(v0[0], v0[1]); w.y = cvt_pk_bf16(v0[2], v0[3]); w.z = cvt_pk_bf16(v1[0], v1[1]); w.w = cvt_pk_bf16(v1[2], v1[3]);
                    *(u32x4*)(rowp + bj * HALF) = w; }
                if (ACT == 1) { if (do_st) {
                    s1 = xrow_sum(s1); s2 = xrow_sum(s2);
                    if (fq == 0) *(f32x2*)(lnst + ((size_t)((u.pn - 16) * 4 + wc) * NTOK_ + (row0 + ai * HALF + m * 16)) * 2) = (f32x2){s1, s2}; } }
            }
    }
};
struct EpiResid {
    static constexpr bool PERM = false, AFTER_DRAIN = false;
    const float* xin; float* xout; const float* gate; float ds;
    __device__ __forceinline__ void operator()(const f32x4 (&acc)[2][2][4][2], const Unit& u, int wr, int wc, int fr, int fq) const {
        { const int l_ = lane_id_v(); fr = l_ & 15; fq = l_ >> 4; }
        const int row0 = u.pm * BM + wr * 64 + fr, col0 = u.pn * BM + wc * 32 + 4 * fq;
        const float* gp = gate + (size_t)((u.pm * BM) >> 13) * 12288 + col0;
        f32x4 gv[2][2];
#pragma unroll
        for (int bj = 0; bj < 2; ++bj)
#pragma unroll
            for (int n = 0; n < 2; ++n) gv[bj][n] = *(const f32x4*)(gp + bj * HALF + n * 16) * ds;
#pragma unroll
        for (int ai = 0; ai < 2; ++ai)
#pragma unroll
            for (int m = 0; m < 4; ++m) { const size_t off = (size_t)(row0 + ai * HALF + m * 16) * 2048 + col0;
#pragma unroll
                for (int bj = 0; bj < 2; ++bj)
#pragma unroll
                    for (int n = 0; n < 2; ++n) { const f32x4 xi = *(const f32x4*)(xin + off + bj * HALF + n * 16);
                        *(f32x4*)(xout + off + bj * HALF + n * 16) = xi + gv[bj][n] * acc[ai][bj][m][n]; } }
    }
};
struct EpiF32B {
    static constexpr bool PERM = false, AFTER_DRAIN = false;
    float* C; int ldc; size_t bs;
    __device__ __forceinline__ void operator()(const f32x4 (&acc)[2][2][4][2], const Unit& u, int wr, int wc, int fr, int fq) const {
        { const int l_ = lane_id_v(); fr = l_ & 15; fq = l_ >> 4; }
        char* base = (char*)(C + (size_t)u.pb * bs + (size_t)(u.pm * BM) * ldc);
        const unsigned off0 = (unsigned)((wr * 64 + fr) * ldc + u.pn * BM + wc * 32 + 4 * fq) * 4u;
#pragma unroll
        for (int ai = 0; ai < 2; ++ai)
#pragma unroll
            for (int m = 0; m < 4; ++m) { const unsigned off = off0 + (unsigned)((ai * HALF + m * 16) * ldc) * 4u;
#pragma unroll
                for (int bj = 0; bj < 2; ++bj)
#pragma unroll
                    for (int n = 0; n < 2; ++n) *(f32x4*)(base + off + (bj * HALF + n * 16) * 4) = acc[ai][bj][m][n]; }
    }
};
struct EpiS5Glu {
    static constexpr bool PERM = false, AFTER_DRAIN = false;
    unsigned char* CAT; const PG8_LAS float* wl;
    __device__ __forceinline__ void operator()(const f32x4 (&acc)[2][2][4][2], const Unit& u, int wr, int wc, int fr, int fq) const {
        { const int l_ = lane_id_v(); fr = l_ & 15; fq = l_ >> 4; }
        const int g = u.pb;
#pragma unroll
        for (int ai = 0; ai < 2; ++ai)
#pragma unroll
            for (int m = 0; m < 4; ++m) {
                const int chunk = u.pm * BM + ai * HALF + wr * 64 + m * 16 + fr, token = chunk * 16 + wc * 4 + fq;
                float y[16];
#pragma unroll
                for (int bj = 0; bj < 2; ++bj)
#pragma unroll
                    for (int n = 0; n < 2; ++n)
#pragma unroll
                        for (int j = 0; j < 4; ++j) y[8 * bj + 4 * n + j] = gelu_t(acc[ai][bj][m][n][j]);
                f32x4 z[4];
#pragma unroll
                for (int kq = 0; kq < 4; ++kq) z[kq] = *(const PG8_LAS f32x4*)(wl + 256 + 4 * kq);
#pragma unroll
                for (int h = 0; h < 16; ++h)
#pragma unroll
                    for (int kq = 0; kq < 4; ++kq) z[kq] += *(const PG8_LAS f32x4*)(wl + h * 16 + 4 * kq) * y[h];
                float o[16];
#pragma unroll
                for (int k = 0; k < 16; ++k) o[k] = y[k] * sigmoid_f(z[k >> 2][k & 3]);
                u32x4 w; w.x = pk_fp8x4(o[0] * F8_CS, o[1] * F8_CS, o[2] * F8_CS, o[3] * F8_CS); w.y = pk_fp8x4(o[4] * F8_CS, o[5] * F8_CS, o[6] * F8_CS, o[7] * F8_CS);
                w.z = pk_fp8x4(o[8] * F8_CS, o[9] * F8_CS, o[10] * F8_CS, o[11] * F8_CS); w.w = pk_fp8x4(o[12] * F8_CS, o[13] * F8_CS, o[14] * F8_CS, o[15] * F8_CS);
                *(u32x4*)(CAT + (size_t)token * 2048 + g * 16) = w;
                asm volatile("" ::: "memory");
            }
    }
};
template <bool FIRST> struct EpiResidB {
    static constexpr bool PERM = false, AFTER_DRAIN = false;
    const float* xin; bf16_t* xb; const float* gate; float* rowsq; unsigned char* x8; float ds;
    __device__ __forceinline__ void operator()(const f32x4 (&acc)[2][2][4][2], const Unit& u, int wr, int wc, int fr, int fq) const {
        { const int l_ = lane_id_v(); fr = l_ & 15; fq = l_ >> 4; }
        const int row0 = u.pm * BM + wr * 64 + fr, col0 = u.pn * BM + wc * 32 + 4 * fq;
        const float* gp = gate + (size_t)((u.pm * BM) >> 13) * 12288 + col0; float* const rq = rowsq;
        f32x4 gv[2][2];
#pragma unroll
        for (int bj = 0; bj < 2; ++bj)
#pragma unroll
            for (int n = 0; n < 2; ++n) gv[bj][n] = *(const f32x4*)(gp + bj * HALF + n * 16) * ds;
#pragma unroll
        for (int ai = 0; ai < 2; ++ai) {
            f32x4 xi[4][2][2];
#pragma unroll
            for (int m = 0; m < 4; ++m) { const size_t off = (size_t)(row0 + ai * HALF + m * 16) * 2048 + col0;
#pragma unroll
                for (int bj = 0; bj < 2; ++bj)
#pragma unroll
                    for (int n = 0; n < 2; ++n) {
                        if (FIRST) xi[m][bj][n] = *(const f32x4*)(xin + off + bj * HALF + n * 16);
                        else { const u32x2 w = *(const u32x2*)(xb + off + bj * HALF + n * 16); xi[m][bj][n] = (f32x4){__uint_as_float(w.x << 16), __uint_as_float(w.x & 0xffff0000u), __uint_as_float(w.y << 16), __uint_as_float(w.y & 0xffff0000u)}; } } }
            asm volatile("" ::: "memory");
#pragma unroll
            for (int m = 0; m < 4; ++m) { const int row = row0 + ai * HALF + m * 16; const size_t off = (size_t)row * 2048 + col0; float ss = 0.f;
#pragma unroll
                for (int bj = 0; bj < 2; ++bj)
#pragma unroll
                    for (int n = 0; n < 2; ++n) { const f32x4 xo = xi[m][bj][n] + gv[bj][n] * acc[ai][bj][m][n]; ss += (xo[0] * xo[0] + xo[1] * xo[1]) + (xo[2] * xo[2] + xo[3] * xo[3]);
                        u32x2 o; o.x = cvt_pk_bf16(xo[0], xo[1]); o.y = cvt_pk_bf16(xo[2], xo[3]); *(u32x2*)(xb + off + bj * HALF + n * 16) = o;
                        *(unsigned*)(x8 + off + bj * HALF + n * 16) = pk_fp8x4(xo[0] * F8_XS, xo[1] * F8_XS, xo[2] * F8_XS, xo[3] * F8_XS); }
                ss = xrow_sum(ss);
                if (fq == 0) rq[(size_t)(u.pn * 4 + wc) * NTOK_ + row] = ss; }
        }
    }
};
struct EpiQ {
    static constexpr bool PERM = true, AFTER_DRAIN = false;
    bf16_t* O; const float* rowsq; const float* bias; float ds;
    __device__ __forceinline__ void operator()(const f32x4 (&acc)[2][2][4][2], const Unit& u, int wr, int wc, int fr, int fq) const {
        { const int l_ = lane_id_v(); fr = l_ & 15; fq = l_ >> 4; }
        const int row0 = u.pm * BM + wr * 64 + fr, col0 = u.pn * BM + wc * 32 + 8 * fq;
        const float* bp = bias + (size_t)((u.pm * BM) >> 13) * 2048 + col0;
        f32x4 bv[2][2];
#pragma unroll
        for (int bj = 0; bj < 2; ++bj)
#pragma unroll
            for (int n = 0; n < 2; ++n) bv[bj][n] = *(const f32x4*)(bp + bj * HALF + 4 * n);
        float rstd[2][4];
#pragma unroll
        for (int ai = 0; ai < 2; ++ai)
#pragma unroll
            for (int m = 0; m < 4; ++m) { const int row = row0 + ai * HALF + m * 16; float sq = 0.f;
#pragma unroll
                for (int t = 0; t < 8; ++t) sq += rowsq[(size_t)(fq * 8 + t) * NTOK_ + row];
                rstd[ai][m] = rsqrtf(xrow_sum(sq) * (1.0f / 2048.0f) + 1e-6f) * ds; }
#pragma unroll
        for (int ai = 0; ai < 2; ++ai)
#pragma unroll
            for (int m = 0; m < 4; ++m) { const int row = row0 + ai * HALF + m * 16; bf16_t* rowp = O + (size_t)row * 2048 + col0;
#pragma unroll
                for (int bj = 0; bj < 2; ++bj) { const f32x4 v0 = acc[ai][bj][m][0] * rstd[ai][m] + bv[bj][0], v1 = acc[ai][bj][m][1] * rstd[ai][m] + bv[bj][1];
                    u32x4 w; w.x = cvt_pk_bf16(v0[0], v0[1]); w.y = cvt_pk_bf16(v0[2], v0[3]); w.z = cvt_pk_bf16(v1[0], v1[1]); w.w = cvt_pk_bf16(v1[2], v1[3]);
                    *(u32x4*)(rowp + bj * HALF) = w; } }
    }
};
struct BatchOrder {
    int nM, nU, G, c;
    __device__ __forceinline__ bool next(int i, Unit& u) const { const int L = i * G + c; if (L >= nU) return false; u.pb = L / nM; u.pm = L % nM; u.pn = 0; return true; }
    __device__ __forceinline__ void a_ready(const Unit&) const {}
    __device__ __forceinline__ void done(const Unit&) const {}
};
}

__device__ __forceinline__ unsigned f2bf_rne(float f) { unsigned u = __builtin_bit_cast(unsigned, f); return (u + 0x7fffu + ((u >> 16) & 1u)) >> 16; }
__device__ __forceinline__ unsigned pk2(float lo, float hi) { return f2bf_rne(lo) | (f2bf_rne(hi) << 16); }
__device__ __forceinline__ void p0_transpose_item(const float* W, int K, int N, bf16_t* WT, LAS float* scr, int item, int lane) {
    const int nblk = N / 32, kb = item / nblk, nb = item % nblk, k0 = 64 * kb, n0 = 32 * nb;
#pragma unroll 8
    for (int i = 0; i < 32; ++i) { const int kk = 2 * i + (lane >> 5); scr[kk * 33 + (lane & 31)] = W[(size_t)(k0 + kk) * N + n0 + (lane & 31)]; }
    LDS_WAIT(); asm volatile("" ::: "memory");
    const int c = lane & 7;
#pragma unroll
    for (int j = 0; j < 4; ++j) { const int n = (lane >> 3) + 8 * j; const LAS float* s = scr + (8 * c) * 33 + n;
        u32x4 o; o.x = pk2(s[0 * 33], s[1 * 33]); o.y = pk2(s[2 * 33], s[3 * 33]); o.z = pk2(s[4 * 33], s[5 * 33]); o.w = pk2(s[6 * 33], s[7 * 33]);
        *(u32x4*)(WT + (size_t)(n0 + n) * K + k0 + 8 * c) = o; }
    LDS_WAIT(); asm volatile("" ::: "memory");
}

__device__ __forceinline__ void p0_transpose_item_f8(const float* W, int K, int N, unsigned char* WT, LAS float* scr, int item, int lane, float sc) {
    const int nblk = N / 32, kb = item / nblk, nb = item % nblk, k0 = 64 * kb, n0 = 32 * nb;
#pragma unroll 8
    for (int i = 0; i < 32; ++i) { const int kk = 2 * i + (lane >> 5); scr[kk * 33 + (lane & 31)] = W[(size_t)(k0 + kk) * N + n0 + (lane & 31)] * sc; }
    LDS_WAIT(); asm volatile("" ::: "memory");
    const int c = lane & 7;
#pragma unroll
    for (int j = 0; j < 4; ++j) { const int n = (lane >> 3) + 8 * j; const LAS float* s = scr + (8 * c) * 33 + n;
        u32x2 o; o.x = pk_fp8x4(s[0 * 33], s[1 * 33], s[2 * 33], s[3 * 33]); o.y = pk_fp8x4(s[4 * 33], s[5 * 33], s[6 * 33], s[7 * 33]);
        *(u32x2*)(WT + (size_t)(n0 + n) * K + k0 + 8 * c) = o; }
    LDS_WAIT(); asm volatile("" ::: "memory");
}

__device__ __forceinline__ void s5_gen_group(const P& p, LAS unsigned char* lds, int g, int tid) {
    LAS f32x2* pw = (LAS f32x2*)lds;
    LAS f32x2* Cc = (LAS f32x2*)(lds + 17408);
    LAS f32x2* Bb = (LAS f32x2*)(lds + 17408 + 16384);
    LAS float* Kt = (LAS float*)(lds + 17408 + 32768);
    LAS float* dsk = (LAS float*)(lds + 17408 + 65536);
    __syncthreads();
    if (tid < 128) {
        const int d = tid >> 6, pp = tid & 63, dgp = (d * 64 + g) * 64 + pp;
        const float lr = fminf(p.lam_re[dgp], -1e-4f), li = p.lam_im[dgp], dt = __expf(p.log_dt[d * 64 + g]);
        const float lrdt = lr * dt, ang = li * dt;
#pragma unroll 1
        for (int e = 0; e <= 16; ++e) { const float mag = __expf((float)e * lrdt); float sn, cs; sincos_rad((float)e * ang, sn, cs); pw[e * 128 + tid] = (f32x2){mag * cs, mag * sn}; }
        const f32x2 a1 = pw[128 + tid]; const float abr = a1.x, abi = a1.y;
        const float den = lr * lr + li * li, nr = abr - 1.0f;
        const float cre = (nr * lr + abi * li) / den, cim = (abi * lr - nr * li) / den;
        ((f32x2*)(p.ws + WS_S5A))[dgp] = pw[16 * 128 + tid];
#pragma unroll 4
        for (int h = 0; h < 16; ++h) { const float br = p.b_re[dgp * 16 + h], bi = p.b_im[dgp * 16 + h]; Bb[(d * 64 + pp) * 16 + h] = (f32x2){cre * br - cim * bi, cre * bi + cim * br}; }
    }
    for (int i = tid; i < 2048; i += 512) { const int d = i >> 10, h = (i >> 6) & 15, pp = i & 63; const size_t src = ((size_t)(d * 64 + g) * 16 + h) * 64 + pp; Cc[i] = (f32x2){p.c_re[src], p.c_im[src]}; }
    if (tid < 16) dsk[tid] = p.s5_d[g * 16 + tid];
    __syncthreads();
    {
        const int d = tid >> 8, tau = (tid >> 4) & 15, h = tid & 15; float acc[16];
#pragma unroll
        for (int hp = 0; hp < 16; ++hp) acc[hp] = 0.f;
#pragma unroll 2
        for (int pp = 0; pp < 64; ++pp) { const f32x2 c = Cc[(d * 16 + h) * 64 + pp], w = pw[tau * 128 + d * 64 + pp]; const float tx = c.x * w.x - c.y * w.y, ty = c.x * w.y + c.y * w.x;
#pragma unroll
            for (int hp = 0; hp < 16; ++hp) { const f32x2 bb = Bb[(d * 64 + pp) * 16 + hp]; acc[hp] += tx * bb.x - ty * bb.y; } }
#pragma unroll
        for (int hp = 0; hp < 16; ++hp) Kt[(d * 16 + tau) * 256 + h * 16 + hp] = acc[hp];
    }
    __syncthreads();
    bf16_t* Wy = (bf16_t*)(p.ws + WS_WY) + (size_t)g * 256 * 512;
#pragma unroll 1
    for (int idx = tid; idx < 256 * 256; idx += 512) {
        const int np = idx >> 8, k0 = (idx & 255) * 2;
        const int bj = (np >> 7) & 1, wc = (np >> 5) & 3, n = (np >> 4) & 1, fq = (np >> 2) & 3, j = np & 3, i = wc * 4 + fq, h = 8 * bj + 4 * n + j;
        float v[2];
#pragma unroll
        for (int kk = 0; kk < 2; ++kk) { const int k = k0 + kk;
            if (k < 256) { const int s = k >> 4, hp = k & 15;
                if (s < i) v[kk] = Kt[(i - s) * 256 + h * 16 + hp]; else if (s > i) v[kk] = Kt[(16 + (s - i)) * 256 + h * 16 + hp];
                else v[kk] = Kt[h * 16 + hp] + Kt[16 * 256 + h * 16 + hp] + (h == hp ? dsk[h] : 0.f);
            } else { const int kc = k - 256, d = kc >> 7, pp = (kc >> 1) & 63, ri = kc & 1, e = d ? 16 - i : i + 1;
                const f32x2 c = Cc[(d * 16 + h) * 64 + pp], w = pw[e * 128 + d * 64 + pp]; v[kk] = ri ? -(c.x * w.y + c.y * w.x) : (c.x * w.x - c.y * w.y); } }
        *(unsigned*)(Wy + (size_t)np * 512 + k0) = cvtpk(v[0], v[1]);
    }
    bf16_t* Wsum = (bf16_t*)(p.ws + WS_WSUM) + (size_t)g * 256 * 256;
#pragma unroll 1
    for (int idx = tid; idx < 256 * 128; idx += 512) {
        const int r = idx >> 7, k0 = (idx & 127) * 2, d = r >> 7, pp = (r >> 1) & 63, ri = r & 1;
        float v[2];
#pragma unroll
        for (int kk = 0; kk < 2; ++kk) { const int k = k0 + kk, s = k >> 4, hp = k & 15, e = d ? s : 15 - s;
            const f32x2 w = pw[e * 128 + d * 64 + pp], bb = Bb[(d * 64 + pp) * 16 + hp]; v[kk] = ri ? (w.x * bb.y + w.y * bb.x) : (w.x * bb.x - w.y * bb.y); }
        *(unsigned*)(Wsum + (size_t)r * 256 + k0) = cvtpk(v[0], v[1]);
    }
}

#ifndef PRO_DBL
#define PRO_DBL 0
#endif
#define PRO_REP(b) for (int _pr = 0; _pr < 1 + ((PRO_DBL >> (b)) & 1); ++_pr)
__device__ __forceinline__ void phase_prologue(const P& p, LAS unsigned char* lds, int tid, int lane, int wid) {
    unsigned char* ws = p.ws;
    LAS float* cact = (LAS float*)lds;
    LAS float* red = (LAS float*)(lds + 16384);
    for (int i = tid; i < 4096; i += 512) { const float cv = p.c[i]; cact[i] = cv * sigmoid_f(cv); }
    __syncthreads();
    float* mod = (float*)(ws + WS_MOD);
    PRO_REP(0) for (int item = blockIdx.x; item < 192; item += gridDim.x) {
        const int l = item / 96, cb = item % 96, cg4 = tid & 31, rl = tid >> 5;
        const float* W = p.ada_w + (size_t)l * 2048 * 12288 + cb * 128 + cg4 * 4;
        f32x4 a0 = {0.f, 0.f, 0.f, 0.f}, a1 = {0.f, 0.f, 0.f, 0.f};
#pragma unroll 8
        for (int r = rl; r < 2048; r += 16) { const f32x4 w = __builtin_nontemporal_load((const f32x4*)(W + (size_t)r * 12288)); const float c0 = cact[r], c1 = cact[2048 + r]; a0 += w * c0; a1 += w * c1; }
        *(LAS f32x4*)(red + (rl * 32 + cg4) * 8) = a0; *(LAS f32x4*)(red + (rl * 32 + cg4) * 8 + 4) = a1;
        __syncthreads();
        if (tid < 256) { const int col = tid & 127, b = tid >> 7; float s = 0.f;
#pragma unroll
            for (int r2 = 0; r2 < 16; ++r2) s += red[(r2 * 32 + (col >> 2)) * 8 + b * 4 + (col & 3)];
            s += p.ada_b[l * 12288 + cb * 128 + col]; mod[(l * 2 + b) * 12288 + cb * 128 + col] = s; }
        __syncthreads();
    }
    PRO_REP(1) {
        LAS float* scr = (LAS float*)(lds + 32768 + wid * 8448);
        const int gw = blockIdx.x * 8 + wid, ngw = gridDim.x * 8;
        constexpr int I0 = 32 * 80, I1 = 32 * 64, I2 = 32 * 256, I3 = 64 * 64, NIT = I0 + I1 + I2 + I3;
        for (int it = gw; it < NIT; it += ngw) {
            int r = it;
            if (r < I0) { p0_transpose_item_f8(p.even_w_in, 2048, 2560, ws + WS_WINE, scr, r, lane, F8_WS); continue; } r -= I0;
            if (r < I1) { p0_transpose_item_f8(p.even_w_out, 2048, 2048, ws + WS_WOUTE, scr, r, lane, F8_WS); continue; } r -= I1;
            if (r < I2) { p0_transpose_item_f8(p.odd_w_in, 2048, 8192, ws + WS_WINO, scr, r, lane, F8_WS); continue; } r -= I2;
            p0_transpose_item_f8(p.odd_w_out, 4096, 2048, ws + WS_WOUTO, scr, r, lane, F8_WS);
        }
    }
    const long gtid = (long)blockIdx.x * 512 + tid, ngt = (long)gridDim.x * 512;
    PRO_REP(2) {
        const int gw = blockIdx.x * 8 + wid, ngw = gridDim.x * 8;
        float* psc = (float*)(ws + WS_PSC);
        for (int row0 = 4 * gw; row0 < 4 * 16384; row0 += 4 * ngw) {
            f32x4 v[4][8]; float am[4]; const float* src[4]; unsigned char* dst[4];
#pragma unroll
            for (int rr = 0; rr < 4; ++rr) { const int row = row0 + rr; const bool tv = row >= 2 * 16384; const int r = tv ? row - 2 * 16384 : row;
                const bool sl = tv ? PEER_SLICE_V : PEER_SLICE_U;
                src[rr] = (tv ? p.peer_v : p.peer_u) + (size_t)r * 2048; dst[rr] = ws + (tv ? WS_PV : WS_PU) + (size_t)r * PEER_ROWB;
#pragma unroll
                for (int j = 0; j < 8; ++j) v[rr][j] = __builtin_nontemporal_load((const f32x4*)(src[rr] + (sl ? 4 * (lane + 64 * j) : 16 * lane + 1024 * (j >> 2) + 4 * (j & 3)))); }
#pragma unroll
            for (int rr = 0; rr < 4; ++rr) { am[rr] = 0.f;
#pragma unroll
                for (int j = 0; j < 8; ++j) am[rr] = fmaxf(am[rr], fmaxf(fmaxf(fabsf(v[rr][j].x), fabsf(v[rr][j].y)), fmaxf(fabsf(v[rr][j].z), fabsf(v[rr][j].w))));
#pragma unroll
                for (int o = 32; o > 0; o >>= 1) am[rr] = fmaxf(am[rr], __shfl_xor(am[rr], o)); }
#pragma unroll
            for (int rr = 0; rr < 4; ++rr) { const int row = row0 + rr;
                const float sc = am[rr] > 0.f ? 7.5f / am[rr] : 1.0f;
                if (lane == 0) psc[row] = am[rr] > 0.f ? am[rr] * (1.0f / 7.5f) : 1.0f;
                f32x16 ev, od;
#pragma unroll
                for (int j = 0; j < 8; ++j) { const f32x4 t = v[rr][j] * sc; ev[2 * j] = t.x; od[2 * j] = t.y; ev[2 * j + 1] = t.z; od[2 * j + 1] = t.w; }
                const u32x6 q = __builtin_amdgcn_cvt_scalef32_2xpk16_fp6_f32(ev, od, 1.0f);
                const bool tv = row >= 2 * 16384; const int r = tv ? row - 2 * 16384 : row;
                if (!(tv ? PEER_SLICE_V : PEER_SLICE_U)) {
                    *(u32x4*)(dst[rr] + 16 * lane) = (u32x4){q[0], q[1], q[2], q[3]};
                    *(u32x2*)(dst[rr] + 1024 + 8 * lane) = (u32x2){q[4], q[5]};
                } else {
                    unsigned char* sb = ws + (tv ? WS_PV : WS_PU) + (size_t)(r >> 14) * 16384 * PEER_ROWB + (size_t)(r & 16383) * 192 + 12 * (lane >> 2) + 4 * (lane & 3);
                    const unsigned pc[8] = {q[0] & 0xFFFFFFu, (q[0] >> 24) | ((q[1] & 0xFFFFu) << 8), (q[1] >> 16) | ((q[2] & 0xFFu) << 16), q[2] >> 8,
                                            q[3] & 0xFFFFFFu, (q[3] >> 24) | ((q[4] & 0xFFFFu) << 8), (q[4] >> 16) | ((q[5] & 0xFFu) << 16), q[5] >> 8};
                    const int i8 = 8 * (lane & 3);
#pragma unroll
                    for (int j = 0; j < 8; ++j) { const unsigned nx = __builtin_amdgcn_update_dpp(0u, pc[j], 0xF9, 0xF, 0xF, true);
                        const unsigned d = (pc[j] >> i8) | (nx << (24 - i8));
                        if ((lane & 3) < 3) *(unsigned*)(sb + (size_t)j * 16384 * 192) = d; }
                } }
        }
    }
    PRO_REP(3) for (int g = (int)gridDim.x - 1 - (int)blockIdx.x; g < 64; g += gridDim.x) s5_gen_group(p, lds, g, tid);
    for (long i = gtid; i < 65536; i += ngt) { const int layer = (int)(i >> 15), half = (int)(i >> 14) & 1, r = (int)(i & 16383);
        ((bf16_t*)(ws + WS_KEYS))[i] = (bf16_t)f2bf_rne((half ? p.peer_k2 : p.peer_k1)[layer * 16384 + r]); }
    for (long i = gtid; i < 131072; i += ngt) ((bf16_t*)(ws + WS_WSB))[i] = (bf16_t)f2bf_rne(p.sgu_w[i]);
}

template <bool OUT8>
__device__ __forceinline__ void phase_adaln(const float* xin, void* hout_, const float* g, const float* shift, const float* scale, int gw, int ngw, int lane) {
    for (int b = 0; b < 2; ++b) {
        f32x4 A[8], Bc[8];
#pragma unroll
        for (int j = 0; j < 8; ++j) { const int c = 8 * lane + 512 * (j >> 1) + 4 * (j & 1);
            const f32x4 gv = *(const f32x4*)(g + c), sc = *(const f32x4*)(scale + b * 12288 + c); A[j] = gv * (sc + 1.0f); Bc[j] = *(const f32x4*)(shift + b * 12288 + c); }
#pragma unroll 1
        for (int row0 = b * 8192 + gw; row0 < (b + 1) * 8192; row0 += 4 * ngw) {
            f32x4 v[4][8];
#pragma unroll
            for (int k = 0; k < 4; ++k) { const int row = row0 + k * ngw < (b + 1) * 8192 ? row0 + k * ngw : row0; const float* xr = xin + (size_t)row * 2048 + 8 * lane;
#pragma unroll
                for (int j = 0; j < 8; ++j) v[k][j] = *(const f32x4*)(xr + 512 * (j >> 1) + 4 * (j & 1)); }
#pragma unroll
            for (int k = 0; k < 4; ++k) { const int row = row0 + k * ngw < (b + 1) * 8192 ? row0 + k * ngw : row0; float ss = 0.f;
#pragma unroll
                for (int j = 0; j < 8; ++j) ss += dot4(v[k][j], v[k][j]);
                ss = wave_sum(ss); const float rstd = rsqrtf(ss * (1.0f / 2048.0f) + 1e-6f);
                bf16_t* hr = (bf16_t*)hout_ + (size_t)row * 2048 + 8 * lane; unsigned char* hr8 = (unsigned char*)hout_ + (size_t)row * 2048 + 8 * lane;
#pragma unroll
                for (int j = 0; j < 4; ++j) { const f32x4 y0 = v[k][2 * j] * rstd * A[2 * j] + Bc[2 * j], y1 = v[k][2 * j + 1] * rstd * A[2 * j + 1] + Bc[2 * j + 1];
                    if (OUT8) { u32x2 o; o.x = pk_fp8x4(y0.x * F8_HS, y0.y * F8_HS, y0.z * F8_HS, y0.w * F8_HS); o.y = pk_fp8x4(y1.x * F8_HS, y1.y * F8_HS, y1.z * F8_HS, y1.w * F8_HS); *(u32x2*)(hr8 + 512 * j) = o; }
                    else { u32x4 o; o.x = cvtpk(y0.x, y0.y); o.y = cvtpk(y0.z, y0.w); o.z = cvtpk(y1.x, y1.y); o.w = cvtpk(y1.z, y1.w);
                    *(u32x4*)(hr + 512 * j) = o; } } }
        }
    }
}

__device__ __forceinline__ void phase_fold_wq(const P& p, LAS unsigned char* lds, int tid, int lane, int wid) {
    unsigned char* ws = p.ws; const float* mod = (const float*)(ws + WS_MOD);
    for (long i = (long)blockIdx.x * 512 + tid; i < 2 * 2 * 2048; i += (long)gridDim.x * 512) { const int l = (int)(i >> 12), b = (int)(i >> 11) & 1, c = (int)(i & 2047);
        float* ab = (float*)(ws + WS_ABT) + (size_t)(l * 2 + b) * 4096;
        ab[c] = p.norm_g[(l * 2 + 1) * 2048 + c] * (1.0f + mod[(size_t)(l * 2 + b) * 12288 + 4 * 2048 + c]); ab[2048 + c] = mod[(size_t)(l * 2 + b) * 12288 + 3 * 2048 + c]; }
    LAS float* scr = (LAS float*)(lds + wid * 8448);
    const int gw = blockIdx.x * 8 + wid, ngw = gridDim.x * 8;
    for (int it = gw; it < 2 * 2048; it += ngw) {
        const int l = it >> 11, item = it & 2047, kb = item >> 6, nb = item & 63, k0 = 64 * kb, n0 = 32 * nb;
        const float* W = p.peer_wq + (size_t)l * 2048 * 2048;
#pragma unroll 8
        for (int i = 0; i < 32; ++i) { const int kk = 2 * i + (lane >> 5); scr[kk * 33 + (lane & 31)] = W[(size_t)(k0 + kk) * 2048 + n0 + (lane & 31)]; }
        LDS_WAIT(); asm volatile("" ::: "memory");
        const int c = lane & 7;
#pragma unroll
        for (int b = 0; b < 2; ++b) {
            const float* mb = mod + (size_t)(l * 2 + b) * 12288; const float* ng = p.norm_g + (l * 2 + 1) * 2048;
            float A[8];
#pragma unroll
            for (int t = 0; t < 8; ++t) A[t] = ng[k0 + 8 * c + t] * (1.0f + mb[4 * 2048 + k0 + 8 * c + t]);
            unsigned char* WT = ws + WS_WQF + (size_t)(l * 2 + b) * 2048 * 2048;
#pragma unroll
            for (int t = 0; t < 8; ++t) A[t] *= F8_WS;
#pragma unroll
            for (int j = 0; j < 4; ++j) { const int n = (lane >> 3) + 8 * j; const LAS float* s = scr + (8 * c) * 33 + n;
                u32x2 o; o.x = pk_fp8x4(s[0 * 33] * A[0], s[1 * 33] * A[1], s[2 * 33] * A[2], s[3 * 33] * A[3]); o.y = pk_fp8x4(s[4 * 33] * A[4], s[5 * 33] * A[5], s[6 * 33] * A[6], s[7 * 33] * A[7]);
                *(u32x2*)(WT + (size_t)(n0 + n) * 2048 + k0 + 8 * c) = o; }
            { const int n = lane & 31, kh = lane >> 5; float acc = 0.f;
#pragma unroll 8
              for (int t = 0; t < 32; ++t) acc += scr[(32 * kh + t) * 33 + n] * mb[3 * 2048 + k0 + 32 * kh + t];
              acc += __shfl_xor(acc, 32);
              if (lane < 32) ((float*)(ws + WS_BIASP))[((size_t)(l * 2 + b) * 32 + kb) * 2048 + n0 + n] = acc; }
        }
        LDS_WAIT(); asm volatile("" ::: "memory");
    }
}

__device__ __forceinline__ void phase_bias_reduce(const P& p, int tid) {
    for (long i = (long)blockIdx.x * 512 + tid; i < 2 * 2 * 2048; i += (long)gridDim.x * 512) { const int lb = (int)(i >> 11), n = (int)(i & 2047); float acc = 0.f;
#pragma unroll 8
        for (int kb = 0; kb < 32; ++kb) acc += ((const float*)(p.ws + WS_BIASP))[((size_t)lb * 32 + kb) * 2048 + n];
        ((float*)(p.ws + WS_BIASQ))[i] = acc; }
}
__device__ __forceinline__ void phase_qkprep(const P& p, int gw, int ngw, int lane) {
    bf16_t* Q = (bf16_t*)(p.ws + WS_Q); bf16_t* K = (bf16_t*)(p.ws + WS_K);
    const int sub = lane >> 4, ll = lane & 15;
    float inv[4], gq[8], gk[8];
#pragma unroll
    for (int e = 0; e < 4; ++e) inv[e] = __builtin_amdgcn_exp2f(-(float)((4 * ll + e) & 31) * 0.41524101186092029f);
#pragma unroll
    for (int e = 0; e < 8; ++e) { gq[e] = p.q_g[8 * ll + e]; gk[e] = p.k_g[8 * ll + e]; }
#pragma unroll 2
    for (int it = gw; it < NTOK * 10 / 4; it += ngw) {
        const int hr = 4 * it + sub, token = hr / 10, hh = hr - token * 10;
        u32x4* ptr = hh < 8 ? (u32x4*)(Q + (size_t)token * 1024 + hh * 128 + 8 * ll) : (u32x4*)(K + (size_t)token * 256 + (hh - 8) * 128 + 8 * ll);
        const u32x4 w = *ptr;
        float x[8] = {bflo(w.x), bfhi(w.x), bflo(w.y), bfhi(w.y), bflo(w.z), bfhi(w.z), bflo(w.w), bfhi(w.w)};
        float ss = 0.f;
#pragma unroll
        for (int e = 0; e < 8; ++e) ss += x[e] * x[e];
        ss = row16_sum(ss);
        const float r = rsqrtf(ss * (1.0f / 128.0f) + 1e-6f);
        const int s = token & 8191; const float pos = (float)(ll < 8 ? (s >> 6) : (s & 63));
        unsigned o[4];
#pragma unroll
        for (int e = 0; e < 4; ++e) { const float x1 = x[2 * e] * r * (hh < 8 ? gq[2 * e] : gk[2 * e]), x2 = x[2 * e + 1] * r * (hh < 8 ? gq[2 * e + 1] : gk[2 * e + 1]);
            float sn, cs; sincos_rad(pos * inv[e], sn, cs); o[e] = cvtpk(x1 * cs - x2 * sn, x1 * sn + x2 * cs); }
        *ptr = (u32x4){o[0], o[1], o[2], o[3]};
    }
}

__device__ __forceinline__ void phase_s5scan(const P& p, LAS unsigned char* lds, int lane, int wid) {
    const f32x2* A16 = (const f32x2*)(p.ws + WS_S5A);
    LAS f32x2* agg = (LAS f32x2*)lds;
    for (int item = blockIdx.x; item < 256; item += gridDim.x) {
        const int b = item >> 7, g = (item >> 1) & 63, d = item & 1;
        const f32x2 a = A16[(d * 64 + g) * 64 + lane];
        const float* S = (const float*)(p.ws + WS_SS) + ((size_t)g * 1024 + b * 512) * 256 + d * 128 + 2 * lane;
        bf16_t* HIN = (bf16_t*)(p.ws + WS_AB) + ((size_t)g * 1024 + b * 512) * 512 + 256 + d * 128 + 2 * lane;
        const int sA = 2 * wid + (d ? 1 : 0), sB = 2 * wid + (d ? 0 : 1), ordA = d ? 15 - sA : sA;
        float ar = 0.f, ai = 0.f, br = 0.f, bi = 0.f;
#pragma unroll 16
        for (int k = 0; k < 32; ++k) { const int o = d ? 31 - k : k; const f32x2 va = *(const f32x2*)(S + (size_t)(32 * sA + o) * 256), vb = *(const f32x2*)(S + (size_t)(32 * sB + o) * 256);
            const float nar = a.x * ar - a.y * ai + va.x, nai = a.x * ai + a.y * ar + va.y, nbr = a.x * br - a.y * bi + vb.x, nbi = a.x * bi + a.y * br + vb.y; ar = nar; ai = nai; br = nbr; bi = nbi; }
        __syncthreads();
        agg[ordA * 64 + lane] = (f32x2){ar, ai}; agg[(ordA + 1) * 64 + lane] = (f32x2){br, bi};
        __syncthreads();
        float pr = a.x, pi = a.y;
#pragma unroll
        for (int q = 0; q < 5; ++q) { const float nr = pr * pr - pi * pi, ni = 2.f * pr * pi; pr = nr; pi = ni; }
        float cr = 0.f, ci = 0.f;
        for (int s2 = 0; s2 < ordA; ++s2) { const f32x2 v = agg[s2 * 64 + lane]; const float nr = pr * cr - pi * ci + v.x, ni = pr * ci + pi * cr + v.y; cr = nr; ci = ni; }
        const float dr = pr * cr - pi * ci + ar, di = pr * ci + pi * cr + ai;
        ar = cr; ai = ci; br = dr; bi = di;
#pragma unroll 16
        for (int k = 0; k < 32; ++k) { const int o = d ? 31 - k : k; const size_t ca = (size_t)(32 * sA + o), cb = (size_t)(32 * sB + o);
            *(unsigned*)(HIN + ca * 512) = cvtpk(ar, ai); *(unsigned*)(HIN + cb * 512) = cvtpk(br, bi);
            const f32x2 va = *(const f32x2*)(S + ca * 256), vb = *(const f32x2*)(S + cb * 256);
            const float nar = a.x * ar - a.y * ai + va.x, nai = a.x * ai + a.y * ar + va.y, nbr = a.x * br - a.y * bi + vb.x, nbi = a.x * bi + a.y * br + vb.y; ar = nar; ai = nai; br = nbr; bi = nbi; }
    }
}

__device__ __forceinline__ void phase_attn(const P& p, char* lds) {
    const bf16_t* Q = (const bf16_t*)(p.ws + WS_Q); const bf16_t* K = (const bf16_t*)(p.ws + WS_K); const bf16_t* V = (const bf16_t*)(p.ws + WS_V);
    unsigned char* CAT = p.ws + WS_CAT;
    const int G = gridDim.x, bx = blockIdx.x, vcu = (G % 8 == 0) ? (bx % 8) * (G / 8) + bx / 8 : bx;
    for (int unit = vcu; unit < 512; unit += G) {
        const int bk = unit >> 7, rem = unit & 127, b = bk >> 1, kvh = bk & 1, h = kvh * 4 + (rem >> 5), qb = rem & 31;
        attn::attn_dense_body<attn::bf16>((const attn::bf16*)(Q + (size_t)(b * 8192 + qb * 256) * 1024 + h * 128),
                                          (const attn::bf16*)(K + (size_t)(b * 8192) * 256 + kvh * 128), (const attn::bf16*)(V + (size_t)(b * 8192) * 256 + kvh * 128),
                                          CAT + (size_t)(b * 8192 + qb * 256) * 2048 + 1024 + h * 128, 8192, lds);
        __syncthreads();
    }
}

constexpr int SGU_VS = 136;
constexpr int SGU_HB = 71680;
constexpr int SGU_VNT = 0, SGU_STG = 128 * SGU_VS * 2, SGU_STAT = 2 * 128 * SGU_VS * 2, SGU_BS = SGU_STAT + 1024;
static_assert(SGU_BS + 512 <= SGU_HB && 2 * SGU_HB <= LDS_BYTES - 64 && SGU_HB % 16 == 0, "SGU LDS map");
__device__ __forceinline__ void phase_sgu(const P& p, LAS unsigned char* lds, int tid, int lane, int wid) {
    const int hb = wid >> 2, w4 = wid & 3, t256 = tid & 255;
    LAS unsigned char* base = lds + hb * SGU_HB;
    LAS bf16_t* vnT = (LAS bf16_t*)(base + SGU_VNT);
    LAS bf16_t* stg = (LAS bf16_t*)(base + SGU_STG);
    LAS f32x2* stats = (LAS f32x2*)(base + SGU_STAT);
    LAS float* bs = (LAS float*)(base + SGU_BS);
    const bf16_t* Z = (const bf16_t*)(p.ws + WS_Z); unsigned char* SG = p.ws + WS_SG;
    const bf16_t* Wsb = (const bf16_t*)(p.ws + WS_WSB);
    const int fr = lane & 15, fq = lane >> 4, wi = w4 & 1, wc = w4 >> 1, i0 = 64 * wi, c0 = 64 * wc;
    for (int up = blockIdx.x; up < 512; up += gridDim.x) {
        const int unit = 2 * up + hb, n = unit >> 3, g = unit & 7;
        __syncthreads();
        if (t256 < 128) { const f32x2* part = (const f32x2*)(p.ws + WS_LNST) + (size_t)(2 * g * 4) * NTOK + (n * 128 + t256); float s1 = 0.f, s2 = 0.f;
#pragma unroll
            for (int q = 0; q < 8; ++q) { const f32x2 a2 = part[(size_t)q * NTOK]; s1 += a2.x; s2 += a2.y; }
            const float mean = s1 * (1.0f / 512.0f), var = fmaxf(s2 * (1.0f / 512.0f) - mean * mean, 0.f); stats[t256] = (f32x2){mean, rsqrtf(var + 1e-6f)};
            bs[t256] = p.sgu_b[g * 128 + t256]; }
        bf16x8 Af[4][4];
#pragma unroll
        for (int m = 0; m < 4; ++m)
#pragma unroll
            for (int ks = 0; ks < 4; ++ks) Af[m][ks] = *(const bf16x8*)(Wsb + (size_t)(g * 128 + i0 + 16 * m + fr) * 128 + 32 * ks + 8 * fq);
#pragma unroll 1
        for (int qt = 0; qt < 4; ++qt) {
            const int chb = g * 512 + qt * 128;
            __syncthreads();
            { u32x4 T[8];
#pragma unroll
              for (int q = 0; q < 8; ++q) { const int pc = t256 + 256 * q, j = pc >> 4, ch = (pc & 15) * 8; T[q] = *(const u32x4*)(Z + ((size_t)(n * 16 + 8 + g) * 128 + j) * 512 + qt * 128 + ch); }
#pragma unroll
              for (int q = 0; q < 8; ++q) { const int pc = t256 + 256 * q, j = pc >> 4, ch = (pc & 15) * 8; *(LAS u32x4*)(stg + j * SGU_VS + ch) = T[q]; } }
            __syncthreads();
#pragma unroll 1
            for (int slab = 0; slab < 2; ++slab) {
                const int cc = slab * 64 + lane; const float lng = p.sgu_ln_g[chb + cc];
                const int cl = cc & 63, rp = (cc & ~63) + ((cl >> 2) & 3) * 16 + (cl >> 4) * 4 + (cl & 3);
#pragma unroll
                for (int jg = 0; jg < 4; ++jg) {
                    const int j0 = 32 * w4 + 8 * jg; float y[8];
#pragma unroll
                    for (int k = 0; k < 8; ++k) { const float xv = bflo((unsigned)stg[(j0 + k) * SGU_VS + cc]); const f32x2 st = stats[j0 + k]; y[k] = (xv - st.x) * st.y * lng; }
                    u32x4 o; o.x = cvtpk(y[0], y[1]); o.y = cvtpk(y[2], y[3]); o.z = cvtpk(y[4], y[5]); o.w = cvtpk(y[6], y[7]);
                    *(LAS u32x4*)(vnT + rp * SGU_VS + j0) = o;
                }
            }
            __syncthreads();
#pragma unroll 1
            for (int np = 0; np < 2; ++np) {
                u32x4 U[4];
#pragma unroll
                for (int m = 0; m < 4; ++m) U[m] = *(const u32x4*)(Z + ((size_t)(n * 16 + g) * 128 + i0 + 16 * m + fr) * 512 + qt * 128 + c0 + 16 * fq + 8 * np);
                f32x4 acc[4][2];
#pragma unroll
                for (int m = 0; m < 4; ++m)
#pragma unroll
                    for (int nn = 0; nn < 2; ++nn) acc[m][nn] = (f32x4){0.f, 0.f, 0.f, 0.f};
#pragma unroll
                for (int ks = 0; ks < 4; ++ks) {
                    bf16x8 Bf[2];
#pragma unroll
                    for (int nn = 0; nn < 2; ++nn) Bf[nn] = *(const LAS bf16x8*)(vnT + (c0 + 16 * (2 * np + nn) + fr) * SGU_VS + 32 * ks + 8 * fq);
#pragma unroll
                    for (int m = 0; m < 4; ++m)
#pragma unroll
                        for (int nn = 0; nn < 2; ++nn) acc[m][nn] = __builtin_amdgcn_mfma_f32_16x16x32_bf16(Bf[nn], Af[m][ks], acc[m][nn], 0, 0, 0);
                }
#pragma unroll
                for (int m = 0; m < 4; ++m) { const int i = i0 + 16 * m + fr; const float bi = bs[i]; const size_t tok = (size_t)(n * 128 + i);
                    const int cch = chb + c0 + 16 * fq + 8 * np;
                    const u32x4 u0 = U[m];
                    const f32x4 s0 = acc[m][0] + bi, s1 = acc[m][1] + bi;
                    u32x2 o;
                    o.x = pk_fp8x4(bflo(u0.x) * s0.x * F8_SGS, bfhi(u0.x) * s0.y * F8_SGS, bflo(u0.y) * s0.z * F8_SGS, bfhi(u0.y) * s0.w * F8_SGS);
                    o.y = pk_fp8x4(bflo(u0.z) * s1.x * F8_SGS, bfhi(u0.z) * s1.y * F8_SGS, bflo(u0.w) * s1.z * F8_SGS, bfhi(u0.w) * s1.w * F8_SGS);
                    *(u32x2*)(SG + tok * 4096 + cch) = o; }
            }
        }
    }
}
#define XB_TMO      128
#define XB_XCNT(j)  (256  + 64 * (j))
#define XB_XSUB(j)  (1280 + 64 * (j))
#define XB_XGEN(j)  (2304 + 64 * (j))
#define XB_TOP      3328
#define XB_TOPGEN   3392
#define XCD_BAR_WORDS 3456
#define XB_SPIN_CAP (1u << 22)

__device__ __forceinline__ unsigned xb_ld(unsigned* p)              { return __hip_atomic_load(p, __ATOMIC_RELAXED, __HIP_MEMORY_SCOPE_AGENT); }
__device__ __forceinline__ unsigned xb_add(unsigned* p, unsigned v) { return __hip_atomic_fetch_add(p, v, __ATOMIC_RELAXED, __HIP_MEMORY_SCOPE_AGENT); }
__device__ __forceinline__ unsigned xb_xcc_id() { return (unsigned)__builtin_amdgcn_s_getreg((3 << 11) | 20) & 0xFu; }
#define XB_SPIN(cond, bar) do { unsigned _sp = 0; while (cond) { __builtin_amdgcn_s_sleep(1); \
    if ((++_sp & 255u) == 0u) { if (xb_ld(&(bar)[XB_TMO])) break; if (_sp > XB_SPIN_CAP) { atomicAdd(&(bar)[XB_TMO], 1u); break; } } } } while (0)

struct XcdBarrier {
    unsigned* bar; unsigned x;
    volatile LAS unsigned* st;
};

__device__ __forceinline__ XcdBarrier xcd_barrier_post(unsigned* bar, volatile LAS unsigned* st) {
    XcdBarrier b; b.bar = bar; b.x = xb_xcc_id(); b.st = st;
    if (threadIdx.x == 0) st[2] = xb_add(&bar[XB_XCNT(b.x)], 1u);
    return b;
}
__device__ __forceinline__ void xcd_barrier_complete(unsigned* bar, unsigned x, unsigned& nloc, unsigned& nx) {
    const unsigned G = gridDim.x * gridDim.y * gridDim.z;
    unsigned sum, cnt, mine, sp = 0u;
    for (;;) {
        sum = 0u; cnt = 0u; mine = 0u;
#pragma unroll
        for (unsigned j = 0; j < 16; ++j) { const unsigned c = xb_ld(&bar[XB_XCNT(j)]); sum += c; cnt += (c > 0u) ? 1u : 0u; mine = (j == x) ? c : mine; }
        if (sum == G) break;
        __builtin_amdgcn_s_sleep(1);
        if ((++sp & 255u) == 0u) { if (xb_ld(&bar[XB_TMO])) break; if (sp > XB_SPIN_CAP) { atomicAdd(&bar[XB_TMO], 1u); break; } }
    }
    nloc = mine > 0u ? mine : 1u; nx = cnt > 0u ? cnt : 1u;
}

__device__ __forceinline__ void xcd_barrier(const XcdBarrier& b) {
    asm volatile("s_waitcnt vmcnt(0)" ::: "memory");
    __syncthreads();
    if (threadIdx.x == 0) {
        unsigned* bar = b.bar;
        __builtin_amdgcn_s_waitcnt(0);
        unsigned nloc = b.st[0], nx = b.st[1];
        if (nloc == 0u) { xcd_barrier_complete(bar, b.x, nloc, nx); b.st[0] = nloc; b.st[1] = nx; }
        const unsigned old = xb_add(&bar[XB_XSUB(b.x)], 1u);
        const unsigned gen = old / nloc;
        if (old + 1u == (gen + 1u) * nloc) {
            __builtin_amdgcn_fence(__ATOMIC_RELEASE, "agent");
            asm volatile("s_waitcnt vmcnt(0)" ::: "memory");
            const unsigned og = xb_add(&bar[XB_TOP], 1u);
            const unsigned tg = og / nx;
            if (og + 1u == (tg + 1u) * nx) xb_add(&bar[XB_TOPGEN], 1u);
            else XB_SPIN(xb_ld(&bar[XB_TOPGEN]) == tg, bar);
            __builtin_amdgcn_fence(__ATOMIC_ACQUIRE, "agent");
            xb_add(&bar[XB_XGEN(b.x)], 1u);
            asm volatile("s_waitcnt vmcnt(0)" ::: "memory");
        } else {
            XB_SPIN(xb_ld(&bar[XB_XGEN(b.x)]) == gen, bar);
            __builtin_amdgcn_fence(__ATOMIC_ACQUIRE, "agent");
            asm volatile("s_waitcnt vmcnt(0)" ::: "memory");
        }
    }
    __syncthreads();
}

__device__ __forceinline__ void ce_desc(float& a, float& b) { const float mx = fmaxf(a, b), mn = fminf(a, b); a = mx; b = mn; }
__device__ __forceinline__ void bitonic_sort16_desc(float (&a)[16]) {
#pragma unroll
    for (int k = 2; k <= 16; k <<= 1)
#pragma unroll
        for (int j = k >> 1; j > 0; j >>= 1)
#pragma unroll
            for (int i = 0; i < 16; ++i) { const int l = i ^ j; if (l > i) { if ((i & k) == 0) ce_desc(a[i], a[l]); else ce_desc(a[l], a[i]); } }
}
__device__ __forceinline__ void merge_top16(float (&V)[16], const float (&S)[16]) {
#pragma unroll
    for (int i = 0; i < 16; ++i) V[i] = fmaxf(V[i], S[15 - i]);
#pragma unroll
    for (int j = 8; j > 0; j >>= 1)
#pragma unroll
        for (int i = 0; i < 16; ++i) { const int l = i ^ j; if (l > i) ce_desc(V[i], V[l]); }
}
__device__ __forceinline__ float with_payload(float v, unsigned mask, unsigned pay) { return __uint_as_float((__float_as_uint(v) & ~mask) | pay); }

__device__ __forceinline__ void peer_topk_half(const bf16_t* qrow, const bf16_t* keys, int r32, int hi, float (&V)[16]) {
    bf16x8 qf[8];
#pragma unroll
    for (int ks = 0; ks < 8; ++ks) qf[ks] = *(const bf16x8*)(qrow + 16 * ks + 8 * hi);
#pragma unroll
    for (int k = 0; k < 16; ++k) V[k] = -INFINITY;
#pragma unroll 1
    for (int t = 0; t < 4; ++t) {
        f32x16 s = (f32x16){0.f, 0.f, 0.f, 0.f, 0.f, 0.f, 0.f, 0.f, 0.f, 0.f, 0.f, 0.f, 0.f, 0.f, 0.f, 0.f};
#pragma unroll
        for (int ks = 0; ks < 8; ++ks) { const bf16x8 kf = *(const bf16x8*)(keys + (size_t)(t * 32 + r32) * 128 + 16 * ks + 8 * hi);
            s = __builtin_amdgcn_mfma_f32_32x32x16_bf16(kf, qf[ks], s, 0, 0, 0); }
        float S[16];
#pragma unroll
        for (int r = 0; r < 16; ++r) S[r] = with_payload(s[r], 0x7Fu, (unsigned)(t * 32 + (r & 3) + 8 * (r >> 2) + 4 * hi));
        bitonic_sort16_desc(S); merge_top16(V, S);
    }
    float PVv[16];
#pragma unroll
    for (int k = 0; k < 16; ++k) { const auto r = __builtin_amdgcn_permlane32_swap(__float_as_uint(V[k]), __float_as_uint(V[k]), false, false); PVv[k] = (hi ? __uint_as_float(r[0]) : __uint_as_float(r[1])); }
    merge_top16(V, PVv);
}

__device__ __forceinline__ void phase_peer_s1(const P& p, int layer, LAS unsigned char* lds, int lane, int wid) {
    LAS int* idxL = (LAS int*)(lds + 65536 + wid * 8192);
    const bf16_t* QP = (const bf16_t*)(p.ws + WS_QP);
    const bf16_t* keys = (const bf16_t*)(p.ws + WS_KEYS) + (size_t)layer * 2 * 16384;
    const float* rowsq = (const float*)(p.ws + WS_ROWSQ) + (size_t)layer * 32 * NTOK; float* RSTD = (float*)(p.ws + WS_RSTD);
    int* EID = (int*)(p.ws + WS_EID); float* GATE = (float*)(p.ws + WS_GATE);
    const int r32 = lane & 31, hi = lane >> 5, gw = blockIdx.x * 8 + wid, ngw = gridDim.x * 8;
#pragma unroll 1
    for (int tq = gw; tq < NTOK / 4; tq += ngw) {
        {
            const bf16_t* qrow = QP + (size_t)(4 * tq + (r32 >> 3)) * 2048 + (r32 & 7) * 256;
            float v1[16], v2[16];
            peer_topk_half(qrow, keys, r32, hi, v1);
            peer_topk_half(qrow + 128, keys + 16384, r32, hi, v2);
#pragma unroll
            for (int k = 0; k < 16; ++k) { idxL[k * 64 + lane] = (int)(__float_as_uint(v1[k]) & 0x7Fu); idxL[(16 + k) * 64 + lane] = (int)(__float_as_uint(v2[k]) & 0x7Fu); }
            float SC[16], S2[16];
#pragma unroll
            for (int b2 = 0; b2 < 16; ++b2) SC[b2] = with_payload(v1[0] + v2[b2], 0xFFu, (unsigned)b2);
#pragma unroll
            for (int a = 1; a <= 4; ++a) {
#pragma unroll
                for (int b2 = 0; b2 < 16; ++b2) S2[b2] = ((a + 1) * (b2 + 1) <= 16) ? with_payload(v1[a] + v2[b2], 0xFFu, (unsigned)(a * 16 + b2)) : -INFINITY;
                merge_top16(SC, S2); }
#pragma unroll
            for (int a = 5; a <= 7; ++a) { S2[2 * (a - 5)] = with_payload(v1[a] + v2[0], 0xFFu, (unsigned)(a * 16)); S2[2 * (a - 5) + 1] = with_payload(v1[a] + v2[1], 0xFFu, (unsigned)(a * 16 + 1)); }
#pragma unroll
            for (int a = 8; a <= 15; ++a) S2[6 + (a - 8)] = with_payload(v1[a] + v2[0], 0xFFu, (unsigned)(a * 16));
            S2[14] = -INFINITY; S2[15] = -INFINITY;
            bitonic_sort16_desc(S2); merge_top16(SC, S2);
            float e[16], sum = 0.f;
#pragma unroll
            for (int k = 0; k < 16; ++k) { e[k] = __expf(SC[k] - SC[0]); sum += e[k]; }
            const float inv = 1.0f / sum;
            if (hi == 0) {
                u32x4 iw[4]; f32x4 gv[4];
#pragma unroll
                for (int k = 0; k < 16; ++k) { const unsigned pay = __float_as_uint(SC[k]) & 0xFFu;
                    iw[k >> 2][k & 3] = (unsigned)(idxL[(pay >> 4) * 64 + lane] * 128 + idxL[(16 + (pay & 15)) * 64 + lane]); gv[k >> 2][k & 3] = e[k] * inv; }
                const size_t gbase = (size_t)(4 * tq + (r32 >> 3)) * 128 + (r32 & 7) * 16;
#pragma unroll
                for (int k4 = 0; k4 < 4; ++k4) { *(u32x4*)(EID + gbase + 4 * k4) = iw[k4]; *(f32x4*)(GATE + gbase + 4 * k4) = gv[k4]; } }
        }
        {
            const int token = 4 * tq + (lane >> 4), w = lane & 15;
            const float sq = row16_sum(rowsq[(size_t)w * NTOK + token] + rowsq[(size_t)(w + 16) * NTOK + token]);
            if (w == 0) RSTD[token] = rsqrtf(sq * (1.0f / 2048.0f) + 1e-6f); }
    }
}

__device__ __forceinline__ float dot2bf(unsigned a, unsigned b, float acc) { return __builtin_amdgcn_fdot2_f32_bf16(__builtin_bit_cast(bf16x2v, a), __builtin_bit_cast(bf16x2v, b), acc, false); }
__device__ __forceinline__ void peer_partition(const P& p, int myrank, int& part, int& rank, int& nwg) {
    unsigned* bar = (unsigned*)(p.ws + WS_BAR); const unsigned x = xb_xcc_id(); unsigned mine = 0u; bool ok = true;
#pragma unroll
    for (unsigned j = 0; j < 16; ++j) { const unsigned cj = xb_ld(&bar[XB_XCNT(j)]); ok = ok && ((j < 8u) ? (cj > 0u) : (cj == 0u)); mine = (j == x) ? cj : mine; }
    if (ok) { part = (int)x; rank = myrank; nwg = (int)mine; } else { part = (int)blockIdx.x & 7; rank = (int)blockIdx.x >> 3; nwg = (int)gridDim.x >> 3; }
    part = __builtin_amdgcn_readfirstlane(part); rank = __builtin_amdgcn_readfirstlane(rank); nwg = __builtin_amdgcn_readfirstlane(nwg);
}
__device__ __forceinline__ void phase_peer_u(const P& p, int layer, LAS unsigned char* lds, int lane, int wid, int myrank) {
    LAS unsigned char* wl = lds + wid * 16384;
    int part, rank, nwg; peer_partition(p, myrank, part, rank, nwg);
    const unsigned char* PUS = p.ws + WS_PU + (size_t)layer * 16384 * PEER_ROWB + (size_t)part * 16384 * 192;
    const int* EID = (const int*)(p.ws + WS_EID);
    const unsigned char* HB = p.ws + WS_XB + 512 * part;
    const float* RSTD = (const float*)(p.ws + WS_RSTD);
    const float* ABs = (const float*)(p.ws + WS_ABT) + (size_t)layer * 2 * 4096 + 256 * part + 4 * lane;
    float* PACT = (float*)(p.ws + WS_PACT) + (size_t)part * NTOK * 128;
    const int g = lane >> 3, s = lane & 7, nb = NTOK / 8, stride = nwg * 8;
    int tb = rank * 8 + wid;
    if (tb >= nb) return;
    int e0[8], e1[8]; u32x2 hs[8]; float rs[8]; f32x4 Av, Bv;
#define PB_LOAD(TB) { _Pragma("unroll") for (int j = 0; j < 8; ++j) { const size_t t = (size_t)(TB) * 8 + j; e0[j] = EID[t * 128 + lane]; e1[j] = EID[t * 128 + 64 + lane]; hs[j] = *(const u32x2*)(HB + t * 4096 + 8 * lane); rs[j] = RSTD[t]; } \
        Av = *(const f32x4*)(ABs + ((TB) >> 10) * 4096); Bv = *(const f32x4*)(ABs + ((TB) >> 10) * 4096 + 2048); }
#define PB_STORE(BUF) _Pragma("unroll") for (int j = 0; j < 8; ++j) { LAS int* il = (LAS int*)(wl + (BUF) * 8192); il[j * 128 + lane] = e0[j]; il[j * 128 + 64 + lane] = e1[j]; \
        u32x2 hw; hw.x = cvtpk(bflo(hs[j].x) * rs[j] * Av.x + Bv.x, bfhi(hs[j].x) * rs[j] * Av.y + Bv.y); hw.y = cvtpk(bflo(hs[j].y) * rs[j] * Av.z + Bv.z, bfhi(hs[j].y) * rs[j] * Av.w + Bv.w); \
        *(LAS u32x2*)(wl + (BUF) * 8192 + 4096 + j * 512 + 8 * lane) = hw; }
#define PR_LOAD(SLOT, ID) { const unsigned char* ur = PUS + (size_t)(ID) * 192 + 24 * s; R[SLOT][0] = *(const u32x2*)ur; R[SLOT][1] = *(const u32x2*)(ur + 8); R[SLOT][2] = *(const u32x2*)(ur + 16); }
    PB_LOAD(tb) PB_STORE(0)
    u32x2 R[8][3];
    { LAS int* il = (LAS int*)wl;
#pragma unroll
      for (int q = 0; q < 8; ++q) { const int id = il[8 * q + g]; PR_LOAD(q, id) } }
    int bi = 0;
#pragma unroll 1
    for (; tb < nb; tb += stride, bi ^= 1) {
        { const int tbn = tb + stride < nb ? tb + stride : tb; PB_LOAD(tbn) }
#pragma unroll 1
        for (int j = 0; j < 8; ++j) {
            if (j == 7) { PB_STORE(bi ^ 1) }
            LAS int* ids = (LAS int*)(wl + bi * 8192) + j * 128;
            LAS int* nid = (j < 7) ? ids + 128 : (LAS int*)(wl + (bi ^ 1) * 8192);
            LAS u32x4* hp = (LAS u32x4*)(wl + bi * 8192 + 4096 + j * 512 + s * 64);
            const u32x4 h0 = hp[0], h1 = hp[1], h2 = hp[2], h3 = hp[3];
            float acc[16];
#pragma unroll
            for (int it = 0; it < 16; ++it) {
                const int sl = it & 7;
                const u32x16 dw = __builtin_bit_cast(u32x16, __builtin_amdgcn_cvt_scalef32_pk32_bf16_fp6((u32x6){R[sl][0].x, R[sl][0].y, R[sl][1].x, R[sl][1].y, R[sl][2].x, R[sl][2].y}, 1.0f));
                { const int idn = (it < 8) ? ids[8 * (it + 8) + g] : nid[8 * (it - 8) + g]; PR_LOAD(sl, idn) }
                float a0 = 0.f, a1 = 0.f;
                a0 = dot2bf(dw[0], h0.x, a0); a1 = dot2bf(dw[1], h0.y, a1); a0 = dot2bf(dw[2], h0.z, a0); a1 = dot2bf(dw[3], h0.w, a1);
                a0 = dot2bf(dw[4], h1.x, a0); a1 = dot2bf(dw[5], h1.y, a1); a0 = dot2bf(dw[6], h1.z, a0); a1 = dot2bf(dw[7], h1.w, a1);
                a0 = dot2bf(dw[8], h2.x, a0); a1 = dot2bf(dw[9], h2.y, a1); a0 = dot2bf(dw[10], h2.z, a0); a1 = dot2bf(dw[11], h2.w, a1);
                a0 = dot2bf(dw[12], h3.x, a0); a1 = dot2bf(dw[13], h3.y, a1); a0 = dot2bf(dw[14], h3.z, a0); a1 = dot2bf(dw[15], h3.w, a1);
                float v = a0 + a1;
                v += __uint_as_float(__builtin_amdgcn_update_dpp(0u, __float_as_uint(v), 0xB1, 0xF, 0xF, true));
                v += __uint_as_float(__builtin_amdgcn_update_dpp(0u, __float_as_uint(v), 0x4E, 0xF, 0xF, true));
                v += __uint_as_float(__builtin_amdgcn_update_dpp(0u, __float_as_uint(v), 0x141, 0xF, 0xF, true));
                acc[it] = v;
            }
            if (s == 0) { float* pa = PACT + ((size_t)tb * 8 + j) * 128 + g;
#pragma unroll
                for (int it = 0; it < 16; ++it) pa[8 * it] = acc[it]; }
        }
    }
#undef PB_LOAD
#undef PB_STORE
#undef PR_LOAD
}

__device__ __forceinline__ void phase_peer_w(const P& p, int layer, int tid) {
    const int* EID = (const int*)(p.ws + WS_EID); const float* GATE = (const float*)(p.ws + WS_GATE); const float* PACT = (const float*)(p.ws + WS_PACT); float* PW = (float*)(p.ws + WS_PW);
    const float* PSU = (const float*)(p.ws + WS_PSC) + layer * 16384; const float* PSV = PSU + 2 * 16384;
#pragma unroll 4
    for (int i = (int)blockIdx.x * 512 + tid; i < NTOK * 128; i += (int)gridDim.x * 512) {
        const int id = EID[i]; float a = 0.f;
#pragma unroll
        for (int x = 0; x < 8; ++x) a += PACT[(size_t)x * NTOK * 128 + i];
        PW[i] = gelu_t(a * PSU[id]) * GATE[i] * PSV[id];
    }
}

__device__ __forceinline__ void phase_peer_vs(const P& p, int layer, LAS unsigned char* lds, int lane, int wid, int myrank) {
    LAS unsigned char* wl = lds + wid * 16384;
    int part, rank, nwg; peer_partition(p, myrank, part, rank, nwg);
    const unsigned char* PVS = p.ws + WS_PV + (size_t)layer * 16384 * PEER_ROWB + (size_t)part * 16384 * 192;
    const int* EID = (const int*)(p.ws + WS_EID); const float* PW = (const float*)(p.ws + WS_PW);
    unsigned char* PO = p.ws + WS_PO + 512 * part;
    const int g = lane >> 3, s = lane & 7, nb = NTOK / 8, stride = nwg * 8;
    const bool b3 = (lane & 8) != 0;
    int tb = rank * 8 + wid;
    if (tb >= nb) return;
    int e0[8], e1[8]; float w0[8], w1[8];
#define PB_LOAD(TB) _Pragma("unroll") for (int j = 0; j < 8; ++j) { const size_t t = (size_t)(TB) * 8 + j; e0[j] = EID[t * 128 + lane]; e1[j] = EID[t * 128 + 64 + lane]; w0[j] = PW[t * 128 + lane]; w1[j] = PW[t * 128 + 64 + lane]; }
#define PB_STORE(BUF) _Pragma("unroll") for (int j = 0; j < 8; ++j) { LAS int* il = (LAS int*)(wl + (BUF) * 8192); LAS float* fl = (LAS float*)(wl + (BUF) * 8192 + 4096); il[j * 128 + lane] = e0[j]; il[j * 128 + 64 + lane] = e1[j]; fl[j * 128 + lane] = w0[j]; fl[j * 128 + 64 + lane] = w1[j]; }
#define PR_LOAD(SLOT, ID) { const unsigned char* vr = PVS + (size_t)(ID) * 192 + 24 * s; R[SLOT][0] = *(const u32x2*)vr; R[SLOT][1] = *(const u32x2*)(vr + 8); R[SLOT][2] = *(const u32x2*)(vr + 16); }
    PB_LOAD(tb) PB_STORE(0)
    u32x2 R[8][3];
    { LAS int* il = (LAS int*)wl;
#pragma unroll
      for (int q = 0; q < 8; ++q) { const int id = il[8 * q + g]; PR_LOAD(q, id) } }
    int bi = 0;
#pragma unroll 1
    for (; tb < nb; tb += stride, bi ^= 1) {
        { const int tbn = tb + stride < nb ? tb + stride : tb; PB_LOAD(tbn) }
#pragma unroll 1
        for (int j = 0; j < 8; ++j) {
            if (j == 7) { PB_STORE(bi ^ 1) }
            LAS int* ids = (LAS int*)(wl + bi * 8192) + j * 128;
            LAS int* nid = (j < 7) ? ids + 128 : (LAS int*)(wl + (bi ^ 1) * 8192);
            LAS float* wv = (LAS float*)(wl + bi * 8192 + 4096) + j * 128;
            h16x2 o2[16];
#pragma unroll
            for (int k = 0; k < 16; ++k) o2[k] = (h16x2){(_Float16)0.f, (_Float16)0.f};
#pragma unroll
            for (int it = 0; it < 16; ++it) {
                const int sl = it & 7;
                const h16x32 d = __builtin_amdgcn_cvt_scalef32_pk32_f16_fp6((u32x6){R[sl][0].x, R[sl][0].y, R[sl][1].x, R[sl][1].y, R[sl][2].x, R[sl][2].y}, 1.0f);
                { const int idn = (it < 8) ? ids[8 * (it + 8) + g] : nid[8 * (it - 8) + g]; PR_LOAD(sl, idn) }
                const _Float16 wh = (_Float16)wv[8 * it + g]; const h16x2 w2 = (h16x2){wh, wh};
#pragma unroll
                for (int k = 0; k < 16; ++k) o2[k] = __builtin_elementwise_fma(w2, (h16x2){d[2 * k], d[2 * k + 1]}, o2[k]);
            }
            h16x2 t8[8], t4[4]; float res[4];
#pragma unroll
            for (int k = 0; k < 8; ++k) { const auto r = __builtin_amdgcn_permlane32_swap(__builtin_bit_cast(unsigned, o2[k]), __builtin_bit_cast(unsigned, o2[8 + k]), false, false);
                unsigned ra = r[0], rb = r[1]; asm volatile("" : "+v"(ra), "+v"(rb)); t8[k] = __builtin_bit_cast(h16x2, ra) + __builtin_bit_cast(h16x2, rb); }
#pragma unroll
            for (int k = 0; k < 4; ++k) { const auto r = __builtin_amdgcn_permlane16_swap(__builtin_bit_cast(unsigned, t8[k]), __builtin_bit_cast(unsigned, t8[4 + k]), false, false);
                unsigned ra = r[0], rb = r[1]; asm volatile("" : "+v"(ra), "+v"(rb)); t4[k] = __builtin_bit_cast(h16x2, ra) + __builtin_bit_cast(h16x2, rb); }
#pragma unroll
            for (int k = 0; k < 2; ++k) { const unsigned lo = __builtin_bit_cast(unsigned, t4[k]), hi = __builtin_bit_cast(unsigned, t4[2 + k]); const unsigned mine = b3 ? hi : lo, send = b3 ? lo : hi;
                const h16x2 rr = __builtin_bit_cast(h16x2, mine) + __builtin_bit_cast(h16x2, (unsigned)__builtin_amdgcn_update_dpp(0u, send, 0x128, 0xF, 0xF, true));
                res[2 * k] = (float)rr.x; res[2 * k + 1] = (float)rr.y; }
            u32x2 ow; ow.x = cvtpk(res[0], res[1]); ow.y = cvtpk(res[2], res[3]);
            *(u32x2*)(PO + ((size_t)tb * 8 + j) * 4096 + 64 * s + 8 * g) = ow;
        }
    }
#undef PB_LOAD
#undef PB_STORE
#undef PR_LOAD
}

template <bool FINAL>
__device__ __forceinline__ void phase_peer_norm(const P& p, int layer, int lane, int wid) {
    bf16_t* XB = (bf16_t*)(p.ws + WS_XB);
    const bf16_t* PO = (const bf16_t*)(p.ws + WS_PO);
    const float* mod = (const float*)(p.ws + WS_MOD);
    float* X = p.out;
    const int gw = blockIdx.x * 8 + wid, ngw = gridDim.x * 8;
    u32x4 pw[4], xw[4];
#define PN_LOAD(T, PWV, XWV) { const bf16_t* por = PO + (size_t)(T) * 2048 + 16 * lane; const bf16_t* xbl = XB + (size_t)(T) * 2048 + 16 * lane; \
        _Pragma("unroll") for (int j = 0; j < 4; ++j) { PWV[j] = *(const u32x4*)(por + 1024 * (j >> 1) + 8 * (j & 1)); XWV[j] = *(const u32x4*)(xbl + 1024 * (j >> 1) + 8 * (j & 1)); } }
    if (gw < NTOK) PN_LOAD(gw, pw, xw)
#pragma unroll 1
    for (int token = gw; token < NTOK; token += ngw) {
        const int b = token >> 13;
        u32x4 pwn[4], xwn[4];
        { const int tn = token + ngw < NTOK ? token + ngw : token; PN_LOAD(tn, pwn, xwn) }
        float o[32];
#pragma unroll
        for (int j = 0; j < 4; ++j) { const u32x4 w = pw[j];
            o[8 * j + 0] = bflo(w.x); o[8 * j + 1] = bfhi(w.x); o[8 * j + 2] = bflo(w.y); o[8 * j + 3] = bfhi(w.y);
            o[8 * j + 4] = bflo(w.z); o[8 * j + 5] = bfhi(w.z); o[8 * j + 6] = bflo(w.w); o[8 * j + 7] = bfhi(w.w); }
        {
            const float* g2 = mod + (size_t)(layer * 2 + b) * 12288 + 5 * 2048 + 16 * lane;
            bf16_t* xbr = XB + (size_t)token * 2048 + 16 * lane; float* xr = X + (size_t)token * 2048 + 16 * lane;
            float xn[32], ss = 0.f;
#pragma unroll
            for (int jh = 0; jh < 2; ++jh) { const u32x4 w0 = xw[2 * jh], w1 = xw[2 * jh + 1];
                const float xi[16] = {bflo(w0.x), bfhi(w0.x), bflo(w0.y), bfhi(w0.y), bflo(w0.z), bfhi(w0.z), bflo(w0.w), bfhi(w0.w), bflo(w1.x), bfhi(w1.x), bflo(w1.y), bfhi(w1.y), bflo(w1.z), bfhi(w1.z), bflo(w1.w), bfhi(w1.w)};
#pragma unroll
                for (int q = 0; q < 4; ++q) { const f32x4 gg = *(const f32x4*)(g2 + 1024 * jh + 4 * q);
#pragma unroll
                    for (int e = 0; e < 4; ++e) { const float t = xi[4 * q + e] + gg[e] * o[16 * jh + 4 * q + e]; xn[16 * jh + 4 * q + e] = t; ss += t * t; } } }
            ss = wave_sum(ss); const float rstd = rsqrtf(ss * (1.0f / 2048.0f) + 1e-6f);
            if (FINAL) {
#pragma unroll
                for (int j = 0; j < 8; ++j) { const int off = 1024 * (j >> 2) + 4 * (j & 3); const f32x4 fg = *(const f32x4*)(p.final_g + 16 * lane + off);
                    f32x4 y;
#pragma unroll
                    for (int e = 0; e < 4; ++e) y[e] = xn[4 * j + e] * rstd * fg[e];
                    *(f32x4*)(xr + off) = y; }
            } else {
                const float* ng = p.norm_g + (size_t)((layer + 1) * 2 + 0) * 2048 + 16 * lane;
                const float* sh = mod + (size_t)((layer + 1) * 2 + b) * 12288 + 16 * lane; const float* sc = sh + 2048;
                unsigned char* hrow8 = p.ws + WS_H8 + (size_t)token * 2048 + 16 * lane;
#pragma unroll
                for (int jh = 0; jh < 2; ++jh) { float y[16];
#pragma unroll
                    for (int hq = 0; hq < 4; ++hq) { const int jj = 4 * jh + hq, off = 1024 * jh + 4 * hq; const f32x4 gv = *(const f32x4*)(ng + off), sv = *(const f32x4*)(sc + off), hv = *(const f32x4*)(sh + off);
                        f32x4 xo;
#pragma unroll
                        for (int e = 0; e < 4; ++e) { xo[e] = xn[4 * jj + e]; y[4 * hq + e] = (xo[e] * rstd * gv[e] * (1.0f + sv[e]) + hv[e]) * F8_HS; }
                        u32x2 xw; xw.x = cvtpk(xo[0], xo[1]); xw.y = cvtpk(xo[2], xo[3]); *(u32x2*)(xbr + off) = xw; }
                    u32x4 w; w.x = pk_fp8x4(y[0], y[1], y[2], y[3]); w.y = pk_fp8x4(y[4], y[5], y[6], y[7]); w.z = pk_fp8x4(y[8], y[9], y[10], y[11]); w.w = pk_fp8x4(y[12], y[13], y[14], y[15]);
                    *(u32x4*)(hrow8 + 1024 * jh) = w; }
            }
        }
#pragma unroll
        for (int j = 0; j < 4; ++j) { pw[j] = pwn[j]; xw[j] = xwn[j]; }
    }
#undef PN_LOAD
}

#ifndef PH_MASK
#define PH_MASK 0xFFFF
#endif
#define PH(b) if constexpr ((PH_MASK >> (b)) & 1)
#ifndef DBL_MASK
#define DBL_MASK 0
#endif
#define REP(b) for (int _r = 0; _r < 1 + ((DBL_MASK >> (b)) & 1); ++_r)
__device__ __forceinline__ int fresh_tid() { int t = threadIdx.x; asm volatile("" : "+v"(t)); return t; }
__device__ __forceinline__ P load_p() {
    typedef __attribute__((address_space(1))) float* gp;
    typedef const gp __attribute__((address_space(4)))* cq;
    cq q = (cq)__builtin_amdgcn_kernarg_segment_ptr(); asm volatile("" : "+s"(q));
    P r; float** d = (float**)&r;
#pragma unroll
    for (int i = 0; i < (int)(sizeof(P) / 8); ++i) d[i] = (float*)q[i];
    return r;
}
#define LP (load_p())
#define WSB (load_p().ws)
#define MODP ((const float*)(load_p().ws + WS_MOD))
#define HP ((bf16_t*)(load_p().ws + WS_H))
__global__ void __launch_bounds__(512, 2) mk_fwd(P p_arg) {
    extern __shared__ __attribute__((aligned(16))) unsigned char lds_raw[];
    LAS unsigned char* lds = (LAS unsigned char*)lds_raw;
    cg::grid_group grid = cg::this_grid();
    const int wid = __builtin_amdgcn_readfirstlane((int)threadIdx.x >> 6);
    const int gw = blockIdx.x * 8 + wid, ngw = gridDim.x * 8, G = gridDim.x;
    volatile LAS unsigned* xst = (volatile LAS unsigned*)(lds + LDS_BYTES - 64);
    if (threadIdx.x < 16) xst[threadIdx.x] = 0u;
    __syncthreads();
    const XcdBarrier xb = xcd_barrier_post((unsigned*)(load_p().ws + WS_BAR), xst);
#define TID (fresh_tid())
#define LANE (fresh_tid() & 63)

    REP(0) { PH(0) phase_prologue(LP, lds, TID, LANE, wid);
    grid.sync(); }
    REP(1) { PH(1) phase_adaln<true>(LP.x, WSB + WS_H8, LP.norm_g, MODP, MODP + 2048, gw, ngw, LANE);
    xcd_barrier(xb); }
    REP(2) { PH(2) {   pg8::Gemm g{(const bf16_t*)(WSB + WS_H8), (const bf16_t*)(WSB + WS_WINE), NTOK, 2560, 1024, 1024, 1024, 0, 0}; pg8::StaticOrder S; S.init(NTOK, 2560, G, (int)blockIdx.x);
        pg8::EpiEvenSplit E{1.0f / (F8_HS * F8_WS), WSB};
        pg8::gemm_phase<pg8::EpiEvenSplit, pg8::StaticOrder, true, true, true>(lds, g, S, E); }
    xcd_barrier(xb); }
    PH(3) { phase_qkprep(LP, gw, ngw, LANE); phase_fold_wq(LP, lds, TID, LANE, wid); __syncthreads(); }
    REP(4) { PH(4) {
        pg8::Gemm g{(const bf16_t*)(WSB + WS_AB), (const bf16_t*)(WSB + WS_WSUM), 1024, 256, 256, 512, 256, (size_t)1024 * 512, (size_t)256 * 256};
        pg8::BatchOrder S{4, 256, G, (int)blockIdx.x}; pg8::EpiF32B E{(float*)(WSB + WS_SS), 256, (size_t)1024 * 256};
        pg8::gemm_phase<pg8::EpiF32B, pg8::BatchOrder, false, false>(lds, g, S, E); }
    xcd_barrier(xb); }
    REP(5) { PH(5) { phase_s5scan(LP, lds, LANE, wid); phase_bias_reduce(LP, TID); }
    xcd_barrier(xb); }
    REP(13) { PH(13) {
        pg8::Gemm g{(const bf16_t*)(WSB + WS_AB), (const bf16_t*)(WSB + WS_WY), 1024, 256, 512, 512, 512, (size_t)1024 * 512, (size_t)256 * 512};
        LAS float* wl = (LAS float*)(lds + 131072);
        { const int un = (int)blockIdx.x;
            const int tid = TID; __syncthreads();
            if (tid < 256) wl[tid] = LP.glu_w[(un >> 2) * 256 + tid]; else if (tid < 272) wl[tid] = LP.glu_b[(un >> 2) * 16 + tid - 256];
            __syncthreads();
            pg8::BatchOrder S{4, un + 1, 256, un}; pg8::EpiS5Glu E{WSB + WS_CAT, wl};
            pg8::gemm_phase<pg8::EpiS5Glu, pg8::BatchOrder, false, false>(lds, g, S, E); }
        __syncthreads(); } }
    REP(6) { PH(6) phase_attn(LP, (char*)lds_raw);
    xcd_barrier(xb); }
    REP(7) { PH(7) {   pg8::Gemm g{(const bf16_t*)(WSB + WS_CAT), (const bf16_t*)(WSB + WS_WOUTE), NTOK, 2048, 1024, 1024, 1024, 0, 0}; pg8::StaticOrder S; S.init(NTOK, 2048, G, (int)blockIdx.x);
        pg8::EpiResidB<true> E{LP.x, (bf16_t*)(WSB + WS_XB), MODP + 2 * 2048, (float*)(WSB + WS_ROWSQ), WSB + WS_X8, 1.0f / (F8_CS * F8_WS)};
        pg8::gemm_phase<pg8::EpiResidB<true>, pg8::StaticOrder, true, true, true>(lds, g, S, E); }
    xcd_barrier(xb); }
    REP(8) { PH(8) {   pg8::Gemm g{(const bf16_t*)(WSB + WS_X8), (const bf16_t*)(WSB + WS_WQF), NTOK, 2048, 1024, 1024, 1024, 0, (size_t)2048 * 1024}; pg8::StaticOrder S; S.init(NTOK, 2048, G, (int)blockIdx.x); S.pbs = 5;
        pg8::EpiQ E{(bf16_t*)(WSB + WS_QP), (const float*)(WSB + WS_ROWSQ), (const float*)(WSB + WS_BIASQ), 1.0f / (F8_XS * F8_WS)};
        pg8::gemm_phase<pg8::EpiQ, pg8::StaticOrder, true, true, true>(lds, g, S, E); }
    xcd_barrier(xb); }
    REP(16) { PH(9) phase_peer_s1(LP, 0, lds, LANE, wid); }
    xcd_barrier(xb);
    REP(17) { PH(9) phase_peer_u(LP, 0, lds, LANE, wid, (int)xst[2]); }
    xcd_barrier(xb);
    REP(18) { PH(9) phase_peer_w(LP, 0, TID); }
    xcd_barrier(xb);
    REP(19) { PH(9) phase_peer_vs(LP, 0, lds, LANE, wid, (int)xst[2]); }
    xcd_barrier(xb);
    PH(9) phase_peer_norm<false>(LP, 0, LANE, wid);
    xcd_barrier(xb);
    REP(10) { PH(10) {   pg8::Gemm g{(const bf16_t*)(WSB + WS_H8), (const bf16_t*)(WSB + WS_WINO), NTOK, 8192, 1024, 1024, 1024, 0, 0}; pg8::StaticOrder S; S.init(NTOK, 8192, G, (int)blockIdx.x);
        pg8::EpiBf16T<1> E{(bf16_t*)(WSB + WS_Z), 8192, 1.0f / (F8_HS * F8_WS), (float*)(WSB + WS_LNST)};
        pg8::gemm_phase<pg8::EpiBf16T<1>, pg8::StaticOrder, true, true, true>(lds, g, S, E); }
    xcd_barrier(xb); }
    REP(11) { PH(11) phase_sgu(LP, lds, TID, LANE, wid);
    xcd_barrier(xb); }
    PH(12) {   pg8::Gemm g{(const bf16_t*)(WSB + WS_SG), (const bf16_t*)(WSB + WS_WOUTO), NTOK, 2048, 2048, 2048, 2048, 0, 0}; pg8::StaticOrder S; S.init(NTOK, 2048, G, (int)blockIdx.x);
        pg8::EpiResidB<false> E{nullptr, (bf16_t*)(WSB + WS_XB), MODP + 2 * 12288 + 2 * 2048, (float*)(WSB + WS_ROWSQ) + (size_t)32 * NTOK, WSB + WS_X8, 1.0f / (F8_SGS * F8_WS)};
        pg8::gemm_phase<pg8::EpiResidB<false>, pg8::StaticOrder, true, true, true>(lds, g, S, E); }
    xcd_barrier(xb);
    REP(8) { PH(8) {   pg8::Gemm g{(const bf16_t*)(WSB + WS_X8), (const bf16_t*)(WSB + WS_WQF) + (size_t)2 * 2048 * 1024, NTOK, 2048, 1024, 1024, 1024, 0, (size_t)2048 * 1024}; pg8::StaticOrder S; S.init(NTOK, 2048, G, (int)blockIdx.x); S.pbs = 5;
        pg8::EpiQ E{(bf16_t*)(WSB + WS_QP), (const float*)(WSB + WS_ROWSQ) + (size_t)32 * NTOK, (const float*)(WSB + WS_BIASQ) + 2 * 2048, 1.0f / (F8_XS * F8_WS)};
        pg8::gemm_phase<pg8::EpiQ, pg8::StaticOrder, true, true, true>(lds, g, S, E); }
    xcd_barrier(xb); }
    REP(16) { PH(9) phase_peer_s1(LP, 1, lds, LANE, wid); }
    xcd_barrier(xb);
    REP(17) { PH(9) phase_peer_u(LP, 1, lds, LANE, wid, (int)xst[2]); }
    xcd_barrier(xb);
    REP(18) { PH(9) phase_peer_w(LP, 1, TID); }
    xcd_barrier(xb);
    REP(19) { PH(9) phase_peer_vs(LP, 1, lds, LANE, wid, (int)xst[2]); }
    xcd_barrier(xb);
    PH(9) phase_peer_norm<true>(LP, 1, LANE, wid);
}

#undef LP
#undef WSB
#undef MODP
#undef HP
extern "C" void kernel_launch(void* const* d_in, const int* in_sizes, int n_in, void* d_out, int out_size, void* d_ws, size_t ws_size, hipStream_t stream) {
    static int grid = 0;
    if (grid == 0) {
        if (n_in != 30 || out_size != NTOK * DMODEL || ws_size < WS_END) { fprintf(stderr, "kernel_launch: unexpected shapes (n_in %d out %d ws %zu, need ws >= %zu)\n", n_in, out_size, ws_size, (size_t)WS_END); grid = -1; return; }
        int dev = 0, cus = 0, per_cu = 0;
        (void)hipGetDevice(&dev); (void)hipDeviceGetAttribute(&cus, hipDeviceAttributeMultiprocessorCount, dev);
        if (hipFuncSetAttribute((const void*)mk_fwd, hipFuncAttributeMaxDynamicSharedMemorySize, LDS_BYTES) != hipSuccess) { fprintf(stderr, "kernel_launch: hipFuncSetAttribute failed\n"); grid = -1; return; }
        if (hipOccupancyMaxActiveBlocksPerMultiprocessor(&per_cu, (const void*)mk_fwd, 512, LDS_BYTES) != hipSuccess || per_cu < 1) { fprintf(stderr, "kernel_launch: occupancy query says %d\n", per_cu); (void)hipGetLastError(); per_cu = 1; }
        grid = cus;
        if (grid > cus * per_cu) grid = cus * per_cu;
        if (grid != 256) { fprintf(stderr, "kernel_launch: this kernel is laid out for a 256-CU device (got %d workgroups)\n", grid); grid = -1; return; }
    }
    if (grid < 0) return;
    if (hipMemsetAsync((char*)d_ws + WS_BAR, 0, 16384, stream) != hipSuccess) { fprintf(stderr, "kernel_launch: hipMemsetAsync failed\n"); return; }
    P p{};
    const float** pf = (const float**)&p;
    for (int i = 0; i < 30; ++i) pf[i] = (const float*)d_in[i];
    p.out = (float*)d_out; p.ws = (unsigned char*)d_ws;
    void* args[] = {&p};
    hipError_t e = hipLaunchCooperativeKernel((const void*)mk_fwd, dim3(grid), dim3(512), args, LDS_BYTES, stream);
    if (e != hipSuccess) fprintf(stderr, "kernel_launch: cooperative launch failed: %s (grid %d)\n", hipGetErrorString(e), grid);
}
```

```cpp
#include <hip/hip_runtime.h>
#include <hip/hip_cooperative_groups.h>
#include <hip/hip_bf16.h>
#include <cstdio>
#include <cstdint>
namespace cg = cooperative_groups;

__device__ __forceinline__ int lane_id_v() { int l; asm volatile("v_mbcnt_lo_u32_b32 %0, -1, 0\n\tv_mbcnt_hi_u32_b32 %0, -1, %0" : "=v"(l)); return l; }

namespace pg8 {
#define PG8_LAS __attribute__((address_space(3)))
typedef unsigned short bf16_t;
typedef short bf16x8 __attribute__((ext_vector_type(8)));
typedef float f32x4 __attribute__((ext_vector_type(4)));
typedef unsigned u32x4 __attribute__((ext_vector_type(4)));
constexpr int BM = 256, BK = 64, HALF = 128, HTB = HALF * BK * 2  , STAGE_BYTES = 8 * HTB, NXCD = 8, WGM = 8;

__host__ __device__ __forceinline__ int lds_byte(int r, int c) { const int st = (r >> 4) * 2 + (c >> 5), rr = r & 15, cc = c & 31, ob = rr * 64 + cc * 2; return st * 1024 + (ob ^ (((ob >> 9) & 1) << 5)); }
__host__ __device__ __forceinline__ void stage_rc(int b, int& R, int& C) { const int st = b / 1024, sb = b % 1024, swz = sb ^ (((sb >> 9) & 1) << 5); R = (st >> 1) * 16 + swz / 64; C = (st & 1) * 32 + (swz % 64) / 2; }
__host__ __device__ __forceinline__ int perm32(int rho) { const int n = rho >> 4, i = rho & 15; return 8 * (i >> 2) + 4 * n + (i & 3); }

struct Unit { int pm, pn, pb; };
struct Gemm { const bf16_t* A; const bf16_t* Bt; int M, N, K; int lda, ldb; size_t bsA, bsB; };

struct StaticOrder {
    int nM, nN, nwg, G, c, pbs;
    __host__ __device__ void init(int M, int N, int G_, int c_) { nM = M / BM; nN = N / BM; nwg = nM * nN; G = G_; c = c_; pbs = -1; }
    __host__ __device__ bool next(int i, Unit& u) const {
        const long L = (long)i * G + c; if (L >= nwg) return false;
        int wgid = (int)L; { const int q = nwg / NXCD, r = nwg % NXCD, xcd = wgid % NXCD, off = wgid / NXCD; wgid = (xcd < r ? xcd * (q + 1) : r * (q + 1) + (xcd - r) * q) + off; }
        const int nig = WGM * nN, gid = wgid / nig, fm = gid * WGM, gsz = (nM - fm) < WGM ? (nM - fm) : WGM;
        u.pm = fm + ((wgid % nig) % gsz); u.pn = (wgid % nig) / gsz; u.pb = pbs >= 0 ? (u.pm >> pbs) : 0; return true;
    }
    __device__ __forceinline__ void a_ready(const Unit&) const {}
    __device__ __forceinline__ void done(const Unit&) const {}
};

__device__ __forceinline__ unsigned cvt_pk_bf16(float lo, float hi) { unsigned r; asm volatile("v_cvt_pk_bf16_f32 %0, %1, %2" : "=v"(r) : "v"(lo), "v"(hi)); return r; }
typedef float f32x2 __attribute__((ext_vector_type(2)));

typedef int i32x8 __attribute__((ext_vector_type(8)));
typedef int i32x4v __attribute__((ext_vector_type(4)));
__device__ __forceinline__ void pg8_mfma_f8(f32x4& c, const i32x8& a, const i32x8& b, int sc) {
    asm("s_nop 1\n\tv_mfma_f32_16x16x128_f8f6f4 %0, %1, %2, %0" : "+v"(c) : "v"(a), "v"(b)); (void)sc; }
__device__ __forceinline__ void pg8_mfma_f8_drain(f32x4 (&acc)[2][2][4][2]) {
#pragma unroll
    for (int a = 0; a < 2; ++a)
#pragma unroll
        for (int b = 0; b < 2; ++b) {
            if (a == 0 && b == 0) asm volatile("s_nop 15\n\ts_nop 15" : "+v"(acc[a][b][0][0]), "+v"(acc[a][b][0][1]), "+v"(acc[a][b][1][0]), "+v"(acc[a][b][1][1]), "+v"(acc[a][b][2][0]), "+v"(acc[a][b][2][1]), "+v"(acc[a][b][3][0]), "+v"(acc[a][b][3][1]));
            else asm volatile("" : "+v"(acc[a][b][0][0]), "+v"(acc[a][b][0][1]), "+v"(acc[a][b][1][0]), "+v"(acc[a][b][1][1]), "+v"(acc[a][b][2][0]), "+v"(acc[a][b][2][1]), "+v"(acc[a][b][3][0]), "+v"(acc[a][b][3][1])); }
}
__device__ __forceinline__ i32x8 pg8_cat(bf16x8 a, bf16x8 b) { return __builtin_shufflevector(__builtin_bit_cast(i32x4v, a), __builtin_bit_cast(i32x4v, b), 0, 1, 2, 3, 4, 5, 6, 7); }
template <class Epi, class Sched, bool ALIGN_EPI = false, bool SP2 = false, bool F8 = false>
__device__ __forceinline__ void gemm_phase(PG8_LAS unsigned char* lds, const Gemm g, const Sched& S, const Epi& E) {
    int tid_o = threadIdx.x; asm volatile("" : "+v"(tid_o)); const int tid = tid_o, wid = __builtin_amdgcn_readfirstlane(tid >> 6), lane = tid & 63, wr = wid >> 2, wc = wid & 3, fr = lane & 15, fq = lane >> 4;
    const int K = g.K, nt = K / BK;
    unsigned voffA[2], voffB[2];
#pragma unroll
    for (int i = 0; i < 2; ++i) { int R, C; stage_rc(tid * 16 + i * 8192, R, C); const int Rb = Epi::PERM ? ((R & ~31) + perm32(R & 31)) : R;
        voffA[i] = (unsigned)(R * g.lda + C) * 2u; voffB[i] = (unsigned)(Rb * g.ldb + C) * 2u; }
    const size_t kstep = (size_t)(BK * 2);
    const size_t hstepA = (size_t)HALF * g.lda * 2, hstepB = (size_t)HALF * g.ldb * 2;
    const size_t tstepA = 2 * hstepA, tstepB = 2 * hstepB;
    const unsigned ldsw = (unsigned)wid * 1024u;
    const int aoff = lds_byte(wr * 64 + fr, fq * 8), boff = lds_byte(wc * 32 + fr, fq * 8);
#define PG8_SA(b, h) (((b) * 2 + (h)) * HTB)
#define PG8_SB(b, h) ((4 + (b) * 2 + (h)) * HTB)
#define PG8_STAGE(bufoff, gbase, voff) do { _Pragma("unroll") for (int _i = 0; _i < 2; ++_i) \
        __builtin_amdgcn_global_load_lds((const unsigned*)((const char*)(gbase) + (voff)[_i]), (PG8_LAS unsigned*)(lds + (bufoff) + ldsw + _i * 8192), 16, 0, 0); } while (0)
#define PG8_LDA(dst, b, h) do { _Pragma("unroll") for (int m = 0; m < 4; ++m) { dst[m].lo = *(const PG8_LAS i32x4v*)(lds + PG8_SA(b, h) + aoff + m * 2048); dst[m].hi = *(const PG8_LAS i32x4v*)(lds + PG8_SA(b, h) + aoff + m * 2048 + 1024); } } while (0)
#define PG8_LDB(dst, b, h) do { _Pragma("unroll") for (int n = 0; n < 2; ++n) { dst[n].lo = *(const PG8_LAS i32x4v*)(lds + PG8_SB(b, h) + boff + n * 2048); dst[n].hi = *(const PG8_LAS i32x4v*)(lds + PG8_SB(b, h) + boff + n * 2048 + 1024); } } while (0)
#define PG8_MMA(ai, bj, At, Bt) do { __builtin_amdgcn_s_setprio(1); \
        if constexpr (F8) { _Pragma("unroll") for (int m = 0; m < 4; ++m) _Pragma("unroll") for (int n = 0; n < 2; ++n) pg8_mfma_f8(acc[ai][bj][m][n], Bt[n], At[m], f8scale); } \
        else { _Pragma("unroll") for (int m = 0; m < 4; ++m) _Pragma("unroll") for (int n = 0; n < 2; ++n) { \
            const i32x4v b_lo = Bt[n].lo, b_hi = Bt[n].hi, a_lo = At[m].lo, a_hi = At[m].hi;     \
            acc[ai][bj][m][n] = __builtin_amdgcn_mfma_f32_16x16x32_bf16(__builtin_bit_cast(bf16x8, b_lo), __builtin_bit_cast(bf16x8, a_lo), acc[ai][bj][m][n], 0, 0, 0); \
            acc[ai][bj][m][n] = __builtin_amdgcn_mfma_f32_16x16x32_bf16(__builtin_bit_cast(bf16x8, b_hi), __builtin_bit_cast(bf16x8, a_hi), acc[ai][bj][m][n], 0, 0, 0); } } \
        __builtin_amdgcn_s_setprio(0); } while (0)
#define PG8_WAIT_V(n) asm volatile("s_waitcnt vmcnt(" #n ")" ::: "memory")
#define PG8_WAIT_L(n) asm volatile("s_waitcnt lgkmcnt(" #n ")" ::: "memory")
#define PG8_BAR __builtin_amdgcn_s_barrier()
#define PG8_SCHED __builtin_amdgcn_sched_barrier(0)
    Unit cur, nxt; int ui = 0;
    if (!S.next(0, cur)) return;
    f32x4 acc[2][2][4][2];
#pragma unroll
    for (int a = 0; a < 2; ++a)
#pragma unroll
        for (int b = 0; b < 2; ++b)
#pragma unroll
            for (int m = 0; m < 4; ++m)
#pragma unroll
                for (int n = 0; n < 2; ++n) acc[a][b][m][n] = (f32x4){0.f, 0.f, 0.f, 0.f};
    int f8scale = 0x7f7f7f7f; asm volatile("" : "+v"(f8scale));
    i32x8 At[4], B0[2], B1[2];
    const char* cA = (const char*)(g.A + (size_t)cur.pb * g.bsA) + (size_t)cur.pm * tstepA; const char* cB = (const char*)(g.Bt + (size_t)cur.pb * g.bsB) + (size_t)cur.pn * tstepB;
    S.a_ready(cur);
    if constexpr (SP2) {
        PG8_STAGE(PG8_SB(0, 0), cB, voffB); PG8_STAGE(PG8_SB(0, 1), cB + hstepB, voffB); PG8_STAGE(PG8_SA(0, 0), cA, voffA); PG8_STAGE(PG8_SA(0, 1), cA + hstepA, voffA);
        if (wr == 1) PG8_BAR;
        PG8_WAIT_V(2); PG8_BAR;
        PG8_STAGE(PG8_SB(1, 0), cB + kstep, voffB); PG8_STAGE(PG8_SA(1, 0), cA + kstep, voffA); PG8_STAGE(PG8_SB(1, 1), cB + hstepB + kstep, voffB);
        PG8_WAIT_V(6); PG8_BAR;
    } else {
        PG8_STAGE(PG8_SB(0, 0), cB, voffB); PG8_STAGE(PG8_SA(0, 0), cA, voffA); PG8_STAGE(PG8_SB(0, 1), cB + hstepB, voffB); PG8_STAGE(PG8_SA(0, 1), cA + hstepA, voffA);
        if (wr == 1) PG8_BAR;
        PG8_WAIT_V(4); PG8_BAR;
        PG8_STAGE(PG8_SB(1, 0), cB + kstep, voffB); PG8_STAGE(PG8_SA(1, 0), cA + kstep, voffA); PG8_STAGE(PG8_SB(1, 1), cB + hstepB + kstep, voffB);
        PG8_WAIT_V(6); PG8_BAR;
    }
    for (;;) {
        const bool has_next = S.next(ui + 1, nxt);
        const char* nA = has_next ? (const char*)(g.A + (size_t)nxt.pb * g.bsA) + (size_t)nxt.pm * tstepA : cA; const char* nB = has_next ? (const char*)(g.Bt + (size_t)nxt.pb * g.bsB) + (size_t)nxt.pn * tstepB : cB;
        for (int t = 0; t < nt; t += 2) {
            const bool last = (t == nt - 2);
            const char* a1 = cA + (size_t)(t + 1) * kstep;
            const char* a2 = last ? nA : cA + (size_t)(t + 2) * kstep; const char* b2 = last ? nB : cB + (size_t)(t + 2) * kstep;
            const char* a3 = a2 + kstep; const char* b3 = b2 + kstep;
            if (last && has_next) S.a_ready(nxt);
            if constexpr (SP2) {
            PG8_LDB(B0, 0, 0); PG8_LDB(B1, 0, 1); PG8_SCHED; PG8_LDA(At, 0, 0); PG8_STAGE(PG8_SA(1, 1), a1 + hstepA, voffA);
            PG8_WAIT_V(8); PG8_WAIT_L(0); PG8_BAR; PG8_MMA(0, 0, At, B0); PG8_MMA(0, 1, At, B1); PG8_BAR; PG8_SCHED;
            PG8_LDA(At, 0, 1); PG8_STAGE(PG8_SB(0, 0), b2, voffB); PG8_STAGE(PG8_SB(0, 1), b2 + hstepB, voffB); PG8_STAGE(PG8_SA(0, 0), a2, voffA);
            PG8_WAIT_V(8); PG8_WAIT_L(0); PG8_BAR; PG8_MMA(1, 0, At, B0); PG8_MMA(1, 1, At, B1); PG8_BAR; PG8_SCHED;
            PG8_LDB(B0, 1, 0); PG8_LDB(B1, 1, 1); PG8_SCHED; PG8_LDA(At, 1, 0); PG8_STAGE(PG8_SA(0, 1), a2 + hstepA, voffA);
            PG8_WAIT_V(8); PG8_WAIT_L(0); PG8_BAR; PG8_MMA(0, 0, At, B0); PG8_MMA(0, 1, At, B1); PG8_BAR; PG8_SCHED;
            PG8_LDA(At, 1, 1); PG8_STAGE(PG8_SB(1, 0), b3, voffB); PG8_STAGE(PG8_SB(1, 1), b3 + hstepB, voffB); PG8_STAGE(PG8_SA(1, 0), a3, voffA);
            PG8_WAIT_V(8); PG8_WAIT_L(0); PG8_BAR; PG8_MMA(1, 0, At, B0); PG8_MMA(1, 1, At, B1); PG8_BAR; PG8_SCHED;
            } else {
            PG8_LDB(B0, 0, 0); PG8_SCHED; PG8_LDA(At, 0, 0); PG8_STAGE(PG8_SA(1, 1), a1 + hstepA, voffA);
            PG8_WAIT_L(8); PG8_BAR; PG8_WAIT_L(0); PG8_MMA(0, 0, At, B0); PG8_BAR; PG8_SCHED;
            PG8_LDB(B1, 0, 1); PG8_STAGE(PG8_SB(0, 0), b2, voffB);
            PG8_BAR; PG8_WAIT_L(0); PG8_MMA(0, 1, At, B1); PG8_BAR;
            PG8_LDA(At, 0, 1); PG8_STAGE(PG8_SA(0, 0), a2, voffA);
            PG8_BAR; PG8_WAIT_L(0); PG8_MMA(1, 0, At, B0); PG8_BAR; PG8_SCHED;
            PG8_STAGE(PG8_SB(0, 1), b2 + hstepB, voffB);
            PG8_WAIT_V(6); PG8_BAR; PG8_MMA(1, 1, At, B1); PG8_BAR;
            PG8_LDB(B0, 1, 0); PG8_SCHED; PG8_LDA(At, 1, 0); PG8_STAGE(PG8_SA(0, 1), a2 + hstepA, voffA);
            PG8_WAIT_L(8); PG8_BAR; PG8_WAIT_L(0); PG8_MMA(0, 0, At, B0); PG8_BAR; PG8_SCHED;
            PG8_LDB(B1, 1, 1); PG8_STAGE(PG8_SB(1, 0), b3, voffB);
            PG8_BAR; PG8_WAIT_L(0); PG8_MMA(0, 1, At, B1); PG8_BAR;
            PG8_LDA(At, 1, 1); PG8_STAGE(PG8_SA(1, 0), a3, voffA);
            PG8_BAR; PG8_WAIT_L(0); PG8_MMA(1, 0, At, B0); PG8_BAR; PG8_SCHED;
            PG8_STAGE(PG8_SB(1, 1), b3 + hstepB, voffB);
            PG8_WAIT_V(6); PG8_BAR; PG8_MMA(1, 1, At, B1); PG8_BAR;
            }
        }
        if constexpr (ALIGN_EPI) { if (wr == 0) PG8_BAR; }
        if constexpr (F8) pg8_mfma_f8_drain(acc);
        if constexpr (!Epi::AFTER_DRAIN) { E(acc, cur, wr, wc, fr, fq); S.done(cur); }
        if (!has_next) break;
#pragma unroll
        for (int a = 0; a < 2; ++a)
#pragma unroll
            for (int b = 0; b < 2; ++b)
#pragma unroll
                for (int m = 0; m < 4; ++m)
#pragma unroll
                    for (int n = 0; n < 2; ++n) acc[a][b][m][n] = (f32x4){0.f, 0.f, 0.f, 0.f};
        cur = nxt; cA = nA; cB = nB; ++ui;
        if constexpr (ALIGN_EPI) { if (wr == 1) PG8_BAR; }
    }
    PG8_WAIT_V(0);
    if constexpr (!ALIGN_EPI) { if (wr == 0) PG8_BAR; }
    PG8_BAR;
    if constexpr (Epi::AFTER_DRAIN) { E.fused(acc, cur, wr, wc, fr, fq, lds, wid, lane); S.done(cur); }
#undef PG8_SA
#undef PG8_SB
#undef PG8_STAGE
#undef PG8_LDA
#undef PG8_LDB
#undef PG8_MMA
#undef PG8_WAIT_V
#undef PG8_WAIT_L
#undef PG8_BAR
#undef PG8_SCHED
}
}
namespace attn {
using bf16 = __hip_bfloat16;
constexpr int   D = 128, NW = 8, QBLK = 32, KVBLK = 64;
constexpr float SCALE = 0.088388347648318440f;
constexpr float THR = 8.f;
constexpr int SDEPTH = 2;
constexpr int LDQ = 1024, LDK = 256, LDO = 2048;
constexpr size_t SHM_V = KVBLK * D * 2, SHM_K = KVBLK * D * 2, SHM_ATTN = 2 * SHM_V + 2 * SHM_K + NW * 64 * 4;
using bf16x8 = __attribute__((ext_vector_type(8))) short;
using s16x4  = __attribute__((ext_vector_type(4))) short;
using f32x16 = __attribute__((ext_vector_type(16))) float;
using f32x8  = __attribute__((ext_vector_type(8))) float;
using u32x4  = __attribute__((ext_vector_type(4))) unsigned;
#define KSWZ(row, colB) ((row) * 256 + ((colB) ^ (((row) & 7) << 4)))
#define SBAR() __builtin_amdgcn_sched_barrier(0)
__device__ __forceinline__ int crow(int r, int hi) { return (r & 3) + 8 * (r >> 2) + 4 * hi; }
__device__ __forceinline__ unsigned cvtpk(float lo, float hi) {
  unsigned r; asm volatile("v_cvt_pk_bf16_f32 %0, %1, %2" : "=v"(r) : "v"(lo), "v"(hi)); return r;
}
template <typename TIn> struct Stage;
template <> struct Stage<bf16>  { using T = bf16x8;
  __device__ static __forceinline__ T ld8(const bf16* p) { return *reinterpret_cast<const bf16x8*>(p); }
  __device__ static __forceinline__ bf16x8 tobf(T x) { return x; } };
template <> struct Stage<float> { using T = f32x8;
  __device__ static __forceinline__ T ld8(const float* p) { return *reinterpret_cast<const f32x8*>(p); }
  __device__ static __forceinline__ bf16x8 tobf(T x) {
    u32x4 w = {cvtpk(x[0], x[1]), cvtpk(x[2], x[3]), cvtpk(x[4], x[5]), cvtpk(x[6], x[7])}; return *reinterpret_cast<bf16x8*>(&w); } };

__device__ __forceinline__ void partialSM(f32x16& p0, f32x16& p1, float& m_reg, float& mn, float& alpha) {
  constexpr float C = SCALE * 1.4426950408889634f;
  float pmax = p0[0]; for (int r = 1; r < 16; ++r) pmax = fmaxf(pmax, p0[r]); for (int r = 0; r < 16; ++r) pmax = fmaxf(pmax, p1[r]);
  { auto rr = __builtin_amdgcn_permlane32_swap(__float_as_uint(pmax), __float_as_uint(pmax), false, false);
    pmax = fmaxf(__uint_as_float(rr[0]), __uint_as_float(rr[1])); }
  if (__builtin_expect(__all(pmax - m_reg <= THR / SCALE), 1)) { mn = m_reg; alpha = 1.f; }
  else { mn = fmaxf(m_reg, pmax); alpha = __builtin_amdgcn_exp2f((m_reg - mn) * C); m_reg = mn; }
  float mnC = -mn * C;
  for (int r = 0; r < 16; ++r) p0[r] = fmaf(p0[r], C, mnC); for (int r = 0; r < 16; ++r) p1[r] = fmaf(p1[r], C, mnC);
  for (int r = 0; r < 16; ++r) p0[r] = __builtin_amdgcn_exp2f(p0[r]);
}
__device__ __forceinline__ void finishSM(f32x16& p0, f32x16& p1, float alpha, float& l_reg, bf16x8& pa0, bf16x8& pa1, bf16x8& pa2, bf16x8& pa3) {
  for (int r = 0; r < 16; ++r) p1[r] = __builtin_amdgcn_exp2f(p1[r]);
  float ps = 0; for (int r = 0; r < 16; ++r) ps += p0[r]; for (int r = 0; r < 16; ++r) ps += p1[r];
  { auto rr = __builtin_amdgcn_permlane32_swap(__float_as_uint(ps), __float_as_uint(ps), false, false);
    ps = __uint_as_float(rr[0]) + __uint_as_float(rr[1]); }
  l_reg = l_reg * alpha + ps;
#define PK4(P, BASE, OUT) do { unsigned a0 = cvtpk(P[BASE + 0], P[BASE + 1]), a1 = cvtpk(P[BASE + 2], P[BASE + 3]);   \
    unsigned b0 = cvtpk(P[BASE + 4], P[BASE + 5]), b1 = cvtpk(P[BASE + 6], P[BASE + 7]);                              \
    auto r0 = __builtin_amdgcn_permlane32_swap(a0, b0, false, false); auto r1 = __builtin_amdgcn_permlane32_swap(a1, b1, false, false); \
    u32x4 w = {r0[0], r1[0], r0[1], r1[1]}; OUT = *reinterpret_cast<bf16x8*>(&w); } while (0)
  PK4(p0, 0, pa0); PK4(p0, 8, pa1); PK4(p1, 0, pa2); PK4(p1, 8, pa3);
#undef PK4
}
__device__ __forceinline__ void qkt(f32x16& p0, f32x16& p1, const bf16* Ks, const bf16x8* qr, int r32, int hi) {
  p0 = f32x16{}; p1 = f32x16{};
  for (int d0 = 0; d0 < 8; ++d0) { int cb = (d0 * 16 + hi * 8) * 2;
    bf16x8 b0 = *reinterpret_cast<const bf16x8*>((const char*)Ks + KSWZ(r32, cb));
    bf16x8 b1 = *reinterpret_cast<const bf16x8*>((const char*)Ks + KSWZ(32 + r32, cb));
    p0 = __builtin_amdgcn_mfma_f32_32x32x16_bf16(b0, qr[d0], p0, 0, 0, 0);
    p1 = __builtin_amdgcn_mfma_f32_32x32x16_bf16(b1, qr[d0], p1, 0, 0, 0); }
}
__device__ __forceinline__ int v_st(int k, int c) { const int kk = (k & ~0xC) | ((k & 4) << 1) | ((k & 8) >> 1); return ((kk >> 3) * 4 + (c >> 5)) * 512 + ((kk & 7) * 32 + (c & 31)) * 2; }
__device__ __forceinline__ int v_rd_base(int lane) { return ((lane & 3) << 3) | (((lane >> 2) & 3) << 6) | (((lane >> 4) & 1) << 5) | (((lane >> 5) & 1) << 8); }
constexpr int v_rd_off(int d0, int ks, int half) { return d0 * 512 + ks * 4096 + half * 2048; }
template <int OFF> __device__ __forceinline__ s16x4 tr_read(int vb) {
  s16x4 r; asm volatile("ds_read_b64_tr_b16 %0, %1 offset:%2" : "=&v"(r) : "v"(vb), "i"(OFF) : "memory"); return r;
}
template <int D0> __device__ __forceinline__ void pv_one(f32x16& od, int vb, bf16x8 pa0, bf16x8 pa1, bf16x8 pa2, bf16x8 pa3) {
  const s16x4 l0 = tr_read<v_rd_off(D0, 0, 0)>(vb), h0 = tr_read<v_rd_off(D0, 0, 1)>(vb), l1 = tr_read<v_rd_off(D0, 1, 0)>(vb), h1 = tr_read<v_rd_off(D0, 1, 1)>(vb);
  const s16x4 l2 = tr_read<v_rd_off(D0, 2, 0)>(vb), h2 = tr_read<v_rd_off(D0, 2, 1)>(vb), l3 = tr_read<v_rd_off(D0, 3, 0)>(vb), h3 = tr_read<v_rd_off(D0, 3, 1)>(vb);
  asm volatile("s_waitcnt lgkmcnt(0)" ::: "memory"); SBAR();
#define PK(L, H) (bf16x8){L[0], L[1], L[2], L[3], H[0], H[1], H[2], H[3]}
  od = __builtin_amdgcn_mfma_f32_32x32x16_bf16(pa0, PK(l0, h0), od, 0, 0, 0);
  od = __builtin_amdgcn_mfma_f32_32x32x16_bf16(pa1, PK(l1, h1), od, 0, 0, 0);
  od = __builtin_amdgcn_mfma_f32_32x32x16_bf16(pa2, PK(l2, h2), od, 0, 0, 0);
  od = __builtin_amdgcn_mfma_f32_32x32x16_bf16(pa3, PK(l3, h3), od, 0, 0, 0);
#undef PK
}
__device__ __forceinline__ void pv_d0(f32x16* o, int vb, bf16x8 pa0, bf16x8 pa1, bf16x8 pa2, bf16x8 pa3) {
  pv_one<0>(o[0], vb, pa0, pa1, pa2, pa3); pv_one<1>(o[1], vb, pa0, pa1, pa2, pa3); pv_one<2>(o[2], vb, pa0, pa1, pa2, pa3); pv_one<3>(o[3], vb, pa0, pa1, pa2, pa3);
}

template <typename TQ>
__device__ __forceinline__ void attn_dense_body(const TQ* __restrict__ Qb, const bf16* __restrict__ Kh, const bf16* __restrict__ Vh,
                                                unsigned char* __restrict__ Ob, int seq, char* lds) {
  using St = Stage<bf16>; using SQ = Stage<TQ>;
  int tid_o = threadIdx.x; asm volatile("" : "+v"(tid_o)); const int tid = tid_o, wid = tid >> 6, lane = tid & 63, r32 = lane & 31, hi = lane >> 5;
  bf16* V_lds = (bf16*)lds; bf16* K_lds = (bf16*)(lds + 2 * SHM_V);
  float* ws = (float*)(lds + 2 * SHM_V + 2 * SHM_K) + wid * 64; float* li_l = ws; float* al_l = ws + 32;
  float m_reg = -1e30f, l_reg = 0; f32x16 o[4] = {}; bf16x8 qr[8];
  const TQ* Qw = Qb + (long)(wid * QBLK + r32) * LDQ + hi * 8;
#pragma unroll
  for (int d0 = 0; d0 < 8; ++d0) qr[d0] = SQ::tobf(SQ::ld8(Qw + d0 * 16));
  const int sr = tid >> 4, sc = (tid & 15) * 8, vst0 = v_st(sr, sc), vst1 = v_st(32 + sr, sc);
  const int vb0 = (int)(uintptr_t)V_lds + v_rd_base(lane);
  struct { typename St::T vs0, vs1, ks0, ks1; } sr_[SDEPTH];
#define SLOAD(i, k0) do { sr_[i].vs0 = St::ld8(&Vh[(long)((k0) + sr) * LDK + sc]); sr_[i].vs1 = St::ld8(&Vh[(long)((k0) + 32 + sr) * LDK + sc]); \
    sr_[i].ks0 = St::ld8(&Kh[(long)((k0) + sr) * LDK + sc]); sr_[i].ks1 = St::ld8(&Kh[(long)((k0) + 32 + sr) * LDK + sc]); } while (0)
#define SWRITE(b, i) do { *(bf16x8*)((char*)V_lds + (b) * SHM_V + vst0) = St::tobf(sr_[i].vs0);          \
    *(bf16x8*)((char*)V_lds + (b) * SHM_V + vst1) = St::tobf(sr_[i].vs1); int kc = sc * 2;               \
    *(bf16x8*)((char*)K_lds + (b) * SHM_K + KSWZ(sr, kc)) = St::tobf(sr_[i].ks0);                       \
    *(bf16x8*)((char*)K_lds + (b) * SHM_K + KSWZ(32 + sr, kc)) = St::tobf(sr_[i].ks1); } while (0)
#define SWAIT() do { if constexpr (SDEPTH == 2) asm volatile("s_waitcnt vmcnt(4)" ::: "memory"); else asm volatile("s_waitcnt vmcnt(0)" ::: "memory"); } while (0)
#define RESC(a) do { if (__any((a) < 1.f)) { if (hi == 0) al_l[r32] = (a); asm volatile("s_waitcnt lgkmcnt(0)" ::: "memory"); \
    for (int d = 0; d < 4; ++d) for (int r = 0; r < 16; ++r) o[d][r] *= al_l[crow(r, hi)]; } } while (0)
  f32x16 pA0, pA1, pB0, pB1; float mnA, mnB, alA, alB; bf16x8 pa0, pa1, pa2, pa3; const int NT = seq / KVBLK;
  constexpr int SE = 0, SO = SDEPTH - 1;
  SLOAD(SE, 0); asm volatile("s_waitcnt vmcnt(0)" ::: "memory"); SWRITE(0, SE); __syncthreads();
  qkt(pA0, pA1, K_lds, qr, r32, hi); partialSM(pA0, pA1, m_reg, mnA, alA);
  SLOAD(SO, KVBLK); if constexpr (SDEPTH == 2) { if (2 < NT) SLOAD(SE, 2 * KVBLK); }
  SWAIT(); SWRITE(1, SO); __syncthreads();
  for (int j = 1; j + 1 < NT; j += 2) {
    SBAR(); qkt(pB0, pB1, (bf16*)((char*)K_lds + SHM_K), qr, r32, hi);
    finishSM(pA0, pA1, alA, l_reg, pa0, pa1, pa2, pa3); SBAR();
    SLOAD(SO, (j + SDEPTH) * KVBLK); SBAR();
    pv_d0(o, vb0, pa0, pa1, pa2, pa3); partialSM(pB0, pB1, m_reg, mnB, alB);
    __syncthreads(); SWAIT(); SWRITE(0, SE);
    RESC(alB); __syncthreads();
    SBAR(); qkt(pA0, pA1, K_lds, qr, r32, hi);
    finishSM(pB0, pB1, alB, l_reg, pa0, pa1, pa2, pa3); SBAR();
    if (SDEPTH == 1 || j + 3 < NT) SLOAD(SE, (j + 1 + SDEPTH) * KVBLK); SBAR();
    pv_d0(o, vb0 + (int)SHM_V, pa0, pa1, pa2, pa3); partialSM(pA0, pA1, m_reg, mnA, alA);
    __syncthreads(); SWAIT(); SWRITE(1, SO);
    RESC(alA); __syncthreads();
  }
  SBAR(); qkt(pB0, pB1, (bf16*)((char*)K_lds + SHM_K), qr, r32, hi);
  finishSM(pA0, pA1, alA, l_reg, pa0, pa1, pa2, pa3); SBAR();
  pv_d0(o, vb0, pa0, pa1, pa2, pa3); partialSM(pB0, pB1, m_reg, mnB, alB);
  __syncthreads(); RESC(alB);
  finishSM(pB0, pB1, alB, l_reg, pa0, pa1, pa2, pa3); SBAR();
  pv_d0(o, vb0 + (int)SHM_V, pa0, pa1, pa2, pa3);
  if (hi == 0) li_l[r32] = l_reg; asm volatile("s_waitcnt lgkmcnt(0)" ::: "memory");
  float rli[16];
#pragma unroll
  for (int r = 0; r < 16; ++r) rli[r] = __builtin_amdgcn_rcpf(li_l[crow(r, hi)]);
  unsigned char* Ow = Ob + (long)(wid * QBLK) * LDO;
#pragma unroll
  for (int r = 0; r < 16; ++r) { int orow = crow(r, hi);
    for (int d0 = 0; d0 < 4; ++d0) Ow[(long)orow * LDO + d0 * 32 + r32] = (unsigned char)(__builtin_amdgcn_cvt_pk_fp8_f32(__builtin_amdgcn_fmed3f(o[d0][r] * rli[r] * 16.0f, -440.f, 440.f), 0.f, 0, false) & 0xff); }
#undef SLOAD
#undef SWRITE
#undef SWAIT
#undef RESC
}
#undef KSWZ
#undef SBAR
}

#define LAS __attribute__((address_space(3)))
typedef unsigned short bf16_t;
typedef short bf16x8 __attribute__((ext_vector_type(8)));
typedef float f32x4 __attribute__((ext_vector_type(4)));
typedef float f32x2 __attribute__((ext_vector_type(2)));
typedef float f32x16 __attribute__((ext_vector_type(16)));
typedef unsigned u32x4 __attribute__((ext_vector_type(4)));
typedef unsigned u32x2 __attribute__((ext_vector_type(2)));

constexpr int NTOK = 16384, DMODEL = 2048, SEQL = 8192;
constexpr size_t MiB = 1u << 20;
constexpr size_t WS_MOD = 0;
constexpr size_t WS_BAR = 512 * 1024;
constexpr size_t WS_S5A = 1 * MiB;
constexpr size_t WS_LNST = 296 * MiB;
constexpr size_t WS_ABT = 2 * MiB;
constexpr size_t WS_BIASQ = 2 * MiB + 64 * 1024;
constexpr size_t WS_ROWSQ = 336 * MiB;
constexpr size_t WS_BIASP = 340 * MiB;
constexpr size_t WS_WQF = 304 * MiB;
constexpr size_t WS_KEYS = 4 * MiB;
constexpr size_t WS_WSB = 5 * MiB;
constexpr size_t WS_WINE = 6 * MiB;
constexpr size_t WS_WOUTE = 16 * MiB;
constexpr size_t WS_WINO = 24 * MiB;
constexpr size_t WS_WOUTO = 56 * MiB;
constexpr size_t WS_WQ = 72 * MiB;
constexpr size_t WS_PU = 88 * MiB;
constexpr size_t WS_PV = 152 * MiB;
constexpr size_t WS_PSC = 5 * MiB + 512 * 1024;
constexpr int PEER_ROWB = 1536;
constexpr bool PEER_SLICE_U = true, PEER_SLICE_V = true;
typedef unsigned u32x6 __attribute__((ext_vector_type(6)));
typedef float f32x16 __attribute__((ext_vector_type(16)));
typedef float f32x32 __attribute__((ext_vector_type(32)));
typedef _Float16 h16x2 __attribute__((ext_vector_type(2)));
typedef _Float16 h16x32 __attribute__((ext_vector_type(32)));
constexpr size_t WS_WY = 216 * MiB;
constexpr size_t WS_WSUM = 232 * MiB;
constexpr size_t WS_H8 = 256 * MiB;
constexpr size_t WS_H = 344 * MiB;
constexpr size_t WS_XB = WS_H;
constexpr size_t WS_TMP = 408 * MiB;
constexpr size_t WS_AB = WS_TMP  , WS_Q = WS_TMP + 64 * MiB, WS_K = WS_TMP + 96 * MiB, WS_V = WS_TMP + 104 * MiB,
                 WS_SS = WS_TMP + 112 * MiB  , WS_CAT = WS_TMP + 176 * MiB;
constexpr size_t WS_Z = WS_TMP, WS_SG = WS_TMP + 256 * MiB;
constexpr size_t WS_QP = WS_TMP;
constexpr size_t WS_X8 = WS_TMP + 64 * MiB;
constexpr size_t WS_RSTD = WS_TMP + 64 * MiB;
constexpr size_t WS_EID = WS_TMP + 128 * MiB;
constexpr size_t WS_GATE = WS_TMP + 136 * MiB;
constexpr size_t WS_PW = WS_TMP + 144 * MiB;
constexpr size_t WS_PO = WS_TMP + 152 * MiB;
constexpr size_t WS_PACT = WS_TMP + 216 * MiB;
typedef unsigned u32x16 __attribute__((ext_vector_type(16)));
typedef __bf16 bf16x2v __attribute__((ext_vector_type(2)));
constexpr size_t WS_END = WS_TMP + 384 * MiB;
constexpr int LDS_BYTES = 147456;

struct P {
    const float *x, *c, *ada_w, *ada_b, *norm_g, *even_w_in, *even_w_out, *lam_re, *lam_im, *log_dt, *b_re, *b_im, *c_re, *c_im, *s5_d, *glu_w, *glu_b,
        *q_g, *k_g, *odd_w_in, *odd_w_out, *sgu_ln_g, *sgu_w, *sgu_b, *peer_wq, *peer_k1, *peer_k2, *peer_u, *peer_v, *final_g;
    float* out; unsigned char* ws;
};

__device__ __forceinline__ unsigned cvtpk(float lo, float hi) { unsigned r; asm("v_cvt_pk_bf16_f32 %0, %1, %2" : "=v"(r) : "v"(lo), "v"(hi)); return r; }
__device__ __forceinline__ unsigned pk_fp8x4(float a, float b, float c, float d) {
    a = __builtin_amdgcn_fmed3f(a, -440.f, 440.f); b = __builtin_amdgcn_fmed3f(b, -440.f, 440.f); c = __builtin_amdgcn_fmed3f(c, -440.f, 440.f); d = __builtin_amdgcn_fmed3f(d, -440.f, 440.f);
    int w = 0; w = __builtin_amdgcn_cvt_pk_fp8_f32(a, b, w, false); w = __builtin_amdgcn_cvt_pk_fp8_f32(c, d, w, true); return (unsigned)w; }
constexpr float F8_WS = 64.0f, F8_HS = 8.0f, F8_SGS = 8.0f, F8_CS = 16.0f, F8_XS = 8.0f;
__device__ __forceinline__ float bflo(unsigned w) { return __uint_as_float(w << 16); }
__device__ __forceinline__ float bfhi(unsigned w) { return __uint_as_float(w & 0xffff0000u); }
__device__ __forceinline__ float wave_sum(float v) {
    v += __uint_as_float(__builtin_amdgcn_update_dpp(0u, __float_as_uint(v), 0xB1, 0xF, 0xF, true));
    v += __uint_as_float(__builtin_amdgcn_update_dpp(0u, __float_as_uint(v), 0x4E, 0xF, 0xF, true));
    v += __uint_as_float(__builtin_amdgcn_update_dpp(0u, __float_as_uint(v), 0x141, 0xF, 0xF, true));
    v += __uint_as_float(__builtin_amdgcn_update_dpp(0u, __float_as_uint(v), 0x140, 0xF, 0xF, true));
    { const auto r = __builtin_amdgcn_permlane16_swap(__float_as_uint(v), __float_as_uint(v), false, false); v = __uint_as_float(r[0]) + __uint_as_float(r[1]); }
    { const auto r = __builtin_amdgcn_permlane32_swap(__float_as_uint(v), __float_as_uint(v), false, false); v = __uint_as_float(r[0]) + __uint_as_float(r[1]); }
    return v;
}
__device__ __forceinline__ float row16_sum(float v) {
    v += __uint_as_float(__builtin_amdgcn_update_dpp(0u, __float_as_uint(v), 0xB1, 0xF, 0xF, true));
    v += __uint_as_float(__builtin_amdgcn_update_dpp(0u, __float_as_uint(v), 0x4E, 0xF, 0xF, true));
    v += __uint_as_float(__builtin_amdgcn_update_dpp(0u, __float_as_uint(v), 0x141, 0xF, 0xF, true));
    v += __uint_as_float(__builtin_amdgcn_update_dpp(0u, __float_as_uint(v), 0x140, 0xF, 0xF, true));
    return v;
}
__device__ __forceinline__ float xrow_sum(float v) {
    { const auto r = __builtin_amdgcn_permlane16_swap(__float_as_uint(v), __float_as_uint(v), false, false); v = __uint_as_float(r[0]) + __uint_as_float(r[1]); }
    { const auto r = __builtin_amdgcn_permlane32_swap(__float_as_uint(v), __float_as_uint(v), false, false); v = __uint_as_float(r[0]) + __uint_as_float(r[1]); }
    return v;
}
__device__ __forceinline__ float sigmoid_f(float x) { return __builtin_amdgcn_rcpf(1.f + __expf(-x)); }
__device__ __forceinline__ float gelu_t(float x) { const float u = 0.7978845608028654f * (x + 0.044715f * x * x * x); return x * __builtin_amdgcn_rcpf(1.f + __expf(-2.f * u)); }
__device__ __forceinline__ void sincos_rad(float ang, float& sn, float& cs) {
    float rev = ang * 0.15915494309189535f; rev = rev - floorf(rev);
    sn = __builtin_amdgcn_sinf(rev); cs = __builtin_amdgcn_cosf(rev);
}
__device__ __forceinline__ float dot4(f32x4 a, f32x4 b) { return (a.x * b.x + a.y * b.y) + (a.z * b.z + a.w * b.w); }
#define LDS_WAIT() asm volatile("s_waitcnt lgkmcnt(0)" ::: "memory")

namespace pg8 {
constexpr int NTOK_ = 16384;
struct EpiEvenSplit {
    static constexpr bool PERM = true, AFTER_DRAIN = false;
    float ds; unsigned char* wsb;
    __device__ __forceinline__ void operator()(const f32x4 (&acc)[2][2][4][2], const Unit& u, int wr, int wc, int fr, int fq) const {
        { const int l_ = lane_id_v(); fr = l_ & 15; fq = l_ >> 4; }
        const int row0 = u.pm * BM + wr * 64 + fr; const int pn = u.pn;
        bf16_t* const UA = (bf16_t*)(wsb + WS_AB);
        if (pn < 4) {
#pragma unroll
            for (int ai = 0; ai < 2; ++ai)
#pragma unroll
                for (int m = 0; m < 4; ++m) { const int t = row0 + ai * HALF + m * 16;
#pragma unroll
                    for (int bj = 0; bj < 2; ++bj) { const int c = pn * 256 + bj * HALF + wc * 32 + 8 * fq; const f32x4 v0 = acc[ai][bj][m][0] * ds, v1 = acc[ai][bj][m][1] * ds;
                        u32x4 w; w.x = cvt_pk_bf16(v0[0], v0[1]); w.y = cvt_pk_bf16(v0[2], v0[3]); w.z = cvt_pk_bf16(v1[0], v1[1]); w.w = cvt_pk_bf16(v1[2], v1[3]);
                        *(u32x4*)(UA + ((size_t)(c >> 4) * 1024 + (t >> 4)) * 512 + (t & 15) * 16 + (c & 15)) = w; } }
            return;
        }
        bf16_t* base; int ldc, colt;
        if (pn < 8) { base = (bf16_t*)(wsb + WS_Q); ldc = 1024; colt = (pn - 4) * 256; } else { base = (bf16_t*)(wsb + (pn == 8 ? WS_K : WS_V)); ldc = 256; colt = 0; }
        const int col0 = colt + wc * 32 + 8 * fq;
#pragma unroll
        for (int ai = 0; ai < 2; ++ai)
#pragma unroll
            for (int m = 0; m < 4; ++m) { bf16_t* rowp = base + (size_t)(row0 + ai * HALF + m * 16) * ldc + col0;
#pragma unroll
                for (int bj = 0; bj < 2; ++bj) { const f32x4 v0 = acc[ai][bj][m][0] * ds, v1 = acc[ai][bj][m][1] * ds;
                    u32x4 w; w.x = cvt_pk_bf16(v0[0], v0[1]); w.y = cvt_pk_bf16(v0[2], v0[3]); w.z = cvt_pk_bf16(v1[0], v1[1]); w.w = cvt_pk_bf16(v1[2], v1[3]);
                    *(u32x4*)(rowp + bj * HALF) = w; } }
    }
};
template <int ACT> struct EpiBf16T {
    static constexpr bool PERM = true, AFTER_DRAIN = false;
    bf16_t* O; int ldc; float ds; float* lnst;
    __device__ __forceinline__ void operator()(const f32x4 (&acc)[2][2][4][2], const Unit& u, int wr, int wc, int fr, int fq) const {
        { const int l_ = lane_id_v(); fr = l_ & 15; fq = l_ >> 4; }
        const int row0 = u.pm * BM + wr * 64 + fr, col0 = u.pn * BM + wc * 32 + 8 * fq;
        const bool do_st = (ACT == 1) && lnst != nullptr && u.pn >= 16;
#pragma unroll
        for (int ai = 0; ai < 2; ++ai)
#pragma unroll
            for (int m = 0; m < 4; ++m) { const int trow = row0 + ai * HALF + m * 16;
                bf16_t* rowp = (ACT == 1) ? O + ((size_t)((trow >> 7) * 16 + (col0 >> 9)) * 128 + (trow & 127)) * 512 + (col0 & 511) : O + (size_t)trow * ldc + col0; float s1 = 0.f, s2 = 0.f;
#pragma unroll
                for (int bj = 0; bj < 2; ++bj) { f32x4 v0 = acc[ai][bj][m][0] * ds, v1 = acc[ai][bj][m][1] * ds;
                    if (ACT == 1) {
#pragma unroll
                        for (int e = 0; e < 4; ++e) { v0[e] = gelu_t(v0[e]); v1[e] = gelu_t(v1[e]); s1 += v0[e] + v1[e]; s2 += v0[e] * v0[e] + v1[e] * v1[e]; } }
                    u32x4 w; w.x = cvt_pk_bf16(v0[0], v0[1]); w.y = cvt_pk_bf16(v0[2], v0[3]); w.z = cvt_pk_bf16(v1[0], v1[1]); w.w = cvt_pk_bf16(v1[2], v1[3]);
                    *(u32x4*)(rowp + bj * HALF) = w; }
                if (ACT == 1) { if (do_st) {
                    s1 = xrow_sum(s1); s2 = xrow_sum(s2);
                    if (fq == 0) *(f32x2*)(lnst + ((size_t)((u.pn - 16) * 4 + wc) * NTOK_ + (row0 + ai * HALF + m * 16)) * 2) = (f32x2){s1, s2}; } }
            }
    }
};
struct EpiResid {
    static constexpr bool PERM = false, AFTER_DRAIN = false;
    const float* xin; float* xout; const float* gate; float ds;
    __device__ __forceinline__ void operator()(const f32x4 (&acc)[2][2][4][2], const Unit& u, int wr, int wc, int fr, int fq) const {
        { const int l_ = lane_id_v(); fr = l_ & 15; fq = l_ >> 4; }
        const int row0 = u.pm * BM + wr * 64 + fr, col0 = u.pn * BM + wc * 32 + 4 * fq;
        const float* gp = gate + (size_t)((u.pm * BM) >> 13) * 12288 + col0;
        f32x4 gv[2][2];
#pragma unroll
        for (int bj = 0; bj < 2; ++bj)
#pragma unroll
            for (int n = 0; n < 2; ++n) gv[bj][n] = *(const f32x4*)(gp + bj * HALF + n * 16) * ds;
#pragma unroll
        for (int ai = 0; ai < 2; ++ai)
#pragma unroll
            for (int m = 0; m < 4; ++m) { const size_t off = (size_t)(row0 + ai * HALF + m * 16) * 2048 + col0;
#pragma unroll
                for (int bj = 0; bj < 2; ++bj)
#pragma unroll
                    for (int n = 0; n < 2; ++n) { const f32x4 xi = *(const f32x4*)(xin + off + bj * HALF + n * 16);
                        *(f32x4*)(xout + off + bj * HALF + n * 16) = xi + gv[bj][n] * acc[ai][bj][m][n]; } }
    }
};
struct EpiF32B {
    static constexpr bool PERM = false, AFTER_DRAIN = false;
    float* C; int ldc; size_t bs;
    __device__ __forceinline__ void operator()(const f32x4 (&acc)[2][2][4][2], const Unit& u, int wr, int wc, int fr, int fq) const {
        { const int l_ = lane_id_v(); fr = l_ & 15; fq = l_ >> 4; }
        char* base = (char*)(C + (size_t)u.pb * bs + (size_t)(u.pm * BM) * ldc);
        const unsigned off0 = (unsigned)((wr * 64 + fr) * ldc + u.pn * BM + wc * 32 + 4 * fq) * 4u;
#pragma unroll
        for (int ai = 0; ai < 2; ++ai)
#pragma unroll
            for (int m = 0; m < 4; ++m) { const unsigned off = off0 + (unsigned)((ai * HALF + m * 16) * ldc) * 4u;
#pragma unroll
                for (int bj = 0; bj < 2; ++bj)
#pragma unroll
                    for (int n = 0; n < 2; ++n) *(f32x4*)(base + off + (bj * HALF + n * 16) * 4) = acc[ai][bj][m][n]; }
    }
};
struct EpiS5Glu {
    static constexpr bool PERM = false, AFTER_DRAIN = false;
    unsigned char* CAT; const PG8_LAS float* wl;
    __device__ __forceinline__ void operator()(const f32x4 (&acc)[2][2][4][2], const Unit& u, int wr, int wc, int fr, int fq) const {
        { const int l_ = lane_id_v(); fr = l_ & 15; fq = l_ >> 4; }
        const int g = u.pb;
#pragma unroll
        for (int ai = 0; ai < 2; ++ai)
#pragma unroll
            for (int m = 0; m < 4; ++m) {
                const int chunk = u.pm * BM + ai * HALF + wr * 64 + m * 16 + fr, token = chunk * 16 + wc * 4 + fq;
                float y[16];
#pragma unroll
                for (int bj = 0; bj < 2; ++bj)
#pragma unroll
                    for (int n = 0; n < 2; ++n)
#pragma unroll
                        for (int j = 0; j < 4; ++j) y[8 * bj + 4 * n + j] = gelu_t(acc[ai][bj][m][n][j]);
                f32x4 z[4];
#pragma unroll
                for (int kq = 0; kq < 4; ++kq) z[kq] = *(const PG8_LAS f32x4*)(wl + 256 + 4 * kq);
#pragma unroll
                for (int h = 0; h < 16; ++h)
#pragma unroll
                    for (int kq = 0; kq < 4; ++kq) z[kq] += *(const PG8_LAS f32x4*)(wl + h * 16 + 4 * kq) * y[h];
                float o[16];
#pragma unroll
                for (int k = 0; k < 16; ++k) o[k] = y[k] * sigmoid_f(z[k >> 2][k & 3]);
                u32x4 w; w.x = pk_fp8x4(o[0] * F8_CS, o[1] * F8_CS, o[2] * F8_CS, o[3] * F8_CS); w.y = pk_fp8x4(o[4] * F8_CS, o[5] * F8_CS, o[6] * F8_CS, o[7] * F8_CS);
                w.z = pk_fp8x4(o[8] * F8_CS, o[9] * F8_CS, o[10] * F8_CS, o[11] * F8_CS); w.w = pk_fp8x4(o[12] * F8_CS, o[13] * F8_CS, o[14] * F8_CS, o[15] * F8_CS);
                *(u32x4*)(CAT + (size_t)token * 2048 + g * 16) = w;
                asm volatile("" ::: "memory");
            }
    }
};
template <bool FIRST> struct EpiResidB {
    static constexpr bool PERM = false, AFTER_DRAIN = false;
    const float* xin; bf16_t* xb; const float* gate; float* rowsq; unsigned char* x8; float ds;
    __device__ __forceinline__ void operator()(const f32x4 (&acc)[2][2][4][2], const Unit& u, int wr, int wc, int fr, int fq) const {
        { const int l_ = lane_id_v(); fr = l_ & 15; fq = l_ >> 4; }
        const int row0 = u.pm * BM + wr * 64 + fr, col0 = u.pn * BM + wc * 32 + 4 * fq;
        const float* gp = gate + (size_t)((u.pm * BM) >> 13) * 12288 + col0; float* const rq = rowsq;
        f32x4 gv[2][2];
#pragma unroll
        for (int bj = 0; bj < 2; ++bj)
#pragma unroll
            for (int n = 0; n < 2; ++n) gv[bj][n] = *(const f32x4*)(gp + bj * HALF + n * 16) * ds;
#pragma unroll
        for (int ai = 0; ai < 2; ++ai) {
            f32x4 xi[4][2][2];
#pragma unroll
            for (int m = 0; m < 4; ++m) { const size_t off = (size_t)(row0 + ai * HALF + m * 16) * 2048 + col0;
#pragma unroll
                for (int bj = 0; bj < 2; ++bj)
#pragma unroll
                    for (int n = 0; n < 2; ++n) {
                        if (FIRST) xi[m][bj][n] = *(const f32x4*)(xin + off + bj * HALF + n * 16);
                        else { const u32x2 w = *(const u32x2*)(xb + off + bj * HALF + n * 16); xi[m][bj][n] = (f32x4){__uint_as_float(w.x << 16), __uint_as_float(w.x & 0xffff0000u), __uint_as_float(w.y << 16), __uint_as_float(w.y & 0xffff0000u)}; } } }
            asm volatile("" ::: "memory");
#pragma unroll
            for (int m = 0; m < 4; ++m) { const int row = row0 + ai * HALF + m * 16; const size_t off = (size_t)row * 2048 + col0; float ss = 0.f;
#pragma unroll
                for (int bj = 0; bj < 2; ++bj)
#pragma unroll
                    for (int n = 0; n < 2; ++n) { const f32x4 xo = xi[m][bj][n] + gv[bj][n] * acc[ai][bj][m][n]; ss += (xo[0] * xo[0] + xo[1] * xo[1]) + (xo[2] * xo[2] + xo[3] * xo[3]);
                        u32x2 o; o.x = cvt_pk_bf16(xo[0], xo[1]); o.y = cvt_pk_bf16(xo[2], xo[3]); *(u32x2*)(xb + off + bj * HALF + n * 16) = o;
                        *(unsigned*)(x8 + off + bj * HALF + n * 16) = pk_fp8x4(xo[0] * F8_XS, xo[1] * F8_XS, xo[2] * F8_XS, xo[3] * F8_XS); }
                ss = xrow_sum(ss);
                if (fq == 0) rq[(size_t)(u.pn * 4 + wc) * NTOK_ + row] = ss; }
        }
    }
};
struct EpiQ {
    static constexpr bool PERM = true, AFTER_DRAIN = false;
    bf16_t* O; const float* rowsq; const float* bias; float ds;
    __device__ __forceinline__ void operator()(const f32x4 (&acc)[2][2][4][2], const Unit& u, int wr, int wc, int fr, int fq) const {
        { const int l_ = lane_id_v(); fr = l_ & 15; fq = l_ >> 4; }
        const int row0 = u.pm * BM + wr * 64 + fr, col0 = u.pn * BM + wc * 32 + 8 * fq;
        const float* bp = bias + (size_t)((u.pm * BM) >> 13) * 2048 + col0;
        f32x4 bv[2][2];
#pragma unroll
        for (int bj = 0; bj < 2; ++bj)
#pragma unroll
            for (int n = 0; n < 2; ++n) bv[bj][n] = *(const f32x4*)(bp + bj * HALF + 4 * n);
        float rstd[2][4];
#pragma unroll
        for (int ai = 0; ai < 2; ++ai)
#pragma unroll
            for (int m = 0; m < 4; ++m) { const int row = row0 + ai * HALF + m * 16; float sq = 0.f;
#pragma unroll
                for (int t = 0; t < 8; ++t) sq += rowsq[(size_t)(fq * 8 + t) * NTOK_ + row];
                rstd[ai][m] = rsqrtf(xrow_sum(sq) * (1.0f / 2048.0f) + 1e-6f) * ds; }
#pragma unroll
        for (int ai = 0; ai < 2; ++ai)
#pragma unroll
            for (int m = 0; m < 4; ++m) { const int row = row0 + ai * HALF + m * 16; bf16_t* rowp = O + (size_t)row * 2048 + col0;
#pragma unroll
                for (int bj = 0; bj < 2; ++bj) { const f32x4 v0 = acc[ai][bj][m][0] * rstd[ai][m] + bv[bj][0], v1 = acc[ai][bj][m][1] * rstd[ai][m] + bv[bj][1];
                    u32x4 w; w.x = cvt_pk_bf16(v0[0], v0[1]); w.y = cvt_pk_bf16(v0[2], v0[3]); w.z = cvt_pk_bf16(v1[0], v1[1]); w.w = cvt_pk_bf16(v1[2], v1[3]);
                    *(u32x4*)(rowp + bj * HALF) = w; } }
    }
};
struct BatchOrder {
    int nM, nU, G, c;
    __device__ __forceinline__ bool next(int i, Unit& u) const { const int L = i * G + c; if (L >= nU) return false; u.pb = L / nM; u.pm = L % nM; u.pn = 0; return true; }
    __device__ __forceinline__ void a_ready(const Unit&) const {}
    __device__ __forceinline__ void done(const Unit&) const {}
};
}

__device__ __forceinline__ unsigned f2bf_rne(float f) { unsigned u = __builtin_bit_cast(unsigned, f); return (u + 0x7fffu + ((u >> 16) & 1u)) >> 16; }
__device__ __forceinline__ unsigned pk2(float lo, float hi) { return f2bf_rne(lo) | (f2bf_rne(hi) << 16); }
__device__ __forceinline__ void p0_transpose_item(const float* W, int K, int N, bf16_t* WT, LAS float* scr, int item, int lane) {
    const int nblk = N / 32, kb = item / nblk, nb = item % nblk, k0 = 64 * kb, n0 = 32 * nb;
#pragma unroll 8
    for (int i = 0; i < 32; ++i) { const int kk = 2 * i + (lane >> 5); scr[kk * 33 + (lane & 31)] = W[(size_t)(k0 + kk) * N + n0 + (lane & 31)]; }
    LDS_WAIT(); asm volatile("" ::: "memory");
    const int c = lane & 7;
#pragma unroll
    for (int j = 0; j < 4; ++j) { const int n = (lane >> 3) + 8 * j; const LAS float* s = scr + (8 * c) * 33 + n;
        u32x4 o; o.x = pk2(s[0 * 33], s[1 * 33]); o.y = pk2(s[2 * 33], s[3 * 33]); o.z = pk2(s[4 * 33], s[5 * 33]); o.w = pk2(s[6 * 33], s[7 * 33]);
        *(u32x4*)(WT + (size_t)(n0 + n) * K + k0 + 8 * c) = o; }
    LDS_WAIT(); asm volatile("" ::: "memory");
}

__device__ __forceinline__ void p0_transpose_item_f8(const float* W, int K, int N, unsigned char* WT, LAS float* scr, int item, int lane, float sc) {
    const int nblk = N / 32, kb = item / nblk, nb = item % nblk, k0 = 64 * kb, n0 = 32 * nb;
#pragma unroll 8
    for (int i = 0; i < 32; ++i) { const int kk = 2 * i + (lane >> 5); scr[kk * 33 + (lane & 31)] = W[(size_t)(k0 + kk) * N + n0 + (lane & 31)] * sc; }
    LDS_WAIT(); asm volatile("" ::: "memory");
    const int c = lane & 7;
#pragma unroll
    for (int j = 0; j < 4; ++j) { const int n = (lane >> 3) + 8 * j; const LAS float* s = scr + (8 * c) * 33 + n;
        u32x2 o; o.x = pk_fp8x4(s[0 * 33], s[1 * 33], s[2 * 33], s[3 * 33]); o.y = pk_fp8x4(s[4 * 33], s[5 * 33], s[6 * 33], s[7 * 33]);
        *(u32x2*)(WT + (size_t)(n0 + n) * K + k0 + 8 * c) = o; }
    LDS_WAIT(); asm volatile("" ::: "memory");
}

__device__ __forceinline__ void s5_gen_group(const P& p, LAS unsigned char* lds, int g, int tid) {
    LAS f32x2* pw = (LAS f32x2*)lds;
    LAS f32x2* Cc = (LAS f32x2*)(lds + 17408);
    LAS f32x2* Bb = (LAS f32x2*)(lds + 17408 + 16384);
    LAS float* Kt = (LAS float*)(lds + 17408 + 32768);
    LAS float* dsk = (LAS float*)(lds + 17408 + 65536);
    __syncthreads();
    if (tid < 128) {
        const int d = tid >> 6, pp = tid & 63, dgp = (d * 64 + g) * 64 + pp;
        const float lr = fminf(p.lam_re[dgp], -1e-4f), li = p.lam_im[dgp], dt = __expf(p.log_dt[d * 64 + g]);
        const float lrdt = lr * dt, ang = li * dt;
#pragma unroll 1
        for (int e = 0; e <= 16; ++e) { const float mag = __expf((float)e * lrdt); float sn, cs; sincos_rad((float)e * ang, sn, cs); pw[e * 128 + tid] = (f32x2){mag * cs, mag * sn}; }
        const f32x2 a1 = pw[128 + tid]; const float abr = a1.x, abi = a1.y;
        const float den = lr * lr + li * li, nr = abr - 1.0f;
        const float cre = (nr * lr + abi * li) / den, cim = (abi * lr - nr * li) / den;
        ((f32x2*)(p.ws + WS_S5A))[dgp] = pw[16 * 128 + tid];
#pragma unroll 4
        for (int h = 0; h < 16; ++h) { const float br = p.b_re[dgp * 16 + h], bi = p.b_im[dgp * 16 + h]; Bb[(d * 64 + pp) * 16 + h] = (f32x2){cre * br - cim * bi, cre * bi + cim * br}; }
    }
    for (int i = tid; i < 2048; i += 512) { const int d = i >> 10, h = (i >> 6) & 15, pp = i & 63; const size_t src = ((size_t)(d * 64 + g) * 16 + h) * 64 + pp; Cc[i] = (f32x2){p.c_re[src], p.c_im[src]}; }
    if (tid < 16) dsk[tid] = p.s5_d[g * 16 + tid];
    __syncthreads();
    {
        const int d = tid >> 8, tau = (tid >> 4) & 15, h = tid & 15; float acc[16];
#pragma unroll
        for (int hp = 0; hp < 16; ++hp) acc[hp] = 0.f;
#pragma unroll 2
        for (int pp = 0; pp < 64; ++pp) { const f32x2 c = Cc[(d * 16 + h) * 64 + pp], w = pw[tau * 128 + d * 64 + pp]; const float tx = c.x * w.x - c.y * w.y, ty = c.x * w.y + c.y * w.x;
#pragma unroll
            for (int hp = 0; hp < 16; ++hp) { const f32x2 bb = Bb[(d * 64 + pp) * 16 + hp]; acc[hp] += tx * bb.x - ty * bb.y; } }
#pragma unroll
        for (int hp = 0; hp < 16; ++hp) Kt[(d * 16 + tau) * 256 + h * 16 + hp] = acc[hp];
    }
    __syncthreads();
    bf16_t* Wy = (bf16_t*)(p.ws + WS_WY) + (size_t)g * 256 * 512;
#pragma unroll 1
    for (int idx = tid; idx < 256 * 256; idx += 512) {
        const int np = idx >> 8, k0 = (idx & 255) * 2;
        const int bj = (np >> 7) & 1, wc = (np >> 5) & 3, n = (np >> 4) & 1, fq = (np >> 2) & 3, j = np & 3, i = wc * 4 + fq, h = 8 * bj + 4 * n + j;
        float v[2];
#pragma unroll
        for (int kk = 0; kk < 2; ++kk) { const int k = k0 + kk;
            if (k < 256) { const int s = k >> 4, hp = k & 15;
                if (s < i) v[kk] = Kt[(i - s) * 256 + h * 16 + hp]; else if (s > i) v[kk] = Kt[(16 + (s - i)) * 256 + h * 16 + hp];
                else v[kk] = Kt[h * 16 + hp] + Kt[16 * 256 + h * 16 + hp] + (h == hp ? dsk[h] : 0.f);
            } else { const int kc = k - 256, d = kc >> 7, pp = (kc >> 1) & 63, ri = kc & 1, e = d ? 16 - i : i + 1;
                const f32x2 c = Cc[(d * 16 + h) * 64 + pp], w = pw[e * 128 + d * 64 + pp]; v[kk] = ri ? -(c.x * w.y + c.y * w.x) : (c.x * w.x - c.y * w.y); } }
        *(unsigned*)(Wy + (size_t)np * 512 + k0) = cvtpk(v[0], v[1]);
    }
    bf16_t* Wsum = (bf16_t*)(p.ws + WS_WSUM) + (size_t)g * 256 * 256;
#pragma unroll 1
    for (int idx = tid; idx < 256 * 128; idx += 512) {
        const int r = idx >> 7, k0 = (idx & 127) * 2, d = r >> 7, pp = (r >> 1) & 63, ri = r & 1;
        float v[2];
#pragma unroll
        for (int kk = 0; kk < 2; ++kk) { const int k = k0 + kk, s = k >> 4, hp = k & 15, e = d ? s : 15 - s;
            const f32x2 w = pw[e * 128 + d * 64 + pp], bb = Bb[(d * 64 + pp) * 16 + hp]; v[kk] = ri ? (w.x * bb.y + w.y * bb.x) : (w.x * bb.x - w.y * bb.y); }
        *(unsigned*)(Wsum + (size_t)r * 256 + k0) = cvtpk(v[0], v[1]);
    }
}

#ifndef PRO_DBL
#define PRO_DBL 0
#endif
#define PRO_REP(b) for (int _pr = 0; _pr < 1 + ((PRO_DBL >> (b)) & 1); ++_pr)
__device__ __forceinline__ void phase_prologue(const P& p, LAS unsigned char* lds, int tid, int lane, int wid) {
    unsigned char* ws = p.ws;
    LAS float* cact = (LAS float*)lds;
    LAS float* red = (LAS float*)(lds + 16384);
    for (int i = tid; i < 4096; i += 512) { const float cv = p.c[i]; cact[i] = cv * sigmoid_f(cv); }
    __syncthreads();
    float* mod = (float*)(ws + WS_MOD);
    PRO_REP(0) for (int item = blockIdx.x; item < 192; item += gridDim.x) {
        const int l = item / 96, cb = item % 96, cg4 = tid & 31, rl = tid >> 5;
        const float* W = p.ada_w + (size_t)l * 2048 * 12288 + cb * 128 + cg4 * 4;
        f32x4 a0 = {0.f, 0.f, 0.f, 0.f}, a1 = {0.f, 0.f, 0.f, 0.f};
#pragma unroll 8
        for (int r = rl; r < 2048; r += 16) { const f32x4 w = __builtin_nontemporal_load((const f32x4*)(W + (size_t)r * 12288)); const float c0 = cact[r], c1 = cact[2048 + r]; a0 += w * c0; a1 += w * c1; }
        *(LAS f32x4*)(red + (rl * 32 + cg4) * 8) = a0; *(LAS f32x4*)(red + (rl * 32 + cg4) * 8 + 4) = a1;
        __syncthreads();
        if (tid < 256) { const int col = tid & 127, b = tid >> 7; float s = 0.f;
#pragma unroll
            for (int r2 = 0; r2 < 16; ++r2) s += red[(r2 * 32 + (col >> 2)) * 8 + b * 4 + (col & 3)];
            s += p.ada_b[l * 12288 + cb * 128 + col]; mod[(l * 2 + b) * 12288 + cb * 128 + col] = s; }
        __syncthreads();
    }
    PRO_REP(1) {
        LAS float* scr = (LAS float*)(lds + 32768 + wid * 8448);
        const int gw = blockIdx.x * 8 + wid, ngw = gridDim.x * 8;
        constexpr int I0 = 32 * 80, I1 = 32 * 64, I2 = 32 * 256, I3 = 64 * 64, NIT = I0 + I1 + I2 + I3;
        for (int it = gw; it < NIT; it += ngw) {
            int r = it;
            if (r < I0) { p0_transpose_item_f8(p.even_w_in, 2048, 2560, ws + WS_WINE, scr, r, lane, F8_WS); continue; } r -= I0;
            if (r < I1) { p0_transpose_item_f8(p.even_w_out, 2048, 2048, ws + WS_WOUTE, scr, r, lane, F8_WS); continue; } r -= I1;
            if (r < I2) { p0_transpose_item_f8(p.odd_w_in, 2048, 8192, ws + WS_WINO, scr, r, lane, F8_WS); continue; } r -= I2;
            p0_transpose_item_f8(p.odd_w_out, 4096, 2048, ws + WS_WOUTO, scr, r, lane, F8_WS);
        }
    }
    const long gtid = (long)blockIdx.x * 512 + tid, ngt = (long)gridDim.x * 512;
    PRO_REP(2) {
        const int gw = blockIdx.x * 8 + wid, ngw = gridDim.x * 8;
        float* psc = (float*)(ws + WS_PSC);
        static_assert(PEER_SLICE_U && PEER_SLICE_V, "the table pass writes the sliced layout");
#define TB_LOAD(V, ROW0) { _Pragma("unroll") for (int rr = 0; rr < 2; ++rr) { const int row = (ROW0) + rr; const bool tv = row >= 2 * 16384; const float* sp = (tv ? p.peer_v : p.peer_u) + (size_t)(tv ? row - 2 * 16384 : row) * 2048 + 4 * lane; \
            _Pragma("unroll") for (int j = 0; j < 8; ++j) V[rr][j] = __builtin_nontemporal_load((const f32x4*)(sp + 256 * j)); } }
#define TB_PROC(V, ROW0) { float am[2]; \
        _Pragma("unroll") for (int rr = 0; rr < 2; ++rr) { am[rr] = 0.f; \
            _Pragma("unroll") for (int j = 0; j < 8; ++j) am[rr] = fmaxf(am[rr], fmaxf(fmaxf(fabsf(V[rr][j].x), fabsf(V[rr][j].y)), fmaxf(fabsf(V[rr][j].z), fabsf(V[rr][j].w)))); \
            _Pragma("unroll") for (int o = 32; o > 0; o >>= 1) am[rr] = fmaxf(am[rr], __shfl_xor(am[rr], o)); } \
        _Pragma("unroll") for (int rr = 0; rr < 2; ++rr) { const int row = (ROW0) + rr; \
            const float sc = am[rr] > 0.f ? 7.5f / am[rr] : 1.0f; \
            if (lane == 0) psc[row] = am[rr] > 0.f ? am[rr] * (1.0f / 7.5f) : 1.0f; \
            f32x16 ev, od;        \
            _Pragma("unroll") for (int j = 0; j < 8; ++j) { const f32x4 t = V[rr][j] * sc; ev[2 * j] = t.x; od[2 * j] = t.y; ev[2 * j + 1] = t.z; od[2 * j + 1] = t.w; } \
            const u32x6 q = __builtin_amdgcn_cvt_scalef32_2xpk16_fp6_f32(ev, od, 1.0f); \
            const bool tv = row >= 2 * 16384; const int r = tv ? row - 2 * 16384 : row; \
              \
            unsigned char* sb = ws + (tv ? WS_PV : WS_PU) + (size_t)(r >> 14) * 16384 * PEER_ROWB + (size_t)(r & 16383) * 192 + 12 * (lane >> 2) + 4 * (lane & 3); \
            const unsigned pc[8] = {q[0] & 0xFFFFFFu, (q[0] >> 24) | ((q[1] & 0xFFFFu) << 8), (q[1] >> 16) | ((q[2] & 0xFFu) << 16), q[2] >> 8, \
                                    q[3] & 0xFFFFFFu, (q[3] >> 24) | ((q[4] & 0xFFFFu) << 8), (q[4] >> 16) | ((q[5] & 0xFFu) << 16), q[5] >> 8}; \
            const int i8 = 8 * (lane & 3); \
            _Pragma("unroll") for (int j = 0; j < 8; ++j) { const unsigned nx = __builtin_amdgcn_update_dpp(0u, pc[j], 0xF9, 0xF, 0xF, true);        \
                const unsigned d = (pc[j] >> i8) | (nx << (24 - i8)); \
                if ((lane & 3) < 3) *(unsigned*)(sb + (size_t)j * 16384 * 192) = d; } } }
        constexpr int NR = 4 * 16384;
        f32x4 va[2][8], vb[2][8];
        int row0 = 2 * gw;
        if (row0 < NR) { TB_LOAD(va, row0) }
#pragma unroll 1
        for (; row0 < NR; row0 += 4 * ngw) {
            const int r1 = row0 + 2 * ngw, r2 = row0 + 4 * ngw;
            { const int rl = r1 < NR ? r1 : row0; TB_LOAD(vb, rl) }
            TB_PROC(va, row0)
            if (r1 >= NR) break;
            { const int rl = r2 < NR ? r2 : row0; TB_LOAD(va, rl) }
            TB_PROC(vb, r1)
        }
#undef TB_LOAD
#undef TB_PROC
    }
    PRO_REP(3) for (int g = (int)gridDim.x - 1 - (int)blockIdx.x; g < 64; g += gridDim.x) s5_gen_group(p, lds, g, tid);
    for (long i = gtid; i < 65536; i += ngt) { const int layer = (int)(i >> 15), half = (int)(i >> 14) & 1, r = (int)(i & 16383);
        ((bf16_t*)(ws + WS_KEYS))[i] = (bf16_t)f2bf_rne((half ? p.peer_k2 : p.peer_k1)[layer * 16384 + r]); }
    for (long i = gtid; i < 131072; i += ngt) ((bf16_t*)(ws + WS_WSB))[i] = (bf16_t)f2bf_rne(p.sgu_w[i]);
}

template <bool OUT8>
__device__ __forceinline__ void phase_adaln(const float* xin, void* hout_, const float* g, const float* shift, const float* scale, int gw, int ngw, int lane) {
    for (int b = 0; b < 2; ++b) {
        f32x4 A[8], Bc[8];
#pragma unroll
        for (int j = 0; j < 8; ++j) { const int c = 8 * lane + 512 * (j >> 1) + 4 * (j & 1);
            const f32x4 gv = *(const f32x4*)(g + c), sc = *(const f32x4*)(scale + b * 12288 + c); A[j] = gv * (sc + 1.0f); Bc[j] = *(const f32x4*)(shift + b * 12288 + c); }
#pragma unroll 1
        for (int row0 = b * 8192 + gw; row0 < (b + 1) * 8192; row0 += 4 * ngw) {
            f32x4 v[4][8];
#pragma unroll
            for (int k = 0; k < 4; ++k) { const int row = row0 + k * ngw < (b + 1) * 8192 ? row0 + k * ngw : row0; const float* xr = xin + (size_t)row * 2048 + 8 * lane;
#pragma unroll
                for (int j = 0; j < 8; ++j) v[k][j] = *(const f32x4*)(xr + 512 * (j >> 1) + 4 * (j & 1)); }
#pragma unroll
            for (int k = 0; k < 4; ++k) { const int row = row0 + k * ngw < (b + 1) * 8192 ? row0 + k * ngw : row0; float ss = 0.f;
#pragma unroll
                for (int j = 0; j < 8; ++j) ss += dot4(v[k][j], v[k][j]);
                ss = wave_sum(ss); const float rstd = rsqrtf(ss * (1.0f / 2048.0f) + 1e-6f);
                bf16_t* hr = (bf16_t*)hout_ + (size_t)row * 2048 + 8 * lane; unsigned char* hr8 = (unsigned char*)hout_ + (size_t)row * 2048 + 8 * lane;
#pragma unroll
                for (int j = 0; j < 4; ++j) { const f32x4 y0 = v[k][2 * j] * rstd * A[2 * j] + Bc[2 * j], y1 = v[k][2 * j + 1] * rstd * A[2 * j + 1] + Bc[2 * j + 1];
                    if (OUT8) { u32x2 o; o.x = pk_fp8x4(y0.x * F8_HS, y0.y * F8_HS, y0.z * F8_HS, y0.w * F8_HS); o.y = pk_fp8x4(y1.x * F8_HS, y1.y * F8_HS, y1.z * F8_HS, y1.w * F8_HS); *(u32x2*)(hr8 + 512 * j) = o; }
                    else { u32x4 o; o.x = cvtpk(y0.x, y0.y); o.y = cvtpk(y0.z, y0.w); o.z = cvtpk(y1.x, y1.y); o.w = cvtpk(y1.z, y1.w);
                    *(u32x4*)(hr + 512 * j) = o; } } }
        }
    }
}

__device__ __forceinline__ void phase_fold_wq(const P& p, LAS unsigned char* lds, int tid, int lane, int wid) {
    unsigned char* ws = p.ws; const float* mod = (const float*)(ws + WS_MOD);
    for (long i = (long)blockIdx.x * 512 + tid; i < 2 * 2 * 2048; i += (long)gridDim.x * 512) { const int l = (int)(i >> 12), b = (int)(i >> 11) & 1, c = (int)(i & 2047);
        float* ab = (float*)(ws + WS_ABT) + (size_t)(l * 2 + b) * 4096;
        ab[c] = p.norm_g[(l * 2 + 1) * 2048 + c] * (1.0f + mod[(size_t)(l * 2 + b) * 12288 + 4 * 2048 + c]); ab[2048 + c] = mod[(size_t)(l * 2 + b) * 12288 + 3 * 2048 + c]; }
    LAS float* scr = (LAS float*)(lds + wid * 8448);
    const int gw = blockIdx.x * 8 + wid, ngw = gridDim.x * 8;
    for (int it = gw; it < 2 * 2048; it += ngw) {
        const int l = it >> 11, item = it & 2047, kb = item >> 6, nb = item & 63, k0 = 64 * kb, n0 = 32 * nb;
        const float* W = p.peer_wq + (size_t)l * 2048 * 2048;
#pragma unroll 8
        for (int i = 0; i < 32; ++i) { const int kk = 2 * i + (lane >> 5); scr[kk * 33 + (lane & 31)] = W[(size_t)(k0 + kk) * 2048 + n0 + (lane & 31)]; }
        LDS_WAIT(); asm volatile("" ::: "memory");
        const int c = lane & 7;
#pragma unroll
        for (int b = 0; b < 2; ++b) {
            const float* mb = mod + (size_t)(l * 2 + b) * 12288; const float* ng = p.norm_g + (l * 2 + 1) * 2048;
            float A[8];
#pragma unroll
            for (int t = 0; t < 8; ++t) A[t] = ng[k0 + 8 * c + t] * (1.0f + mb[4 * 2048 + k0 + 8 * c + t]);
            unsigned char* WT = ws + WS_WQF + (size_t)(l * 2 + b) * 2048 * 2048;
#pragma unroll
            for (int t = 0; t < 8; ++t) A[t] *= F8_WS;
#pragma unroll
            for (int j = 0; j < 4; ++j) { const int n = (lane >> 3) + 8 * j; const LAS float* s = scr + (8 * c) * 33 + n;
                u32x2 o; o.x = pk_fp8x4(s[0 * 33] * A[0], s[1 * 33] * A[1], s[2 * 33] * A[2], s[3 * 33] * A[3]); o.y = pk_fp8x4(s[4 * 33] * A[4], s[5 * 33] * A[5], s[6 * 33] * A[6], s[7 * 33] * A[7]);
                *(u32x2*)(WT + (size_t)(n0 + n) * 2048 + k0 + 8 * c) = o; }
            { const int n = lane & 31, kh = lane >> 5; float acc = 0.f;
#pragma unroll 8
              for (int t = 0; t < 32; ++t) acc += scr[(32 * kh + t) * 33 + n] * mb[3 * 2048 + k0 + 32 * kh + t];
              acc += __shfl_xor(acc, 32);
              if (lane < 32) ((float*)(ws + WS_BIASP))[((size_t)(l * 2 + b) * 32 + kb) * 2048 + n0 + n] = acc; }
        }
        LDS_WAIT(); asm volatile("" ::: "memory");
    }
}

__device__ __forceinline__ void phase_bias_reduce(const P& p, int tid) {
    for (long i = (long)blockIdx.x * 512 + tid; i < 2 * 2 * 2048; i += (long)gridDim.x * 512) { const int lb = (int)(i >> 11), n = (int)(i & 2047); float acc = 0.f;
#pragma unroll 8
        for (int kb = 0; kb < 32; ++kb) acc += ((const float*)(p.ws + WS_BIASP))[((size_t)lb * 32 + kb) * 2048 + n];
        ((float*)(p.ws + WS_BIASQ))[i] = acc; }
}
__device__ __forceinline__ void phase_qkprep(const P& p, int gw, int ngw, int lane) {
    bf16_t* Q = (bf16_t*)(p.ws + WS_Q); bf16_t* K = (bf16_t*)(p.ws + WS_K);
    const int sub = lane >> 4, ll = lane & 15;
    float inv[4], gq[8], gk[8];
#pragma unroll
    for (int e = 0; e < 4; ++e) inv[e] = __builtin_amdgcn_exp2f(-(float)((4 * ll + e) & 31) * 0.41524101186092029f);
#pragma unroll
    for (int e = 0; e < 8; ++e) { gq[e] = p.q_g[8 * ll + e]; gk[e] = p.k_g[8 * ll + e]; }
#pragma unroll 2
    for (int it = gw; it < NTOK * 10 / 4; it += ngw) {
        const int hr = 4 * it + sub, token = hr / 10, hh = hr - token * 10;
        u32x4* ptr = hh < 8 ? (u32x4*)(Q + (size_t)token * 1024 + hh * 128 + 8 * ll) : (u32x4*)(K + (size_t)token * 256 + (hh - 8) * 128 + 8 * ll);
        const u32x4 w = *ptr;
        float x[8] = {bflo(w.x), bfhi(w.x), bflo(w.y), bfhi(w.y), bflo(w.z), bfhi(w.z), bflo(w.w), bfhi(w.w)};
        float ss = 0.f;
#pragma unroll
        for (int e = 0; e < 8; ++e) ss += x[e] * x[e];
        ss = row16_sum(ss);
        const float r = rsqrtf(ss * (1.0f / 128.0f) + 1e-6f);
        const int s = token & 8191; const float pos = (float)(ll < 8 ? (s >> 6) : (s & 63));
        unsigned o[4];
#pragma unroll
        for (int e = 0; e < 4; ++e) { const float x1 = x[2 * e] * r * (hh < 8 ? gq[2 * e] : gk[2 * e]), x2 = x[2 * e + 1] * r * (hh < 8 ? gq[2 * e + 1] : gk[2 * e + 1]);
            float sn, cs; sincos_rad(pos * inv[e], sn, cs); o[e] = cvtpk(x1 * cs - x2 * sn, x1 * sn + x2 * cs); }
        *ptr = (u32x4){o[0], o[1], o[2], o[3]};
    }
}

__device__ __forceinline__ void phase_s5scan(const P& p, LAS unsigned char* lds, int lane, int wid) {
    const f32x2* A16 = (const f32x2*)(p.ws + WS_S5A);
    LAS f32x2* agg = (LAS f32x2*)lds;
    for (int item = blockIdx.x; item < 256; item += gridDim.x) {
        const int b = item >> 7, g = (item >> 1) & 63, d = item & 1;
        const f32x2 a = A16[(d * 64 + g) * 64 + lane];
        const float* S = (const float*)(p.ws + WS_SS) + ((size_t)g * 1024 + b * 512) * 256 + d * 128 + 2 * lane;
        bf16_t* HIN = (bf16_t*)(p.ws + WS_AB) + ((size_t)g * 1024 + b * 512) * 512 + 256 + d * 128 + 2 * lane;
        const int sA = 2 * wid + (d ? 1 : 0), sB = 2 * wid + (d ? 0 : 1), ordA = d ? 15 - sA : sA;
        float ar = 0.f, ai = 0.f, br = 0.f, bi = 0.f;
#pragma unroll 16
        for (int k = 0; k < 32; ++k) { const int o = d ? 31 - k : k; const f32x2 va = *(const f32x2*)(S + (size_t)(32 * sA + o) * 256), vb = *(const f32x2*)(S + (size_t)(32 * sB + o) * 256);
            const float nar = a.x * ar - a.y * ai + va.x, nai = a.x * ai + a.y * ar + va.y, nbr = a.x * br - a.y * bi + vb.x, nbi = a.x * bi + a.y * br + vb.y; ar = nar; ai = nai; br = nbr; bi = nbi; }
        __syncthreads();
        agg[ordA * 64 + lane] = (f32x2){ar, ai}; agg[(ordA + 1) * 64 + lane] = (f32x2){br, bi};
        __syncthreads();
        float pr = a.x, pi = a.y;
#pragma unroll
        for (int q = 0; q < 5; ++q) { const float nr = pr * pr - pi * pi, ni = 2.f * pr * pi; pr = nr; pi = ni; }
        float cr = 0.f, ci = 0.f;
        for (int s2 = 0; s2 < ordA; ++s2) { const f32x2 v = agg[s2 * 64 + lane]; const float nr = pr * cr - pi * ci + v.x, ni = pr * ci + pi * cr + v.y; cr = nr; ci = ni; }
        const float dr = pr * cr - pi * ci + ar, di = pr * ci + pi * cr + ai;
        ar = cr; ai = ci; br = dr; bi = di;
#pragma unroll 16
        for (int k = 0; k < 32; ++k) { const int o = d ? 31 - k : k; const size_t ca = (size_t)(32 * sA + o), cb = (size_t)(32 * sB + o);
            *(unsigned*)(HIN + ca * 512) = cvtpk(ar, ai); *(unsigned*)(HIN + cb * 512) = cvtpk(br, bi);
            const f32x2 va = *(const f32x2*)(S + ca * 256), vb = *(const f32x2*)(S + cb * 256);
            const float nar = a.x * ar - a.y * ai + va.x, nai = a.x * ai + a.y * ar + va.y, nbr = a.x * br - a.y * bi + vb.x, nbi = a.x * bi + a.y * br + vb.y; ar = nar; ai = nai; br = nbr; bi = nbi; }
    }
}

__device__ __forceinline__ void phase_attn(const P& p, char* lds) {
    const bf16_t* Q = (const bf16_t*)(p.ws + WS_Q); const bf16_t* K = (const bf16_t*)(p.ws + WS_K); const bf16_t* V = (const bf16_t*)(p.ws + WS_V);
    unsigned char* CAT = p.ws + WS_CAT;
    const int G = gridDim.x, bx = blockIdx.x, vcu = (G % 8 == 0) ? (bx % 8) * (G / 8) + bx / 8 : bx;
    for (int unit = vcu; unit < 512; unit += G) {
        const int bk = unit >> 7, rem = unit & 127, b = bk >> 1, kvh = bk & 1, h = kvh * 4 + (rem >> 5), qb = rem & 31;
        attn::attn_dense_body<attn::bf16>((const attn::bf16*)(Q + (size_t)(b * 8192 + qb * 256) * 1024 + h * 128),
                                          (const attn::bf16*)(K + (size_t)(b * 8192) * 256 + kvh * 128), (const attn::bf16*)(V + (size_t)(b * 8192) * 256 + kvh * 128),
                                          CAT + (size_t)(b * 8192 + qb * 256) * 2048 + 1024 + h * 128, 8192, lds);
        __syncthreads();
    }
}

constexpr int SGU_VS = 136;
constexpr int SGU_HB = 71680;
constexpr int SGU_VNT = 0, SGU_STG = 128 * SGU_VS * 2, SGU_STAT = 2 * 128 * SGU_VS * 2, SGU_BS = SGU_STAT + 1024;
static_assert(SGU_BS + 512 <= SGU_HB && 2 * SGU_HB <= LDS_BYTES - 64 && SGU_HB % 16 == 0, "SGU LDS map");
__device__ __forceinline__ void phase_sgu(const P& p, LAS unsigned char* lds, int tid, int lane, int wid) {
    const int hb = wid >> 2, w4 = wid & 3, t256 = tid & 255;
    LAS unsigned char* base = lds + hb * SGU_HB;
    LAS bf16_t* vnT = (LAS bf16_t*)(base + SGU_VNT);
    LAS bf16_t* stg = (LAS bf16_t*)(base + SGU_STG);
    LAS f32x2* stats = (LAS f32x2*)(base + SGU_STAT);
    LAS float* bs = (LAS float*)(base + SGU_BS);
    const bf16_t* Z = (const bf16_t*)(p.ws + WS_Z); unsigned char* SG = p.ws + WS_SG;
    const bf16_t* Wsb = (const bf16_t*)(p.ws + WS_WSB);
    const int fr = lane & 15, fq = lane >> 4, wi = w4 & 1, wc = w4 >> 1, i0 = 64 * wi, c0 = 64 * wc;
    for (int up = blockIdx.x; up < 512; up += gridDim.x) {
        const int unit = 2 * up + hb, n = unit >> 3, g = unit & 7;
        __syncthreads();
        if (t256 < 128) { const f32x2* part = (const f32x2*)(p.ws + WS_LNST) + (size_t)(2 * g * 4) * NTOK + (n * 128 + t256); float s1 = 0.f, s2 = 0.f;
#pragma unroll
            for (int q = 0; q < 8; ++q) { const f32x2 a2 = part[(size_t)q * NTOK]; s1 += a2.x; s2 += a2.y; }
            const float mean = s1 * (1.0f / 512.0f), var = fmaxf(s2 * (1.0f / 512.0f) - mean * mean, 0.f); stats[t256] = (f32x2){mean, rsqrtf(var + 1e-6f)};
            bs[t256] = p.sgu_b[g * 128 + t256]; }
        bf16x8 Af[4][4];
#pragma unroll
        for (int m = 0; m < 4; ++m)
#pragma unroll
            for (int ks = 0; ks < 4; ++ks) Af[m][ks] = *(const bf16x8*)(Wsb + (size_t)(g * 128 + i0 + 16 * m + fr) * 128 + 32 * ks + 8 * fq);
#pragma unroll 1
        for (int qt = 0; qt < 4; ++qt) {
            const int chb = g * 512 + qt * 128;
            __syncthreads();
            { u32x4 T[8];
#pragma unroll
              for (int q = 0; q < 8; ++q) { const int pc = t256 + 256 * q, j = pc >> 4, ch = (pc & 15) * 8; T[q] = *(const u32x4*)(Z + ((size_t)(n * 16 + 8 + g) * 128 + j) * 512 + qt * 128 + ch); }
#pragma unroll
              for (int q = 0; q < 8; ++q) { const int pc = t256 + 256 * q, j = pc >> 4, ch = (pc & 15) * 8; *(LAS u32x4*)(stg + j * SGU_VS + ch) = T[q]; } }
            __syncthreads();
#pragma unroll 1
            for (int slab = 0; slab < 2; ++slab) {
                const int cc = slab * 64 + lane; const float lng = p.sgu_ln_g[chb + cc];
                const int cl = cc & 63, rp = (cc & ~63) + ((cl >> 2) & 3) * 16 + (cl >> 4) * 4 + (cl & 3);
#pragma unroll
                for (int jg = 0; jg < 4; ++jg) {
                    const int j0 = 32 * w4 + 8 * jg; float y[8];
#pragma unroll
                    for (int k = 0; k < 8; ++k) { const float xv = bflo((unsigned)stg[(j0 + k) * SGU_VS + cc]); const f32x2 st = stats[j0 + k]; y[k] = (xv - st.x) * st.y * lng; }
                    u32x4 o; o.x = cvtpk(y[0], y[1]); o.y = cvtpk(y[2], y[3]); o.z = cvtpk(y[4], y[5]); o.w = cvtpk(y[6], y[7]);
                    *(LAS u32x4*)(vnT + rp * SGU_VS + j0) = o;
                }
            }
            __syncthreads();
#pragma unroll 1
            for (int np = 0; np < 2; ++np) {
                u32x4 U[4];
#pragma unroll
                for (int m = 0; m < 4; ++m) U[m] = *(const u32x4*)(Z + ((size_t)(n * 16 + g) * 128 + i0 + 16 * m + fr) * 512 + qt * 128 + c0 + 16 * fq + 8 * np);
                f32x4 acc[4][2];
#pragma unroll
                for (int m = 0; m < 4; ++m)
#pragma unroll
                    for (int nn = 0; nn < 2; ++nn) acc[m][nn] = (f32x4){0.f, 0.f, 0.f, 0.f};
#pragma unroll
                for (int ks = 0; ks < 4; ++ks) {
                    bf16x8 Bf[2];
#pragma unroll
                    for (int nn = 0; nn < 2; ++nn) Bf[nn] = *(const LAS bf16x8*)(vnT + (c0 + 16 * (2 * np + nn) + fr) * SGU_VS + 32 * ks + 8 * fq);
#pragma unroll
                    for (int m = 0; m < 4; ++m)
#pragma unroll
                        for (int nn = 0; nn < 2; ++nn) acc[m][nn] = __builtin_amdgcn_mfma_f32_16x16x32_bf16(Bf[nn], Af[m][ks], acc[m][nn], 0, 0, 0);
                }
#pragma unroll
                for (int m = 0; m < 4; ++m) { const int i = i0 + 16 * m + fr; const float bi = bs[i]; const size_t tok = (size_t)(n * 128 + i);
                    const int cch = chb + c0 + 16 * fq + 8 * np;
                    const u32x4 u0 = U[m];
                    const f32x4 s0 = acc[m][0] + bi, s1 = acc[m][1] + bi;
                    u32x2 o;
                    o.x = pk_fp8x4(bflo(u0.x) * s0.x * F8_SGS, bfhi(u0.x) * s0.y * F8_SGS, bflo(u0.y) * s0.z * F8_SGS, bfhi(u0.y) * s0.w * F8_SGS);
                    o.y = pk_fp8x4(bflo(u0.z) * s1.x * F8_SGS, bfhi(u0.z) * s1.y * F8_SGS, bflo(u0.w) * s1.z * F8_SGS, bfhi(u0.w) * s1.w * F8_SGS);
                    *(u32x2*)(SG + tok * 4096 + cch) = o; }
            }
        }
    }
}
#define XB_TMO      128
#define XB_XCNT(j)  (256  + 64 * (j))
#define XB_XSUB(j)  (1280 + 64 * (j))
#define XB_XGEN(j)  (2304 + 64 * (j))
#define XB_TOP      3328
#define XB_TOPGEN   3392
#define XCD_BAR_WORDS 3456
#define XB_SPIN_CAP (1u << 22)

__device__ __forceinline__ unsigned xb_ld(unsigned* p)              { return __hip_atomic_load(p, __ATOMIC_RELAXED, __HIP_MEMORY_SCOPE_AGENT); }
__device__ __forceinline__ unsigned xb_add(unsigned* p, unsigned v) { return __hip_atomic_fetch_add(p, v, __ATOMIC_RELAXED, __HIP_MEMORY_SCOPE_AGENT); }
__device__ __forceinline__ unsigned xb_xcc_id() { return (unsigned)__builtin_amdgcn_s_getreg((3 << 11) | 20) & 0xFu; }
#define XB_SPIN(cond, bar) do { unsigned _sp = 0; while (cond) { __builtin_amdgcn_s_sleep(1); \
    if ((++_sp & 255u) == 0u) { if (xb_ld(&(bar)[XB_TMO])) break; if (_sp > XB_SPIN_CAP) { atomicAdd(&(bar)[XB_TMO], 1u); break; } } } } while (0)

struct XcdBarrier {
    unsigned* bar; unsigned x;
    volatile LAS unsigned* st;
};

__device__ __forceinline__ XcdBarrier xcd_barrier_post(unsigned* bar, volatile LAS unsigned* st) {
    XcdBarrier b; b.bar = bar; b.x = xb_xcc_id(); b.st = st;
    if (threadIdx.x == 0) st[2] = xb_add(&bar[XB_XCNT(b.x)], 1u);
    return b;
}
__device__ __forceinline__ void xcd_barrier_complete(unsigned* bar, unsigned x, unsigned& nloc, unsigned& nx) {
    const unsigned G = gridDim.x * gridDim.y * gridDim.z;
    unsigned sum, cnt, mine, sp = 0u;
    for (;;) {
        sum = 0u; cnt = 0u; mine = 0u;
#pragma unroll
        for (unsigned j = 0; j < 16; ++j) { const unsigned c = xb_ld(&bar[XB_XCNT(j)]); sum += c; cnt += (c > 0u) ? 1u : 0u; mine = (j == x) ? c : mine; }
        if (sum == G) break;
        __builtin_amdgcn_s_sleep(1);
        if ((++sp & 255u) == 0u) { if (xb_ld(&bar[XB_TMO])) break; if (sp > XB_SPIN_CAP) { atomicAdd(&bar[XB_TMO], 1u); break; } }
    }
    nloc = mine > 0u ? mine : 1u; nx = cnt > 0u ? cnt : 1u;
}

__device__ __forceinline__ void xcd_barrier(const XcdBarrier& b) {
    asm volatile("s_waitcnt vmcnt(0)" ::: "memory");
    __syncthreads();
    if (threadIdx.x == 0) {
        unsigned* bar = b.bar;
        __builtin_amdgcn_s_waitcnt(0);
        unsigned nloc = b.st[0], nx = b.st[1];
        if (nloc == 0u) { xcd_barrier_complete(bar, b.x, nloc, nx); b.st[0] = nloc; b.st[1] = nx; }
        const unsigned old = xb_add(&bar[XB_XSUB(b.x)], 1u);
        const unsigned gen = old / nloc;
        if (old + 1u == (gen + 1u) * nloc) {
            __builtin_amdgcn_fence(__ATOMIC_RELEASE, "agent");
            asm volatile("s_waitcnt vmcnt(0)" ::: "memory");
            const unsigned og = xb_add(&bar[XB_TOP], 1u);
            const unsigned tg = og / nx;
            if (og + 1u == (tg + 1u) * nx) xb_add(&bar[XB_TOPGEN], 1u);
            else XB_SPIN(xb_ld(&bar[XB_TOPGEN]) == tg, bar);
            __builtin_amdgcn_fence(__ATOMIC_ACQUIRE, "agent");
            xb_add(&bar[XB_XGEN(b.x)], 1u);
            asm volatile("s_waitcnt vmcnt(0)" ::: "memory");
        } else {
            XB_SPIN(xb_ld(&bar[XB_XGEN(b.x)]) == gen, bar);
            __builtin_amdgcn_fence(__ATOMIC_ACQUIRE, "agent");
            asm volatile("s_waitcnt vmcnt(0)" ::: "memory");
        }
    }
    __syncthreads();
}

__device__ __forceinline__ void ce_desc(float& a, float& b) { const float mx = fmaxf(a, b), mn = fminf(a, b); a = mx; b = mn; }
__device__ __forceinline__ void bitonic_sort16_desc(float (&a)[16]) {
#pragma unroll
    for (int k = 2; k <= 16; k <<= 1)
#pragma unroll
        for (int j = k >> 1; j > 0; j >>= 1)
#pragma unroll
            for (int i = 0; i < 16; ++i) { const int l = i ^ j; if (l > i) { if ((i & k) == 0) ce_desc(a[i], a[l]); else ce_desc(a[l], a[i]); } }
}
__device__ __forceinline__ void merge_top16(float (&V)[16], const float (&S)[16]) {
#pragma unroll
    for (int i = 0; i < 16; ++i) V[i] = fmaxf(V[i], S[15 - i]);
#pragma unroll
    for (int j = 8; j > 0; j >>= 1)
#pragma unroll
        for (int i = 0; i < 16; ++i) { const int l = i ^ j; if (l > i) ce_desc(V[i], V[l]); }
}
__device__ __forceinline__ float with_payload(float v, unsigned mask, unsigned pay) { return __uint_as_float((__float_as_uint(v) & ~mask) | pay); }

__device__ __forceinline__ void peer_topk_half(const bf16_t* qrow, const bf16_t* keys, int r32, int hi, float (&V)[16]) {
    bf16x8 qf[8];
#pragma unroll
    for (int ks = 0; ks < 8; ++ks) qf[ks] = *(const bf16x8*)(qrow + 16 * ks + 8 * hi);
#pragma unroll
    for (int k = 0; k < 16; ++k) V[k] = -INFINITY;
#pragma unroll 1
    for (int t = 0; t < 4; ++t) {
        f32x16 s = (f32x16){0.f, 0.f, 0.f, 0.f, 0.f, 0.f, 0.f, 0.f, 0.f, 0.f, 0.f, 0.f, 0.f, 0.f, 0.f, 0.f};
#pragma unroll
        for (int ks = 0; ks < 8; ++ks) { const bf16x8 kf = *(const bf16x8*)(keys + (size_t)(t * 32 + r32) * 128 + 16 * ks + 8 * hi);
            s = __builtin_amdgcn_mfma_f32_32x32x16_bf16(kf, qf[ks], s, 0, 0, 0); }
        float S[16];
#pragma unroll
        for (int r = 0; r < 16; ++r) S[r] = with_payload(s[r], 0x7Fu, (unsigned)(t * 32 + (r & 3) + 8 * (r >> 2) + 4 * hi));
        bitonic_sort16_desc(S); merge_top16(V, S);
    }
    float PVv[16];
#pragma unroll
    for (int k = 0; k < 16; ++k) { const auto r = __builtin_amdgcn_permlane32_swap(__float_as_uint(V[k]), __float_as_uint(V[k]), false, false); PVv[k] = (hi ? __uint_as_float(r[0]) : __uint_as_float(r[1])); }
    merge_top16(V, PVv);
}

__device__ __forceinline__ void phase_peer_s1(const P& p, int layer, LAS unsigned char* lds, int lane, int wid) {
    LAS int* idxL = (LAS int*)(lds + 65536 + wid * 8192);
    const bf16_t* QP = (const bf16_t*)(p.ws + WS_QP);
    const bf16_t* keys = (const bf16_t*)(p.ws + WS_KEYS) + (size_t)layer * 2 * 16384;
    const float* rowsq = (const float*)(p.ws + WS_ROWSQ) + (size_t)layer * 32 * NTOK; float* RSTD = (float*)(p.ws + WS_RSTD);
    int* EID = (int*)(p.ws + WS_EID); float* GATE = (float*)(p.ws + WS_GATE);
    const int r32 = lane & 31, hi = lane >> 5, gw = blockIdx.x * 8 + wid, ngw = gridDim.x * 8;
#pragma unroll 1
    for (int tq = gw; tq < NTOK / 4; tq += ngw) {
        {
            const bf16_t* qrow = QP + (size_t)(4 * tq + (r32 >> 3)) * 2048 + (r32 & 7) * 256;
            float v1[16], v2[16];
            peer_topk_half(qrow, keys, r32, hi, v1);
            peer_topk_half(qrow + 128, keys + 16384, r32, hi, v2);
#pragma unroll
            for (int k = 0; k < 16; ++k) { idxL[k * 64 + lane] = (int)(__float_as_uint(v1[k]) & 0x7Fu); idxL[(16 + k) * 64 + lane] = (int)(__float_as_uint(v2[k]) & 0x7Fu); }
            float SC[16], S2[16];
#pragma unroll
            for (int b2 = 0; b2 < 16; ++b2) SC[b2] = with_payload(v1[0] + v2[b2], 0xFFu, (unsigned)b2);
#pragma unroll
            for (int a = 1; a <= 4; ++a) {
#pragma unroll
                for (int b2 = 0; b2 < 16; ++b2) S2[b2] = ((a + 1) * (b2 + 1) <= 16) ? with_payload(v1[a] + v2[b2], 0xFFu, (unsigned)(a * 16 + b2)) : -INFINITY;
                merge_top16(SC, S2); }
#pragma unroll
            for (int a = 5; a <= 7; ++a) { S2[2 * (a - 5)] = with_payload(v1[a] + v2[0], 0xFFu, (unsigned)(a * 16)); S2[2 * (a - 5) + 1] = with_payload(v1[a] + v2[1], 0xFFu, (unsigned)(a * 16 + 1)); }
#pragma unroll
            for (int a = 8; a <= 15; ++a) S2[6 + (a - 8)] = with_payload(v1[a] + v2[0], 0xFFu, (unsigned)(a * 16));
            S2[14] = -INFINITY; S2[15] = -INFINITY;
            bitonic_sort16_desc(S2); merge_top16(SC, S2);
            float e[16], sum = 0.f;
#pragma unroll
            for (int k = 0; k < 16; ++k) { e[k] = __expf(SC[k] - SC[0]); sum += e[k]; }
            const float inv = 1.0f / sum;
            if (hi == 0) {
                u32x4 iw[4]; f32x4 gv[4];
#pragma unroll
                for (int k = 0; k < 16; ++k) { const unsigned pay = __float_as_uint(SC[k]) & 0xFFu;
                    iw[k >> 2][k & 3] = (unsigned)(idxL[(pay >> 4) * 64 + lane] * 128 + idxL[(16 + (pay & 15)) * 64 + lane]); gv[k >> 2][k & 3] = e[k] * inv; }
                const size_t gbase = (size_t)(4 * tq + (r32 >> 3)) * 128 + (r32 & 7) * 16;
#pragma unroll
                for (int k4 = 0; k4 < 4; ++k4) { *(u32x4*)(EID + gbase + 4 * k4) = iw[k4]; *(f32x4*)(GATE + gbase + 4 * k4) = gv[k4]; } }
        }
        {
            const int token = 4 * tq + (lane >> 4), w = lane & 15;
            const float sq = row16_sum(rowsq[(size_t)w * NTOK + token] + rowsq[(size_t)(w + 16) * NTOK + token]);
            if (w == 0) RSTD[token] = rsqrtf(sq * (1.0f / 2048.0f) + 1e-6f); }
    }
}

__device__ __forceinline__ float dot2bf(unsigned a, unsigned b, float acc) { return __builtin_amdgcn_fdot2_f32_bf16(__builtin_bit_cast(bf16x2v, a), __builtin_bit_cast(bf16x2v, b), acc, false); }
__device__ __forceinline__ void peer_partition(const P& p, int myrank, int& part, int& rank, int& nwg) {
    unsigned* bar = (unsigned*)(p.ws + WS_BAR); const unsigned x = xb_xcc_id(); unsigned mine = 0u; bool ok = true;
#pragma unroll
    for (unsigned j = 0; j < 16; ++j) { const unsigned cj = xb_ld(&bar[XB_XCNT(j)]); ok = ok && ((j < 8u) ? (cj > 0u) : (cj == 0u)); mine = (j == x) ? cj : mine; }
    if (ok) { part = (int)x; rank = myrank; nwg = (int)mine; } else { part = (int)blockIdx.x & 7; rank = (int)blockIdx.x >> 3; nwg = (int)gridDim.x >> 3; }
    part = __builtin_amdgcn_readfirstlane(part); rank = __builtin_amdgcn_readfirstlane(rank); nwg = __builtin_amdgcn_readfirstlane(nwg);
}
__device__ __forceinline__ void phase_peer_u(const P& p, int layer, LAS unsigned char* lds, int lane, int wid, int myrank) {
    LAS unsigned char* wl = lds + wid * 16384;
    int part, rank, nwg; peer_partition(p, myrank, part, rank, nwg);
    const unsigned char* PUS = p.ws + WS_PU + (size_t)layer * 16384 * PEER_ROWB + (size_t)part * 16384 * 192;
    const int* EID = (const int*)(p.ws + WS_EID);
    const unsigned char* HB = p.ws + WS_XB + 512 * part;
    const float* RSTD = (const float*)(p.ws + WS_RSTD);
    const float* ABs = (const float*)(p.ws + WS_ABT) + (size_t)layer * 2 * 4096 + 256 * part + 4 * lane;
    float* PACT = (float*)(p.ws + WS_PACT) + (size_t)part * NTOK * 128;
    const int g = lane >> 3, s = lane & 7, nb = NTOK / 8, stride = nwg * 8;
    int tb = rank * 8 + wid;
    if (tb >= nb) return;
    int e0[8], e1[8]; u32x2 hs[8]; float rs[8]; f32x4 Av, Bv;
#define PB_LOAD(TB) { _Pragma("unroll") for (int j = 0; j < 8; ++j) { const size_t t = (size_t)(TB) * 8 + j; e0[j] = EID[t * 128 + lane]; e1[j] = EID[t * 128 + 64 + lane]; hs[j] = *(const u32x2*)(HB + t * 4096 + 8 * lane); rs[j] = RSTD[t]; } \
        Av = *(const f32x4*)(ABs + ((TB) >> 10) * 4096); Bv = *(const f32x4*)(ABs + ((TB) >> 10) * 4096 + 2048); }
#define PB_STORE(BUF) _Pragma("unroll") for (int j = 0; j < 8; ++j) { LAS int* il = (LAS int*)(wl + (BUF) * 8192); il[j * 128 + lane] = e0[j]; il[j * 128 + 64 + lane] = e1[j]; \
        u32x2 hw; hw.x = cvtpk(bflo(hs[j].x) * rs[j] * Av.x + Bv.x, bfhi(hs[j].x) * rs[j] * Av.y + Bv.y); hw.y = cvtpk(bflo(hs[j].y) * rs[j] * Av.z + Bv.z, bfhi(hs[j].y) * rs[j] * Av.w + Bv.w); \
        *(LAS u32x2*)(wl + (BUF) * 8192 + 4096 + j * 512 + 8 * lane) = hw; }
#define PR_LOAD(SLOT, ID) { const unsigned char* ur = PUS + (size_t)(ID) * 192 + 24 * s; R[SLOT][0] = *(const u32x2*)ur; R[SLOT][1] = *(const u32x2*)(ur + 8); R[SLOT][2] = *(const u32x2*)(ur + 16); }
    PB_LOAD(tb) PB_STORE(0)
    u32x2 R[8][3];
    { LAS int* il = (LAS int*)wl;
#pragma unroll
      for (int q = 0; q < 8; ++q) { const int id = il[8 * q + g]; PR_LOAD(q, id) } }
    int bi = 0;
#pragma unroll 1
    for (; tb < nb; tb += stride, bi ^= 1) {
        { const int tbn = tb + stride < nb ? tb + stride : tb; PB_LOAD(tbn) }
#pragma unroll 1
        for (int j = 0; j < 8; ++j) {
            if (j == 7) { PB_STORE(bi ^ 1) }
            LAS int* ids = (LAS int*)(wl + bi * 8192) + j * 128;
            LAS int* nid = (j < 7) ? ids + 128 : (LAS int*)(wl + (bi ^ 1) * 8192);
            LAS u32x4* hp = (LAS u32x4*)(wl + bi * 8192 + 4096 + j * 512 + s * 64);
            const u32x4 h0 = hp[0], h1 = hp[1], h2 = hp[2], h3 = hp[3];
            float acc[16];
#pragma unroll
            for (int it = 0; it < 16; ++it) {
                const int sl = it & 7;
                const u32x16 dw = __builtin_bit_cast(u32x16, __builtin_amdgcn_cvt_scalef32_pk32_bf16_fp6((u32x6){R[sl][0].x, R[sl][0].y, R[sl][1].x, R[sl][1].y, R[sl][2].x, R[sl][2].y}, 1.0f));
                { const int idn = (it < 8) ? ids[8 * (it + 8) + g] : nid[8 * (it - 8) + g]; PR_LOAD(sl, idn) }
                float a0 = 0.f, a1 = 0.f;
                a0 = dot2bf(dw[0], h0.x, a0); a1 = dot2bf(dw[1], h0.y, a1); a0 = dot2bf(dw[2], h0.z, a0); a1 = dot2bf(dw[3], h0.w, a1);
                a0 = dot2bf(dw[4], h1.x, a0); a1 = dot2bf(dw[5], h1.y, a1); a0 = dot2bf(dw[6], h1.z, a0); a1 = dot2bf(dw[7], h1.w, a1);
                a0 = dot2bf(dw[8], h2.x, a0); a1 = dot2bf(dw[9], h2.y, a1); a0 = dot2bf(dw[10], h2.z, a0); a1 = dot2bf(dw[11], h2.w, a1);
                a0 = dot2bf(dw[12], h3.x, a0); a1 = dot2bf(dw[13], h3.y, a1); a0 = dot2bf(dw[14], h3.z, a0); a1 = dot2bf(dw[15], h3.w, a1);
                float v = a0 + a1;
                v += __uint_as_float(__builtin_amdgcn_update_dpp(0u, __float_as_uint(v), 0xB1, 0xF, 0xF, true));
                v += __uint_as_float(__builtin_amdgcn_update_dpp(0u, __float_as_uint(v), 0x4E, 0xF, 0xF, true));
                v += __uint_as_float(__builtin_amdgcn_update_dpp(0u, __float_as_uint(v), 0x141, 0xF, 0xF, true));
                acc[it] = v;
            }
            if (s == 0) { float* pa = PACT + ((size_t)tb * 8 + j) * 128 + g;
#pragma unroll
                for (int it = 0; it < 16; ++it) pa[8 * it] = acc[it]; }
        }
    }
#undef PB_LOAD
#undef PB_STORE
#undef PR_LOAD
}

__device__ __forceinline__ void phase_peer_w(const P& p, int layer, int tid) {
    const int* EID = (const int*)(p.ws + WS_EID); const float* GATE = (const float*)(p.ws + WS_GATE); const float* PACT = (const float*)(p.ws + WS_PACT); float* PW = (float*)(p.ws + WS_PW);
    const float* PSU = (const float*)(p.ws + WS_PSC) + layer * 16384; const float* PSV = PSU + 2 * 16384;
#pragma unroll 4
    for (int i = (int)blockIdx.x * 512 + tid; i < NTOK * 128; i += (int)gridDim.x * 512) {
        const int id = EID[i]; float a = 0.f;
#pragma unroll
        for (int x = 0; x < 8; ++x) a += PACT[(size_t)x * NTOK * 128 + i];
        PW[i] = gelu_t(a * PSU[id]) * GATE[i] * PSV[id];
    }
}

__device__ __forceinline__ void phase_peer_vs(const P& p, int layer, LAS unsigned char* lds, int lane, int wid, int myrank) {
    LAS unsigned char* wl = lds + wid * 16384;
    int part, rank, nwg; peer_partition(p, myrank, part, rank, nwg);
    const unsigned char* PVS = p.ws + WS_PV + (size_t)layer * 16384 * PEER_ROWB + (size_t)part * 16384 * 192;
    const int* EID = (const int*)(p.ws + WS_EID); const float* PW = (const float*)(p.ws + WS_PW);
    unsigned char* PO = p.ws + WS_PO + 512 * part;
    const int g = lane >> 3, s = lane & 7, nb = NTOK / 8, stride = nwg * 8;
    const bool b3 = (lane & 8) != 0;
    int tb = rank * 8 + wid;
    if (tb >= nb) return;
    int e0[8], e1[8]; float w0[8], w1[8];
#define PB_LOAD(TB) _Pragma("unroll") for (int j = 0; j < 8; ++j) { const size_t t = (size_t)(TB) * 8 + j; e0[j] = EID[t * 128 + lane]; e1[j] = EID[t * 128 + 64 + lane]; w0[j] = PW[t * 128 + lane]; w1[j] = PW[t * 128 + 64 + lane]; }
#define PB_STORE(BUF) _Pragma("unroll") for (int j = 0; j < 8; ++j) { LAS int* il = (LAS int*)(wl + (BUF) * 8192); LAS float* fl = (LAS float*)(wl + (BUF) * 8192 + 4096); il[j * 128 + lane] = e0[j]; il[j * 128 + 64 + lane] = e1[j]; fl[j * 128 + lane] = w0[j]; fl[j * 128 + 64 + lane] = w1[j]; }
#define PR_LOAD(SLOT, ID) { const unsigned char* vr = PVS + (size_t)(ID) * 192 + 24 * s; R[SLOT][0] = *(const u32x2*)vr; R[SLOT][1] = *(const u32x2*)(vr + 8); R[SLOT][2] = *(const u32x2*)(vr + 16); }
    PB_LOAD(tb) PB_STORE(0)
    u32x2 R[8][3];
    { LAS int* il = (LAS int*)wl;
#pragma unroll
      for (int q = 0; q < 8; ++q) { const int id = il[8 * q + g]; PR_LOAD(q, id) } }
    int bi = 0;
#pragma unroll 1
    for (; tb < nb; tb += stride, bi ^= 1) {
        { const int tbn = tb + stride < nb ? tb + stride : tb; PB_LOAD(tbn) }
#pragma unroll 1
        for (int j = 0; j < 8; ++j) {
            if (j == 7) { PB_STORE(bi ^ 1) }
            LAS int* ids = (LAS int*)(wl + bi * 8192) + j * 128;
            LAS int* nid = (j < 7) ? ids + 128 : (LAS int*)(wl + (bi ^ 1) * 8192);
            LAS float* wv = (LAS float*)(wl + bi * 8192 + 4096) + j * 128;
            h16x2 o2[16];
#pragma unroll
            for (int k = 0; k < 16; ++k) o2[k] = (h16x2){(_Float16)0.f, (_Float16)0.f};
#pragma unroll
            for (int it = 0; it < 16; ++it) {
                const int sl = it & 7;
                const h16x32 d = __builtin_amdgcn_cvt_scalef32_pk32_f16_fp6((u32x6){R[sl][0].x, R[sl][0].y, R[sl][1].x, R[sl][1].y, R[sl][2].x, R[sl][2].y}, 1.0f);
                { const int idn = (it < 8) ? ids[8 * (it + 8) + g] : nid[8 * (it - 8) + g]; PR_LOAD(sl, idn) }
                const _Float16 wh = (_Float16)wv[8 * it + g]; const h16x2 w2 = (h16x2){wh, wh};
#pragma unroll
                for (int k = 0; k < 16; ++k) o2[k] = __builtin_elementwise_fma(w2, (h16x2){d[2 * k], d[2 * k + 1]}, o2[k]);
            }
            h16x2 t8[8], t4[4]; float res[4];
#pragma unroll
            for (int k = 0; k < 8; ++k) { const auto r = __builtin_amdgcn_permlane32_swap(__builtin_bit_cast(unsigned, o2[k]), __builtin_bit_cast(unsigned, o2[8 + k]), false, false);
                unsigned ra = r[0], rb = r[1]; asm volatile("" : "+v"(ra), "+v"(rb)); t8[k] = __builtin_bit_cast(h16x2, ra) + __builtin_bit_cast(h16x2, rb); }
#pragma unroll
            for (int k = 0; k < 4; ++k) { const auto r = __builtin_amdgcn_permlane16_swap(__builtin_bit_cast(unsigned, t8[k]), __builtin_bit_cast(unsigned, t8[4 + k]), false, false);
                unsigned ra = r[0], rb = r[1]; asm volatile("" : "+v"(ra), "+v"(rb)); t4[k] = __builtin_bit_cast(h16x2, ra) + __builtin_bit_cast(h16x2, rb); }
#pragma unroll
            for (int k = 0; k < 2; ++k) { const unsigned lo = __builtin_bit_cast(unsigned, t4[k]), hi = __builtin_bit_cast(unsigned, t4[2 + k]); const unsigned mine = b3 ? hi : lo, send = b3 ? lo : hi;
                const h16x2 rr = __builtin_bit_cast(h16x2, mine) + __builtin_bit_cast(h16x2, (unsigned)__builtin_amdgcn_update_dpp(0u, send, 0x128, 0xF, 0xF, true));
                res[2 * k] = (float)rr.x; res[2 * k + 1] = (float)rr.y; }
            u32x2 ow; ow.x = cvtpk(res[0], res[1]); ow.y = cvtpk(res[2], res[3]);
            *(u32x2*)(PO + ((size_t)tb * 8 + j) * 4096 + 64 * s + 8 * g) = ow;
        }
    }
#undef PB_LOAD
#undef PB_STORE
#undef PR_LOAD
}

template <bool FINAL>
__device__ __forceinline__ void phase_peer_norm(const P& p, int layer, int lane, int wid) {
    bf16_t* XB = (bf16_t*)(p.ws + WS_XB);
    const bf16_t* PO = (const bf16_t*)(p.ws + WS_PO);
    const float* mod = (const float*)(p.ws + WS_MOD);
    float* X = p.out;
    const int gw = blockIdx.x * 8 + wid, ngw = gridDim.x * 8;
    u32x4 pw[4], xw[4];
#define PN_LOAD(T, PWV, XWV) { const bf16_t* por = PO + (size_t)(T) * 2048 + 16 * lane; const bf16_t* xbl = XB + (size_t)(T) * 2048 + 16 * lane; \
        _Pragma("unroll") for (int j = 0; j < 4; ++j) { PWV[j] = *(const u32x4*)(por + 1024 * (j >> 1) + 8 * (j & 1)); XWV[j] = *(const u32x4*)(xbl + 1024 * (j >> 1) + 8 * (j & 1)); } }
    if (gw < NTOK) PN_LOAD(gw, pw, xw)
#pragma unroll 1
    for (int token = gw; token < NTOK; token += ngw) {
        const int b = token >> 13;
        u32x4 pwn[4], xwn[4];
        { const int tn = token + ngw < NTOK ? token + ngw : token; PN_LOAD(tn, pwn, xwn) }
        float o[32];
#pragma unroll
        for (int j = 0; j < 4; ++j) { const u32x4 w = pw[j];
            o[8 * j + 0] = bflo(w.x); o[8 * j + 1] = bfhi(w.x); o[8 * j + 2] = bflo(w.y); o[8 * j + 3] = bfhi(w.y);
            o[8 * j + 4] = bflo(w.z); o[8 * j + 5] = bfhi(w.z); o[8 * j + 6] = bflo(w.w); o[8 * j + 7] = bfhi(w.w); }
        {
            const float* g2 = mod + (size_t)(layer * 2 + b) * 12288 + 5 * 2048 + 16 * lane;
            bf16_t* xbr = XB + (size_t)token * 2048 + 16 * lane; float* xr = X + (size_t)token * 2048 + 16 * lane;
            float xn[32], ss = 0.f;
#pragma unroll
            for (int jh = 0; jh < 2; ++jh) { const u32x4 w0 = xw[2 * jh], w1 = xw[2 * jh + 1];
                const float xi[16] = {bflo(w0.x), bfhi(w0.x), bflo(w0.y), bfhi(w0.y), bflo(w0.z), bfhi(w0.z), bflo(w0.w), bfhi(w0.w), bflo(w1.x), bfhi(w1.x), bflo(w1.y), bfhi(w1.y), bflo(w1.z), bfhi(w1.z), bflo(w1.w), bfhi(w1.w)};
#pragma unroll
                for (int q = 0; q < 4; ++q) { const f32x4 gg = *(const f32x4*)(g2 + 1024 * jh + 4 * q);
#pragma unroll
                    for (int e = 0; e < 4; ++e) { const float t = xi[4 * q + e] + gg[e] * o[16 * jh + 4 * q + e]; xn[16 * jh + 4 * q + e] = t; ss += t * t; } } }
            ss = wave_sum(ss); const float rstd = rsqrtf(ss * (1.0f / 2048.0f) + 1e-6f);
            if (FINAL) {
#pragma unroll
                for (int j = 0; j < 8; ++j) { const int off = 1024 * (j >> 2) + 4 * (j & 3); const f32x4 fg = *(const f32x4*)(p.final_g + 16 * lane + off);
                    f32x4 y;
#pragma unroll
                    for (int e = 0; e < 4; ++e) y[e] = xn[4 * j + e] * rstd * fg[e];
                    *(f32x4*)(xr + off) = y; }
            } else {
                const float* ng = p.norm_g + (size_t)((layer + 1) * 2 + 0) * 2048 + 16 * lane;
                const float* sh = mod + (size_t)((layer + 1) * 2 + b) * 12288 + 16 * lane; const float* sc = sh + 2048;
                unsigned char* hrow8 = p.ws + WS_H8 + (size_t)token * 2048 + 16 * lane;
#pragma unroll
                for (int jh = 0; jh < 2; ++jh) { float y[16];
#pragma unroll
                    for (int hq = 0; hq < 4; ++hq) { const int jj = 4 * jh + hq, off = 1024 * jh + 4 * hq; const f32x4 gv = *(const f32x4*)(ng + off), sv = *(const f32x4*)(sc + off), hv = *(const f32x4*)(sh + off);
                        f32x4 xo;
#pragma unroll
                        for (int e = 0; e < 4; ++e) { xo[e] = xn[4 * jj + e]; y[4 * hq + e] = (xo[e] * rstd * gv[e] * (1.0f + sv[e]) + hv[e]) * F8_HS; }
                        u32x2 xw; xw.x = cvtpk(xo[0], xo[1]); xw.y = cvtpk(xo[2], xo[3]); *(u32x2*)(xbr + off) = xw; }
                    u32x4 w; w.x = pk_fp8x4(y[0], y[1], y[2], y[3]); w.y = pk_fp8x4(y[4], y[5], y[6], y[7]); w.z = pk_fp8x4(y[8], y[9], y[10], y[11]); w.w = pk_fp8x4(y[12], y[13], y[14], y[15]);
                    *(u32x4*)(hrow8 + 1024 * jh) = w; }
            }
        }
#pragma unroll
        for (int j = 0; j < 4; ++j) { pw[j] = pwn[j]; xw[j] = xwn[j]; }
    }
#undef PN_LOAD
}

#ifndef PH_MASK
#define PH_MASK 0xFFFF
#endif
#define PH(b) if constexpr ((PH_MASK >> (b)) & 1)
#ifndef DBL_MASK
#define DBL_MASK 0
#endif
#define REP(b) for (int _r = 0; _r < 1 + ((DBL_MASK >> (b)) & 1); ++_r)
__device__ __forceinline__ int fresh_tid() { int t = threadIdx.x; asm volatile("" : "+v"(t)); return t; }
__device__ __forceinline__ P load_p() {
    typedef __attribute__((address_space(1))) float* gp;
    typedef const gp __attribute__((address_space(4)))* cq;
    cq q = (cq)__builtin_amdgcn_kernarg_segment_ptr(); asm volatile("" : "+s"(q));
    P r; float** d = (float**)&r;
#pragma unroll
    for (int i = 0; i < (int)(sizeof(P) / 8); ++i) d[i] = (float*)q[i];
    return r;
}
#define LP (load_p())
#define WSB (load_p().ws)
#define MODP ((const float*)(load_p().ws + WS_MOD))
#define HP ((bf16_t*)(load_p().ws + WS_H))
__global__ void __launch_bounds__(512, 2) mk_fwd(P p_arg) {
    extern __shared__ __attribute__((aligned(16))) unsigned char lds_raw[];
    LAS unsigned char* lds = (LAS unsigned char*)lds_raw;
    cg::grid_group grid = cg::this_grid();
    const int wid = __builtin_amdgcn_readfirstlane((int)threadIdx.x >> 6);
    const int gw = blockIdx.x * 8 + wid, ngw = gridDim.x * 8, G = gridDim.x;
    volatile LAS unsigned* xst = (volatile LAS unsigned*)(lds + LDS_BYTES - 64);
    if (threadIdx.x < 16) xst[threadIdx.x] = 0u;
    __syncthreads();
    const XcdBarrier xb = xcd_barrier_post((unsigned*)(load_p().ws + WS_BAR), xst);
#define TID (fresh_tid())
#define LANE (fresh_tid() & 63)

    REP(0) { PH(0) phase_prologue(LP, lds, TID, LANE, wid);
    grid.sync(); }
    REP(1) { PH(1) phase_adaln<true>(LP.x, WSB + WS_H8, LP.norm_g, MODP, MODP + 2048, gw, ngw, LANE);
    xcd_barrier(xb); }
    REP(2) { PH(2) {   pg8::Gemm g{(const bf16_t*)(WSB + WS_H8), (const bf16_t*)(WSB + WS_WINE), NTOK, 2560, 1024, 1024, 1024, 0, 0}; pg8::StaticOrder S; S.init(NTOK, 2560, G, (int)blockIdx.x);
        pg8::EpiEvenSplit E{1.0f / (F8_HS * F8_WS), WSB};
        pg8::gemm_phase<pg8::EpiEvenSplit, pg8::StaticOrder, true, true, true>(lds, g, S, E); }
    xcd_barrier(xb); }
    PH(3) { phase_qkprep(LP, gw, ngw, LANE); phase_fold_wq(LP, lds, TID, LANE, wid); __syncthreads(); }
    REP(4) { PH(4) {
        pg8::Gemm g{(const bf16_t*)(WSB + WS_AB), (const bf16_t*)(WSB + WS_WSUM), 1024, 256, 256, 512, 256, (size_t)1024 * 512, (size_t)256 * 256};
        pg8::BatchOrder S{4, 256, G, (int)blockIdx.x}; pg8::EpiF32B E{(float*)(WSB + WS_SS), 256, (size_t)1024 * 256};
        pg8::gemm_phase<pg8::EpiF32B, pg8::BatchOrder, false, false>(lds, g, S, E); }
    xcd_barrier(xb); }
    REP(5) { PH(5) { phase_s5scan(LP, lds, LANE, wid); phase_bias_reduce(LP, TID); }
    xcd_barrier(xb); }
    REP(13) { PH(13) {
        pg8::Gemm g{(const bf16_t*)(WSB + WS_AB), (const bf16_t*)(WSB + WS_WY), 1024, 256, 512, 512, 512, (size_t)1024 * 512, (size_t)256 * 512};
        LAS float* wl = (LAS float*)(lds + 131072);
        { const int un = (int)blockIdx.x;
            const int tid = TID; __syncthreads();
            if (tid < 256) wl[tid] = LP.glu_w[(un >> 2) * 256 + tid]; else if (tid < 272) wl[tid] = LP.glu_b[(un >> 2) * 16 + tid - 256];
            __syncthreads();
            pg8::BatchOrder S{4, un + 1, 256, un}; pg8::EpiS5Glu E{WSB + WS_CAT, wl};
            pg8::gemm_phase<pg8::EpiS5Glu, pg8::BatchOrder, false, false>(lds, g, S, E); }
        __syncthreads(); } }
    REP(6) { PH(6) phase_attn(LP, (char*)lds_raw);
    xcd_barrier(xb); }
    REP(7) { PH(7) {   pg8::Gemm g{(const bf16_t*)(WSB + WS_CAT), (const bf16_t*)(WSB + WS_WOUTE), NTOK, 2048, 1024, 1024, 1024, 0, 0}; pg8::StaticOrder S; S.init(NTOK, 2048, G, (int)blockIdx.x);
        pg8::EpiResidB<true> E{LP.x, (bf16_t*)(WSB + WS_XB), MODP + 2 * 2048, (float*)(WSB + WS_ROWSQ), WSB + WS_X8, 1.0f / (F8_CS * F8_WS)};
        pg8::gemm_phase<pg8::EpiResidB<true>, pg8::StaticOrder, true, true, true>(lds, g, S, E); }
    xcd_barrier(xb); }
    REP(8) { PH(8) {   pg8::Gemm g{(const bf16_t*)(WSB + WS_X8), (const bf16_t*)(WSB + WS_WQF), NTOK, 2048, 1024, 1024, 1024, 0, (size_t)2048 * 1024}; pg8::StaticOrder S; S.init(NTOK, 2048, G, (int)blockIdx.x); S.pbs = 5;
        pg8::EpiQ E{(bf16_t*)(WSB + WS_QP), (const float*)(WSB + WS_ROWSQ), (const float*)(WSB + WS_BIASQ), 1.0f / (F8_XS * F8_WS)};
        pg8::gemm_phase<pg8::EpiQ, pg8::StaticOrder, true, true, true>(lds, g, S, E); }
    xcd_barrier(xb); }
    REP(16) { PH(9) phase_peer_s1(LP, 0, lds, LANE, wid); }
    xcd_barrier(xb);
    REP(17) { PH(9) phase_peer_u(LP, 0, lds, LANE, wid, (int)xst[2]); }
    xcd_barrier(xb);
    REP(18) { PH(9) phase_peer_w(LP, 0, TID); }
    xcd_barrier(xb);
    REP(19) { PH(9) phase_peer_vs(LP, 0, lds, LANE, wid, (int)xst[2]); }
    xcd_barrier(xb);
    PH(9) phase_peer_norm<false>(LP, 0, LANE, wid);
    xcd_barrier(xb);
    REP(10) { PH(10) {   pg8::Gemm g{(const bf16_t*)(WSB + WS_H8), (const bf16_t*)(WSB + WS_WINO), NTOK, 8192, 1024, 1024, 1024, 0, 0}; pg8::StaticOrder S; S.init(NTOK, 8192, G, (int)blockIdx.x);
        pg8::EpiBf16T<1> E{(bf16_t*)(WSB + WS_Z), 8192, 1.0f / (F8_HS * F8_WS), (float*)(WSB + WS_LNST)};
        pg8::gemm_phase<pg8::EpiBf16T<1>, pg8::StaticOrder, true, true, true>(lds, g, S, E); }
    xcd_barrier(xb); }
    REP(11) { PH(11) phase_sgu(LP, lds, TID, LANE, wid);
    xcd_barrier(xb); }
    PH(12) {   pg8::Gemm g{(const bf16_t*)(WSB + WS_SG), (const bf16_t*)(WSB + WS_WOUTO), NTOK, 2048, 2048, 2048, 2048, 0, 0}; pg8::StaticOrder S; S.init(NTOK, 2048, G, (int)blockIdx.x);
        pg8::EpiResidB<false> E{nullptr, (bf16_t*)(WSB + WS_XB), MODP + 2 * 12288 + 2 * 2048, (float*)(WSB + WS_ROWSQ) + (size_t)32 * NTOK, WSB + WS_X8, 1.0f / (F8_SGS * F8_WS)};
        pg8::gemm_phase<pg8::EpiResidB<false>, pg8::StaticOrder, true, true, true>(lds, g, S, E); }
    xcd_barrier(xb);
    REP(8) { PH(8) {   pg8::Gemm g{(const bf16_t*)(WSB + WS_X8), (const bf16_t*)(WSB + WS_WQF) + (size_t)2 * 2048 * 1024, NTOK, 2048, 1024, 1024, 1024, 0, (size_t)2048 * 1024}; pg8::StaticOrder S; S.init(NTOK, 2048, G, (int)blockIdx.x); S.pbs = 5;
        pg8::EpiQ E{(bf16_t*)(WSB + WS_QP), (const float*)(WSB + WS_ROWSQ) + (size_t)32 * NTOK, (const float*)(WSB + WS_BIASQ) + 2 * 2048, 1.0f / (F8_XS * F8_WS)};
        pg8::gemm_phase<pg8::EpiQ, pg8::StaticOrder, true, true, true>(lds, g, S, E); }
    xcd_barrier(xb); }
    REP(16) { PH(9) phase_peer_s1(LP, 1, lds, LANE, wid); }
    xcd_barrier(xb);
    REP(17) { PH(9) phase_peer_u(LP, 1, lds, LANE, wid, (int)xst[2]); }
    xcd_barrier(xb);
    REP(18) { PH(9) phase_peer_w(LP, 1, TID); }
    xcd_barrier(xb);
    REP(19) { PH(9) phase_peer_vs(LP, 1, lds, LANE, wid, (int)xst[2]); }
    xcd_barrier(xb);
    PH(9) phase_peer_norm<true>(LP, 1, LANE, wid);
}

#undef LP
#undef WSB
#undef MODP
#undef HP
extern "C" void kernel_launch(void* const* d_in, const int* in_sizes, int n_in, void* d_out, int out_size, void* d_ws, size_t ws_size, hipStream_t stream) {
    static int grid = 0;
    if (grid == 0) {
        if (n_in != 30 || out_size != NTOK * DMODEL || ws_size < WS_END) { fprintf(stderr, "kernel_launch: unexpected shapes (n_in %d out %d ws %zu, need ws >= %zu)\n", n_in, out_size, ws_size, (size_t)WS_END); grid = -1; return; }
        int dev = 0, cus = 0, per_cu = 0;
        (void)hipGetDevice(&dev); (void)hipDeviceGetAttribute(&cus, hipDeviceAttributeMultiprocessorCount, dev);
        if (hipFuncSetAttribute((const void*)mk_fwd, hipFuncAttributeMaxDynamicSharedMemorySize, LDS_BYTES) != hipSuccess) { fprintf(stderr, "kernel_launch: hipFuncSetAttribute failed\n"); grid = -1; return; }
        if (hipOccupancyMaxActiveBlocksPerMultiprocessor(&per_cu, (const void*)mk_fwd, 512, LDS_BYTES) != hipSuccess || per_cu < 1) { fprintf(stderr, "kernel_launch: occupancy query says %d\n", per_cu); (void)hipGetLastError(); per_cu = 1; }
        grid = cus;
        if (grid > cus * per_cu) grid = cus * per_cu;
        if (grid != 256) { fprintf(stderr, "kernel_launch: this kernel is laid out for a 256-CU device (got %d workgroups)\n", grid); grid = -1; return; }
    }
    if (grid < 0) return;
    if (hipMemsetAsync((char*)d_ws + WS_BAR, 0, 16384, stream) != hipSuccess) { fprintf(stderr, "kernel_launch: hipMemsetAsync failed\n"); return; }
    P p{};
    const float** pf = (const float**)&p;
    for (int i = 0; i < 30; ++i) pf[i] = (const float*)d_in[i];
    p.out = (float*)d_out; p.ws = (unsigned char*)d_ws;
    void* args[] = {&p};
    hipError_t e = hipLaunchCooperativeKernel((const void*)mk_fwd, dim3(grid), dim3(512), args, LDS_BYTES, stream);
    if (e != hipSuccess) fprintf(stderr, "kernel_launch: cooperative launch failed: %s (grid %d)\n", hipGetErrorString(e), grid);
}
```

```cpp
#include <hip/hip_runtime.h>
#include <hip/hip_cooperative_groups.h>
#include <hip/hip_bf16.h>
#include <cstdio>
#include <cstdint>
namespace cg = cooperative_groups;

__device__ __forceinline__ int lane_id_v() { int l; asm volatile("v_mbcnt_lo_u32_b32 %0, -1, 0\n\tv_mbcnt_hi_u32_b32 %0, -1, %0" : "=v"(l)); return l; }

namespace pg8 {
#define PG8_LAS __attribute__((address_space(3)))
typedef unsigned short bf16_t;
typedef short bf16x8 __attribute__((ext_vector_type(8)));
typedef float f32x4 __attribute__((ext_vector_type(4)));
typedef unsigned u32x4 __attribute__((ext_vector_type(4)));
constexpr int BM = 256, BK = 64, HALF = 128, HTB = HALF * BK * 2  , STAGE_BYTES = 8 * HTB, NXCD = 8, WGM = 8;

__host__ __device__ __forceinline__ int lds_byte(int r, int c) { const int st = (r >> 4) * 2 + (c >> 5), rr = r & 15, cc = c & 31, ob = rr * 64 + cc * 2; return st * 1024 + (ob ^ (((ob >> 9) & 1) << 5)); }
__host__ __device__ __forceinline__ void stage_rc(int b, int& R, int& C) { const int st = b / 1024, sb = b % 1024, swz = sb ^ (((sb >> 9) & 1) << 5); R = (st >> 1) * 16 + swz / 64; C = (st & 1) * 32 + (swz % 64) / 2; }
__host__ __device__ __forceinline__ int perm32(int rho) { const int n = rho >> 4, i = rho & 15; return 8 * (i >> 2) + 4 * n + (i & 3); }

struct Unit { int pm, pn, pb; };
struct Gemm { const bf16_t* A; const bf16_t* Bt; int M, N, K; int lda, ldb; size_t bsA, bsB; };

struct StaticOrder {
    int nM, nN, nwg, G, c, pbs;
    __host__ __device__ void init(int M, int N, int G_, int c_) { nM = M / BM; nN = N / BM; nwg = nM * nN; G = G_; c = c_; pbs = -1; }
    __host__ __device__ bool next(int i, Unit& u) const {
        const long L = (long)i * G + c; if (L >= nwg) return false;
        int wgid = (int)L; { const int q = nwg / NXCD, r = nwg % NXCD, xcd = wgid % NXCD, off = wgid / NXCD; wgid = (xcd < r ? xcd * (q + 1) : r * (q + 1) + (xcd - r) * q) + off; }
        const int nig = WGM * nN, gid = wgid / nig, fm = gid * WGM, gsz = (nM - fm) < WGM ? (nM - fm) : WGM;
        u.pm = fm + ((wgid % nig) % gsz); u.pn = (wgid % nig) / gsz; u.pb = pbs >= 0 ? (u.pm >> pbs) : 0; return true;
    }
    __device__ __forceinline__ void a_ready(const Unit&) const {}
    __device__ __forceinline__ void done(const Unit&) const {}
};

__device__ __forceinline__ unsigned cvt_pk_bf16(float lo, float hi) { unsigned r; asm volatile("v_cvt_pk_bf16_f32 %0, %1, %2" : "=v"(r) : "v"(lo), "v"(hi)); return r; }
typedef float f32x2 __attribute__((ext_vector_type(2)));

typedef int i32x8 __attribute__((ext_vector_type(8)));
typedef int i32x4v __attribute__((ext_vector_type(4)));
__device__ __forceinline__ void pg8_mfma_f8(f32x4& c, const i32x8& a, const i32x8& b, int sc) {
    asm("s_nop 1\n\tv_mfma_f32_16x16x128_f8f6f4 %0, %1, %2, %0" : "+v"(c) : "v"(a), "v"(b)); (void)sc; }
__device__ __forceinline__ void pg8_mfma_f8_drain(f32x4 (&acc)[2][2][4][2]) {
#pragma unroll
    for (int a = 0; a < 2; ++a)
#pragma unroll
        for (int b = 0; b < 2; ++b) {
            if (a == 0 && b == 0) asm volatile("s_nop 15\n\ts_nop 15" : "+v"(acc[a][b][0][0]), "+v"(acc[a][b][0][1]), "+v"(acc[a][b][1][0]), "+v"(acc[a][b][1][1]), "+v"(acc[a][b][2][0]), "+v"(acc[a][b][2][1]), "+v"(acc[a][b][3][0]), "+v"(acc[a][b][3][1]));
            else asm volatile("" : "+v"(acc[a][b][0][0]), "+v"(acc[a][b][0][1]), "+v"(acc[a][b][1][0]), "+v"(acc[a][b][1][1]), "+v"(acc[a][b][2][0]), "+v"(acc[a][b][2][1]), "+v"(acc[a][b][3][0]), "+v"(acc[a][b][3][1])); }
}
__device__ __forceinline__ i32x8 pg8_cat(bf16x8 a, bf16x8 b) { return __builtin_shufflevector(__builtin_bit_cast(i32x4v, a), __builtin_bit_cast(i32x4v, b), 0, 1, 2, 3, 4, 5, 6, 7); }
template <class Epi, class Sched, bool ALIGN_EPI = false, bool SP2 = false, bool F8 = false>
__device__ __forceinline__ void gemm_phase(PG8_LAS unsigned char* lds, const Gemm g, const Sched& S, const Epi& E) {
    int tid_o = threadIdx.x; asm volatile("" : "+v"(tid_o)); const int tid = tid_o, wid = __builtin_amdgcn_readfirstlane(tid >> 6), lane = tid & 63, wr = wid >> 2, wc = wid & 3, fr = lane & 15, fq = lane >> 4;
    const int K = g.K, nt = K / BK;
    unsigned voffA[2], voffB[2];
#pragma unroll
    for (int i = 0; i < 2; ++i) { int R, C; stage_rc(tid * 16 + i * 8192, R, C); const int Rb = Epi::PERM ? ((R & ~31) + perm32(R & 31)) : R;
        voffA[i] = (unsigned)(R * g.lda + C) * 2u; voffB[i] = (unsigned)(Rb * g.ldb + C) * 2u; }
    const size_t kstep = (size_t)(BK * 2);
    const size_t hstepA = (size_t)HALF * g.lda * 2, hstepB = (size_t)HALF * g.ldb * 2;
    const size_t tstepA = 2 * hstepA, tstepB = 2 * hstepB;
    const unsigned ldsw = (unsigned)wid * 1024u;
    const int aoff = lds_byte(wr * 64 + fr, fq * 8), boff = lds_byte(wc * 32 + fr, fq * 8);
#define PG8_SA(b, h) (((b) * 2 + (h)) * HTB)
#define PG8_SB(b, h) ((4 + (b) * 2 + (h)) * HTB)
#define PG8_STAGE(bufoff, gbase, voff) do { _Pragma("unroll") for (int _i = 0; _i < 2; ++_i) \
        __builtin_amdgcn_global_load_lds((const unsigned*)((const char*)(gbase) + (voff)[_i]), (PG8_LAS unsigned*)(lds + (bufoff) + ldsw + _i * 8192), 16, 0, 0); } while (0)
#define PG8_LDA(dst, b, h) do { _Pragma("unroll") for (int m = 0; m < 4; ++m) { dst[m].lo = *(const PG8_LAS i32x4v*)(lds + PG8_SA(b, h) + aoff + m * 2048); dst[m].hi = *(const PG8_LAS i32x4v*)(lds + PG8_SA(b, h) + aoff + m * 2048 + 1024); } } while (0)
#define PG8_LDB(dst, b, h) do { _Pragma("unroll") for (int n = 0; n < 2; ++n) { dst[n].lo = *(const PG8_LAS i32x4v*)(lds + PG8_SB(b, h) + boff + n * 2048); dst[n].hi = *(const PG8_LAS i32x4v*)(lds + PG8_SB(b, h) + boff + n * 2048 + 1024); } } while (0)
#define PG8_MMA(ai, bj, At, Bt) do { __builtin_amdgcn_s_setprio(1); \
        if constexpr (F8) { _Pragma("unroll") for (int m = 0; m < 4; ++m) _Pragma("unroll") for (int n = 0; n < 2; ++n) pg8_mfma_f8(acc[ai][bj][m][n], Bt[n], At[m], f8scale); } \
        else { _Pragma("unroll") for (int m = 0; m < 4; ++m) _Pragma("unroll") for (int n = 0; n < 2; ++n) { \
            const i32x4v b_lo = Bt[n].lo, b_hi = Bt[n].hi, a_lo = At[m].lo, a_hi = At[m].hi;     \
            acc[ai][bj][m][n] = __builtin_amdgcn_mfma_f32_16x16x32_bf16(__builtin_bit_cast(bf16x8, b_lo), __builtin_bit_cast(bf16x8, a_lo), acc[ai][bj][m][n], 0, 0, 0); \
            acc[ai][bj][m][n] = __builtin_amdgcn_mfma_f32_16x16x32_bf16(__builtin_bit_cast(bf16x8, b_hi), __builtin_bit_cast(bf16x8, a_hi), acc[ai][bj][m][n], 0, 0, 0); } } \
        __builtin_amdgcn_s_setprio(0); } while (0)
#define PG8_WAIT_V(n) asm volatile("s_waitcnt vmcnt(" #n ")" ::: "memory")
#define PG8_WAIT_L(n) asm volatile("s_waitcnt lgkmcnt(" #n ")" ::: "memory")
#define PG8_BAR __builtin_amdgcn_s_barrier()
#define PG8_SCHED __builtin_amdgcn_sched_barrier(0)
    Unit cur, nxt; int ui = 0;
    if (!S.next(0, cur)) return;
    f32x4 acc[2][2][4][2];
#pragma unroll
    for (int a = 0; a < 2; ++a)
#pragma unroll
        for (int b = 0; b < 2; ++b)
#pragma unroll
            for (int m = 0; m < 4; ++m)
#pragma unroll
                for (int n = 0; n < 2; ++n) acc[a][b][m][n] = (f32x4){0.f, 0.f, 0.f, 0.f};
    int f8scale = 0x7f7f7f7f; asm volatile("" : "+v"(f8scale));
    i32x8 At[4], B0[2], B1[2];
    const char* cA = (const char*)(g.A + (size_t)cur.pb * g.bsA) + (size_t)cur.pm * tstepA; const char* cB = (const char*)(g.Bt + (size_t)cur.pb * g.bsB) + (size_t)cur.pn * tstepB;
    S.a_ready(cur);
    if constexpr (SP2) {
        PG8_STAGE(PG8_SB(0, 0), cB, voffB); PG8_STAGE(PG8_SB(0, 1), cB + hstepB, voffB); PG8_STAGE(PG8_SA(0, 0), cA, voffA); PG8_STAGE(PG8_SA(0, 1), cA + hstepA, voffA);
        if (wr == 1) PG8_BAR;
        PG8_WAIT_V(2); PG8_BAR;
        PG8_STAGE(PG8_SB(1, 0), cB + kstep, voffB); PG8_STAGE(PG8_SA(1, 0), cA + kstep, voffA); PG8_STAGE(PG8_SB(1, 1), cB + hstepB + kstep, voffB);
        PG8_WAIT_V(6); PG8_BAR;
    } else {
        PG8_STAGE(PG8_SB(0, 0), cB, voffB); PG8_STAGE(PG8_SA(0, 0), cA, voffA); PG8_STAGE(PG8_SB(0, 1), cB + hstepB, voffB); PG8_STAGE(PG8_SA(0, 1), cA + hstepA, voffA);
        if (wr == 1) PG8_BAR;
        PG8_WAIT_V(4); PG8_BAR;
        PG8_STAGE(PG8_SB(1, 0), cB + kstep, voffB); PG8_STAGE(PG8_SA(1, 0), cA + kstep, voffA); PG8_STAGE(PG8_SB(1, 1), cB + hstepB + kstep, voffB);
        PG8_WAIT_V(6); PG8_BAR;
    }
    for (;;) {
        const bool has_next = S.next(ui + 1, nxt);
        const char* nA = has_next ? (const char*)(g.A + (size_t)nxt.pb * g.bsA) + (size_t)nxt.pm * tstepA : cA; const char* nB = has_next ? (const char*)(g.Bt + (size_t)nxt.pb * g.bsB) + (size_t)nxt.pn * tstepB : cB;
        for (int t = 0; t < nt; t += 2) {
            const bool last = (t == nt - 2);
            const char* a1 = cA + (size_t)(t + 1) * kstep;
            const char* a2 = last ? nA : cA + (size_t)(t + 2) * kstep; const char* b2 = last ? nB : cB + (size_t)(t + 2) * kstep;
            const char* a3 = a2 + kstep; const char* b3 = b2 + kstep;
            if (last && has_next) S.a_ready(nxt);
            if constexpr (SP2) {
            PG8_LDB(B0, 0, 0); PG8_LDB(B1, 0, 1); PG8_SCHED; PG8_LDA(At, 0, 0); PG8_STAGE(PG8_SA(1, 1), a1 + hstepA, voffA);
            PG8_WAIT_V(8); PG8_WAIT_L(0); PG8_BAR; PG8_MMA(0, 0, At, B0); PG8_MMA(0, 1, At, B1); PG8_BAR; PG8_SCHED;
            PG8_LDA(At, 0, 1); PG8_STAGE(PG8_SB(0, 0), b2, voffB); PG8_STAGE(PG8_SB(0, 1), b2 + hstepB, voffB); PG8_STAGE(PG8_SA(0, 0), a2, voffA);
            PG8_WAIT_V(8); PG8_WAIT_L(0); PG8_BAR; PG8_MMA(1, 0, At, B0); PG8_MMA(1, 1, At, B1); PG8_BAR; PG8_SCHED;
            PG8_LDB(B0, 1, 0); PG8_LDB(B1, 1, 1); PG8_SCHED; PG8_LDA(At, 1, 0); PG8_STAGE(PG8_SA(0, 1), a2 + hstepA, voffA);
            PG8_WAIT_V(8); PG8_WAIT_L(0); PG8_BAR; PG8_MMA(0, 0, At, B0); PG8_MMA(0, 1, At, B1); PG8_BAR; PG8_SCHED;
            PG8_LDA(At, 1, 1); PG8_STAGE(PG8_SB(1, 0), b3, voffB); PG8_STAGE(PG8_SB(1, 1), b3 + hstepB, voffB); PG8_STAGE(PG8_SA(1, 0), a3, voffA);
            PG8_WAIT_V(8); PG8_WAIT_L(0); PG8_BAR; PG8_MMA(1, 0, At, B0); PG8_MMA(1, 1, At, B1); PG8_BAR; PG8_SCHED;
            } else {
            PG8_LDB(B0, 0, 0); PG8_SCHED; PG8_LDA(At, 0, 0); PG8_STAGE(PG8_SA(1, 1), a1 + hstepA, voffA);
            PG8_WAIT_L(8); PG8_BAR; PG8_WAIT_L(0); PG8_MMA(0, 0, At, B0); PG8_BAR; PG8_SCHED;
            PG8_LDB(B1, 0, 1); PG8_STAGE(PG8_SB(0, 0), b2, voffB);
            PG8_BAR; PG8_WAIT_L(0); PG8_MMA(0, 1, At, B1); PG8_BAR;
            PG8_LDA(At, 0, 1); PG8_STAGE(PG8_SA(0, 0), a2, voffA);
            PG8_BAR; PG8_WAIT_L(0); PG8_MMA(1, 0, At, B0); PG8_BAR; PG8_SCHED;
            PG8_STAGE(PG8_SB(0, 1), b2 + hstepB, voffB);
            PG8_WAIT_V(6); PG8_BAR; PG8_MMA(1, 1, At, B1); PG8_BAR;
            PG8_LDB(B0, 1, 0); PG8_SCHED; PG8_LDA(At, 1, 0); PG8_STAGE(PG8_SA(0, 1), a2 + hstepA, voffA);
            PG8_WAIT_L(8); PG8_BAR; PG8_WAIT_L(0); PG8_MMA(0, 0, At, B0); PG8_BAR; PG8_SCHED;
            PG8_LDB(B1, 1, 1); PG8_STAGE(PG8_SB(1, 0), b3, voffB);
            PG8_BAR; PG8_WAIT_L(0); PG8_MMA(0, 1, At, B1); PG8_BAR;
            PG8_LDA(At, 1, 1); PG8_STAGE(PG8_SA(1, 0), a3, voffA);
            PG8_BAR; PG8_WAIT_L(0); PG8_MMA(1, 0, At, B0); PG8_BAR; PG8_SCHED;
            PG8_STAGE(PG8_SB(1, 1), b3 + hstepB, voffB);
            PG8_WAIT_V(6); PG8_BAR; PG8_MMA(1, 1, At, B1); PG8_BAR;
            }
        }
        if constexpr (ALIGN_EPI) { if (wr == 0) PG8_BAR; }
        if constexpr (F8) pg8_mfma_f8_drain(acc);
        if constexpr (!Epi::AFTER_DRAIN) { E(acc, cur, wr, wc, fr, fq); S.done(cur); }
        if (!has_next) break;
#pragma unroll
        for (int a = 0; a < 2; ++a)
#pragma unroll
            for (int b = 0; b < 2; ++b)
#pragma unroll
                for (int m = 0; m < 4; ++m)
#pragma unroll
                    for (int n = 0; n < 2; ++n) acc[a][b][m][n] = (f32x4){0.f, 0.f, 0.f, 0.f};
        cur = nxt; cA = nA; cB = nB; ++ui;
        if constexpr (ALIGN_EPI) { if (wr == 1) PG8_BAR; }
    }
    PG8_WAIT_V(0);
    if constexpr (!ALIGN_EPI) { if (wr == 0) PG8_BAR; }
    PG8_BAR;
    if constexpr (Epi::AFTER_DRAIN) { E.fused(acc, cur, wr, wc, fr, fq, lds, wid, lane); S.done(cur); }
#undef PG8_SA
#undef PG8_SB
#undef PG8_STAGE
#undef PG8_LDA
#undef PG8_LDB
#undef PG8_MMA
#undef PG8_WAIT_V
#undef PG8_WAIT_L
#undef PG8_BAR
#undef PG8_SCHED
}
}
namespace attn {
using bf16 = __hip_bfloat16;
constexpr int   D = 128, NW = 8, QBLK = 32, KVBLK = 64;
constexpr float SCALE = 0.088388347648318440f;
constexpr float THR = 8.f;
constexpr int SDEPTH = 2;
constexpr int LDQ = 1024, LDK = 256, LDO = 2048;
constexpr size_t SHM_V = KVBLK * D * 2, SHM_K = KVBLK * D * 2, SHM_ATTN = 2 * SHM_V + 2 * SHM_K + NW * 64 * 4;
using bf16x8 = __attribute__((ext_vector_type(8))) short;
using s16x4  = __attribute__((ext_vector_type(4))) short;
using f32x16 = __attribute__((ext_vector_type(16))) float;
using f32x8  = __attribute__((ext_vector_type(8))) float;
using u32x4  = __attribute__((ext_vector_type(4))) unsigned;
#define KSWZ(row, colB) ((row) * 256 + ((colB) ^ (((row) & 7) << 4)))
#define SBAR() __builtin_amdgcn_sched_barrier(0)
__device__ __forceinline__ int crow(int r, int hi) { return (r & 3) + 8 * (r >> 2) + 4 * hi; }
__device__ __forceinline__ unsigned cvtpk(float lo, float hi) {
  unsigned r; asm volatile("v_cvt_pk_bf16_f32 %0, %1, %2" : "=v"(r) : "v"(lo), "v"(hi)); return r;
}
template <typename TIn> struct Stage;
template <> struct Stage<bf16>  { using T = bf16x8;
  __device__ static __forceinline__ T ld8(const bf16* p) { return *reinterpret_cast<const bf16x8*>(p); }
  __device__ static __forceinline__ bf16x8 tobf(T x) { return x; } };
template <> struct Stage<float> { using T = f32x8;
  __device__ static __forceinline__ T ld8(const float* p) { return *reinterpret_cast<const f32x8*>(p); }
  __device__ static __forceinline__ bf16x8 tobf(T x) {
    u32x4 w = {cvtpk(x[0], x[1]), cvtpk(x[2], x[3]), cvtpk(x[4], x[5]), cvtpk(x[6], x[7])}; return *reinterpret_cast<bf16x8*>(&w); } };

__device__ __forceinline__ void partialSM(f32x16& p0, f32x16& p1, float& m_reg, float& mn, float& alpha) {
  constexpr float C = SCALE * 1.4426950408889634f;
  float pmax = p0[0]; for (int r = 1; r < 16; ++r) pmax = fmaxf(pmax, p0[r]); for (int r = 0; r < 16; ++r) pmax = fmaxf(pmax, p1[r]);
  { auto rr = __builtin_amdgcn_permlane32_swap(__float_as_uint(pmax), __float_as_uint(pmax), false, false);
    pmax = fmaxf(__uint_as_float(rr[0]), __uint_as_float(rr[1])); }
  if (__builtin_expect(__all(pmax - m_reg <= THR / SCALE), 1)) { mn = m_reg; alpha = 1.f; }
  else { mn = fmaxf(m_reg, pmax); alpha = __builtin_amdgcn_exp2f((m_reg - mn) * C); m_reg = mn; }
  float mnC = -mn * C;
  for (int r = 0; r < 16; ++r) p0[r] = fmaf(p0[r], C, mnC); for (int r = 0; r < 16; ++r) p1[r] = fmaf(p1[r], C, mnC);
  for (int r = 0; r < 16; ++r) p0[r] = __builtin_amdgcn_exp2f(p0[r]);
}
__device__ __forceinline__ void finishSM(f32x16& p0, f32x16& p1, float alpha, float& l_reg, bf16x8& pa0, bf16x8& pa1, bf16x8& pa2, bf16x8& pa3) {
  for (int r = 0; r < 16; ++r) p1[r] = __builtin_amdgcn_exp2f(p1[r]);
  float ps = 0; for (int r = 0; r < 16; ++r) ps += p0[r]; for (int r = 0; r < 16; ++r) ps += p1[r];
  { auto rr = __builtin_amdgcn_permlane32_swap(__float_as_uint(ps), __float_as_uint(ps), false, false);
    ps = __uint_as_float(rr[0]) + __uint_as_float(rr[1]); }
  l_reg = l_reg * alpha + ps;
#define PK4(P, BASE, OUT) do { unsigned a0 = cvtpk(P[BASE + 0], P[BASE + 1]), a1 = cvtpk(P[BASE + 2], P[BASE + 3]);   \
    unsigned b0 = cvtpk(P[BASE + 4], P[BASE + 5]), b1 = cvtpk(P[BASE + 6], P[BASE + 7]);                              \
    auto r0 = __builtin_amdgcn_permlane32_swap(a0, b0, false, false); auto r1 = __builtin_amdgcn_permlane32_swap(a1, b1, false, false); \
    u32x4 w = {r0[0], r1[0], r0[1], r1[1]}; OUT = *reinterpret_cast<bf16x8*>(&w); } while (0)
  PK4(p0, 0, pa0); PK4(p0, 8, pa1); PK4(p1, 0, pa2); PK4(p1, 8, pa3);
#undef PK4
}
__device__ __forceinline__ void qkt(f32x16& p0, f32x16& p1, const bf16* Ks, const bf16x8* qr, int r32, int hi) {
  p0 = f32x16{}; p1 = f32x16{};
  for (int d0 = 0; d0 < 8; ++d0) { int cb = (d0 * 16 + hi * 8) * 2;
    bf16x8 b0 = *reinterpret_cast<const bf16x8*>((const char*)Ks + KSWZ(r32, cb));
    bf16x8 b1 = *reinterpret_cast<const bf16x8*>((const char*)Ks + KSWZ(32 + r32, cb));
    p0 = __builtin_amdgcn_mfma_f32_32x32x16_bf16(b0, qr[d0], p0, 0, 0, 0);
    p1 = __builtin_amdgcn_mfma_f32_32x32x16_bf16(b1, qr[d0], p1, 0, 0, 0); }
}
__device__ __forceinline__ int v_st(int k, int c) { const int kk = (k & ~0xC) | ((k & 4) << 1) | ((k & 8) >> 1); return ((kk >> 3) * 4 + (c >> 5)) * 512 + ((kk & 7) * 32 + (c & 31)) * 2; }
__device__ __forceinline__ int v_rd_base(int lane) { return ((lane & 3) << 3) | (((lane >> 2) & 3) << 6) | (((lane >> 4) & 1) << 5) | (((lane >> 5) & 1) << 8); }
constexpr int v_rd_off(int d0, int ks, int half) { return d0 * 512 + ks * 4096 + half * 2048; }
template <int OFF> __device__ __forceinline__ s16x4 tr_read(int vb) {
  s16x4 r; asm volatile("ds_read_b64_tr_b16 %0, %1 offset:%2" : "=&v"(r) : "v"(vb), "i"(OFF) : "memory"); return r;
}
template <int D0> __device__ __forceinline__ void pv_one(f32x16& od, int vb, bf16x8 pa0, bf16x8 pa1, bf16x8 pa2, bf16x8 pa3) {
  const s16x4 l0 = tr_read<v_rd_off(D0, 0, 0)>(vb), h0 = tr_read<v_rd_off(D0, 0, 1)>(vb), l1 = tr_read<v_rd_off(D0, 1, 0)>(vb), h1 = tr_read<v_rd_off(D0, 1, 1)>(vb);
  const s16x4 l2 = tr_read<v_rd_off(D0, 2, 0)>(vb), h2 = tr_read<v_rd_off(D0, 2, 1)>(vb), l3 = tr_read<v_rd_off(D0, 3, 0)>(vb), h3 = tr_read<v_rd_off(D0, 3, 1)>(vb);
  asm volatile("s_waitcnt lgkmcnt(0)" ::: "memory"); SBAR();
#define PK(L, H) (bf16x8){L[0], L[1], L[2], L[3], H[0], H[1], H[2], H[3]}
  od = __builtin_amdgcn_mfma_f32_32x32x16_bf16(pa0, PK(l0, h0), od, 0, 0, 0);
  od = __builtin_amdgcn_mfma_f32_32x32x16_bf16(pa1, PK(l1, h1), od, 0, 0, 0);
  od = __builtin_amdgcn_mfma_f32_32x32x16_bf16(pa2, PK(l2, h2), od, 0, 0, 0);
  od = __builtin_amdgcn_mfma_f32_32x32x16_bf16(pa3, PK(l3, h3), od, 0, 0, 0);
#undef PK
}
__device__ __forceinline__ void pv_d0(f32x16* o, int vb, bf16x8 pa0, bf16x8 pa1, bf16x8 pa2, bf16x8 pa3) {
  pv_one<0>(o[0], vb, pa0, pa1, pa2, pa3); pv_one<1>(o[1], vb, pa0, pa1, pa2, pa3); pv_one<2>(o[2], vb, pa0, pa1, pa2, pa3); pv_one<3>(o[3], vb, pa0, pa1, pa2, pa3);
}

template <typename TQ>
__device__ __forceinline__ void attn_dense_body(const TQ* __restrict__ Qb, const bf16* __restrict__ Kh, const bf16* __restrict__ Vh,
                                                unsigned char* __restrict__ Ob, int seq, char* lds) {
  using St = Stage<bf16>; using SQ = Stage<TQ>;
  int tid_o = threadIdx.x; asm volatile("" : "+v"(tid_o)); const int tid = tid_o, wid = tid >> 6, lane = tid & 63, r32 = lane & 31, hi = lane >> 5;
  bf16* V_lds = (bf16*)lds; bf16* K_lds = (bf16*)(lds + 2 * SHM_V);
  float* ws = (float*)(lds + 2 * SHM_V + 2 * SHM_K) + wid * 64; float* li_l = ws; float* al_l = ws + 32;
  float m_reg = -1e30f, l_reg = 0; f32x16 o[4] = {}; bf16x8 qr[8];
  const TQ* Qw = Qb + (long)(wid * QBLK + r32) * LDQ + hi * 8;
#pragma unroll
  for (int d0 = 0; d0 < 8; ++d0) qr[d0] = SQ::tobf(SQ::ld8(Qw + d0 * 16));
  const int sr = tid >> 4, sc = (tid & 15) * 8, vst0 = v_st(sr, sc), vst1 = v_st(32 + sr, sc);
  const int vb0 = (int)(uintptr_t)V_lds + v_rd_base(lane);
  struct { typename St::T vs0, vs1, ks0, ks1; } sr_[SDEPTH];
#define SLOAD(i, k0) do { sr_[i].vs0 = St::ld8(&Vh[(long)((k0) + sr) * LDK + sc]); sr_[i].vs1 = St::ld8(&Vh[(long)((k0) + 32 + sr) * LDK + sc]); \
    sr_[i].ks0 = St::ld8(&Kh[(long)((k0) + sr) * LDK + sc]); sr_[i].ks1 = St::ld8(&Kh[(long)((k0) + 32 + sr) * LDK + sc]); } while (0)
#define SWRITE(b, i) do { *(bf16x8*)((char*)V_lds + (b) * SHM_V + vst0) = St::tobf(sr_[i].vs0);          \
    *(bf16x8*)((char*)V_lds + (b) * SHM_V + vst1) = St::tobf(sr_[i].vs1); int kc = sc * 2;               \
    *(bf16x8*)((char*)K_lds + (b) * SHM_K + KSWZ(sr, kc)) = St::tobf(sr_[i].ks0);                       \
    *(bf16x8*)((char*)K_lds + (b) * SHM_K + KSWZ(32 + sr, kc)) = St::tobf(sr_[i].ks1); } while (0)
#define SWAIT() do { if constexpr (SDEPTH == 2) asm volatile("s_waitcnt vmcnt(4)" ::: "memory"); else asm volatile("s_waitcnt vmcnt(0)" ::: "memory"); } while (0)
#define RESC(a) do { if (__any((a) < 1.f)) { if (hi == 0) al_l[r32] = (a); asm volatile("s_waitcnt lgkmcnt(0)" ::: "memory"); \
    for (int d = 0; d < 4; ++d) for (int r = 0; r < 16; ++r) o[d][r] *= al_l[crow(r, hi)]; } } while (0)
  f32x16 pA0, pA1, pB0, pB1; float mnA, mnB, alA, alB; bf16x8 pa0, pa1, pa2, pa3; const int NT = seq / KVBLK;
  constexpr int SE = 0, SO = SDEPTH - 1;
  SLOAD(SE, 0); asm volatile("s_waitcnt vmcnt(0)" ::: "memory"); SWRITE(0, SE); __syncthreads();
  qkt(pA0, pA1, K_lds, qr, r32, hi); partialSM(pA0, pA1, m_reg, mnA, alA);
  SLOAD(SO, KVBLK); if constexpr (SDEPTH == 2) { if (2 < NT) SLOAD(SE, 2 * KVBLK); }
  SWAIT(); SWRITE(1, SO); __syncthreads();
  for (int j = 1; j + 1 < NT; j += 2) {
    SBAR(); qkt(pB0, pB1, (bf16*)((char*)K_lds + SHM_K), qr, r32, hi);
    finishSM(pA0, pA1, alA, l_reg, pa0, pa1, pa2, pa3); SBAR();
    SLOAD(SO, (j + SDEPTH) * KVBLK); SBAR();
    pv_d0(o, vb0, pa0, pa1, pa2, pa3); partialSM(pB0, pB1, m_reg, mnB, alB);
    __syncthreads(); SWAIT(); SWRITE(0, SE);
    RESC(alB); __syncthreads();
    SBAR(); qkt(pA0, pA1, K_lds, qr, r32, hi);
    finishSM(pB0, pB1, alB, l_reg, pa0, pa1, pa2, pa3); SBAR();
    if (SDEPTH == 1 || j + 3 < NT) SLOAD(SE, (j + 1 + SDEPTH) * KVBLK); SBAR();
    pv_d0(o, vb0 + (int)SHM_V, pa0, pa1, pa2, pa3); partialSM(pA0, pA1, m_reg, mnA, alA);
    __syncthreads(); SWAIT(); SWRITE(1, SO);
    RESC(alA); __syncthreads();
  }
  SBAR(); qkt(pB0, pB1, (bf16*)((char*)K_lds + SHM_K), qr, r32, hi);
  finishSM(pA0, pA1, alA, l_reg, pa0, pa1, pa2, pa3); SBAR();
  pv_d0(o, vb0, pa0, pa1, pa2, pa3); partialSM(pB0, pB1, m_reg, mnB, alB);
  __syncthreads(); RESC(alB);
  finishSM(pB0, pB1, alB, l_reg, pa0, pa1, pa2, pa3); SBAR();
  pv_d0(o, vb0 + (int)SHM_V, pa0, pa1, pa2, pa3);
  if (hi == 0) li_l[r32] = l_reg; asm volatile("s_waitcnt lgkmcnt(0)" ::: "memory");
  float rli[16];
#pragma unroll
  for (int r = 0; r < 16; ++r) rli[r] = __builtin_amdgcn_rcpf(li_l[crow(r, hi)]);
  unsigned char* Ow = Ob + (long)(wid * QBLK) * LDO;
#pragma unroll
  for (int r = 0; r < 16; ++r) { int orow = crow(r, hi);
    for (int d0 = 0; d0 < 4; ++d0) Ow[(long)orow * LDO + d0 * 32 + r32] = (unsigned char)(__builtin_amdgcn_cvt_pk_fp8_f32(__builtin_amdgcn_fmed3f(o[d0][r] * rli[r] * 16.0f, -440.f, 440.f), 0.f, 0, false) & 0xff); }
#undef SLOAD
#undef SWRITE
#undef SWAIT
#undef RESC
}
#undef KSWZ
#undef SBAR
}

#define LAS __attribute__((address_space(3)))
typedef unsigned short bf16_t;
typedef short bf16x8 __attribute__((ext_vector_type(8)));
typedef float f32x4 __attribute__((ext_vector_type(4)));
typedef float f32x2 __attribute__((ext_vector_type(2)));
typedef float f32x16 __attribute__((ext_vector_type(16)));
typedef unsigned u32x4 __attribute__((ext_vector_type(4)));
typedef unsigned u32x2 __attribute__((ext_vector_type(2)));

constexpr int NTOK = 16384, DMODEL = 2048, SEQL = 8192;
constexpr size_t MiB = 1u << 20;
constexpr size_t WS_MOD = 0;
constexpr size_t WS_BAR = 512 * 1024;
constexpr size_t WS_S5A = 1 * MiB;
constexpr size_t WS_LNST = 296 * MiB;
constexpr size_t WS_ABT = 2 * MiB;
constexpr size_t WS_BIASQ = 2 * MiB + 64 * 1024;
constexpr size_t WS_ROWSQ = 336 * MiB;
constexpr size_t WS_BIASP = 340 * MiB;
constexpr size_t WS_WQF = 304 * MiB;
constexpr size_t WS_KEYS = 4 * MiB;
constexpr size_t WS_WSB = 5 * MiB;
constexpr size_t WS_WINE = 6 * MiB;
constexpr size_t WS_WOUTE = 16 * MiB;
constexpr size_t WS_WINO = 24 * MiB;
constexpr size_t WS_WOUTO = 56 * MiB;
constexpr size_t WS_WQ = 72 * MiB;
constexpr size_t WS_PU = 88 * MiB;
constexpr size_t WS_PV = 152 * MiB;
constexpr size_t WS_PSC = 5 * MiB + 512 * 1024;
constexpr int PEER_ROWB = 1536;
constexpr bool PEER_SLICE_U = true, PEER_SLICE_V = true;
typedef unsigned u32x6 __attribute__((ext_vector_type(6)));
typedef float f32x16 __attribute__((ext_vector_type(16)));
typedef float f32x32 __attribute__((ext_vector_type(32)));
typedef _Float16 h16x2 __attribute__((ext_vector_type(2)));
typedef _Float16 h16x32 __attribute__((ext_vector_type(32)));
constexpr size_t WS_WY = 216 * MiB;
constexpr size_t WS_WSUM = 232 * MiB;
constexpr size_t WS_H8 = 256 * MiB;
constexpr size_t WS_H = 344 * MiB;
constexpr size_t WS_XB = WS_H;
constexpr size_t WS_TMP = 408 * MiB;
constexpr size_t WS_AB = WS_TMP  , WS_Q = WS_TMP + 64 * MiB, WS_K = WS_TMP + 96 * MiB, WS_V = WS_TMP + 104 * MiB,
                 WS_SS = WS_TMP + 112 * MiB  , WS_CAT = WS_TMP + 176 * MiB;
constexpr size_t WS_Z = WS_TMP, WS_SG = WS_TMP + 256 * MiB;
constexpr size_t WS_QP = WS_TMP;
constexpr size_t WS_X8 = WS_TMP + 64 * MiB;
constexpr size_t WS_RSTD = WS_TMP + 64 * MiB;
constexpr size_t WS_EID = WS_TMP + 128 * MiB;
constexpr size_t WS_GATE = WS_TMP + 136 * MiB;
constexpr size_t WS_PW = WS_TMP + 144 * MiB;
constexpr size_t WS_PO = WS_TMP + 152 * MiB;
constexpr size_t WS_PACT = WS_TMP + 216 * MiB;
typedef unsigned u32x16 __attribute__((ext_vector_type(16)));
typedef __bf16 bf16x2v __attribute__((ext_vector_type(2)));
constexpr size_t WS_END = WS_TMP + 384 * MiB;
constexpr int LDS_BYTES = 147456;

struct P {
    const float *x, *c, *ada_w, *ada_b, *norm_g, *even_w_in, *even_w_out, *lam_re, *lam_im, *log_dt, *b_re, *b_im, *c_re, *c_im, *s5_d, *glu_w, *glu_b,
        *q_g, *k_g, *odd_w_in, *odd_w_out, *sgu_ln_g, *sgu_w, *sgu_b, *peer_wq, *peer_k1, *peer_k2, *peer_u, *peer_v, *final_g;
    float* out; unsigned char* ws;
};

__device__ __forceinline__ unsigned cvtpk(float lo, float hi) { unsigned r; asm("v_cvt_pk_bf16_f32 %0, %1, %2" : "=v"(r) : "v"(lo), "v"(hi)); return r; }
__device__ __forceinline__ unsigned pk_fp8x4(float a, float b, float c, float d) {
    a = __builtin_amdgcn_fmed3f(a, -440.f, 440.f); b = __builtin_amdgcn_fmed3f(b, -440.f, 440.f); c = __builtin_amdgcn_fmed3f(c, -440.f, 440.f); d = __builtin_amdgcn_fmed3f(d, -440.f, 440.f);
    int w = 0; w = __builtin_amdgcn_cvt_pk_fp8_f32(a, b, w, false); w = __builtin_amdgcn_cvt_pk_fp8_f32(c, d, w, true); return (unsigned)w; }
constexpr float F8_WS = 64.0f, F8_HS = 8.0f, F8_SGS = 8.0f, F8_CS = 16.0f, F8_XS = 8.0f;
__device__ __forceinline__ float bflo(unsigned w) { return __uint_as_float(w << 16); }
__device__ __forceinline__ float bfhi(unsigned w) { return __uint_as_float(w & 0xffff0000u); }
__device__ __forceinline__ float wave_sum(float v) {
    v += __uint_as_float(__builtin_amdgcn_update_dpp(0u, __float_as_uint(v), 0xB1, 0xF, 0xF, true));
    v += __uint_as_float(__builtin_amdgcn_update_dpp(0u, __float_as_uint(v), 0x4E, 0xF, 0xF, true));
    v += __uint_as_float(__builtin_amdgcn_update_dpp(0u, __float_as_uint(v), 0x141, 0xF, 0xF, true));
    v += __uint_as_float(__builtin_amdgcn_update_dpp(0u, __float_as_uint(v), 0x140, 0xF, 0xF, true));
    { const auto r = __builtin_amdgcn_permlane16_swap(__float_as_uint(v), __float_as_uint(v), false, false); v = __uint_as_float(r[0]) + __uint_as_float(r[1]); }
    { const auto r = __builtin_amdgcn_permlane32_swap(__float_as_uint(v), __float_as_uint(v), false, false); v = __uint_as_float(r[0]) + __uint_as_float(r[1]); }
    return v;
}
__device__ __forceinline__ float row16_sum(float v) {
    v += __uint_as_float(__builtin_amdgcn_update_dpp(0u, __float_as_uint(v), 0xB1, 0xF, 0xF, true));
    v += __uint_as_float(__builtin_amdgcn_update_dpp(0u, __float_as_uint(v), 0x4E, 0xF, 0xF, true));
    v += __uint_as_float(__builtin_amdgcn_update_dpp(0u, __float_as_uint(v), 0x141, 0xF, 0xF, true));
    v += __uint_as_float(__builtin_amdgcn_update_dpp(0u, __float_as_uint(v), 0x140, 0xF, 0xF, true));
    return v;
}
__device__ __forceinline__ float xrow_sum(float v) {
    { const auto r = __builtin_amdgcn_permlane16_swap(__float_as_uint(v), __float_as_uint(v), false, false); v = __uint_as_float(r[0]) + __uint_as_float(r[1]); }
    { const auto r = __builtin_amdgcn_permlane32_swap(__float_as_uint(v), __float_as_uint(v), false, false); v = __uint_as_float(r[0]) + __uint_as_float(r[1]); }
    return v;
}
__device__ __forceinline__ float sigmoid_f(float x) { return __builtin_amdgcn_rcpf(1.f + __expf(-x)); }
__device__ __forceinline__ float gelu_t(float x) { const float u = 0.7978845608028654f * (x + 0.044715f * x * x * x); return x * __builtin_amdgcn_rcpf(1.f + __expf(-2.f * u)); }
__device__ __forceinline__ void sincos_rad(float ang, float& sn, float& cs) {
    float rev = ang * 0.15915494309189535f; rev = rev - floorf(rev);
    sn = __builtin_amdgcn_sinf(rev); cs = __builtin_amdgcn_cosf(rev);
}
__device__ __forceinline__ float dot4(f32x4 a, f32x4 b) { return (a.x * b.x + a.y * b.y) + (a.z * b.z + a.w * b.w); }
#define LDS_WAIT() asm volatile("s_waitcnt lgkmcnt(0)" ::: "memory")

namespace pg8 {
constexpr int NTOK_ = 16384;
struct EpiEvenSplit {
    static constexpr bool PERM = true, AFTER_DRAIN = false;
    float ds; unsigned char* wsb;
    __device__ __forceinline__ void operator()(const f32x4 (&acc)[2][2][4][2], const Unit& u, int wr, int wc, int fr, int fq) const {
        { const int l_ = lane_id_v(); fr = l_ & 15; fq = l_ >> 4; }
        const int row0 = u.pm * BM + wr * 64 + fr; const int pn = u.pn;
        bf16_t* const UA = (bf16_t*)(wsb + WS_AB);
        if (pn < 4) {
#pragma unroll
            for (int ai = 0; ai < 2; ++ai)
#pragma unroll
                for (int m = 0; m < 4; ++m) { const int t = row0 + ai * HALF + m * 16;
#pragma unroll
                    for (int bj = 0; bj < 2; ++bj) { const int c = pn * 256 + bj * HALF + wc * 32 + 8 * fq; const f32x4 v0 = acc[ai][bj][m][0] * ds, v1 = acc[ai][bj][m][1] * ds;
                        u32x4 w; w.x = cvt_pk_bf16(v0[0], v0[1]); w.y = cvt_pk_bf16(v0[2], v0[3]); w.z = cvt_pk_bf16(v1[0], v1[1]); w.w = cvt_pk_bf16(v1[2], v1[3]);
                        *(u32x4*)(UA + ((size_t)(c >> 4) * 1024 + (t >> 4)) * 512 + (t & 15) * 16 + (c & 15)) = w; } }
            return;
        }
        bf16_t* base; int ldc, colt;
        if (pn < 8) { base = (bf16_t*)(wsb + WS_Q); ldc = 1024; colt = (pn - 4) * 256; } else { base = (bf16_t*)(wsb + (pn == 8 ? WS_K : WS_V)); ldc = 256; colt = 0; }
        const int col0 = colt + wc * 32 + 8 * fq;
#pragma unroll
        for (int ai = 0; ai < 2; ++ai)
#pragma unroll
            for (int m = 0; m < 4; ++m) { bf16_t* rowp = base + (size_t)(row0 + ai * HALF + m * 16) * ldc + col0;
#pragma unroll
                for (int bj = 0; bj < 2; ++bj) { const f32x4 v0 = acc[ai][bj][m][0] * ds, v1 = acc[ai][bj][m][1] * ds;
                    u32x4 w; w.x = cvt_pk_bf16(v0[0], v0[1]); w.y = cvt_pk_bf16(v0[2], v0[3]); w.z = cvt_pk_bf16(v1[0], v1[1]); w.w = cvt_pk_bf16(v1[2], v1[3]);
                    *(u32x4*)(rowp + bj * HALF) = w; } }
    }
};
template <int ACT> struct EpiBf16T {
    static constexpr bool PERM = true, AFTER_DRAIN = false;
    bf16_t* O; int ldc; float ds; float* lnst;
    __device__ __forceinline__ void operator()(const f32x4 (&acc)[2][2][4][2], const Unit& u, int wr, int wc, int fr, int fq) const {
        { const int l_ = lane_id_v(); fr = l_ & 15; fq = l_ >> 4; }
        const int row0 = u.pm * BM + wr * 64 + fr, col0 = u.pn * BM + wc * 32 + 8 * fq;
        const bool do_st = (ACT == 1) && lnst != nullptr && u.pn >= 16;
#pragma unroll
        for (int ai = 0; ai < 2; ++ai)
#pragma unroll
            for (int m = 0; m < 4; ++m) { const int trow = row0 + ai * HALF + m * 16;
                bf16_t* rowp = (ACT == 1) ? O + ((size_t)((trow >> 7) * 16 + (col0 >> 9)) * 128 + (trow & 127)) * 512 + (col0 & 511) : O + (size_t)trow * ldc + col0; float s1 = 0.f, s2 = 0.f;
#pragma unroll
                for (int bj = 0; bj < 2; ++bj) { f32x4 v0 = acc[ai][bj][m][0] * ds, v1 = acc[ai][bj][m][1] * ds;
                    if (ACT == 1) {
#pragma unroll
                        for (int e = 0; e < 4; ++e) { v0[e] = gelu_t(v0[e]); v1[e] = gelu_t(v1[e]); s1 += v0[e] + v1[e]; s2 += v0[e] * v0[e] + v1[e] * v1[e]; } }
                    u32x4 w; w.x = cvt_pk_bf16(v0[0], v0[1]); w.y = cvt_pk_bf16(v0[2], v0[3]); w.z = cvt_pk_bf16(v1[0], v1[1]); w.w = cvt_pk_bf16(v1[2], v1[3]);
                    *(u32x4*)(rowp + bj * HALF) = w; }
                if (ACT == 1) { if (do_st) {
                    s1 = xrow_sum(s1); s2 = xrow_sum(s2);
                    if (fq == 0) *(f32x2*)(lnst + ((size_t)((u.pn - 16) * 4 + wc) * NTOK_ + (row0 + ai * HALF + m * 16)) * 2) = (f32x2){s1, s2}; } }
            }
    }
};
struct EpiResid {
    static constexpr bool PERM = false, AFTER_DRAIN = false;
    const float* xin; float* xout; const float* gate; float ds;
    __device__ __forceinline__ void operator()(const f32x4 (&acc)[2][2][4][2], const Unit& u, int wr, int wc, int fr, int fq) const {
        { const int l_ = lane_id_v(); fr = l_ & 15; fq = l_ >> 4; }
        const int row0 = u.pm * BM + wr * 64 + fr, col0 = u.pn * BM + wc * 32 + 4 * fq;
        const float* gp = gate + (size_t)((u.pm * BM) >> 13) * 12288 + col0;
        f32x4 gv[2][2];
#pragma unroll
        for (int bj = 0; bj < 2; ++bj)
#pragma unroll
            for (int n = 0; n < 2; ++n) gv[bj][n] = *(const f32x4*)(gp + bj * HALF + n * 16) * ds;
#pragma unroll
        for (int ai = 0; ai < 2; ++ai)
#pragma unroll
            for (int m = 0; m < 4; ++m) { const size_t off = (size_t)(row0 + ai * HALF + m * 16) * 2048 + col0;
#pragma unroll
                for (int bj = 0; bj < 2; ++bj)
#pragma unroll
                    for (int n = 0; n < 2; ++n) { const f32x4 xi = *(const f32x4*)(xin + off + bj * HALF + n * 16);
                        *(f32x4*)(xout + off + bj * HALF + n * 16) = xi + gv[bj][n] * acc[ai][bj][m][n]; } }
    }
};
struct EpiF32B {
    static constexpr bool PERM = false, AFTER_DRAIN = false;
    float* C; int ldc; size_t bs;
    __device__ __forceinline__ void operator()(const f32x4 (&acc)[2][2][4][2], const Unit& u, int wr, int wc, int fr, int fq) const {
        { const int l_ = lane_id_v(); fr = l_ & 15; fq = l_ >> 4; }
        char* base = (char*)(C + (size_t)u.pb * bs + (size_t)(u.pm * BM) * ldc);
        const unsigned off0 = (unsigned)((wr * 64 + fr) * ldc + u.pn * BM + wc * 32 + 4 * fq) * 4u;
#pragma unroll
        for (int ai = 0; ai < 2; ++ai)
#pragma unroll
            for (int m = 0; m < 4; ++m) { const unsigned off = off0 + (unsigned)((ai * HALF + m * 16) * ldc) * 4u;
#pragma unroll
                for (int bj = 0; bj < 2; ++bj)
#pragma unroll
                    for (int n = 0; n < 2; ++n) *(f32x4*)(base + off + (bj * HALF + n * 16) * 4) = acc[ai][bj][m][n]; }
    }
};
struct EpiS5Glu {
    static constexpr bool PERM = false, AFTER_DRAIN = false;
    unsigned char* CAT; const PG8_LAS float* wl;
    __device__ __forceinline__ void operator()(const f32x4 (&acc)[2][2][4][2], const Unit& u, int wr, int wc, int fr, int fq) const {
        { const int l_ = lane_id_v(); fr = l_ & 15; fq = l_ >> 4; }
        const int g = u.pb;
#pragma unroll
        for (int ai = 0; ai < 2; ++ai)
#pragma unroll
            for (int m = 0; m < 4; ++m) {
                const int chunk = u.pm * BM + ai * HALF + wr * 64 + m * 16 + fr, token = chunk * 16 + wc * 4 + fq;
                float y[16];
#pragma unroll
                for (int bj = 0; bj < 2; ++bj)
#pragma unroll
                    for (int n = 0; n < 2; ++n)
#pragma unroll
                        for (int j = 0; j < 4; ++j) y[8 * bj + 4 * n + j] = gelu_t(acc[ai][bj][m][n][j]);
                f32x4 z[4];
#pragma unroll
                for (int kq = 0; kq < 4; ++kq) z[kq] = *(const PG8_LAS f32x4*)(wl + 256 + 4 * kq);
#pragma unroll
                for (int h = 0; h < 16; ++h)
#pragma unroll
                    for (int kq = 0; kq < 4; ++kq) z[kq] += *(const PG8_LAS f32x4*)(wl + h * 16 + 4 * kq) * y[h];
                float o[16];
#pragma unroll
                for (int k = 0; k < 16; ++k) o[k] = y[k] * sigmoid_f(z[k >> 2][k & 3]);
                u32x4 w; w.x = pk_fp8x4(o[0] * F8_CS, o[1] * F8_CS, o[2] * F8_CS, o[3] * F8_CS); w.y = pk_fp8x4(o[4] * F8_CS, o[5] * F8_CS, o[6] * F8_CS, o[7] * F8_CS);
                w.z = pk_fp8x4(o[8] * F8_CS, o[9] * F8_CS, o[10] * F8_CS, o[11] * F8_CS); w.w = pk_fp8x4(o[12] * F8_CS, o[13] * F8_CS, o[14] * F8_CS, o[15] * F8_CS);
                *(u32x4*)(CAT + (size_t)token * 2048 + g * 16) = w;
                asm volatile("" ::: "memory");
            }
    }
};
template <bool FIRST> struct EpiResidB {
    static constexpr bool PERM = false, AFTER_DRAIN = false;
    const float* xin; bf16_t* xb; const float* gate; float* rowsq; unsigned char* x8; float ds;
    __device__ __forceinline__ void operator()(const f32x4 (&acc)[2][2][4][2], const Unit& u, int wr, int wc, int fr, int fq) const {
        { const int l_ = lane_id_v(); fr = l_ & 15; fq = l_ >> 4; }
        const int row0 = u.pm * BM + wr * 64 + fr, col0 = u.pn * BM + wc * 32 + 4 * fq;
        const float* gp = gate + (size_t)((u.pm * BM) >> 13) * 12288 + col0; float* const rq = rowsq;
        f32x4 gv[2][2];
#pragma unroll
        for (int bj = 0; bj < 2; ++bj)
#pragma unroll
            for (int n = 0; n < 2; ++n) gv[bj][n] = *(const f32x4*)(gp + bj * HALF + n * 16) * ds;
#pragma unroll
        for (int ai = 0; ai < 2; ++ai) {
            f32x4 xi[4][2][2];
#pragma unroll
            for (int m = 0; m < 4; ++m) { const size_t off = (size_t)(row0 + ai * HALF + m * 16) * 2048 + col0;
#pragma unroll
                for (int bj = 0; bj < 2; ++bj)
#pragma unroll
                    for (int n = 0; n < 2; ++n) {
                        if (FIRST) xi[m][bj][n] = *(const f32x4*)(xin + off + bj * HALF + n * 16);
                        else { const u32x2 w = *(const u32x2*)(xb + off + bj * HALF + n * 16); xi[m][bj][n] = (f32x4){__uint_as_float(w.x << 16), __uint_as_float(w.x & 0xffff0000u), __uint_as_float(w.y << 16), __uint_as_float(w.y & 0xffff0000u)}; } } }
            asm volatile("" ::: "memory");
#pragma unroll
            for (int m = 0; m < 4; ++m) { const int row = row0 + ai * HALF + m * 16; const size_t off = (size_t)row * 2048 + col0; float ss = 0.f;
#pragma unroll
                for (int bj = 0; bj < 2; ++bj)
#pragma unroll
                    for (int n = 0; n < 2; ++n) { const f32x4 xo = xi[m][bj][n] + gv[bj][n] * acc[ai][bj][m][n]; ss += (xo[0] * xo[0] + xo[1] * xo[1]) + (xo[2] * xo[2] + xo[3] * xo[3]);
                        u32x2 o; o.x = cvt_pk_bf16(xo[0], xo[1]); o.y = cvt_pk_bf16(xo[2], xo[3]); *(u32x2*)(xb + off + bj * HALF + n * 16) = o;
                        *(unsigned*)(x8 + off + bj * HALF + n * 16) = pk_fp8x4(xo[0] * F8_XS, xo[1] * F8_XS, xo[2] * F8_XS, xo[3] * F8_XS); }
                ss = xrow_sum(ss);
                if (fq == 0) rq[(size_t)(u.pn * 4 + wc) * NTOK_ + row] = ss; }
        }
    }
};
struct EpiQ {
    static constexpr bool PERM = true, AFTER_DRAIN = false;
    bf16_t* O; const float* rowsq; const float* bias; float ds;
    __device__ __forceinline__ void operator()(const f32x4 (&acc)[2][2][4][2], const Unit& u, int wr, int wc, int fr, int fq) const {
        { const int l_ = lane_id_v(); fr = l_ & 15; fq = l_ >> 4; }
        const int row0 = u.pm * BM + wr * 64 + fr, col0 = u.pn * BM + wc * 32 + 8 * fq;
        const float* bp = bias + (size_t)((u.pm * BM) >> 13) * 2048 + col0;
        f32x4 bv[2][2];
#pragma unroll
        for (int bj = 0; bj < 2; ++bj)
#pragma unroll
            for (int n = 0; n < 2; ++n) bv[bj][n] = *(const f32x4*)(bp + bj * HALF + 4 * n);
        float rstd[2][4];
#pragma unroll
        for (int ai = 0; ai < 2; ++ai)
#pragma unroll
            for (int m = 0; m < 4; ++m) { const int row = row0 + ai * HALF + m * 16; float sq = 0.f;
#pragma unroll
                for (int t = 0; t < 8; ++t) sq += rowsq[(size_t)(fq * 8 + t) * NTOK_ + row];
                rstd[ai][m] = rsqrtf(xrow_sum(sq) * (1.0f / 2048.0f) + 1e-6f) * ds; }
#pragma unroll
        for (int ai = 0; ai < 2; ++ai)
#pragma unroll
            for (int m = 0; m < 4; ++m) { const int row = row0 + ai * HALF + m * 16; bf16_t* rowp = O + (size_t)row * 2048 + col0;
#pragma unroll
                for (int bj = 0; bj < 2; ++bj) { const f32x4 v0 = acc[ai][bj][m][0] * rstd[ai][m] + bv[bj][0], v1 = acc[ai][bj][m][1] * rstd[ai][m] + bv[bj][1];
                    u32x4 w; w.x = cvt_pk_bf16(v0[0], v0[1]); w.y = cvt_pk_bf16(v0[2], v0[3]); w.z = cvt_pk_bf16(v1[0], v1[1]); w.w = cvt_pk_bf16(v1[2], v1[3]);
                    *(u32x4*)(rowp + bj * HALF) = w; } }
    }
};
struct BatchOrder {
    int nM, nU, G, c;
    __device__ __forceinline__ bool next(int i, Unit& u) const { const int L = i * G + c; if (L >= nU) return false; u.pb = L / nM; u.pm = L % nM; u.pn = 0; return true; }
    __device__ __forceinline__ void a_ready(const Unit&) const {}
    __device__ __forceinline__ void done(const Unit&) const {}
};
}

__device__ __forceinline__ unsigned f2bf_rne(float f) { unsigned u = __builtin_bit_cast(unsigned, f); return (u + 0x7fffu + ((u >> 16) & 1u)) >> 16; }
__device__ __forceinline__ unsigned pk2(float lo, float hi) { return f2bf_rne(lo) | (f2bf_rne(hi) << 16); }
__device__ __forceinline__ void p0_transpose_item(const float* W, int K, int N, bf16_t* WT, LAS float* scr, int item, int lane) {
    const int nblk = N / 32, kb = item / nblk, nb = item % nblk, k0 = 64 * kb, n0 = 32 * nb;
#pragma unroll 8
    for (int i = 0; i < 32; ++i) { const int kk = 2 * i + (lane >> 5); scr[kk * 33 + (lane & 31)] = W[(size_t)(k0 + kk) * N + n0 + (lane & 31)]; }
    LDS_WAIT(); asm volatile("" ::: "memory");
    const int c = lane & 7;
#pragma unroll
    for (int j = 0; j < 4; ++j) { const int n = (lane >> 3) + 8 * j; const LAS float* s = scr + (8 * c) * 33 + n;
        u32x4 o; o.x = pk2(s[0 * 33], s[1 * 33]); o.y = pk2(s[2 * 33], s[3 * 33]); o.z = pk2(s[4 * 33], s[5 * 33]); o.w = pk2(s[6 * 33], s[7 * 33]);
        *(u32x4*)(WT + (size_t)(n0 + n) * K + k0 + 8 * c) = o; }
    LDS_WAIT(); asm volatile("" ::: "memory");
}

__device__ __forceinline__ void p0_transpose_item_f8(const float* W, int K, int N, unsigned char* WT, LAS float* scr, int item, int lane, float sc) {
    const int nblk = N / 32, kb = item / nblk, nb = item % nblk, k0 = 64 * kb, n0 = 32 * nb;
#pragma unroll 8
    for (int i = 0; i < 32; ++i) { const int kk = 2 * i + (lane >> 5); scr[kk * 33 + (lane & 31)] = W[(size_t)(k0 + kk) * N + n0 + (lane & 31)] * sc; }
    LDS_WAIT(); asm volatile("" ::: "memory");
    const int c = lane & 7;
#pragma unroll
    for (int j = 0; j < 4; ++j) { const int n = (lane >> 3) + 8 * j; const LAS float* s = scr + (8 * c) * 33 + n;
        u32x2 o; o.x = pk_fp8x4(s[0 * 33], s[1 * 33], s[2 * 33], s[3 * 33]); o.y = pk_fp8x4(s[4 * 33], s[5 * 33], s[6 * 33], s[7 * 33]);
        *(u32x2*)(WT + (size_t)(n0 + n) * K + k0 + 8 * c) = o; }
    LDS_WAIT(); asm volatile("" ::: "memory");
}

__device__ __forceinline__ void s5_gen_group(const P& p, LAS unsigned char* lds, int g, int tid) {
    LAS f32x2* pw = (LAS f32x2*)lds;
    LAS f32x2* Cc = (LAS f32x2*)(lds + 17408);
    LAS f32x2* Bb = (LAS f32x2*)(lds + 17408 + 16384);
    LAS float* Kt = (LAS float*)(lds + 17408 + 32768);
    LAS float* dsk = (LAS float*)(lds + 17408 + 65536);
    __syncthreads();
    if (tid < 128) {
        const int d = tid >> 6, pp = tid & 63, dgp = (d * 64 + g) * 64 + pp;
        const float lr = fminf(p.lam_re[dgp], -1e-4f), li = p.lam_im[dgp], dt = __expf(p.log_dt[d * 64 + g]);
        const float lrdt = lr * dt, ang = li * dt;
#pragma unroll 1
        for (int e = 0; e <= 16; ++e) { const float mag = __expf((float)e * lrdt); float sn, cs; sincos_rad((float)e * ang, sn, cs); pw[e * 128 + tid] = (f32x2){mag * cs, mag * sn}; }
        const f32x2 a1 = pw[128 + tid]; const float abr = a1.x, abi = a1.y;
        const float den = lr * lr + li * li, nr = abr - 1.0f;
        const float cre = (nr * lr + abi * li) / den, cim = (abi * lr - nr * li) / den;
        ((f32x2*)(p.ws + WS_S5A))[dgp] = pw[16 * 128 + tid];
#pragma unroll 4
        for (int h = 0; h < 16; ++h) { const float br = p.b_re[dgp * 16 + h], bi = p.b_im[dgp * 16 + h]; Bb[(d * 64 + pp) * 16 + h] = (f32x2){cre * br - cim * bi, cre * bi + cim * br}; }
    }
    for (int i = tid; i < 2048; i += 512) { const int d = i >> 10, h = (i >> 6) & 15, pp = i & 63; const size_t src = ((size_t)(d * 64 + g) * 16 + h) * 64 + pp; Cc[i] = (f32x2){p.c_re[src], p.c_im[src]}; }
    if (tid < 16) dsk[tid] = p.s5_d[g * 16 + tid];
    __syncthreads();
    {
        const int d = tid >> 8, tau = (tid >> 4) & 15, h = tid & 15; float acc[16];
#pragma unroll
        for (int hp = 0; hp < 16; ++hp) acc[hp] = 0.f;
#pragma unroll 2
        for (int pp = 0; pp < 64; ++pp) { const f32x2 c = Cc[(d * 16 + h) * 64 + pp], w = pw[tau * 128 + d * 64 + pp]; const float tx = c.x * w.x - c.y * w.y, ty = c.x * w.y + c.y * w.x;
#pragma unroll
            for (int hp = 0; hp < 16; ++hp) { const f32x2 bb = Bb[(d * 64 + pp) * 16 + hp]; acc[hp] += tx * bb.x - ty * bb.y; } }
#pragma unroll
        for (int hp = 0; hp < 16; ++hp) Kt[(d * 16 + tau) * 256 + h * 16 + hp] = acc[hp];
    }
    __syncthreads();
    bf16_t* Wy = (bf16_t*)(p.ws + WS_WY) + (size_t)g * 256 * 512;
#pragma unroll 1
    for (int idx = tid; idx < 256 * 256; idx += 512) {
        const int np = idx >> 8, k0 = (idx & 255) * 2;
        const int bj = (np >> 7) & 1, wc = (np >> 5) & 3, n = (np >> 4) & 1, fq = (np >> 2) & 3, j = np & 3, i = wc * 4 + fq, h = 8 * bj + 4 * n + j;
        float v[2];
#pragma unroll
        for (int kk = 0; kk < 2; ++kk) { const int k = k0 + kk;
            if (k < 256) { const int s = k >> 4, hp = k & 15;
                if (s < i) v[kk] = Kt[(i - s) * 256 + h * 16 + hp]; else if (s > i) v[kk] = Kt[(16 + (s - i)) * 256 + h * 16 + hp];
                else v[kk] = Kt[h * 16 + hp] + Kt[16 * 256 + h * 16 + hp] + (h == hp ? dsk[h] : 0.f);
            } else { const int kc = k - 256, d = kc >> 7, pp = (kc >> 1) & 63, ri = kc & 1, e = d ? 16 - i : i + 1;
                const f32x2 c = Cc[(d * 16 + h) * 64 + pp], w = pw[e * 128 + d * 64 + pp]; v[kk] = ri ? -(c.x * w.y + c.y * w.x) : (c.x * w.x - c.y * w.y); } }
        *(unsigned*)(Wy + (size_t)np * 512 + k0) = cvtpk(v[0], v[1]);
    }
    bf16_t* Wsum = (bf16_t*)(p.ws + WS_WSUM) + (size_t)g * 256 * 256;
#pragma unroll 1
    for (int idx = tid; idx < 256 * 128; idx += 512) {
        const int r = idx >> 7, k0 = (idx & 127) * 2, d = r >> 7, pp = (r >> 1) & 63, ri = r & 1;
        float v[2];
#pragma unroll
        for (int kk = 0; kk < 2; ++kk) { const int k = k0 + kk, s = k >> 4, hp = k & 15, e = d ? s : 15 - s;
            const f32x2 w = pw[e * 128 + d * 64 + pp], bb = Bb[(d * 64 + pp) * 16 + hp]; v[kk] = ri ? (w.x * bb.y + w.y * bb.x) : (w.x * bb.x - w.y * bb.y); }
        *(unsigned*)(Wsum + (size_t)r * 256 + k0) = cvtpk(v[0], v[1]);
    }
}

#ifndef PRO_DBL
#define PRO_DBL 0
#endif
#define PRO_REP(b) for (int _pr = 0; _pr < 1 + ((PRO_DBL >> (b)) & 1); ++_pr)
__device__ __forceinline__ void phase_prologue(const P& p, LAS unsigned char* lds, int tid, int lane, int wid) {
    unsigned char* ws = p.ws;
    LAS float* cact = (LAS float*)lds;
    LAS float* red = (LAS float*)(lds + 16384);
    for (int i = tid; i < 4096; i += 512) { const float cv = p.c[i]; cact[i] = cv * sigmoid_f(cv); }
    __syncthreads();
    float* mod = (float*)(ws + WS_MOD);
    PRO_REP(0) for (int item = blockIdx.x; item < 192; item += gridDim.x) {
        const int l = item / 96, cb = item % 96, cg4 = tid & 31, rl = tid >> 5;
        const float* W = p.ada_w + (size_t)l * 2048 * 12288 + cb * 128 + cg4 * 4;
        f32x4 a0 = {0.f, 0.f, 0.f, 0.f}, a1 = {0.f, 0.f, 0.f, 0.f};
#pragma unroll 8
        for (int r = rl; r < 2048; r += 16) { const f32x4 w = *(const f32x4*)(W + (size_t)r * 12288); const float c0 = cact[r], c1 = cact[2048 + r]; a0 += w * c0; a1 += w * c1; }
        *(LAS f32x4*)(red + (rl * 32 + cg4) * 8) = a0; *(LAS f32x4*)(red + (rl * 32 + cg4) * 8 + 4) = a1;
        __syncthreads();
        if (tid < 256) { const int col = tid & 127, b = tid >> 7; float s = 0.f;
#pragma unroll
            for (int r2 = 0; r2 < 16; ++r2) s += red[(r2 * 32 + (col >> 2)) * 8 + b * 4 + (col & 3)];
            s += p.ada_b[l * 12288 + cb * 128 + col]; mod[(l * 2 + b) * 12288 + cb * 128 + col] = s; }
        __syncthreads();
    }
    PRO_REP(1) {
        LAS float* scr = (LAS float*)(lds + 32768 + wid * 8448);
        const int gw = blockIdx.x * 8 + wid, ngw = gridDim.x * 8;
        constexpr int I0 = 32 * 80, I1 = 32 * 64, I2 = 32 * 256, I3 = 64 * 64, NIT = I0 + I1 + I2 + I3;
        for (int it = gw; it < NIT; it += ngw) {
            int r = it;
            if (r < I0) { p0_transpose_item_f8(p.even_w_in, 2048, 2560, ws + WS_WINE, scr, r, lane, F8_WS); continue; } r -= I0;
            if (r < I1) { p0_transpose_item_f8(p.even_w_out, 2048, 2048, ws + WS_WOUTE, scr, r, lane, F8_WS); continue; } r -= I1;
            if (r < I2) { p0_transpose_item_f8(p.odd_w_in, 2048, 8192, ws + WS_WINO, scr, r, lane, F8_WS); continue; } r -= I2;
            p0_transpose_item_f8(p.odd_w_out, 4096, 2048, ws + WS_WOUTO, scr, r, lane, F8_WS);
        }
    }
    const long gtid = (long)blockIdx.x * 512 + tid, ngt = (long)gridDim.x * 512;
    PRO_REP(2) {
        const int gw = blockIdx.x * 8 + wid, ngw = gridDim.x * 8;
        float* psc = (float*)(ws + WS_PSC);
        for (int row0 = 4 * gw; row0 < 4 * 16384; row0 += 4 * ngw) {
            f32x4 v[4][8]; float am[4]; const float* src[4]; unsigned char* dst[4];
#pragma unroll
            for (int rr = 0; rr < 4; ++rr) { const int row = row0 + rr; const bool tv = row >= 2 * 16384; const int r = tv ? row - 2 * 16384 : row;
                const bool sl = tv ? PEER_SLICE_V : PEER_SLICE_U;
                src[rr] = (tv ? p.peer_v : p.peer_u) + (size_t)r * 2048; dst[rr] = ws + (tv ? WS_PV : WS_PU) + (size_t)r * PEER_ROWB;
#pragma unroll
                for (int j = 0; j < 8; ++j) v[rr][j] = *(const f32x4*)(src[rr] + (sl ? 4 * (lane + 64 * j) : 16 * lane + 1024 * (j >> 2) + 4 * (j & 3))); }
#pragma unroll
            for (int rr = 0; rr < 4; ++rr) { am[rr] = 0.f;
#pragma unroll
                for (int j = 0; j < 8; ++j) am[rr] = fmaxf(am[rr], fmaxf(fmaxf(fabsf(v[rr][j].x), fabsf(v[rr][j].y)), fmaxf(fabsf(v[rr][j].z), fabsf(v[rr][j].w))));
#pragma unroll
                for (int o = 32; o > 0; o >>= 1) am[rr] = fmaxf(am[rr], __shfl_xor(am[rr], o)); }
#pragma unroll
            for (int rr = 0; rr < 4; ++rr) { const int row = row0 + rr;
                const float sc = am[rr] > 0.f ? 7.5f / am[rr] : 1.0f;
                if (lane == 0) psc[row] = am[rr] > 0.f ? am[rr] * (1.0f / 7.5f) : 1.0f;
                f32x16 ev, od;
#pragma unroll
                for (int j = 0; j < 8; ++j) { const f32x4 t = v[rr][j] * sc; ev[2 * j] = t.x; od[2 * j] = t.y; ev[2 * j + 1] = t.z; od[2 * j + 1] = t.w; }
                const u32x6 q = __builtin_amdgcn_cvt_scalef32_2xpk16_fp6_f32(ev, od, 1.0f);
                const bool tv = row >= 2 * 16384; const int r = tv ? row - 2 * 16384 : row;
                if (!(tv ? PEER_SLICE_V : PEER_SLICE_U)) {
                    *(u32x4*)(dst[rr] + 16 * lane) = (u32x4){q[0], q[1], q[2], q[3]};
                    *(u32x2*)(dst[rr] + 1024 + 8 * lane) = (u32x2){q[4], q[5]};
                } else {
                    unsigned char* sb = ws + (tv ? WS_PV : WS_PU) + (size_t)(r >> 14) * 16384 * PEER_ROWB + (size_t)(r & 16383) * 192 + 12 * (lane >> 2) + 4 * (lane & 3);
                    const unsigned pc[8] = {q[0] & 0xFFFFFFu, (q[0] >> 24) | ((q[1] & 0xFFFFu) << 8), (q[1] >> 16) | ((q[2] & 0xFFu) << 16), q[2] >> 8,
                                            q[3] & 0xFFFFFFu, (q[3] >> 24) | ((q[4] & 0xFFFFu) << 8), (q[4] >> 16) | ((q[5] & 0xFFu) << 16), q[5] >> 8};
                    const int i8 = 8 * (lane & 3);
#pragma unroll
                    for (int j = 0; j < 8; ++j) { const unsigned nx = __builtin_amdgcn_update_dpp(0u, pc[j], 0xF9, 0xF, 0xF, true);
                        const unsigned d = (pc[j] >> i8) | (nx << (24 - i8));
                        if ((lane & 3) < 3) *(unsigned*)(sb + (size_t)j * 16384 * 192) = d; }
                } }
        }
    }
    PRO_REP(3) for (int g = (int)gridDim.x - 1 - (int)blockIdx.x; g < 64; g += gridDim.x) s5_gen_group(p, lds, g, tid);
    for (long i = gtid; i < 65536; i += ngt) { const int layer = (int)(i >> 15), half = (int)(i >> 14) & 1, r = (int)(i & 16383);
        ((bf16_t*)(ws + WS_KEYS))[i] = (bf16_t)f2bf_rne((half ? p.peer_k2 : p.peer_k1)[layer * 16384 + r]); }
    for (long i = gtid; i < 131072; i += ngt) ((bf16_t*)(ws + WS_WSB))[i] = (bf16_t)f2bf_rne(p.sgu_w[i]);
}

template <bool OUT8>
__device__ __forceinline__ void phase_adaln(const float* xin, void* hout_, const float* g, const float* shift, const float* scale, int gw, int ngw, int lane) {
    for (int b = 0; b < 2; ++b) {
        f32x4 A[8], Bc[8];
#pragma unroll
        for (int j = 0; j < 8; ++j) { const int c = 8 * lane + 512 * (j >> 1) + 4 * (j & 1);
            const f32x4 gv = *(const f32x4*)(g + c), sc = *(const f32x4*)(scale + b * 12288 + c); A[j] = gv * (sc + 1.0f); Bc[j] = *(const f32x4*)(shift + b * 12288 + c); }
#pragma unroll 1
        for (int row0 = b * 8192 + gw; row0 < (b + 1) * 8192; row0 += 4 * ngw) {
            f32x4 v[4][8];
#pragma unroll
            for (int k = 0; k < 4; ++k) { const int row = row0 + k * ngw < (b + 1) * 8192 ? row0 + k * ngw : row0; const float* xr = xin + (size_t)row * 2048 + 8 * lane;
#pragma unroll
                for (int j = 0; j < 8; ++j) v[k][j] = *(const f32x4*)(xr + 512 * (j >> 1) + 4 * (j & 1)); }
#pragma unroll
            for (int k = 0; k < 4; ++k) { const int row = row0 + k * ngw < (b + 1) * 8192 ? row0 + k * ngw : row0; float ss = 0.f;
#pragma unroll
                for (int j = 0; j < 8; ++j) ss += dot4(v[k][j], v[k][j]);
                ss = wave_sum(ss); const float rstd = rsqrtf(ss * (1.0f / 2048.0f) + 1e-6f);
                bf16_t* hr = (bf16_t*)hout_ + (size_t)row * 2048 + 8 * lane; unsigned char* hr8 = (unsigned char*)hout_ + (size_t)row * 2048 + 8 * lane;
#pragma unroll
                for (int j = 0; j < 4; ++j) { const f32x4 y0 = v[k][2 * j] * rstd * A[2 * j] + Bc[2 * j], y1 = v[k][2 * j + 1] * rstd * A[2 * j + 1] + Bc[2 * j + 1];
                    if (OUT8) { u32x2 o; o.x = pk_fp8x4(y0.x * F8_HS, y0.y * F8_HS, y0.z * F8_HS, y0.w * F8_HS); o.y = pk_fp8x4(y1.x * F8_HS, y1.y * F8_HS, y1.z * F8_HS, y1.w * F8_HS); *(u32x2*)(hr8 + 512 * j) = o; }
                    else { u32x4 o; o.x = cvtpk(y0.x, y0.y); o.y = cvtpk(y0.z, y0.w); o.z = cvtpk(y1.x, y1.y); o.w = cvtpk(y1.z, y1.w);
                    *(u32x4*)(hr + 512 * j) = o; } } }
        }
    }
}

__device__ __forceinline__ void phase_fold_wq(const P& p, LAS unsigned char* lds, int tid, int lane, int wid) {
    unsigned char* ws = p.ws; const float* mod = (const float*)(ws + WS_MOD);
    for (long i = (long)blockIdx.x * 512 + tid; i < 2 * 2 * 2048; i += (long)gridDim.x * 512) { const int l = (int)(i >> 12), b = (int)(i >> 11) & 1, c = (int)(i & 2047);
        float* ab = (float*)(ws + WS_ABT) + (size_t)(l * 2 + b) * 4096;
        ab[c] = p.norm_g[(l * 2 + 1) * 2048 + c] * (1.0f + mod[(size_t)(l * 2 + b) * 12288 + 4 * 2048 + c]); ab[2048 + c] = mod[(size_t)(l * 2 + b) * 12288 + 3 * 2048 + c]; }
    LAS float* scr = (LAS float*)(lds + wid * 8448);
    const int gw = blockIdx.x * 8 + wid, ngw = gridDim.x * 8;
    for (int it = gw; it < 2 * 2048; it += ngw) {
        const int l = it >> 11, item = it & 2047, kb = item >> 6, nb = item & 63, k0 = 64 * kb, n0 = 32 * nb;
        const float* W = p.peer_wq + (size_t)l * 2048 * 2048;
#pragma unroll 8
        for (int i = 0; i < 32; ++i) { const int kk = 2 * i + (lane >> 5); scr[kk * 33 + (lane & 31)] = W[(size_t)(k0 + kk) * 2048 + n0 + (lane & 31)]; }
        LDS_WAIT(); asm volatile("" ::: "memory");
        const int c = lane & 7;
#pragma unroll
        for (int b = 0; b < 2; ++b) {
            const float* mb = mod + (size_t)(l * 2 + b) * 12288; const float* ng = p.norm_g + (l * 2 + 1) * 2048;
            float A[8];
#pragma unroll
            for (int t = 0; t < 8; ++t) A[t] = ng[k0 + 8 * c + t] * (1.0f + mb[4 * 2048 + k0 + 8 * c + t]);
            unsigned char* WT = ws + WS_WQF + (size_t)(l * 2 + b) * 2048 * 2048;
#pragma unroll
            for (int t = 0; t < 8; ++t) A[t] *= F8_WS;
#pragma unroll
            for (int j = 0; j < 4; ++j) { const int n = (lane >> 3) + 8 * j; const LAS float* s = scr + (8 * c) * 33 + n;
                u32x2 o; o.x = pk_fp8x4(s[0 * 33] * A[0], s[1 * 33] * A[1], s[2 * 33] * A[2], s[3 * 33] * A[3]); o.y = pk_fp8x4(s[4 * 33] * A[4], s[5 * 33] * A[5], s[6 * 33] * A[6], s[7 * 33] * A[7]);
                *(u32x2*)(WT + (size_t)(n0 + n) * 2048 + k0 + 8 * c) = o; }
            { const int n = lane & 31, kh = lane >> 5; float acc = 0.f;
#pragma unroll 8
              for (int t = 0; t < 32; ++t) acc += scr[(32 * kh + t) * 33 + n] * mb[3 * 2048 + k0 + 32 * kh + t];
              acc += __shfl_xor(acc, 32);
              if (lane < 32) ((float*)(ws + WS_BIASP))[((size_t)(l * 2 + b) * 32 + kb) * 2048 + n0 + n] = acc; }
        }
        LDS_WAIT(); asm volatile("" ::: "memory");
    }
}

__device__ __forceinline__ void phase_bias_reduce(const P& p, int tid) {
    for (long i = (long)blockIdx.x * 512 + tid; i < 2 * 2 * 2048; i += (long)gridDim.x * 512) { const int lb = (int)(i >> 11), n = (int)(i & 2047); float acc = 0.f;
#pragma unroll 8
        for (int kb = 0; kb < 32; ++kb) acc += ((const float*)(p.ws + WS_BIASP))[((size_t)lb * 32 + kb) * 2048 + n];
        ((float*)(p.ws + WS_BIASQ))[i] = acc; }
}
__device__ __forceinline__ void phase_qkprep(const P& p, int gw, int ngw, int lane) {
    bf16_t* Q = (bf16_t*)(p.ws + WS_Q); bf16_t* K = (bf16_t*)(p.ws + WS_K);
    const int sub = lane >> 4, ll = lane & 15;
    float inv[4], gq[8], gk[8];
#pragma unroll
    for (int e = 0; e < 4; ++e) inv[e] = __builtin_amdgcn_exp2f(-(float)((4 * ll + e) & 31) * 0.41524101186092029f);
#pragma unroll
    for (int e = 0; e < 8; ++e) { gq[e] = p.q_g[8 * ll + e]; gk[e] = p.k_g[8 * ll + e]; }
#pragma unroll 2
    for (int it = gw; it < NTOK * 10 / 4; it += ngw) {
        const int hr = 4 * it + sub, token = hr / 10, hh = hr - token * 10;
        u32x4* ptr = hh < 8 ? (u32x4*)(Q + (size_t)token * 1024 + hh * 128 + 8 * ll) : (u32x4*)(K + (size_t)token * 256 + (hh - 8) * 128 + 8 * ll);
        const u32x4 w = *ptr;
        float x[8] = {bflo(w.x), bfhi(w.x), bflo(w.y), bfhi(w.y), bflo(w.z), bfhi(w.z), bflo(w.w), bfhi(w.w)};
        float ss = 0.f;
#pragma unroll
        for (int e = 0; e < 8; ++e) ss += x[e] * x[e];
        ss = row16_sum(ss);
        const float r = rsqrtf(ss * (1.0f / 128.0f) + 1e-6f);
        const int s = token & 8191; const float pos = (float)(ll < 8 ? (s >> 6) : (s & 63));
        unsigned o[4];
#pragma unroll
        for (int e = 0; e < 4; ++e) { const float x1 = x[2 * e] * r * (hh < 8 ? gq[2 * e] : gk[2 * e]), x2 = x[2 * e + 1] * r * (hh < 8 ? gq[2 * e + 1] : gk[2 * e + 1]);
            float sn, cs; sincos_rad(pos * inv[e], sn, cs); o[e] = cvtpk(x1 * cs - x2 * sn, x1 * sn + x2 * cs); }
        *ptr = (u32x4){o[0], o[1], o[2], o[3]};
    }
}

__device__ __forceinline__ void phase_s5scan(const P& p, LAS unsigned char* lds, int lane, int wid) {
    const f32x2* A16 = (const f32x2*)(p.ws + WS_S5A);
    LAS f32x2* agg = (LAS f32x2*)lds;
    for (int item = blockIdx.x; item < 256; item += gridDim.x) {
        const int b = item >> 7, g = (item >> 1) & 63, d = item & 1;
        const f32x2 a = A16[(d * 64 + g) * 64 + lane];
        const float* S = (const float*)(p.ws + WS_SS) + ((size_t)g * 1024 + b * 512) * 256 + d * 128 + 2 * lane;
        bf16_t* HIN = (bf16_t*)(p.ws + WS_AB) + ((size_t)g * 1024 + b * 512) * 512 + 256 + d * 128 + 2 * lane;
        const int sA = 2 * wid + (d ? 1 : 0), sB = 2 * wid + (d ? 0 : 1), ordA = d ? 15 - sA : sA;
        float ar = 0.f, ai = 0.f, br = 0.f, bi = 0.f;
#pragma unroll 16
        for (int k = 0; k < 32; ++k) { const int o = d ? 31 - k : k; const f32x2 va = *(const f32x2*)(S + (size_t)(32 * sA + o) * 256), vb = *(const f32x2*)(S + (size_t)(32 * sB + o) * 256);
            const float nar = a.x * ar - a.y * ai + va.x, nai = a.x * ai + a.y * ar + va.y, nbr = a.x * br - a.y * bi + vb.x, nbi = a.x * bi + a.y * br + vb.y; ar = nar; ai = nai; br = nbr; bi = nbi; }
        __syncthreads();
        agg[ordA * 64 + lane] = (f32x2){ar, ai}; agg[(ordA + 1) * 64 + lane] = (f32x2){br, bi};
        __syncthreads();
        float pr = a.x, pi = a.y;
#pragma unroll
        for (int q = 0; q < 5; ++q) { const float nr = pr * pr - pi * pi, ni = 2.f * pr * pi; pr = nr; pi = ni; }
        float cr = 0.f, ci = 0.f;
        for (int s2 = 0; s2 < ordA; ++s2) { const f32x2 v = agg[s2 * 64 + lane]; const float nr = pr * cr - pi * ci + v.x, ni = pr * ci + pi * cr + v.y; cr = nr; ci = ni; }
        const float dr = pr * cr - pi * ci + ar, di = pr * ci + pi * cr + ai;
        ar = cr; ai = ci; br = dr; bi = di;
#pragma unroll 16
        for (int k = 0; k < 32; ++k) { const int o = d ? 31 - k : k; const size_t ca = (size_t)(32 * sA + o), cb = (size_t)(32 * sB + o);
            *(unsigned*)(HIN + ca * 512) = cvtpk(ar, ai); *(unsigned*)(HIN + cb * 512) = cvtpk(br, bi);
            const f32x2 va = *(const f32x2*)(S + ca * 256), vb = *(const f32x2*)(S + cb * 256);
            const float nar = a.x * ar - a.y * ai + va.x, nai = a.x * ai + a.y * ar + va.y, nbr = a.x * br - a.y * bi + vb.x, nbi = a.x * bi + a.y * br + vb.y; ar = nar; ai = nai; br = nbr; bi = nbi; }
    }
}

__device__ __forceinline__ void phase_attn(const P& p, char* lds) {
    const bf16_t* Q = (const bf16_t*)(p.ws + WS_Q); const bf16_t* K = (const bf16_t*)(p.ws + WS_K); const bf16_t* V = (const bf16_t*)(p.ws + WS_V);
    unsigned char* CAT = p.ws + WS_CAT;
    const int G = gridDim.x, bx = blockIdx.x, vcu = (G % 8 == 0) ? (bx % 8) * (G / 8) + bx / 8 : bx;
    for (int unit = vcu; unit < 512; unit += G) {
        const int bk = unit >> 7, rem = unit & 127, b = bk >> 1, kvh = bk & 1, h = kvh * 4 + (rem >> 5), qb = rem & 31;
        attn::attn_dense_body<attn::bf16>((const attn::bf16*)(Q + (size_t)(b * 8192 + qb * 256) * 1024 + h * 128),
                                          (const attn::bf16*)(K + (size_t)(b * 8192) * 256 + kvh * 128), (const attn::bf16*)(V + (size_t)(b * 8192) * 256 + kvh * 128),
                                          CAT + (size_t)(b * 8192 + qb * 256) * 2048 + 1024 + h * 128, 8192, lds);
        __syncthreads();
    }
}

constexpr int SGU_VS = 136;
constexpr int SGU_HB = 71680;
constexpr int SGU_VNT = 0, SGU_STG = 128 * SGU_VS * 2, SGU_STAT = 2 * 128 * SGU_VS * 2, SGU_BS = SGU_STAT + 1024;
static_assert(SGU_BS + 512 <= SGU_HB && 2 * SGU_HB <= LDS_BYTES - 64 && SGU_HB % 16 == 0, "SGU LDS map");
__device__ __forceinline__ void phase_sgu(const P& p, LAS unsigned char* lds, int tid, int lane, int wid) {
    const int hb = wid >> 2, w4 = wid & 3, t256 = tid & 255;
    LAS unsigned char* base = lds + hb * SGU_HB;
    LAS bf16_t* vnT = (LAS bf16_t*)(base + SGU_VNT);
    LAS bf16_t* stg = (LAS bf16_t*)(base + SGU_STG);
    LAS f32x2* stats = (LAS f32x2*)(base + SGU_STAT);
    LAS float* bs = (LAS float*)(base + SGU_BS);
    const bf16_t* Z = (const bf16_t*)(p.ws + WS_Z); unsigned char* SG = p.ws + WS_SG;
    const bf16_t* Wsb = (const bf16_t*)(p.ws + WS_WSB);
    const int fr = lane & 15, fq = lane >> 4, wi = w4 & 1, wc = w4 >> 1, i0 = 64 * wi, c0 = 64 * wc;
    for (int up = blockIdx.x; up < 512; up += gridDim.x) {
        const int unit = 2 * up + hb, n = unit >> 3, g = unit & 7;
        __syncthreads();
        if (t256 < 128) { const f32x2* part = (const f32x2*)(p.ws + WS_LNST) + (size_t)(2 * g * 4) * NTOK + (n * 128 + t256); float s1 = 0.f, s2 = 0.f;
#pragma unroll
            for (int q = 0; q < 8; ++q) { const f32x2 a2 = part[(size_t)q * NTOK]; s1 += a2.x; s2 += a2.y; }
            const float mean = s1 * (1.0f / 512.0f), var = fmaxf(s2 * (1.0f / 512.0f) - mean * mean, 0.f); stats[t256] = (f32x2){mean, rsqrtf(var + 1e-6f)};
            bs[t256] = p.sgu_b[g * 128 + t256]; }
        bf16x8 Af[4][4];
#pragma unroll
        for (int m = 0; m < 4; ++m)
#pragma unroll
            for (int ks = 0; ks < 4; ++ks) Af[m][ks] = *(const bf16x8*)(Wsb + (size_t)(g * 128 + i0 + 16 * m + fr) * 128 + 32 * ks + 8 * fq);
#pragma unroll 1
        for (int qt = 0; qt < 4; ++qt) {
            const int chb = g * 512 + qt * 128;
            __syncthreads();
            { u32x4 T[8];
#pragma unroll
              for (int q = 0; q < 8; ++q) { const int pc = t256 + 256 * q, j = pc >> 4, ch = (pc & 15) * 8; T[q] = *(const u32x4*)(Z + ((size_t)(n * 16 + 8 + g) * 128 + j) * 512 + qt * 128 + ch); }
#pragma unroll
              for (int q = 0; q < 8; ++q) { const int pc = t256 + 256 * q, j = pc >> 4, ch = (pc & 15) * 8; *(LAS u32x4*)(stg + j * SGU_VS + ch) = T[q]; } }
            __syncthreads();
#pragma unroll 1
            for (int slab = 0; slab < 2; ++slab) {
                const int cc = slab * 64 + lane; const float lng = p.sgu_ln_g[chb + cc];
                const int cl = cc & 63, rp = (cc & ~63) + ((cl >> 2) & 3) * 16 + (cl >> 4) * 4 + (cl & 3);
#pragma unroll
                for (int jg = 0; jg < 4; ++jg) {
                    const int j0 = 32 * w4 + 8 * jg; float y[8];
#pragma unroll
                    for (int k = 0; k < 8; ++k) { const float xv = bflo((unsigned)stg[(j0 + k) * SGU_VS + cc]); const f32x2 st = stats[j0 + k]; y[k] = (xv - st.x) * st.y * lng; }
                    u32x4 o; o.x = cvtpk(y[0], y[1]); o.y = cvtpk(y[2], y[3]); o.z = cvtpk(y[4], y[5]); o.w = cvtpk(y[6], y[7]);
                    *(LAS u32x4*)(vnT + rp * SGU_VS + j0) = o;
                }
            }
            __syncthreads();
#pragma unroll 1
            for (int np = 0; np < 2; ++np) {
                u32x4 U[4];
#pragma unroll
                for (int m = 0; m < 4; ++m) U[m] = *(const u32x4*)(Z + ((size_t)(n * 16 + g) * 128 + i0 + 16 * m + fr) * 512 + qt * 128 + c0 + 16 * fq + 8 * np);
                f32x4 acc[4][2];
#pragma unroll
                for (int m = 0; m < 4; ++m)
#pragma unroll
                    for (int nn = 0; nn < 2; ++nn) acc[m][nn] = (f32x4){0.f, 0.f, 0.f, 0.f};
#pragma unroll
                for (int ks = 0; ks < 4; ++ks) {
                    bf16x8 Bf[2];
#pragma unroll
                    for (int nn = 0; nn < 2; ++nn) Bf[nn] = *(const LAS bf16x8*)(vnT + (c0 + 16 * (2 * np + nn) + fr) * SGU_VS + 32 * ks + 8 * fq);
#pragma unroll
                    for (int m = 0; m < 4; ++m)
#pragma unroll
                        for (int nn = 0; nn < 2; ++nn) acc[m][nn] = __builtin_amdgcn_mfma_f32_16x16x32_bf16(Bf[nn], Af[m][ks], acc[m][nn], 0, 0, 0);
                }
#pragma unroll
                for (int m = 0; m < 4; ++m) { const int i = i0 + 16 * m + fr; const float bi = bs[i]; const size_t tok = (size_t)(n * 128 + i);
                    const int cch = chb + c0 + 16 * fq + 8 * np;
                    const u32x4 u0 = U[m];
                    const f32x4 s0 = acc[m][0] + bi, s1 = acc[m][1] + bi;
                    u32x2 o;
                    o.x = pk_fp8x4(bflo(u0.x) * s0.x * F8_SGS, bfhi(u0.x) * s0.y * F8_SGS, bflo(u0.y) * s0.z * F8_SGS, bfhi(u0.y) * s0.w * F8_SGS);
                    o.y = pk_fp8x4(bflo(u0.z) * s1.x * F8_SGS, bfhi(u0.z) * s1.y * F8_SGS, bflo(u0.w) * s1.z * F8_SGS, bfhi(u0.w) * s1.w * F8_SGS);
                    *(u32x2*)(SG + tok * 4096 + cch) = o; }
            }
        }
    }
}
#define XB_TMO      128
#define XB_XCNT(j)  (256  + 64 * (j))
#define XB_XSUB(j)  (1280 + 64 * (j))
#define XB_XGEN(j)  (2304 + 64 * (j))
#define XB_TOP      3328
#define XB_TOPGEN   3392
#define XCD_BAR_WORDS 3456
#define XB_SPIN_CAP (1u << 22)

__device__ __forceinline__ unsigned xb_ld(unsigned* p)              { return __hip_atomic_load(p, __ATOMIC_RELAXED, __HIP_MEMORY_SCOPE_AGENT); }
__device__ __forceinline__ unsigned xb_add(unsigned* p, unsigned v) { return __hip_atomic_fetch_add(p, v, __ATOMIC_RELAXED, __HIP_MEMORY_SCOPE_AGENT); }
__device__ __forceinline__ unsigned xb_xcc_id() { return (unsigned)__builtin_amdgcn_s_getreg((3 << 11) | 20) & 0xFu; }
#define XB_SPIN(cond, bar) do { unsigned _sp = 0; while (cond) { __builtin_amdgcn_s_sleep(1); \
    if ((++_sp & 255u) == 0u) { if (xb_ld(&(bar)[XB_TMO])) break; if (_sp > XB_SPIN_CAP) { atomicAdd(&(bar)[XB_TMO], 1u); break; } } } } while (0)

struct XcdBarrier {
    unsigned* bar; unsigned x;
    volatile LAS unsigned* st;
};

__device__ __forceinline__ XcdBarrier xcd_barrier_post(unsigned* bar, volatile LAS unsigned* st) {
    XcdBarrier b; b.bar = bar; b.x = xb_xcc_id(); b.st = st;
    if (threadIdx.x == 0) st[2] = xb_add(&bar[XB_XCNT(b.x)], 1u);
    return b;
}
__device__ __forceinline__ void xcd_barrier_complete(unsigned* bar, unsigned x, unsigned& nloc, unsigned& nx) {
    const unsigned G = gridDim.x * gridDim.y * gridDim.z;
    unsigned sum, cnt, mine, sp = 0u;
    for (;;) {
        sum = 0u; cnt = 0u; mine = 0u;
#pragma unroll
        for (unsigned j = 0; j < 16; ++j) { const unsigned c = xb_ld(&bar[XB_XCNT(j)]); sum += c; cnt += (c > 0u) ? 1u : 0u; mine = (j == x) ? c : mine; }
        if (sum == G) break;
        __builtin_amdgcn_s_sleep(1);
        if ((++sp & 255u) == 0u) { if (xb_ld(&bar[XB_TMO])) break; if (sp > XB_SPIN_CAP) { atomicAdd(&bar[XB_TMO], 1u); break; } }
    }
    nloc = mine > 0u ? mine : 1u; nx = cnt > 0u ? cnt : 1u;
}

__device__ __forceinline__ void xcd_barrier(const XcdBarrier& b) {
    asm volatile("s_waitcnt vmcnt(0)" ::: "memory");
    __syncthreads();
    if (threadIdx.x == 0) {
        unsigned* bar = b.bar;
        __builtin_amdgcn_s_waitcnt(0);
        unsigned nloc = b.st[0], nx = b.st[1];
        if (nloc == 0u) { xcd_barrier_complete(bar, b.x, nloc, nx); b.st[0] = nloc; b.st[1] = nx; }
        const unsigned old = xb_add(&bar[XB_XSUB(b.x)], 1u);
        const unsigned gen = old / nloc;
        if (old + 1u == (gen + 1u) * nloc) {
            __builtin_amdgcn_fence(__ATOMIC_RELEASE, "agent");
            asm volatile("s_waitcnt vmcnt(0)" ::: "memory");
            const unsigned og = xb_add(&bar[XB_TOP], 1u);
            const unsigned tg = og / nx;
            if (og + 1u == (tg + 1u) * nx) xb_add(&bar[XB_TOPGEN], 1u);
            else XB_SPIN(xb_ld(&bar[XB_TOPGEN]) == tg, bar);
            __builtin_amdgcn_fence(__ATOMIC_ACQUIRE, "agent");
            xb_add(&bar[XB_XGEN(b.x)], 1u);
            asm volatile("s_waitcnt vmcnt(0)" ::: "memory");
        } else {
            XB_SPIN(xb_ld(&bar[XB_XGEN(b.x)]) == gen, bar);
            __builtin_amdgcn_fence(__ATOMIC_ACQUIRE, "agent");
            asm volatile("s_waitcnt vmcnt(0)" ::: "memory");
        }
    }
    __syncthreads();
}

__device__ __forceinline__ void ce_desc(float& a, float& b) { const float mx = fmaxf(a, b), mn = fminf(a, b); a = mx; b = mn; }
__device__ __forceinline__ void bitonic_sort16_desc(float (&a)[16]) {
#pragma unroll
    for (int k = 2; k <= 16; k <<= 1)
#pragma unroll
        for (int j = k >> 1; j > 0; j >>= 1)
#pragma unroll
            for (int i = 0; i < 16; ++i) { const int l = i ^ j; if (l > i) { if ((i & k) == 0) ce_desc(a[i], a[l]); else ce_desc(a[l], a[i]); } }
}
__device__ __forceinline__ void merge_top16(float (&V)[16], const float (&S)[16]) {
#pragma unroll
    for (int i = 0; i < 16; ++i) V[i] = fmaxf(V[i], S[15 - i]);
#pragma unroll
    for (int j = 8; j > 0; j >>= 1)
#pragma unroll
        for (int i = 0; i < 16; ++i) { const int l = i ^ j; if (l > i) ce_desc(V[i], V[l]); }
}
__device__ __forceinline__ float with_payload(float v, unsigned mask, unsigned pay) { return __uint_as_float((__float_as_uint(v) & ~mask) | pay); }

__device__ __forceinline__ void peer_topk_half(const bf16_t* qrow, const bf16_t* keys, int r32, int hi, float (&V)[16]) {
    bf16x8 qf[8];
#pragma unroll
    for (int ks = 0; ks < 8; ++ks) qf[ks] = *(const bf16x8*)(qrow + 16 * ks + 8 * hi);
#pragma unroll
    for (int k = 0; k < 16; ++k) V[k] = -INFINITY;
#pragma unroll 1
    for (int t = 0; t < 4; ++t) {
        f32x16 s = (f32x16){0.f, 0.f, 0.f, 0.f, 0.f, 0.f, 0.f, 0.f, 0.f, 0.f, 0.f, 0.f, 0.f, 0.f, 0.f, 0.f};
#pragma unroll
        for (int ks = 0; ks < 8; ++ks) { const bf16x8 kf = *(const bf16x8*)(keys + (size_t)(t * 32 + r32) * 128 + 16 * ks + 8 * hi);
            s = __builtin_amdgcn_mfma_f32_32x32x16_bf16(kf, qf[ks], s, 0, 0, 0); }
        float S[16];
#pragma unroll
        for (int r = 0; r < 16; ++r) S[r] = with_payload(s[r], 0x7Fu, (unsigned)(t * 32 + (r & 3) + 8 * (r >> 2) + 4 * hi));
        bitonic_sort16_desc(S); merge_top16(V, S);
    }
    float PVv[16];
#pragma unroll
    for (int k = 0; k < 16; ++k) { const auto r = __builtin_amdgcn_permlane32_swap(__float_as_uint(V[k]), __float_as_uint(V[k]), false, false); PVv[k] = (hi ? __uint_as_float(r[0]) : __uint_as_float(r[1])); }
    merge_top16(V, PVv);
}

__device__ __forceinline__ void phase_peer_s1(const P& p, int layer, LAS unsigned char* lds, int lane, int wid) {
    LAS int* idxL = (LAS int*)(lds + 65536 + wid * 8192);
    const bf16_t* QP = (const bf16_t*)(p.ws + WS_QP);
    const bf16_t* keys = (const bf16_t*)(p.ws + WS_KEYS) + (size_t)layer * 2 * 16384;
    const float* rowsq = (const float*)(p.ws + WS_ROWSQ) + (size_t)layer * 32 * NTOK; float* RSTD = (float*)(p.ws + WS_RSTD);
    int* EID = (int*)(p.ws + WS_EID); float* GATE = (float*)(p.ws + WS_GATE);
    const int r32 = lane & 31, hi = lane >> 5, gw = blockIdx.x * 8 + wid, ngw = gridDim.x * 8;
#pragma unroll 1
    for (int tq = gw; tq < NTOK / 4; tq += ngw) {
        {
            const bf16_t* qrow = QP + (size_t)(4 * tq + (r32 >> 3)) * 2048 + (r32 & 7) * 256;
            float v1[16], v2[16];
            peer_topk_half(qrow, keys, r32, hi, v1);
            peer_topk_half(qrow + 128, keys + 16384, r32, hi, v2);
#pragma unroll
            for (int k = 0; k < 16; ++k) { idxL[k * 64 + lane] = (int)(__float_as_uint(v1[k]) & 0x7Fu); idxL[(16 + k) * 64 + lane] = (int)(__float_as_uint(v2[k]) & 0x7Fu); }
            float SC[16], S2[16];
#pragma unroll
            for (int b2 = 0; b2 < 16; ++b2) SC[b2] = with_payload(v1[0] + v2[b2], 0xFFu, (unsigned)b2);
#pragma unroll
            for (int a = 1; a <= 4; ++a) {
#pragma unroll
                for (int b2 = 0; b2 < 16; ++b2) S2[b2] = ((a + 1) * (b2 + 1) <= 16) ? with_payload(v1[a] + v2[b2], 0xFFu, (unsigned)(a * 16 + b2)) : -INFINITY;
                merge_top16(SC, S2); }
#pragma unroll
            for (int a = 5; a <= 7; ++a) { S2[2 * (a - 5)] = with_payload(v1[a] + v2[0], 0xFFu, (unsigned)(a * 16)); S2[2 * (a - 5) + 1] = with_payload(v1[a] + v2[1], 0xFFu, (unsigned)(a * 16 + 1)); }
#pragma unroll
            for (int a = 8; a <= 15; ++a) S2[6 + (a - 8)] = with_payload(v1[a] + v2[0], 0xFFu, (unsigned)(a * 16));
            S2[14] = -INFINITY; S2[15] = -INFINITY;
            bitonic_sort16_desc(S2); merge_top16(SC, S2);
            float e[16], sum = 0.f;
#pragma unroll
            for (int k = 0; k < 16; ++k) { e[k] = __expf(SC[k] - SC[0]); sum += e[k]; }
            const float inv = 1.0f / sum;
            if (hi == 0) {
                u32x4 iw[4]; f32x4 gv[4];
#pragma unroll
                for (int k = 0; k < 16; ++k) { const unsigned pay = __float_as_uint(SC[k]) & 0xFFu;
                    iw[k >> 2][k & 3] = (unsigned)(idxL[(pay >> 4) * 64 + lane] * 128 + idxL[(16 + (pay & 15)) * 64 + lane]); gv[k >> 2][k & 3] = e[k] * inv; }
                const size_t gbase = (size_t)(4 * tq + (r32 >> 3)) * 128 + (r32 & 7) * 16;
#pragma unroll
                for (int k4 = 0; k4 < 4; ++k4) { *(u32x4*)(EID + gbase + 4 * k4) = iw[k4]; *(f32x4*)(GATE + gbase + 4 * k4) = gv[k4]; } }
        }
        {
            const int token = 4 * tq + (lane >> 4), w = lane & 15;
            const float sq = row16_sum(rowsq[(size_t)w * NTOK + token] + rowsq[(size_t)(w + 16) * NTOK + token]);
            if (w == 0) RSTD[token] = rsqrtf(sq * (1.0f / 2048.0f) + 1e-6f); }
    }
}

__device__ __forceinline__ float dot2bf(unsigned a, unsigned b, float acc) { return __builtin_amdgcn_fdot2_f32_bf16(__builtin_bit_cast(bf16x2v, a), __builtin_bit_cast(bf16x2v, b), acc, false); }
__device__ __forceinline__ void peer_partition(const P& p, int myrank, int& part, int& rank, int& nwg) {
    unsigned* bar = (unsigned*)(p.ws + WS_BAR); const unsigned x = xb_xcc_id(); unsigned mine = 0u; bool ok = true;
#pragma unroll
    for (unsigned j = 0; j < 16; ++j) { const unsigned cj = xb_ld(&bar[XB_XCNT(j)]); ok = ok && ((j < 8u) ? (cj > 0u) : (cj == 0u)); mine = (j == x) ? cj : mine; }
    if (ok) { part = (int)x; rank = myrank; nwg = (int)mine; } else { part = (int)blockIdx.x & 7; rank = (int)blockIdx.x >> 3; nwg = (int)gridDim.x >> 3; }
    part = __builtin_amdgcn_readfirstlane(part); rank = __builtin_amdgcn_readfirstlane(rank); nwg = __builtin_amdgcn_readfirstlane(nwg);
}
__device__ __forceinline__ void phase_peer_u(const P& p, int layer, LAS unsigned char* lds, int lane, int wid, int myrank) {
    LAS unsigned char* wl = lds + wid * 16384;
    int part, rank, nwg; peer_partition(p, myrank, part, rank, nwg);
    const unsigned char* PUS = p.ws + WS_PU + (size_t)layer * 16384 * PEER_ROWB + (size_t)part * 16384 * 192;
    const int* EID = (const int*)(p.ws + WS_EID);
    const unsigned char* HB = p.ws + WS_XB + 512 * part;
    const float* RSTD = (const float*)(p.ws + WS_RSTD);
    const float* ABs = (const float*)(p.ws + WS_ABT) + (size_t)layer * 2 * 4096 + 256 * part + 4 * lane;
    float* PACT = (float*)(p.ws + WS_PACT) + (size_t)part * NTOK * 128;
    const int g = lane >> 2, s = lane & 3, nb = NTOK / 8, stride = nwg * 8;
    int tb = rank * 8 + wid;
    if (tb >= nb) return;
    int e0[8], e1[8]; u32x2 hs[8]; float rs[8]; f32x4 Av, Bv;
#define PB_LOAD(TB) { _Pragma("unroll") for (int j = 0; j < 8; ++j) { const size_t t = (size_t)(TB) * 8 + j; e0[j] = EID[t * 128 + lane]; e1[j] = EID[t * 128 + 64 + lane]; hs[j] = *(const u32x2*)(HB + t * 4096 + 8 * lane); rs[j] = RSTD[t]; } \
        Av = *(const f32x4*)(ABs + ((TB) >> 10) * 4096); Bv = *(const f32x4*)(ABs + ((TB) >> 10) * 4096 + 2048); }
#define PB_STORE(BUF) _Pragma("unroll") for (int j = 0; j < 8; ++j) { LAS int* il = (LAS int*)(wl + (BUF) * 8192); il[j * 128 + lane] = e0[j]; il[j * 128 + 64 + lane] = e1[j]; \
        u32x2 hw; hw.x = cvtpk(bflo(hs[j].x) * rs[j] * Av.x + Bv.x, bfhi(hs[j].x) * rs[j] * Av.y + Bv.y); hw.y = cvtpk(bflo(hs[j].y) * rs[j] * Av.z + Bv.z, bfhi(hs[j].y) * rs[j] * Av.w + Bv.w); \
        *(LAS u32x2*)(wl + (BUF) * 8192 + 4096 + j * 512 + 8 * lane) = hw; }
#define PR_LOAD(SLOT, ID) { const unsigned char* ur = PUS + (size_t)(ID) * 192 + 48 * s; R[SLOT][0] = *(const u32x4*)ur; R[SLOT][1] = *(const u32x4*)(ur + 16); R[SLOT][2] = *(const u32x4*)(ur + 32); }
    PB_LOAD(tb) PB_STORE(0)
    u32x4 R[8][3];
    { LAS int* il = (LAS int*)wl;
#pragma unroll
      for (int q = 0; q < 8; ++q) { const int id = il[16 * q + g]; PR_LOAD(q, id) } }
    int bi = 0;
#pragma unroll 1
    for (; tb < nb; tb += stride, bi ^= 1) {
        { const int tbn = tb + stride < nb ? tb + stride : tb; PB_LOAD(tbn) }
#pragma unroll 1
        for (int j = 0; j < 8; ++j) {
            if (j == 7) { PB_STORE(bi ^ 1) }
            LAS int* nid = (j < 7) ? (LAS int*)(wl + bi * 8192) + (j + 1) * 128 : (LAS int*)(wl + (bi ^ 1) * 8192);
            LAS u32x4* hp = (LAS u32x4*)(wl + bi * 8192 + 4096 + j * 512 + s * 128);
            const u32x4 h0 = hp[0], h1 = hp[1], h2 = hp[2], h3 = hp[3], h4 = hp[4], h5 = hp[5], h6 = hp[6], h7 = hp[7];
            float acc[8];
#pragma unroll
            for (int it = 0; it < 8; ++it) {
                const u32x16 dw = __builtin_bit_cast(u32x16, __builtin_amdgcn_cvt_scalef32_pk32_bf16_fp6((u32x6){R[it][0].x, R[it][0].y, R[it][0].z, R[it][0].w, R[it][1].x, R[it][1].y}, 1.0f));
                const u32x16 dx = __builtin_bit_cast(u32x16, __builtin_amdgcn_cvt_scalef32_pk32_bf16_fp6((u32x6){R[it][1].z, R[it][1].w, R[it][2].x, R[it][2].y, R[it][2].z, R[it][2].w}, 1.0f));
                { const int idn = nid[16 * it + g]; PR_LOAD(it, idn) }
                float a0 = 0.f, a1 = 0.f;
                a0 = dot2bf(dw[0], h0.x, a0); a1 = dot2bf(dw[1], h0.y, a1); a0 = dot2bf(dw[2], h0.z, a0); a1 = dot2bf(dw[3], h0.w, a1);
                a0 = dot2bf(dw[4], h1.x, a0); a1 = dot2bf(dw[5], h1.y, a1); a0 = dot2bf(dw[6], h1.z, a0); a1 = dot2bf(dw[7], h1.w, a1);
                a0 = dot2bf(dw[8], h2.x, a0); a1 = dot2bf(dw[9], h2.y, a1); a0 = dot2bf(dw[10], h2.z, a0); a1 = dot2bf(dw[11], h2.w, a1);
                a0 = dot2bf(dw[12], h3.x, a0); a1 = dot2bf(dw[13], h3.y, a1); a0 = dot2bf(dw[14], h3.z, a0); a1 = dot2bf(dw[15], h3.w, a1);
                a0 = dot2bf(dx[0], h4.x, a0); a1 = dot2bf(dx[1], h4.y, a1); a0 = dot2bf(dx[2], h4.z, a0); a1 = dot2bf(dx[3], h4.w, a1);
                a0 = dot2bf(dx[4], h5.x, a0); a1 = dot2bf(dx[5], h5.y, a1); a0 = dot2bf(dx[6], h5.z, a0); a1 = dot2bf(dx[7], h5.w, a1);
                a0 = dot2bf(dx[8], h6.x, a0); a1 = dot2bf(dx[9], h6.y, a1); a0 = dot2bf(dx[10], h6.z, a0); a1 = dot2bf(dx[11], h6.w, a1);
                a0 = dot2bf(dx[12], h7.x, a0); a1 = dot2bf(dx[13], h7.y, a1); a0 = dot2bf(dx[14], h7.z, a0); a1 = dot2bf(dx[15], h7.w, a1);
                float v = a0 + a1;
                v += __uint_as_float(__builtin_amdgcn_update_dpp(0u, __float_as_uint(v), 0xB1, 0xF, 0xF, true));
                v += __uint_as_float(__builtin_amdgcn_update_dpp(0u, __float_as_uint(v), 0x4E, 0xF, 0xF, true));
                acc[it] = v;
            }
            if (s == 0) { float* pa = PACT + ((size_t)tb * 8 + j) * 128 + g;
#pragma unroll
                for (int it = 0; it < 8; ++it) pa[16 * it] = acc[it]; }
        }
    }
#undef PB_LOAD
#undef PB_STORE
#undef PR_LOAD
}

__device__ __forceinline__ void phase_peer_w(const P& p, int layer, int tid) {
    const int* EID = (const int*)(p.ws + WS_EID); const float* GATE = (const float*)(p.ws + WS_GATE); const float* PACT = (const float*)(p.ws + WS_PACT); float* PW = (float*)(p.ws + WS_PW);
    const float* PSU = (const float*)(p.ws + WS_PSC) + layer * 16384; const float* PSV = PSU + 2 * 16384;
#pragma unroll 4
    for (int i = (int)blockIdx.x * 512 + tid; i < NTOK * 128; i += (int)gridDim.x * 512) {
        const int id = EID[i]; float a = 0.f;
#pragma unroll
        for (int x = 0; x < 8; ++x) a += PACT[(size_t)x * NTOK * 128 + i];
        PW[i] = gelu_t(a * PSU[id]) * GATE[i] * PSV[id];
    }
}

__device__ __forceinline__ void phase_peer_vs(const P& p, int layer, LAS unsigned char* lds, int lane, int wid, int myrank) {
    LAS unsigned char* wl = lds + wid * 16384;
    int part, rank, nwg; peer_partition(p, myrank, part, rank, nwg);
    const unsigned char* PVS = p.ws + WS_PV + (size_t)layer * 16384 * PEER_ROWB + (size_t)part * 16384 * 192;
    const int* EID = (const int*)(p.ws + WS_EID); const float* PW = (const float*)(p.ws + WS_PW);
    unsigned char* PO = p.ws + WS_PO + 512 * part;
    const int g = lane >> 3, s = lane & 7, nb = NTOK / 8, stride = nwg * 8;
    const bool b3 = (lane & 8) != 0;
    int tb = rank * 8 + wid;
    if (tb >= nb) return;
    int e0[8], e1[8]; float w0[8], w1[8];
#define PB_LOAD(TB) _Pragma("unroll") for (int j = 0; j < 8; ++j) { const size_t t = (size_t)(TB) * 8 + j; e0[j] = EID[t * 128 + lane]; e1[j] = EID[t * 128 + 64 + lane]; w0[j] = PW[t * 128 + lane]; w1[j] = PW[t * 128 + 64 + lane]; }
#define PB_STORE(BUF) _Pragma("unroll") for (int j = 0; j < 8; ++j) { LAS int* il = (LAS int*)(wl + (BUF) * 8192); LAS float* fl = (LAS float*)(wl + (BUF) * 8192 + 4096); il[j * 128 + lane] = e0[j]; il[j * 128 + 64 + lane] = e1[j]; fl[j * 128 + lane] = w0[j]; fl[j * 128 + 64 + lane] = w1[j]; }
#define PR_LOAD(SLOT, ID) { const unsigned char* vr = PVS + (size_t)(ID) * 192 + 24 * s; R[SLOT][0] = *(const u32x2*)vr; R[SLOT][1] = *(const u32x2*)(vr + 8); R[SLOT][2] = *(const u32x2*)(vr + 16); }
    PB_LOAD(tb) PB_STORE(0)
    u32x2 R[8][3];
    { LAS int* il = (LAS int*)wl;
#pragma unroll
      for (int q = 0; q < 8; ++q) { const int id = il[8 * q + g]; PR_LOAD(q, id) } }
    int bi = 0;
#pragma unroll 1
    for (; tb < nb; tb += stride, bi ^= 1) {
        { const int tbn = tb + stride < nb ? tb + stride : tb; PB_LOAD(tbn) }
#pragma unroll 1
        for (int j = 0; j < 8; ++j) {
            if (j == 7) { PB_STORE(bi ^ 1) }
            LAS int* ids = (LAS int*)(wl + bi * 8192) + j * 128;
            LAS int* nid = (j < 7) ? ids + 128 : (LAS int*)(wl + (bi ^ 1) * 8192);
            LAS float* wv = (LAS float*)(wl + bi * 8192 + 4096) + j * 128;
            h16x2 o2[16];
#pragma unroll
            for (int k = 0; k < 16; ++k) o2[k] = (h16x2){(_Float16)0.f, (_Float16)0.f};
#pragma unroll
            for (int it = 0; it < 16; ++it) {
                const int sl = it & 7;
                const h16x32 d = __builtin_amdgcn_cvt_scalef32_pk32_f16_fp6((u32x6){R[sl][0].x, R[sl][0].y, R[sl][1].x, R[sl][1].y, R[sl][2].x, R[sl][2].y}, 1.0f);
                { const int idn = (it < 8) ? ids[8 * (it + 8) + g] : nid[8 * (it - 8) + g]; PR_LOAD(sl, idn) }
                const _Float16 wh = (_Float16)wv[8 * it + g]; const h16x2 w2 = (h16x2){wh, wh};
#pragma unroll
                for (int k = 0; k < 16; ++k) o2[k] = __builtin_elementwise_fma(w2, (h16x2){d[2 * k], d[2 * k + 1]}, o2[k]);
            }
            h16x2 t8[8], t4[4]; float res[4];
#pragma unroll
            for (int k = 0; k < 8; ++k) { const auto r = __builtin_amdgcn_permlane32_swap(__builtin_bit_cast(unsigned, o2[k]), __builtin_bit_cast(unsigned, o2[8 + k]), false, false);
                unsigned ra = r[0], rb = r[1]; asm volatile("" : "+v"(ra), "+v"(rb)); t8[k] = __builtin_bit_cast(h16x2, ra) + __builtin_bit_cast(h16x2, rb); }
#pragma unroll
            for (int k = 0; k < 4; ++k) { const auto r = __builtin_amdgcn_permlane16_swap(__builtin_bit_cast(unsigned, t8[k]), __builtin_bit_cast(unsigned, t8[4 + k]), false, false);
                unsigned ra = r[0], rb = r[1]; asm volatile("" : "+v"(ra), "+v"(rb)); t4[k] = __builtin_bit_cast(h16x2, ra) + __builtin_bit_cast(h16x2, rb); }
#pragma unroll
            for (int k = 0; k < 2; ++k) { const unsigned lo = __builtin_bit_cast(unsigned, t4[k]), hi = __builtin_bit_cast(unsigned, t4[2 + k]); const unsigned mine = b3 ? hi : lo, send = b3 ? lo : hi;
                const h16x2 rr = __builtin_bit_cast(h16x2, mine) + __builtin_bit_cast(h16x2, (unsigned)__builtin_amdgcn_update_dpp(0u, send, 0x128, 0xF, 0xF, true));
                res[2 * k] = (float)rr.x; res[2 * k + 1] = (float)rr.y; }
            u32x2 ow; ow.x = cvtpk(res[0], res[1]); ow.y = cvtpk(res[2], res[3]);
            *(u32x2*)(PO + ((size_t)tb * 8 + j) * 4096 + 64 * s + 8 * g) = ow;
        }
    }
#undef PB_LOAD
#undef PB_STORE
#undef PR_LOAD
}

template <bool FINAL>
__device__ __forceinline__ void phase_peer_norm(const P& p, int layer, int lane, int wid) {
    bf16_t* XB = (bf16_t*)(p.ws + WS_XB);
    const bf16_t* PO = (const bf16_t*)(p.ws + WS_PO);
    const float* mod = (const float*)(p.ws + WS_MOD);
    float* X = p.out;
    const int gw = blockIdx.x * 8 + wid, ngw = gridDim.x * 8;
    u32x4 pw[4], xw[4];
#define PN_LOAD(T, PWV, XWV) { const bf16_t* por = PO + (size_t)(T) * 2048 + 16 * lane; const bf16_t* xbl = XB + (size_t)(T) * 2048 + 16 * lane; \
        _Pragma("unroll") for (int j = 0; j < 4; ++j) { PWV[j] = *(const u32x4*)(por + 1024 * (j >> 1) + 8 * (j & 1)); XWV[j] = *(const u32x4*)(xbl + 1024 * (j >> 1) + 8 * (j & 1)); } }
    if (gw < NTOK) PN_LOAD(gw, pw, xw)
#pragma unroll 1
    for (int token = gw; token < NTOK; token += ngw) {
        const int b = token >> 13;
        u32x4 pwn[4], xwn[4];
        { const int tn = token + ngw < NTOK ? token + ngw : token; PN_LOAD(tn, pwn, xwn) }
        float o[32];
#pragma unroll
        for (int j = 0; j < 4; ++j) { const u32x4 w = pw[j];
            o[8 * j + 0] = bflo(w.x); o[8 * j + 1] = bfhi(w.x); o[8 * j + 2] = bflo(w.y); o[8 * j + 3] = bfhi(w.y);
            o[8 * j + 4] = bflo(w.z); o[8 * j + 5] = bfhi(w.z); o[8 * j + 6] = bflo(w.w); o[8 * j + 7] = bfhi(w.w); }
        {
            const float* g2 = mod + (size_t)(layer * 2 + b) * 12288 + 5 * 2048 + 16 * lane;
            bf16_t* xbr = XB + (size_t)token * 2048 + 16 * lane; float* xr = X + (size_t)token * 2048 + 16 * lane;
            float xn[32], ss = 0.f;
#pragma unroll
            for (int jh = 0; jh < 2; ++jh) { const u32x4 w0 = xw[2 * jh], w1 = xw[2 * jh + 1];
                const float xi[16] = {bflo(w0.x), bfhi(w0.x), bflo(w0.y), bfhi(w0.y), bflo(w0.z), bfhi(w0.z), bflo(w0.w), bfhi(w0.w), bflo(w1.x), bfhi(w1.x), bflo(w1.y), bfhi(w1.y), bflo(w1.z), bfhi(w1.z), bflo(w1.w), bfhi(w1.w)};
#pragma unroll
                for (int q = 0; q < 4; ++q) { const f32x4 gg = *(const f32x4*)(g2 + 1024 * jh + 4 * q);
#pragma unroll
                    for (int e = 0; e < 4; ++e) { const float t = xi[4 * q + e] + gg[e] * o[16 * jh + 4 * q + e]; xn[16 * jh + 4 * q + e] = t; ss += t * t; } } }
            ss = wave_sum(ss); const float rstd = rsqrtf(ss * (1.0f / 2048.0f) + 1e-6f);
            if (FINAL) {
#pragma unroll
                for (int j = 0; j < 8; ++j) { const int off = 1024 * (j >> 2) + 4 * (j & 3); const f32x4 fg = *(const f32x4*)(p.final_g + 16 * lane + off);
                    f32x4 y;
#pragma unroll
                    for (int e = 0; e < 4; ++e) y[e] = xn[4 * j + e] * rstd * fg[e];
                    *(f32x4*)(xr + off) = y; }
            } else {
                const float* ng = p.norm_g + (size_t)((layer + 1) * 2 + 0) * 2048 + 16 * lane;
                const float* sh = mod + (size_t)((layer + 1) * 2 + b) * 12288 + 16 * lane; const float* sc = sh + 2048;
                unsigned char* hrow8 = p.ws + WS_H8 + (size_t)token * 2048 + 16 * lane;
#pragma unroll
                for (int jh = 0; jh < 2; ++jh) { float y[16];
#pragma unroll
                    for (int hq = 0; hq < 4; ++hq) { const int jj = 4 * jh + hq, off = 1024 * jh + 4 * hq; const f32x4 gv = *(const f32x4*)(ng + off), sv = *(const f32x4*)(sc + off), hv = *(const f32x4*)(sh + off);
                        f32x4 xo;
#pragma unroll
                        for (int e = 0; e < 4; ++e) { xo[e] = xn[4 * jj + e]; y[4 * hq + e] = (xo[e] * rstd * gv[e] * (1.0f + sv[e]) + hv[e]) * F8_HS; }
                        u32x2 xw; xw.x = cvtpk(xo[0], xo[1]); xw.y = cvtpk(xo[2], xo[3]); *(u32x2*)(xbr + off) = xw; }
                    u32x4 w; w.x = pk_fp8x4(y[0], y[1], y[2], y[3]); w.y = pk_fp8x4(y[4], y[5], y[6], y[7]); w.z = pk_fp8x4(y[8], y[9], y[10], y[11]); w.w = pk_fp8x4(y[12], y[13], y[14], y[15]);
                    *(u32x4*)(hrow8 + 1024 * jh) = w; }
            }
        }
#pragma unroll
        for (int j = 0; j < 4; ++j) { pw[j] = pwn[j]; xw[j] = xwn[j]; }
    }
#undef PN_LOAD
}

#ifndef PH_MASK
#define PH_MASK 0xFFFF
#endif
#define PH(b) if constexpr ((PH_MASK >> (b)) & 1)
#ifndef DBL_MASK
#define DBL_MASK 0
#endif
#define REP(b) for (int _r = 0; _r < 1 + ((DBL_MASK >> (b)) & 1); ++_r)
__device__ __forceinline__ int fresh_tid() { int t = threadIdx.x; asm volatile("" : "+v"(t)); return t; }
__device__ __forceinline__ P load_p() {
    typedef __attribute__((address_space(1))) float* gp;
    typedef const gp __attribute__((address_space(4)))* cq;
    cq q = (cq)__builtin_amdgcn_kernarg_segment_ptr(); asm volatile("" : "+s"(q));
    P r; float** d = (float**)&r;
#pragma unroll
    for (int i = 0; i < (int)(sizeof(P) / 8); ++i) d[i] = (float*)q[i];
    return r;
}
#define LP (load_p())
#define WSB (load_p().ws)
#define MODP ((const float*)(load_p().ws + WS_MOD))
#define HP ((bf16_t*)(load_p().ws + WS_H))
__global__ void __launch_bounds__(512, 2) mk_fwd(P p_arg) {
    extern __shared__ __attribute__((aligned(16))) unsigned char lds_raw[];
    LAS unsigned char* lds = (LAS unsigned char*)lds_raw;
    cg::grid_group grid = cg::this_grid();
    const int wid = __builtin_amdgcn_readfirstlane((int)threadIdx.x >> 6);
    const int gw = blockIdx.x * 8 + wid, ngw = gridDim.x * 8, G = gridDim.x;
    volatile LAS unsigned* xst = (volatile LAS unsigned*)(lds + LDS_BYTES - 64);
    if (threadIdx.x < 16) xst[threadIdx.x] = 0u;
    __syncthreads();
    const XcdBarrier xb = xcd_barrier_post((unsigned*)(load_p().ws + WS_BAR), xst);
#define TID (fresh_tid())
#define LANE (fresh_tid() & 63)

    REP(0) { PH(0) phase_prologue(LP, lds, TID, LANE, wid);
    grid.sync(); }
    REP(1) { PH(1) phase_adaln<true>(LP.x, WSB + WS_H8, LP.norm_g, MODP, MODP + 2048, gw, ngw, LANE);
    xcd_barrier(xb); }
    REP(2) { PH(2) {   pg8::Gemm g{(const bf16_t*)(WSB + WS_H8), (const bf16_t*)(WSB + WS_WINE), NTOK, 2560, 1024, 1024, 1024, 0, 0}; pg8::StaticOrder S; S.init(NTOK, 2560, G, (int)blockIdx.x);
        pg8::EpiEvenSplit E{1.0f / (F8_HS * F8_WS), WSB};
        pg8::gemm_phase<pg8::EpiEvenSplit, pg8::StaticOrder, true, true, true>(lds, g, S, E); }
    xcd_barrier(xb); }
    PH(3) { phase_qkprep(LP, gw, ngw, LANE); phase_fold_wq(LP, lds, TID, LANE, wid); __syncthreads(); }
    REP(4) { PH(4) {
        pg8::Gemm g{(const bf16_t*)(WSB + WS_AB), (const bf16_t*)(WSB + WS_WSUM), 1024, 256, 256, 512, 256, (size_t)1024 * 512, (size_t)256 * 256};
        pg8::BatchOrder S{4, 256, G, (int)blockIdx.x}; pg8::EpiF32B E{(float*)(WSB + WS_SS), 256, (size_t)1024 * 256};
        pg8::gemm_phase<pg8::EpiF32B, pg8::BatchOrder, false, false>(lds, g, S, E); }
    xcd_barrier(xb); }
    REP(5) { PH(5) { phase_s5scan(LP, lds, LANE, wid); phase_bias_reduce(LP, TID); }
    xcd_barrier(xb); }
    REP(13) { PH(13) {
        pg8::Gemm g{(const bf16_t*)(WSB + WS_AB), (const bf16_t*)(WSB + WS_WY), 1024, 256, 512, 512, 512, (size_t)1024 * 512, (size_t)256 * 512};
        LAS float* wl = (LAS float*)(lds + 131072);
        { const int un = (int)blockIdx.x;
            const int tid = TID; __syncthreads();
            if (tid < 256) wl[tid] = LP.glu_w[(un >> 2) * 256 + tid]; else if (tid < 272) wl[tid] = LP.glu_b[(un >> 2) * 16 + tid - 256];
            __syncthreads();
            pg8::BatchOrder S{4, un + 1, 256, un}; pg8::EpiS5Glu E{WSB + WS_CAT, wl};
            pg8::gemm_phase<pg8::EpiS5Glu, pg8::BatchOrder, false, false>(lds, g, S, E); }
        __syncthreads(); } }
    REP(6) { PH(6) phase_attn(LP, (char*)lds_raw);
    xcd_barrier(xb); }
    REP(7) { PH(7) {   pg8::Gemm g{(const bf16_t*)(WSB + WS_CAT), (const bf16_t*)(WSB + WS_WOUTE), NTOK, 2048, 1024, 1024, 1024, 0, 0}; pg8::StaticOrder S; S.init(NTOK, 2048, G, (int)blockIdx.x);
        pg8::EpiResidB<true> E{LP.x, (bf16_t*)(WSB + WS_XB), MODP + 2 * 2048, (float*)(WSB + WS_ROWSQ), WSB + WS_X8, 1.0f / (F8_CS * F8_WS)};
        pg8::gemm_phase<pg8::EpiResidB<true>, pg8::StaticOrder, true, true, true>(lds, g, S, E); }
    xcd_barrier(xb); }
    REP(8) { PH(8) {   pg8::Gemm g{(const bf16_t*)(WSB + WS_X8), (const bf16_t*)(WSB + WS_WQF), NTOK, 2048, 1024, 1024, 1024, 0, (size_t)2048 * 1024}; pg8::StaticOrder S; S.init(NTOK, 2048, G, (int)blockIdx.x); S.pbs = 5;
        pg8::EpiQ E{(bf16_t*)(WSB + WS_QP), (const float*)(WSB + WS_ROWSQ), (const float*)(WSB + WS_BIASQ), 1.0f / (F8_XS * F8_WS)};
        pg8::gemm_phase<pg8::EpiQ, pg8::StaticOrder, true, true, true>(lds, g, S, E); }
    xcd_barrier(xb); }
    REP(16) { PH(9) phase_peer_s1(LP, 0, lds, LANE, wid); }
    xcd_barrier(xb);
    REP(17) { PH(9) phase_peer_u(LP, 0, lds, LANE, wid, (int)xst[2]); }
    xcd_barrier(xb);
    REP(18) { PH(9) phase_peer_w(LP, 0, TID); }
    xcd_barrier(xb);
    REP(19) { PH(9) phase_peer_vs(LP, 0, lds, LANE, wid, (int)xst[2]); }
    xcd_barrier(xb);
    PH(9) phase_peer_norm<false>(LP, 0, LANE, wid);
    xcd_barrier(xb);
    REP(10) { PH(10) {   pg8::Gemm g{(const bf16_t*)(WSB + WS_H8), (const bf16_t*)(WSB + WS_WINO), NTOK, 8192, 1024, 1024, 1024, 0, 0}; pg8::StaticOrder S; S.init(NTOK, 8192, G, (int)blockIdx.x);
        pg8::EpiBf16T<1> E{(bf16_t*)(WSB + WS_Z), 8192, 1.0f / (F8_HS * F8_WS), (float*)(WSB + WS_LNST)};
        pg8::gemm_phase<pg8::EpiBf16T<1>, pg8::StaticOrder, true, true, true>(lds, g, S, E); }
    xcd_barrier(xb); }
    REP(11) { PH(11) phase_sgu(LP, lds, TID, LANE, wid);
    xcd_barrier(xb); }
    PH(12) {   pg8::Gemm g{(const bf16_t*)(WSB + WS_SG), (const bf16_t*)(WSB + WS_WOUTO), NTOK, 2048, 2048, 2048, 2048, 0, 0}; pg8::StaticOrder S; S.init(NTOK, 2048, G, (int)blockIdx.x);
        pg8::EpiResidB<false> E{nullptr, (bf16_t*)(WSB + WS_XB), MODP + 2 * 12288 + 2 * 2048, (float*)(WSB + WS_ROWSQ) + (size_t)32 * NTOK, WSB + WS_X8, 1.0f / (F8_SGS * F8_WS)};
        pg8::gemm_phase<pg8::EpiResidB<false>, pg8::StaticOrder, true, true, true>(lds, g, S, E); }
    xcd_barrier(xb);
    REP(8) { PH(8) {   pg8::Gemm g{(const bf16_t*)(WSB + WS_X8), (const bf16_t*)(WSB + WS_WQF) + (size_t)2 * 2048 * 1024, NTOK, 2048, 1024, 1024, 1024, 0, (size_t)2048 * 1024}; pg8::StaticOrder S; S.init(NTOK, 2048, G, (int)blockIdx.x); S.pbs = 5;
        pg8::EpiQ E{(bf16_t*)(WSB + WS_QP), (const float*)(WSB + WS_ROWSQ) + (size_t)32 * NTOK, (const float*)(WSB + WS_BIASQ) + 2 * 2048, 1.0f / (F8_XS * F8_WS)};
        pg8::gemm_phase<pg8::EpiQ, pg8::StaticOrder, true, true, true>(lds, g, S, E); }
    xcd_barrier(xb); }
    REP(16) { PH(9) phase_peer_s1(LP, 1, lds, LANE, wid); }
    xcd_barrier(xb);
    REP(17) { PH(9) phase_peer_u(LP, 1, lds, LANE, wid, (int)xst[2]); }
    xcd_barrier(xb);
    REP(18) { PH(9) phase_peer_w(LP, 1, TID); }
    xcd_barrier(xb);
    REP(19) { PH(9) phase_peer_vs(LP, 1, lds, LANE, wid, (int)xst[2]); }
    xcd_barrier(xb);
    PH(9) phase_peer_norm<true>(LP, 1, LANE, wid);
}

#undef LP
#undef WSB
#undef MODP
#undef HP
extern "C" void kernel_launch(void* const* d_in, const int* in_sizes, int n_in, void* d_out, int out_size, void* d_ws, size_t ws_size, hipStream_t stream) {
    static int grid = 0;
    if (grid == 0) {
        if (n_in != 30 || out_size != NTOK * DMODEL || ws_size < WS_END) { fprintf(stderr, "kernel_launch: unexpected shapes (n_in %d out %d ws %zu, need ws >= %zu)\n", n_in, out_size, ws_size, (size_t)WS_END); grid = -1; return; }
        int dev = 0, cus = 0, per_cu = 0;
        (void)hipGetDevice(&dev); (void)hipDeviceGetAttribute(&cus, hipDeviceAttributeMultiprocessorCount, dev);
        if (hipFuncSetAttribute((const void*)mk_fwd, hipFuncAttributeMaxDynamicSharedMemorySize, LDS_BYTES) != hipSuccess) { fprintf(stderr, "kernel_launch: hipFuncSetAttribute failed\n"); grid = -1; return; }
        if (hipOccupancyMaxActiveBlocksPerMultiprocessor(&per_cu, (const void*)mk_fwd, 512, LDS_BYTES) != hipSuccess || per_cu < 1) { fprintf(stderr, "kernel_launch: occupancy query says %d\n", per_cu); (void)hipGetLastError(); per_cu = 1; }
        grid = cus;
        if (grid > cus * per_cu) grid = cus * per_cu;
        if (grid != 256) { fprintf(stderr, "kernel_launch: this kernel is laid out for a 256-CU device (got %d workgroups)\n", grid); grid = -1; return; }
    }
    if (grid < 0) return;
    if (hipMemsetAsync((char*)d_ws + WS_BAR, 0, 16384, stream) != hipSuccess) { fprintf(stderr, "kernel_launch: hipMemsetAsync failed\n"); return; }
    P p{};
    const float** pf = (const float**)&p;
    for (int i = 0; i < 30; ++i) pf[i] = (const float*)d_in[i];
    p.out = (float*)d_out; p.ws = (unsigned char*)d_ws;
    void* args[] = {&p};
    hipError_t e = hipLaunchCooperativeKernel((const void*)mk_fwd, dim3(grid), dim3(512), args, LDS_BYTES, stream);
    if (e != hipSuccess) fprintf(stderr, "kernel_launch: cooperative launch failed: %s (grid %d)\n", hipGetErrorString(e), grid);
}
```

```cpp
#include <hip/hip_runtime.h>
#include <hip/hip_cooperative_groups.h>
#include <hip/hip_bf16.h>
#include <cstdio>
#include <cstdint>
namespace cg = cooperative_groups;

__device__ __forceinline__ int lane_id_v() { int l; asm volatile("v_mbcnt_lo_u32_b32 %0, -1, 0\n\tv_mbcnt_hi_u32_b32 %0, -1, %0" : "=v"(l)); return l; }

namespace pg8 {
#define PG8_LAS __attribute__((address_space(3)))
typedef unsigned short bf16_t;
typedef short bf16x8 __attribute__((ext_vector_type(8)));
typedef float f32x4 __attribute__((ext_vector_type(4)));
typedef unsigned u32x4 __attribute__((ext_vector_type(4)));
constexpr int BM = 256, BK = 64, HALF = 128, HTB = HALF * BK * 2  , STAGE_BYTES = 8 * HTB, NXCD = 8, WGM = 8;

__host__ __device__ __forceinline__ int lds_byte(int r, int c) { const int st = (r >> 4) * 2 + (c >> 5), rr = r & 15, cc = c & 31, ob = rr * 64 + cc * 2; return st * 1024 + (ob ^ (((ob >> 9) & 1) << 5)); }
__host__ __device__ __forceinline__ void stage_rc(int b, int& R, int& C) { const int st = b / 1024, sb = b % 1024, swz = sb ^ (((sb >> 9) & 1) << 5); R = (st >> 1) * 16 + swz / 64; C = (st & 1) * 32 + (swz % 64) / 2; }
__host__ __device__ __forceinline__ int perm32(int rho) { const int n = rho >> 4, i = rho & 15; return 8 * (i >> 2) + 4 * n + (i & 3); }

struct Unit { int pm, pn, pb; };
struct Gemm { const bf16_t* A; const bf16_t* Bt; int M, N, K; int lda, ldb; size_t bsA, bsB; };

struct StaticOrder {
    int nM, nN, nwg, G, c, pbs;
    __host__ __device__ void init(int M, int N, int G_, int c_) { nM = M / BM; nN = N / BM; nwg = nM * nN; G = G_; c = c_; pbs = -1; }
    __host__ __device__ bool next(int i, Unit& u) const {
        const long L = (long)i * G + c; if (L >= nwg) return false;
        int wgid = (int)L; { const int q = nwg / NXCD, r = nwg % NXCD, xcd = wgid % NXCD, off = wgid / NXCD; wgid = (xcd < r ? xcd * (q + 1) : r * (q + 1) + (xcd - r) * q) + off; }
        const int nig = WGM * nN, gid = wgid / nig, fm = gid * WGM, gsz = (nM - fm) < WGM ? (nM - fm) : WGM;
        u.pm = fm + ((wgid % nig) % gsz); u.pn = (wgid % nig) / gsz; u.pb = pbs >= 0 ? (u.pm >> pbs) : 0; return true;
    }
    __device__ __forceinline__ void a_ready(const Unit&) const {}
    __device__ __forceinline__ void done(const Unit&) const {}
};

__device__ __forceinline__ unsigned cvt_pk_bf16(float lo, float hi) { unsigned r; asm volatile("v_cvt_pk_bf16_f32 %0, %1, %2" : "=v"(r) : "v"(lo), "v"(hi)); return r; }
typedef float f32x2 __attribute__((ext_vector_type(2)));

typedef int i32x8 __attribute__((ext_vector_type(8)));
typedef int i32x4v __attribute__((ext_vector_type(4)));
__device__ __forceinline__ void pg8_mfma_f8(f32x4& c, const i32x8& a, const i32x8& b, int sc) {
    asm("s_nop 1\n\tv_mfma_f32_16x16x128_f8f6f4 %0, %1, %2, %0" : "+v"(c) : "v"(a), "v"(b)); (void)sc; }
__device__ __forceinline__ void pg8_mfma_f8_drain(f32x4 (&acc)[2][2][4][2]) {
#pragma unroll
    for (int a = 0; a < 2; ++a)
#pragma unroll
        for (int b = 0; b < 2; ++b) {
            if (a == 0 && b == 0) asm volatile("s_nop 15\n\ts_nop 15" : "+v"(acc[a][b][0][0]), "+v"(acc[a][b][0][1]), "+v"(acc[a][b][1][0]), "+v"(acc[a][b][1][1]), "+v"(acc[a][b][2][0]), "+v"(acc[a][b][2][1]), "+v"(acc[a][b][3][0]), "+v"(acc[a][b][3][1]));
            else asm volatile("" : "+v"(acc[a][b][0][0]), "+v"(acc[a][b][0][1]), "+v"(acc[a][b][1][0]), "+v"(acc[a][b][1][1]), "+v"(acc[a][b][2][0]), "+v"(acc[a][b][2][1]), "+v"(acc[a][b][3][0]), "+v"(acc[a][b][3][1])); }
}
__device__ __forceinline__ i32x8 pg8_cat(bf16x8 a, bf16x8 b) { return __builtin_shufflevector(__builtin_bit_cast(i32x4v, a), __builtin_bit_cast(i32x4v, b), 0, 1, 2, 3, 4, 5, 6, 7); }
template <class Epi, class Sched, bool ALIGN_EPI = false, bool SP2 = false, bool F8 = false>
__device__ __forceinline__ void gemm_phase(PG8_LAS unsigned char* lds, const Gemm g, const Sched& S, const Epi& E) {
    int tid_o = threadIdx.x; asm volatile("" : "+v"(tid_o)); const int tid = tid_o, wid = __builtin_amdgcn_readfirstlane(tid >> 6), lane = tid & 63, wr = wid >> 2, wc = wid & 3, fr = lane & 15, fq = lane >> 4;
    const int K = g.K, nt = K / BK;
    unsigned voffA[2], voffB[2];
#pragma unroll
    for (int i = 0; i < 2; ++i) { int R, C; stage_rc(tid * 16 + i * 8192, R, C); const int Rb = Epi::PERM ? ((R & ~31) + perm32(R & 31)) : R;
        voffA[i] = (unsigned)(R * g.lda + C) * 2u; voffB[i] = (unsigned)(Rb * g.ldb + C) * 2u; }
    const size_t kstep = (size_t)(BK * 2);
    const size_t hstepA = (size_t)HALF * g.lda * 2, hstepB = (size_t)HALF * g.ldb * 2;
    const size_t tstepA = 2 * hstepA, tstepB = 2 * hstepB;
    const unsigned ldsw = (unsigned)wid * 1024u;
    const int aoff = lds_byte(wr * 64 + fr, fq * 8), boff = lds_byte(wc * 32 + fr, fq * 8);
#define PG8_SA(b, h) (((b) * 2 + (h)) * HTB)
#define PG8_SB(b, h) ((4 + (b) * 2 + (h)) * HTB)
#define PG8_STAGE(bufoff, gbase, voff) do { _Pragma("unroll") for (int _i = 0; _i < 2; ++_i) \
        __builtin_amdgcn_global_load_lds((const unsigned*)((const char*)(gbase) + (voff)[_i]), (PG8_LAS unsigned*)(lds + (bufoff) + ldsw + _i * 8192), 16, 0, 0); } while (0)
#define PG8_LDA(dst, b, h) do { _Pragma("unroll") for (int m = 0; m < 4; ++m) { dst[m].lo = *(const PG8_LAS i32x4v*)(lds + PG8_SA(b, h) + aoff + m * 2048); dst[m].hi = *(const PG8_LAS i32x4v*)(lds + PG8_SA(b, h) + aoff + m * 2048 + 1024); } } while (0)
#define PG8_LDB(dst, b, h) do { _Pragma("unroll") for (int n = 0; n < 2; ++n) { dst[n].lo = *(const PG8_LAS i32x4v*)(lds + PG8_SB(b, h) + boff + n * 2048); dst[n].hi = *(const PG8_LAS i32x4v*)(lds + PG8_SB(b, h) + boff + n * 2048 + 1024); } } while (0)
#define PG8_MMA(ai, bj, At, Bt) do { __builtin_amdgcn_s_setprio(1); \
        if constexpr (F8) { _Pragma("unroll") for (int m = 0; m < 4; ++m) _Pragma("unroll") for (int n = 0; n < 2; ++n) pg8_mfma_f8(acc[ai][bj][m][n], Bt[n], At[m], f8scale); } \
        else { _Pragma("unroll") for (int m = 0; m < 4; ++m) _Pragma("unroll") for (int n = 0; n < 2; ++n) { \
            const i32x4v b_lo = Bt[n].lo, b_hi = Bt[n].hi, a_lo = At[m].lo, a_hi = At[m].hi;     \
            acc[ai][bj][m][n] = __builtin_amdgcn_mfma_f32_16x16x32_bf16(__builtin_bit_cast(bf16x8, b_lo), __builtin_bit_cast(bf16x8, a_lo), acc[ai][bj][m][n], 0, 0, 0); \
            acc[ai][bj][m][n] = __builtin_amdgcn_mfma_f32_16x16x32_bf16(__builtin_bit_cast(bf16x8, b_hi), __builtin_bit_cast(bf16x8, a_hi), acc[ai][bj][m][n], 0, 0, 0); } } \
        __builtin_amdgcn_s_setprio(0); } while (0)
#define PG8_WAIT_V(n) asm volatile("s_waitcnt vmcnt(" #n ")" ::: "memory")
#define PG8_WAIT_L(n) asm volatile("s_waitcnt lgkmcnt(" #n ")" ::: "memory")
#define PG8_BAR __builtin_amdgcn_s_barrier()
#define PG8_SCHED __builtin_amdgcn_sched_barrier(0)
    Unit cur, nxt; int ui = 0;
    if (!S.next(0, cur)) return;
    f32x4 acc[2][2][4][2];
#pragma unroll
    for (int a = 0; a < 2; ++a)
#pragma unroll
        for (int b = 0; b < 2; ++b)
#pragma unroll
            for (int m = 0; m < 4; ++m)
#pragma unroll
                for (int n = 0; n < 2; ++n) acc[a][b][m][n] = (f32x4){0.f, 0.f, 0.f, 0.f};
    int f8scale = 0x7f7f7f7f; asm volatile("" : "+v"(f8scale));
    i32x8 At[4], B0[2], B1[2];
    const char* cA = (const char*)(g.A + (size_t)cur.pb * g.bsA) + (size_t)cur.pm * tstepA; const char* cB = (const char*)(g.Bt + (size_t)cur.pb * g.bsB) + (size_t)cur.pn * tstepB;
    S.a_ready(cur);
    if constexpr (SP2) {
        PG8_STAGE(PG8_SB(0, 0), cB, voffB); PG8_STAGE(PG8_SB(0, 1), cB + hstepB, voffB); PG8_STAGE(PG8_SA(0, 0), cA, voffA); PG8_STAGE(PG8_SA(0, 1), cA + hstepA, voffA);
        if (wr == 1) PG8_BAR;
        PG8_WAIT_V(2); PG8_BAR;
        PG8_STAGE(PG8_SB(1, 0), cB + kstep, voffB); PG8_STAGE(PG8_SA(1, 0), cA + kstep, voffA); PG8_STAGE(PG8_SB(1, 1), cB + hstepB + kstep, voffB);
        PG8_WAIT_V(6); PG8_BAR;
    } else {
        PG8_STAGE(PG8_SB(0, 0), cB, voffB); PG8_STAGE(PG8_SA(0, 0), cA, voffA); PG8_STAGE(PG8_SB(0, 1), cB + hstepB, voffB); PG8_STAGE(PG8_SA(0, 1), cA + hstepA, voffA);
        if (wr == 1) PG8_BAR;
        PG8_WAIT_V(4); PG8_BAR;
        PG8_STAGE(PG8_SB(1, 0), cB + kstep, voffB); PG8_STAGE(PG8_SA(1, 0), cA + kstep, voffA); PG8_STAGE(PG8_SB(1, 1), cB + hstepB + kstep, voffB);
        PG8_WAIT_V(6); PG8_BAR;
    }
    for (;;) {
        const bool has_next = S.next(ui + 1, nxt);
        const char* nA = has_next ? (const char*)(g.A + (size_t)nxt.pb * g.bsA) + (size_t)nxt.pm * tstepA : cA; const char* nB = has_next ? (const char*)(g.Bt + (size_t)nxt.pb * g.bsB) + (size_t)nxt.pn * tstepB : cB;
        for (int t = 0; t < nt; t += 2) {
            const bool last = (t == nt - 2);
            const char* a1 = cA + (size_t)(t + 1) * kstep;
            const char* a2 = last ? nA : cA + (size_t)(t + 2) * kstep; const char* b2 = last ? nB : cB + (size_t)(t + 2) * kstep;
            const char* a3 = a2 + kstep; const char* b3 = b2 + kstep;
            if (last && has_next) S.a_ready(nxt);
            if constexpr (SP2) {
            PG8_LDB(B0, 0, 0); PG8_LDB(B1, 0, 1); PG8_SCHED; PG8_LDA(At, 0, 0); PG8_STAGE(PG8_SA(1, 1), a1 + hstepA, voffA);
            PG8_WAIT_V(8); PG8_WAIT_L(0); PG8_BAR; PG8_MMA(0, 0, At, B0); PG8_MMA(0, 1, At, B1); PG8_BAR; PG8_SCHED;
            PG8_LDA(At, 0, 1); PG8_STAGE(PG8_SB(0, 0), b2, voffB); PG8_STAGE(PG8_SB(0, 1), b2 + hstepB, voffB); PG8_STAGE(PG8_SA(0, 0), a2, voffA);
            PG8_WAIT_V(8); PG8_WAIT_L(0); PG8_BAR; PG8_MMA(1, 0, At, B0); PG8_MMA(1, 1, At, B1); PG8_BAR; PG8_SCHED;
            PG8_LDB(B0, 1, 0); PG8_LDB(B1, 1, 1); PG8_SCHED; PG8_LDA(At, 1, 0); PG8_STAGE(PG8_SA(0, 1), a2 + hstepA, voffA);
            PG8_WAIT_V(8); PG8_WAIT_L(0); PG8_BAR; PG8_MMA(0, 0, At, B0); PG8_MMA(0, 1, At, B1); PG8_BAR; PG8_SCHED;
            PG8_LDA(At, 1, 1); PG8_STAGE(PG8_SB(1, 0), b3, voffB); PG8_STAGE(PG8_SB(1, 1), b3 + hstepB, voffB); PG8_STAGE(PG8_SA(1, 0), a3, voffA);
            PG8_WAIT_V(8); PG8_WAIT_L(0); PG8_BAR; PG8_MMA(1, 0, At, B0); PG8_MMA(1, 1, At, B1); PG8_BAR; PG8_SCHED;
            } else {
            PG8_LDB(B0, 0, 0); PG8_SCHED; PG8_LDA(At, 0, 0); PG8_STAGE(PG8_SA(1, 1), a1 + hstepA, voffA);
            PG8_WAIT_L(8); PG8_BAR; PG8_WAIT_L(0); PG8_MMA(0, 0, At, B0); PG8_BAR; PG8_SCHED;
            PG8_LDB(B1, 0, 1); PG8_STAGE(PG8_SB(0, 0), b2, voffB);
            PG8_BAR; PG8_WAIT_L(0); PG8_MMA(0, 1, At, B1); PG8_BAR;
            PG8_LDA(At, 0, 1); PG8_STAGE(PG8_SA(0, 0), a2, voffA);
            PG8_BAR; PG8_WAIT_L(0); PG8_MMA(1, 0, At, B0); PG8_BAR; PG8_SCHED;
            PG8_STAGE(PG8_SB(0, 1), b2 + hstepB, voffB);
            PG8_WAIT_V(6); PG8_BAR; PG8_MMA(1, 1, At, B1); PG8_BAR;
            PG8_LDB(B0, 1, 0); PG8_SCHED; PG8_LDA(At, 1, 0); PG8_STAGE(PG8_SA(0, 1), a2 + hstepA, voffA);
            PG8_WAIT_L(8); PG8_BAR; PG8_WAIT_L(0); PG8_MMA(0, 0, At, B0); PG8_BAR; PG8_SCHED;
            PG8_LDB(B1, 1, 1); PG8_STAGE(PG8_SB(1, 0), b3, voffB);
            PG8_BAR; PG8_WAIT_L(0); PG8_MMA(0, 1, At, B1); PG8_BAR;
            PG8_LDA(At, 1, 1); PG8_STAGE(PG8_SA(1, 0), a3, voffA);
            PG8_BAR; PG8_WAIT_L(0); PG8_MMA(1, 0, At, B0); PG8_BAR; PG8_SCHED;
            PG8_STAGE(PG8_SB(1, 1), b3 + hstepB, voffB);
            PG8_WAIT_V(6); PG8_BAR; PG8_MMA(1, 1, At, B1); PG8_BAR;
            }
        }
        if constexpr (ALIGN_EPI) { if (wr == 0) PG8_BAR; }
        if constexpr (F8) pg8_mfma_f8_drain(acc);
        if constexpr (!Epi::AFTER_DRAIN) { E(acc, cur, wr, wc, fr, fq); S.done(cur); }
        if (!has_next) break;
#pragma unroll
        for (int a = 0; a < 2; ++a)
#pragma unroll
            for (int b = 0; b < 2; ++b)
#pragma unroll
                for (int m = 0; m < 4; ++m)
#pragma unroll
                    for (int n = 0; n < 2; ++n) acc[a][b][m][n] = (f32x4){0.f, 0.f, 0.f, 0.f};
        cur = nxt; cA = nA; cB = nB; ++ui;
        if constexpr (ALIGN_EPI) { if (wr == 1) PG8_BAR; }
    }
    PG8_WAIT_V(0);
    if constexpr (!ALIGN_EPI) { if (wr == 0) PG8_BAR; }
    PG8_BAR;
    if constexpr (Epi::AFTER_DRAIN) { E.fused(acc, cur, wr, wc, fr, fq, lds, wid, lane); S.done(cur); }
#undef PG8_SA
#undef PG8_SB
#undef PG8_STAGE
#undef PG8_LDA
#undef PG8_LDB
#undef PG8_MMA
#undef PG8_WAIT_V
#undef PG8_WAIT_L
#undef PG8_BAR
#undef PG8_SCHED
}
}
namespace attn {
using bf16 = __hip_bfloat16;
constexpr int   D = 128, NW = 8, QBLK = 32, KVBLK = 64;
constexpr float SCALE = 0.088388347648318440f;
constexpr float THR = 8.f;
constexpr int SDEPTH = 2;
constexpr int LDQ = 1024, LDK = 256, LDO = 2048;
constexpr size_t SHM_V = KVBLK * D * 2, SHM_K = KVBLK * D * 2, SHM_ATTN = 2 * SHM_V + 2 * SHM_K + NW * 64 * 4;
using bf16x8 = __attribute__((ext_vector_type(8))) short;
using s16x4  = __attribute__((ext_vector_type(4))) short;
using f32x16 = __attribute__((ext_vector_type(16))) float;
using f32x8  = __attribute__((ext_vector_type(8))) float;
using u32x4  = __attribute__((ext_vector_type(4))) unsigned;
#define KSWZ(row, colB) ((row) * 256 + ((colB) ^ (((row) & 7) << 4)))
#define SBAR() __builtin_amdgcn_sched_barrier(0)
__device__ __forceinline__ int crow(int r, int hi) { return (r & 3) + 8 * (r >> 2) + 4 * hi; }
__device__ __forceinline__ unsigned cvtpk(float lo, float hi) {
  unsigned r; asm volatile("v_cvt_pk_bf16_f32 %0, %1, %2" : "=v"(r) : "v"(lo), "v"(hi)); return r;
}
template <typename TIn> struct Stage;
template <> struct Stage<bf16>  { using T = bf16x8;
  __device__ static __forceinline__ T ld8(const bf16* p) { return *reinterpret_cast<const bf16x8*>(p); }
  __device__ static __forceinline__ bf16x8 tobf(T x) { return x; } };
template <> struct Stage<float> { using T = f32x8;
  __device__ static __forceinline__ T ld8(const float* p) { return *reinterpret_cast<const f32x8*>(p); }
  __device__ static __forceinline__ bf16x8 tobf(T x) {
    u32x4 w = {cvtpk(x[0], x[1]), cvtpk(x[2], x[3]), cvtpk(x[4], x[5]), cvtpk(x[6], x[7])}; return *reinterpret_cast<bf16x8*>(&w); } };

__device__ __forceinline__ void partialSM(f32x16& p0, f32x16& p1, float& m_reg, float& mn, float& alpha) {
  constexpr float C = SCALE * 1.4426950408889634f;
  float pmax = p0[0]; for (int r = 1; r < 16; ++r) pmax = fmaxf(pmax, p0[r]); for (int r = 0; r < 16; ++r) pmax = fmaxf(pmax, p1[r]);
  { auto rr = __builtin_amdgcn_permlane32_swap(__float_as_uint(pmax), __float_as_uint(pmax), false, false);
    pmax = fmaxf(__uint_as_float(rr[0]), __uint_as_float(rr[1])); }
  if (__builtin_expect(__all(pmax - m_reg <= THR / SCALE), 1)) { mn = m_reg; alpha = 1.f; }
  else { mn = fmaxf(m_reg, pmax); alpha = __builtin_amdgcn_exp2f((m_reg - mn) * C); m_reg = mn; }
  float mnC = -mn * C;
  for (int r = 0; r < 16; ++r) p0[r] = fmaf(p0[r], C, mnC); for (int r = 0; r < 16; ++r) p1[r] = fmaf(p1[r], C, mnC);
  for (int r = 0; r < 16; ++r) p0[r] = __builtin_amdgcn_exp2f(p0[r]);
}
__device__ __forceinline__ void finishSM(f32x16& p0, f32x16& p1, float alpha, float& l_reg, bf16x8& pa0, bf16x8& pa1, bf16x8& pa2, bf16x8& pa3) {
  for (int r = 0; r < 16; ++r) p1[r] = __builtin_amdgcn_exp2f(p1[r]);
  float ps = 0; for (int r = 0; r < 16; ++r) ps += p0[r]; for (int r = 0; r < 16; ++r) ps += p1[r];
  { auto rr = __builtin_amdgcn_permlane32_swap(__float_as_uint(ps), __float_as_uint(ps), false, false);
    ps = __uint_as_float(rr[0]) + __uint_as_float(rr[1]); }
  l_reg = l_reg * alpha + ps;
#define PK4(P, BASE, OUT) do { unsigned a0 = cvtpk(P[BASE + 0], P[BASE + 1]), a1 = cvtpk(P[BASE + 2], P[BASE + 3]);   \
    unsigned b0 = cvtpk(P[BASE + 4], P[BASE + 5]), b1 = cvtpk(P[BASE + 6], P[BASE + 7]);                              \
    auto r0 = __builtin_amdgcn_permlane32_swap(a0, b0, false, false); auto r1 = __builtin_amdgcn_permlane32_swap(a1, b1, false, false); \
    u32x4 w = {r0[0], r1[0], r0[1], r1[1]}; OUT = *reinterpret_cast<bf16x8*>(&w); } while (0)
  PK4(p0, 0, pa0); PK4(p0, 8, pa1); PK4(p1, 0, pa2); PK4(p1, 8, pa3);
#undef PK4
}
__device__ __forceinline__ void qkt(f32x16& p0, f32x16& p1, const bf16* Ks, const bf16x8* qr, int r32, int hi) {
  p0 = f32x16{}; p1 = f32x16{};
  for (int d0 = 0; d0 < 8; ++d0) { int cb = (d0 * 16 + hi * 8) * 2;
    bf16x8 b0 = *reinterpret_cast<const bf16x8*>((const char*)Ks + KSWZ(r32, cb));
    bf16x8 b1 = *reinterpret_cast<const bf16x8*>((const char*)Ks + KSWZ(32 + r32, cb));
    p0 = __builtin_amdgcn_mfma_f32_32x32x16_bf16(b0, qr[d0], p0, 0, 0, 0);
    p1 = __builtin_amdgcn_mfma_f32_32x32x16_bf16(b1, qr[d0], p1, 0, 0, 0); }
}
__device__ __forceinline__ int v_st(int k, int c) { const int kk = (k & ~0xC) | ((k & 4) << 1) | ((k & 8) >> 1); return ((kk >> 3) * 4 + (c >> 5)) * 512 + ((kk & 7) * 32 + (c & 31)) * 2; }
__device__ __forceinline__ int v_rd_base(int lane) { return ((lane & 3) << 3) | (((lane >> 2) & 3) << 6) | (((lane >> 4) & 1) << 5) | (((lane >> 5) & 1) << 8); }
constexpr int v_rd_off(int d0, int ks, int half) { return d0 * 512 + ks * 4096 + half * 2048; }
template <int OFF> __device__ __forceinline__ s16x4 tr_read(int vb) {
  s16x4 r; asm volatile("ds_read_b64_tr_b16 %0, %1 offset:%2" : "=&v"(r) : "v"(vb), "i"(OFF) : "memory"); return r;
}
template <int D0> __device__ __forceinline__ void pv_one(f32x16& od, int vb, bf16x8 pa0, bf16x8 pa1, bf16x8 pa2, bf16x8 pa3) {
  const s16x4 l0 = tr_read<v_rd_off(D0, 0, 0)>(vb), h0 = tr_read<v_rd_off(D0, 0, 1)>(vb), l1 = tr_read<v_rd_off(D0, 1, 0)>(vb), h1 = tr_read<v_rd_off(D0, 1, 1)>(vb);
  const s16x4 l2 = tr_read<v_rd_off(D0, 2, 0)>(vb), h2 = tr_read<v_rd_off(D0, 2, 1)>(vb), l3 = tr_read<v_rd_off(D0, 3, 0)>(vb), h3 = tr_read<v_rd_off(D0, 3, 1)>(vb);
  asm volatile("s_waitcnt lgkmcnt(0)" ::: "memory"); SBAR();
#define PK(L, H) (bf16x8){L[0], L[1], L[2], L[3], H[0], H[1], H[2], H[3]}
  od = __builtin_amdgcn_mfma_f32_32x32x16_bf16(pa0, PK(l0, h0), od, 0, 0, 0);
  od = __builtin_amdgcn_mfma_f32_32x32x16_bf16(pa1, PK(l1, h1), od, 0, 0, 0);
  od = __builtin_amdgcn_mfma_f32_32x32x16_bf16(pa2, PK(l2, h2), od, 0, 0, 0);
  od = __builtin_amdgcn_mfma_f32_32x32x16_bf16(pa3, PK(l3, h3), od, 0, 0, 0);
#undef PK
}
__device__ __forceinline__ void pv_d0(f32x16* o, int vb, bf16x8 pa0, bf16x8 pa1, bf16x8 pa2, bf16x8 pa3) {
  pv_one<0>(o[0], vb, pa0, pa1, pa2, pa3); pv_one<1>(o[1], vb, pa0, pa1, pa2, pa3); pv_one<2>(o[2], vb, pa0, pa1, pa2, pa3); pv_one<3>(o[3], vb, pa0, pa1, pa2, pa3);
}

template <typename TQ>
__device__ __forceinline__ void attn_dense_body(const TQ* __restrict__ Qb, const bf16* __restrict__ Kh, const bf16* __restrict__ Vh,
                                                unsigned char* __restrict__ Ob, int seq, char* lds) {
  using St = Stage<bf16>; using SQ = Stage<TQ>;
  int tid_o = threadIdx.x; asm volatile("" : "+v"(tid_o)); const int tid = tid_o, wid = tid >> 6, lane = tid & 63, r32 = lane & 31, hi = lane >> 5;
  bf16* V_lds = (bf16*)lds; bf16* K_lds = (bf16*)(lds + 2 * SHM_V);
  float* ws = (float*)(lds + 2 * SHM_V + 2 * SHM_K) + wid * 64; float* li_l = ws; float* al_l = ws + 32;
  float m_reg = -1e30f, l_reg = 0; f32x16 o[4] = {}; bf16x8 qr[8];
  const TQ* Qw = Qb + (long)(wid * QBLK + r32) * LDQ + hi * 8;
#pragma unroll
  for (int d0 = 0; d0 < 8; ++d0) qr[d0] = SQ::tobf(SQ::ld8(Qw + d0 * 16));
  const int sr = tid >> 4, sc = (tid & 15) * 8, vst0 = v_st(sr, sc), vst1 = v_st(32 + sr, sc);
  const int vb0 = (int)(uintptr_t)V_lds + v_rd_base(lane);
  struct { typename St::T vs0, vs1, ks0, ks1; } sr_[SDEPTH];
#define SLOAD(i, k0) do { sr_[i].vs0 = St::ld8(&Vh[(long)((k0) + sr) * LDK + sc]); sr_[i].vs1 = St::ld8(&Vh[(long)((k0) + 32 + sr) * LDK + sc]); \
    sr_[i].ks0 = St::ld8(&Kh[(long)((k0) + sr) * LDK + sc]); sr_[i].ks1 = St::ld8(&Kh[(long)((k0) + 32 + sr) * LDK + sc]); } while (0)
#define SWRITE(b, i) do { *(bf16x8*)((char*)V_lds + (b) * SHM_V + vst0) = St::tobf(sr_[i].vs0);          \
    *(bf16x8*)((char*)V_lds + (b) * SHM_V + vst1) = St::tobf(sr_[i].vs1); int kc = sc * 2;               \
    *(bf16x8*)((char*)K_lds + (b) * SHM_K + KSWZ(sr, kc)) = St::tobf(sr_[i].ks0);                       \
    *(bf16x8*)((char*)K_lds + (b) * SHM_K + KSWZ(32 + sr, kc)) = St::tobf(sr_[i].ks1); } while (0)
#define SWAIT() do { if constexpr (SDEPTH == 2) asm volatile("s_waitcnt vmcnt(4)" ::: "memory"); else asm volatile("s_waitcnt vmcnt(0)" ::: "memory"); } while (0)
#define RESC(a) do { if (__any((a) < 1.f)) { if (hi == 0) al_l[r32] = (a); asm volatile("s_waitcnt lgkmcnt(0)" ::: "memory"); \
    for (int d = 0; d < 4; ++d) for (int r = 0; r < 16; ++r) o[d][r] *= al_l[crow(r, hi)]; } } while (0)
  f32x16 pA0, pA1, pB0, pB1; float mnA, mnB, alA, alB; bf16x8 pa0, pa1, pa2, pa3; const int NT = seq / KVBLK;
  constexpr int SE = 0, SO = SDEPTH - 1;
  SLOAD(SE, 0); asm volatile("s_waitcnt vmcnt(0)" ::: "memory"); SWRITE(0, SE); __syncthreads();
  qkt(pA0, pA1, K_lds, qr, r32, hi); partialSM(pA0, pA1, m_reg, mnA, alA);
  SLOAD(SO, KVBLK); if constexpr (SDEPTH == 2) { if (2 < NT) SLOAD(SE, 2 * KVBLK); }
  SWAIT(); SWRITE(1, SO); __syncthreads();
  for (int j = 1; j + 1 < NT; j += 2) {
    SBAR(); qkt(pB0, pB1, (bf16*)((char*)K_lds + SHM_K), qr, r32, hi);
    finishSM(pA0, pA1, alA, l_reg, pa0, pa1, pa2, pa3); SBAR();
    SLOAD(SO, (j + SDEPTH) * KVBLK); SBAR();
    pv_d0(o, vb0, pa0, pa1, pa2, pa3); partialSM(pB0, pB1, m_reg, mnB, alB);
    __syncthreads(); SWAIT(); SWRITE(0, SE);
    RESC(alB); __syncthreads();
    SBAR(); qkt(pA0, pA1, K_lds, qr, r32, hi);
    finishSM(pB0, pB1, alB, l_reg, pa0, pa1, pa2, pa3); SBAR();
    if (SDEPTH == 1 || j + 3 < NT) SLOAD(SE, (j + 1 + SDEPTH) * KVBLK); SBAR();
    pv_d0(o, vb0 + (int)SHM_V, pa0, pa1, pa2, pa3); partialSM(pA0, pA1, m_reg, mnA, alA);
    __syncthreads(); SWAIT(); SWRITE(1, SO);
    RESC(alA); __syncthreads();
  }
  SBAR(); qkt(pB0, pB1, (bf16*)((char*)K_lds + SHM_K), qr, r32, hi);
  finishSM(pA0, pA1, alA, l_reg, pa0, pa1, pa2, pa3); SBAR();
  pv_d0(o, vb0, pa0, pa1, pa2, pa3); partialSM(pB0, pB1, m_reg, mnB, alB);
  __syncthreads(); RESC(alB);
  finishSM(pB0, pB1, alB, l_reg, pa0, pa1, pa2, pa3); SBAR();
  pv_d0(o, vb0 + (int)SHM_V, pa0, pa1, pa2, pa3);
  if (hi == 0) li_l[r32] = l_reg; asm volatile("s_waitcnt lgkmcnt(0)" ::: "memory");
  float rli[16];
#pragma unroll
  for (int r = 0; r < 16; ++r) rli[r] = __builtin_amdgcn_rcpf(li_l[crow(r, hi)]);
  unsigned char* Ow = Ob + (long)(wid * QBLK) * LDO;
#pragma unroll
  for (int r = 0; r < 16; ++r) { int orow = crow(r, hi);
    for (int d0 = 0; d0 < 4; ++d0) Ow[(long)orow * LDO + d0 * 32 + r32] = (unsigned char)(__builtin_amdgcn_cvt_pk_fp8_f32(__builtin_amdgcn_fmed3f(o[d0][r] * rli[r] * 16.0f, -440.f, 440.f), 0.f, 0, false) & 0xff); }
#undef SLOAD
#undef SWRITE
#undef SWAIT
#undef RESC
}
#undef KSWZ
#undef SBAR
}

#define LAS __attribute__((address_space(3)))
typedef unsigned short bf16_t;
typedef short bf16x8 __attribute__((ext_vector_type(8)));
typedef float f32x4 __attribute__((ext_vector_type(4)));
typedef float f32x2 __attribute__((ext_vector_type(2)));
typedef float f32x16 __attribute__((ext_vector_type(16)));
typedef unsigned u32x4 __attribute__((ext_vector_type(4)));
typedef unsigned u32x2 __attribute__((ext_vector_type(2)));

constexpr int NTOK = 16384, DMODEL = 2048, SEQL = 8192;
constexpr size_t MiB = 1u << 20;
constexpr size_t WS_MOD = 0;
constexpr size_t WS_BAR = 512 * 1024;
constexpr size_t WS_S5A = 1 * MiB;
constexpr size_t WS_LNST = 296 * MiB;
constexpr size_t WS_ABT = 2 * MiB;
constexpr size_t WS_BIASQ = 2 * MiB + 64 * 1024;
constexpr size_t WS_ROWSQ = 336 * MiB;
constexpr size_t WS_BIASP = 340 * MiB;
constexpr size_t WS_WQF = 304 * MiB;
constexpr size_t WS_KEYS = 4 * MiB;
constexpr size_t WS_WSB = 5 * MiB;
constexpr size_t WS_WINE = 6 * MiB;
constexpr size_t WS_WOUTE = 16 * MiB;
constexpr size_t WS_WINO = 24 * MiB;
constexpr size_t WS_WOUTO = 56 * MiB;
constexpr size_t WS_WQ = 72 * MiB;
constexpr size_t WS_PU = 88 * MiB;
constexpr size_t WS_PV = 152 * MiB;
constexpr size_t WS_PSC = 5 * MiB + 512 * 1024;
constexpr int PEER_ROWB = 1536;
constexpr bool PEER_SLICE_U = true, PEER_SLICE_V = true;
typedef unsigned u32x6 __attribute__((ext_vector_type(6)));
typedef float f32x16 __attribute__((ext_vector_type(16)));
typedef float f32x32 __attribute__((ext_vector_type(32)));
typedef _Float16 h16x2 __attribute__((ext_vector_type(2)));
typedef _Float16 h16x32 __attribute__((ext_vector_type(32)));
constexpr size_t WS_WY = 216 * MiB;
constexpr size_t WS_WSUM = 232 * MiB;
constexpr size_t WS_H8 = 256 * MiB;
constexpr size_t WS_H = 344 * MiB;
constexpr size_t WS_XB = WS_H;
constexpr size_t WS_TMP = 408 * MiB;
constexpr size_t WS_AB = WS_TMP  , WS_Q = WS_TMP + 64 * MiB, WS_K = WS_TMP + 96 * MiB, WS_V = WS_TMP + 104 * MiB,
                 WS_SS = WS_TMP + 112 * MiB  , WS_CAT = WS_TMP + 176 * MiB;
constexpr size_t WS_Z = WS_TMP, WS_SG = WS_TMP + 256 * MiB;
constexpr size_t WS_QP = WS_TMP;
constexpr size_t WS_X8 = WS_TMP + 64 * MiB;
constexpr size_t WS_RSTD = WS_TMP + 64 * MiB;
constexpr size_t WS_EID = WS_TMP + 128 * MiB;
constexpr size_t WS_GATE = WS_TMP + 136 * MiB;
constexpr size_t WS_PW = WS_TMP + 144 * MiB;
constexpr size_t WS_PO = WS_TMP + 152 * MiB;
constexpr size_t WS_PACT = WS_TMP + 216 * MiB;
typedef unsigned u32x16 __attribute__((ext_vector_type(16)));
typedef __bf16 bf16x2v __attribute__((ext_vector_type(2)));
constexpr size_t WS_END = WS_TMP + 384 * MiB;
constexpr int LDS_BYTES = 147456;

struct P {
    const float *x, *c, *ada_w, *ada_b, *norm_g, *even_w_in, *even_w_out, *lam_re, *lam_im, *log_dt, *b_re, *b_im, *c_re, *c_im, *s5_d, *glu_w, *glu_b,
        *q_g, *k_g, *odd_w_in, *odd_w_out, *sgu_ln_g, *sgu_w, *sgu_b, *peer_wq, *peer_k1, *peer_k2, *peer_u, *peer_v, *final_g;
    float* out; unsigned char* ws;
};

__device__ __forceinline__ unsigned cvtpk(float lo, float hi) { unsigned r; asm("v_cvt_pk_bf16_f32 %0, %1, %2" : "=v"(r) : "v"(lo), "v"(hi)); return r; }
__device__ __forceinline__ unsigned pk_fp8x4(float a, float b, float c, float d) {
    a = __builtin_amdgcn_fmed3f(a, -440.f, 440.f); b = __builtin_amdgcn_fmed3f(b, -440.f, 440.f); c = __builtin_amdgcn_fmed3f(c, -440.f, 440.f); d = __builtin_amdgcn_fmed3f(d, -440.f, 440.f);
    int w = 0; w = __builtin_amdgcn_cvt_pk_fp8_f32(a, b, w, false); w = __builtin_amdgcn_cvt_pk_fp8_f32(c, d, w, true); return (unsigned)w; }
constexpr float F8_WS = 64.0f, F8_HS = 8.0f, F8_SGS = 8.0f, F8_CS = 16.0f, F8_XS = 8.0f;
__device__ __forceinline__ float bflo(unsigned w) { return __uint_as_float(w << 16); }
__device__ __forceinline__ float bfhi(unsigned w) { return __uint_as_float(w & 0xffff0000u); }
__device__ __forceinline__ float wave_sum(float v) {
    v += __uint_as_float(__builtin_amdgcn_update_dpp(0u, __float_as_uint(v), 0xB1, 0xF, 0xF, true));
    v += __uint_as_float(__builtin_amdgcn_update_dpp(0u, __float_as_uint(v), 0x4E, 0xF, 0xF, true));
    v += __uint_as_float(__builtin_amdgcn_update_dpp(0u, __float_as_uint(v), 0x141, 0xF, 0xF, true));
    v += __uint_as_float(__builtin_amdgcn_update_dpp(0u, __float_as_uint(v), 0x140, 0xF, 0xF, true));
    { const auto r = __builtin_amdgcn_permlane16_swap(__float_as_uint(v), __float_as_uint(v), false, false); v = __uint_as_float(r[0]) + __uint_as_float(r[1]); }
    { const auto r = __builtin_amdgcn_permlane32_swap(__float_as_uint(v), __float_as_uint(v), false, false); v = __uint_as_float(r[0]) + __uint_as_float(r[1]); }
    return v;
}
__device__ __forceinline__ float row16_sum(float v) {
    v += __uint_as_float(__builtin_amdgcn_update_dpp(0u, __float_as_uint(v), 0xB1, 0xF, 0xF, true));
    v += __uint_as_float(__builtin_amdgcn_update_dpp(0u, __float_as_uint(v), 0x4E, 0xF, 0xF, true));
    v += __uint_as_float(__builtin_amdgcn_update_dpp(0u, __float_as_uint(v), 0x141, 0xF, 0xF, true));
    v += __uint_as_float(__builtin_amdgcn_update_dpp(0u, __float_as_uint(v), 0x140, 0xF, 0xF, true));
    return v;
}
__device__ __forceinline__ float xrow_sum(float v) {
    { const auto r = __builtin_amdgcn_permlane16_swap(__float_as_uint(v), __float_as_uint(v), false, false); v = __uint_as_float(r[0]) + __uint_as_float(r[1]); }
    { const auto r = __builtin_amdgcn_permlane32_swap(__float_as_uint(v), __float_as_uint(v), false, false); v = __uint_as_float(r[0]) + __uint_as_float(r[1]); }
    return v;
}
__device__ __forceinline__ float sigmoid_f(float x) { return __builtin_amdgcn_rcpf(1.f + __expf(-x)); }
__device__ __forceinline__ float gelu_t(float x) { const float u = 0.7978845608028654f * (x + 0.044715f * x * x * x); return x * __builtin_amdgcn_rcpf(1.f + __expf(-2.f * u)); }
__device__ __forceinline__ void sincos_rad(float ang, float& sn, float& cs) {
    float rev = ang * 0.15915494309189535f; rev = rev - floorf(rev);
    sn = __builtin_amdgcn_sinf(rev); cs = __builtin_amdgcn_cosf(rev);
}
__device__ __forceinline__ float dot4(f32x4 a, f32x4 b) { return (a.x * b.x + a.y * b.y) + (a.z * b.z + a.w * b.w); }
#define LDS_WAIT() asm volatile("s_waitcnt lgkmcnt(0)" ::: "memory")

namespace pg8 {
constexpr int NTOK_ = 16384;
struct EpiEvenSplit {
    static constexpr bool PERM = true, AFTER_DRAIN = false;
    float ds; unsigned char* wsb;
    __device__ __forceinline__ void operator()(const f32x4 (&acc)[2][2][4][2], const Unit& u, int wr, int wc, int fr, int fq) const {
        { const int l_ = lane_id_v(); fr = l_ & 15; fq = l_ >> 4; }
        const int row0 = u.pm * BM + wr * 64 + fr; const int pn = u.pn;
        bf16_t* const UA = (bf16_t*)(wsb + WS_AB);
        if (pn < 4) {
#pragma unroll
            for (int ai = 0; ai < 2; ++ai)
#pragma unroll
                for (int m = 0; m < 4; ++m) { const int t = row0 + ai * HALF + m * 16;
#pragma unroll
                    for (int bj = 0; bj < 2; ++bj) { const int c = pn * 256 + bj * HALF + wc * 32 + 8 * fq; const f32x4 v0 = acc[ai][bj][m][0] * ds, v1 = acc[ai][bj][m][1] * ds;
                        u32x4 w; w.x = cvt_pk_bf16(v0[0], v0[1]); w.y = cvt_pk_bf16(v0[2], v0[3]); w.z = cvt_pk_bf16(v1[0], v1[1]); w.w = cvt_pk_bf16(v1[2], v1[3]);
                        *(u32x4*)(UA + ((size_t)(c >> 4) * 1024 + (t >> 4)) * 512 + (t & 15) * 16 + (c & 15)) = w; } }
            return;
        }
        bf16_t* base; int ldc, colt;
        if (pn < 8) { base = (bf16_t*)(wsb + WS_Q); ldc = 1024; colt = (pn - 4) * 256; } else { base = (bf16_t*)(wsb + (pn == 8 ? WS_K : WS_V)); ldc = 256; colt = 0; }
        const int col0 = colt + wc * 32 + 8 * fq;
#pragma unroll
        for (int ai = 0; ai < 2; ++ai)
#pragma unroll
            for (int m = 0; m < 4; ++m) { bf16_t* rowp = base + (size_t)(row0 + ai * HALF + m * 16) * ldc + col0;
#pragma unroll
                for (int bj = 0; bj < 2; ++bj) { const f32x4 v0 = acc[ai][bj][m][0] * ds, v1 = acc[ai][bj][m][1] * ds;
                    u32x4 w; w.x = cvt_pk_bf16(v0[0], v0[1]); w.y = cvt_pk_bf16(v0[2], v0[3]); w.z = cvt_pk_bf16(v1[0], v1[1]); w.w = cvt_pk_bf16(v1[2], v1[3]);
                    *(u32x4*)(rowp + bj * HALF) = w; } }
    }
};
template <int ACT> struct EpiBf16T {
    static constexpr bool PERM = true, AFTER_DRAIN = false;
    bf16_t* O; int ldc; float ds; float* lnst;
    __device__ __forceinline__ void operator()(const f32x4 (&acc)[2][2][4][2], const Unit& u, int wr, int wc, int fr, int fq) const {
        { const int l_ = lane_id_v(); fr = l_ & 15; fq = l_ >> 4; }
        const int row0 = u.pm * BM + wr * 64 + fr, col0 = u.pn * BM + wc * 32 + 8 * fq;
        const bool do_st = (ACT == 1) && lnst != nullptr && u.pn >= 16;
#pragma unroll
        for (int ai = 0; ai < 2; ++ai)
#pragma unroll
            for (int m = 0; m < 4; ++m) { const int trow = row0 + ai * HALF + m * 16;
                bf16_t* rowp = (ACT == 1) ? O + ((size_t)((trow >> 7) * 16 + (col0 >> 9)) * 128 + (trow & 127)) * 512 + (col0 & 511) : O + (size_t)trow * ldc + col0; float s1 = 0.f, s2 = 0.f;
#pragma unroll
                for (int bj = 0; bj < 2; ++bj) { f32x4 v0 = acc[ai][bj][m][0] * ds, v1 = acc[ai][bj][m][1] * ds;
                    if (ACT == 1) {
#pragma unroll
                        for (int e = 0; e < 4; ++e) { v0[e] = gelu_t(v0[e]); v1[e] = gelu_t(v1[e]); s1 += v0[e] + v1[e]; s2 += v0[e] * v0[e] + v1[e] * v1[e]; } }
                    u32x4 w; w.x = cvt_pk_bf16(v0[0], v0[1]); w.y = cvt_pk_bf16(v0[2], v0[3]); w.z = cvt_pk_bf16(v1[0], v1[1]); w.w = cvt_pk_bf16(v1[2], v1[3]);
                    *(u32x4*)(rowp + bj * HALF) = w; }
                if (ACT == 1) { if (do_st) {
                    s1 = xrow_sum(s1); s2 = xrow_sum(s2);
                    if (fq == 0) *(f32x2*)(lnst + ((size_t)((u.pn - 16) * 4 + wc) * NTOK_ + (row0 + ai * HALF + m * 16)) * 2) = (f32x2){s1, s2}; } }
            }
    }
};
struct EpiResid {
    static constexpr bool PERM = false, AFTER_DRAIN = false;
    const float* xin; float* xout; const float* gate; float ds;
    __device__ __forceinline__ void operator()(const f32x4 (&acc)[2][2][4][2], const Unit& u, int wr, int wc, int fr, int fq) const {
        { const int l_ = lane_id_v(); fr = l_ & 15; fq = l_ >> 4; }
        const int row0 = u.pm * BM + wr * 64 + fr, col0 = u.pn * BM + wc * 32 + 4 * fq;
        const float* gp = gate + (size_t)((u.pm * BM) >> 13) * 12288 + col0;
        f32x4 gv[2][2];
#pragma unroll
        for (int bj = 0; bj < 2; ++bj)
#pragma unroll
            for (int n = 0; n < 2; ++n) gv[bj][n] = *(const f32x4*)(gp + bj * HALF + n * 16) * ds;
#pragma unroll
        for (int ai = 0; ai < 2; ++ai)
#pragma unroll
            for (int m = 0; m < 4; ++m) { const size_t off = (size_t)(row0 + ai * HALF + m * 16) * 2048 + col0;
#pragma unroll
                for (int bj = 0; bj < 2; ++bj)
#pragma unroll
                    for (int n = 0; n < 2; ++n) { const f32x4 xi = *(const f32x4*)(xin + off + bj * HALF + n * 16);
                        *(f32x4*)(xout + off + bj * HALF + n * 16) = xi + gv[bj][n] * acc[ai][bj][m][n]; } }
    }
};
struct EpiF32B {
    static constexpr bool PERM = false, AFTER_DRAIN = false;
    float* C; int ldc; size_t bs;
    __device__ __forceinline__ void operator()(const f32x4 (&acc)[2][2][4][2], const Unit& u, int wr, int wc, int fr, int fq) const {
        { const int l_ = lane_id_v(); fr = l_ & 15; fq = l_ >> 4; }
        char* base = (char*)(C + (size_t)u.pb * bs + (size_t)(u.pm * BM) * ldc);
        const unsigned off0 = (unsigned)((wr * 64 + fr) * ldc + u.pn * BM + wc * 32 + 4 * fq) * 4u;
#pragma unroll
        for (int ai = 0; ai < 2; ++ai)
#pragma unroll
            for (int m = 0; m < 4; ++m) { const unsigned off = off0 + (unsigned)((ai * HALF + m * 16) * ldc) * 4u;
#pragma unroll
                for (int bj = 0; bj < 2; ++bj)
#pragma unroll
                    for (int n = 0; n < 2; ++n) *(f32x4*)(base + off + (bj * HALF + n * 16) * 4) = acc[ai][bj][m][n]; }
    }
};
struct EpiS5Glu {
    static constexpr bool PERM = false, AFTER_DRAIN = false;
    unsigned char* CAT; const PG8_LAS float* wl;
    __device__ __forceinline__ void operator()(const f32x4 (&acc)[2][2][4][2], const Unit& u, int wr, int wc, int fr, int fq) const {
        { const int l_ = lane_id_v(); fr = l_ & 15; fq = l_ >> 4; }
        const int g = u.pb;
#pragma unroll
        for (int ai = 0; ai < 2; ++ai)
#pragma unroll
            for (int m = 0; m < 4; ++m) {
                const int chunk = u.pm * BM + ai * HALF + wr * 64 + m * 16 + fr, token = chunk * 16 + wc * 4 + fq;
                float y[16];
#pragma unroll
                for (int bj = 0; bj < 2; ++bj)
#pragma unroll
                    for (int n = 0; n < 2; ++n)
#pragma unroll
                        for (int j = 0; j < 4; ++j) y[8 * bj + 4 * n + j] = gelu_t(acc[ai][bj][m][n][j]);
                f32x4 z[4];
#pragma unroll
                for (int kq = 0; kq < 4; ++kq) z[kq] = *(const PG8_LAS f32x4*)(wl + 256 + 4 * kq);
#pragma unroll
                for (int h = 0; h < 16; ++h)
#pragma unroll
                    for (int kq = 0; kq < 4; ++kq) z[kq] += *(const PG8_LAS f32x4*)(wl + h * 16 + 4 * kq) * y[h];
                float o[16];
#pragma unroll
                for (int k = 0; k < 16; ++k) o[k] = y[k] * sigmoid_f(z[k >> 2][k & 3]);
                u32x4 w; w.x = pk_fp8x4(o[0] * F8_CS, o[1] * F8_CS, o[2] * F8_CS, o[3] * F8_CS); w.y = pk_fp8x4(o[4] * F8_CS, o[5] * F8_CS, o[6] * F8_CS, o[7] * F8_CS);
                w.z = pk_fp8x4(o[8] * F8_CS, o[9] * F8_CS, o[10] * F8_CS, o[11] * F8_CS); w.w = pk_fp8x4(o[12] * F8_CS, o[13] * F8_CS, o[14] * F8_CS, o[15] * F8_CS);
                *(u32x4*)(CAT + (size_t)token * 2048 + g * 16) = w;
                asm volatile("" ::: "memory");
            }
    }
};
template <bool FIRST> struct EpiResidB {
    static constexpr bool PERM = false, AFTER_DRAIN = false;
    const float* xin; bf16_t* xb; const float* gate; float* rowsq; unsigned char* x8; float ds;
    __device__ __forceinline__ void operator()(const f32x4 (&acc)[2][2][4][2], const Unit& u, int wr, int wc, int fr, int fq) const {
        { const int l_ = lane_id_v(); fr = l_ & 15; fq = l_ >> 4; }
        const int row0 = u.pm * BM + wr * 64 + fr, col0 = u.pn * BM + wc * 32 + 4 * fq;
        const float* gp = gate + (size_t)((u.pm * BM) >> 13) * 12288 + col0; float* const rq = rowsq;
        f32x4 gv[2][2];
#pragma unroll
        for (int bj = 0; bj < 2; ++bj)
#pragma unroll
            for (int n = 0; n < 2; ++n) gv[bj][n] = *(const f32x4*)(gp + bj * HALF + n * 16) * ds;
#pragma unroll
        for (int ai = 0; ai < 2; ++ai) {
            f32x4 xi[4][2][2];
#pragma unroll
            for (int m = 0; m < 4; ++m) { const size_t off = (size_t)(row0 + ai * HALF + m * 16) * 2048 + col0;
#pragma unroll
                for (int bj = 0; bj < 2; ++bj)
#pragma unroll
                    for (int n = 0; n < 2; ++n) {
                        if (FIRST) xi[m][bj][n] = *(const f32x4*)(xin + off + bj * HALF + n * 16);
                        else { const u32x2 w = *(const u32x2*)(xb + off + bj * HALF + n * 16); xi[m][bj][n] = (f32x4){__uint_as_float(w.x << 16), __uint_as_float(w.x & 0xffff0000u), __uint_as_float(w.y << 16), __uint_as_float(w.y & 0xffff0000u)}; } } }
            asm volatile("" ::: "memory");
#pragma unroll
            for (int m = 0; m < 4; ++m) { const int row = row0 + ai * HALF + m * 16; const size_t off = (size_t)row * 2048 + col0; float ss = 0.f;
#pragma unroll
                for (int bj = 0; bj < 2; ++bj)
#pragma unroll
                    for (int n = 0; n < 2; ++n) { const f32x4 xo = xi[m][bj][n] + gv[bj][n] * acc[ai][bj][m][n]; ss += (xo[0] * xo[0] + xo[1] * xo[1]) + (xo[2] * xo[2] + xo[3] * xo[3]);
                        u32x2 o; o.x = cvt_pk_bf16(xo[0], xo[1]); o.y = cvt_pk_bf16(xo[2], xo[3]); *(u32x2*)(xb + off + bj * HALF + n * 16) = o;
                        *(unsigned*)(x8 + off + bj * HALF + n * 16) = pk_fp8x4(xo[0] * F8_XS, xo[1] * F8_XS, xo[2] * F8_XS, xo[3] * F8_XS); }
                ss = xrow_sum(ss);
                if (fq == 0) rq[(size_t)(u.pn * 4 + wc) * NTOK_ + row] = ss; }
        }
    }
};
struct EpiQ {
    static constexpr bool PERM = true, AFTER_DRAIN = false;
    bf16_t* O; const float* rowsq; const float* bias; float ds;
    __device__ __forceinline__ void operator()(const f32x4 (&acc)[2][2][4][2], const Unit& u, int wr, int wc, int fr, int fq) const {
        { const int l_ = lane_id_v(); fr = l_ & 15; fq = l_ >> 4; }
        const int row0 = u.pm * BM + wr * 64 + fr, col0 = u.pn * BM + wc * 32 + 8 * fq;
        const float* bp = bias + (size_t)((u.pm * BM) >> 13) * 2048 + col0;
        f32x4 bv[2][2];
#pragma unroll
        for (int bj = 0; bj < 2; ++bj)
#pragma unroll
            for (int n = 0; n < 2; ++n) bv[bj][n] = *(const f32x4*)(bp + bj * HALF + 4 * n);
        float rstd[2][4];
#pragma unroll
        for (int ai = 0; ai < 2; ++ai)
#pragma unroll
            for (int m = 0; m < 4; ++m) { const int row = row0 + ai * HALF + m * 16; float sq = 0.f;
#pragma unroll
                for (int t = 0; t < 8; ++t) sq += rowsq[(size_t)(fq * 8 + t) * NTOK_ + row];
                rstd[ai][m] = rsqrtf(xrow_sum(sq) * (1.0f / 2048.0f) + 1e-6f) * ds; }
#pragma unroll
        for (int ai = 0; ai < 2; ++ai)
#pragma unroll
            for (int m = 0; m < 4; ++m) { const int row = row0 + ai * HALF + m * 16; bf16_t* rowp = O + (size_t)row * 2048 + col0;
#pragma unroll
                for (int bj = 0; bj < 2; ++bj) { const f32x4 v0 = acc[ai][bj][m][0] * rstd[ai][m] + bv[bj][0], v1 = acc[ai][bj][m][1] * rstd[ai][m] + bv[bj][1];
                    u32x4 w; w.x = cvt_pk_bf16(v0[0], v0[1]); w.y = cvt_pk_bf16(v0[2], v0[3]); w.z = cvt_pk_bf16(v1[0], v1[1]); w.w = cvt_pk_bf16(v1[2], v1[3]);
                    *(u32x4*)(rowp + bj * HALF) = w; } }
    }
};
struct BatchOrder {
    int nM, nU, G, c;
    __device__ __forceinline__ bool next(int i, Unit& u) const { const int L = i * G + c; if (L >= nU) return false; u.pb = L / nM; u.pm = L % nM; u.pn = 0; return true; }
    __device__ __forceinline__ void a_ready(const Unit&) const {}
    __device__ __forceinline__ void done(const Unit&) const {}
};
}

__device__ __forceinline__ unsigned f2bf_rne(float f) { unsigned u = __builtin_bit_cast(unsigned, f); return (u + 0x7fffu + ((u >> 16) & 1u)) >> 16; }
__device__ __forceinline__ unsigned pk2(float lo, float hi) { return f2bf_rne(lo) | (f2bf_rne(hi) << 16); }
__device__ __forceinline__ void p0_transpose_item(const float* W, int K, int N, bf16_t* WT, LAS float* scr, int item, int lane) {
    const int nblk = N / 32, kb = item / nblk, nb = item % nblk, k0 = 64 * kb, n0 = 32 * nb;
#pragma unroll 8
    for (int i = 0; i < 32; ++i) { const int kk = 2 * i + (lane >> 5); scr[kk * 33 + (lane & 31)] = W[(size_t)(k0 + kk) * N + n0 + (lane & 31)]; }
    LDS_WAIT(); asm volatile("" ::: "memory");
    const int c = lane & 7;
#pragma unroll
    for (int j = 0; j < 4; ++j) { const int n = (lane >> 3) + 8 * j; const LAS float* s = scr + (8 * c) * 33 + n;
        u32x4 o; o.x = pk2(s[0 * 33], s[1 * 33]); o.y = pk2(s[2 * 33], s[3 * 33]); o.z = pk2(s[4 * 33], s[5 * 33]); o.w = pk2(s[6 * 33], s[7 * 33]);
        *(u32x4*)(WT + (size_t)(n0 + n) * K + k0 + 8 * c) = o; }
    LDS_WAIT(); asm volatile("" ::: "memory");
}

__device__ __forceinline__ void p0_transpose_item_f8(const float* W, int K, int N, unsigned char* WT, LAS float* scr, int item, int lane, float sc) {
    const int nblk = N / 32, kb = item / nblk, nb = item % nblk, k0 = 64 * kb, n0 = 32 * nb;
#pragma unroll 8
    for (int i = 0; i < 32; ++i) { const int kk = 2 * i + (lane >> 5); scr[kk * 33 + (lane & 31)] = W[(size_t)(k0 + kk) * N + n0 + (lane & 31)] * sc; }
    LDS_WAIT(); asm volatile("" ::: "memory");
    const int c = lane & 7;
#pragma unroll
    for (int j = 0; j < 4; ++j) { const int n = (lane >> 3) + 8 * j; const LAS float* s = scr + (8 * c) * 33 + n;
        u32x2 o; o.x = pk_fp8x4(s[0 * 33], s[1 * 33], s[2 * 33], s[3 * 33]); o.y = pk_fp8x4(s[4 * 33], s[5 * 33], s[6 * 33], s[7 * 33]);
        *(u32x2*)(WT + (size_t)(n0 + n) * K + k0 + 8 * c) = o; }
    LDS_WAIT(); asm volatile("" ::: "memory");
}

__device__ __forceinline__ void s5_gen_group(const P& p, LAS unsigned char* lds, int g, int tid) {
    LAS f32x2* pw = (LAS f32x2*)lds;
    LAS f32x2* Cc = (LAS f32x2*)(lds + 17408);
    LAS f32x2* Bb = (LAS f32x2*)(lds + 17408 + 16384);
    LAS float* Kt = (LAS float*)(lds + 17408 + 32768);
    LAS float* dsk = (LAS float*)(lds + 17408 + 65536);
    __syncthreads();
    if (tid < 128) {
        const int d = tid >> 6, pp = tid & 63, dgp = (d * 64 + g) * 64 + pp;
        const float lr = fminf(p.lam_re[dgp], -1e-4f), li = p.lam_im[dgp], dt = __expf(p.log_dt[d * 64 + g]);
        const float lrdt = lr * dt, ang = li * dt;
#pragma unroll 1
        for (int e = 0; e <= 16; ++e) { const float mag = __expf((float)e * lrdt); float sn, cs; sincos_rad((float)e * ang, sn, cs); pw[e * 128 + tid] = (f32x2){mag * cs, mag * sn}; }
        const f32x2 a1 = pw[128 + tid]; const float abr = a1.x, abi = a1.y;
        const float den = lr * lr + li * li, nr = abr - 1.0f;
        const float cre = (nr * lr + abi * li) / den, cim = (abi * lr - nr * li) / den;
        ((f32x2*)(p.ws + WS_S5A))[dgp] = pw[16 * 128 + tid];
#pragma unroll 4
        for (int h = 0; h < 16; ++h) { const float br = p.b_re[dgp * 16 + h], bi = p.b_im[dgp * 16 + h]; Bb[(d * 64 + pp) * 16 + h] = (f32x2){cre * br - cim * bi, cre * bi + cim * br}; }
    }
    for (int i = tid; i < 2048; i += 512) { const int d = i >> 10, h = (i >> 6) & 15, pp = i & 63; const size_t src = ((size_t)(d * 64 + g) * 16 + h) * 64 + pp; Cc[i] = (f32x2){p.c_re[src], p.c_im[src]}; }
    if (tid < 16) dsk[tid] = p.s5_d[g * 16 + tid];
    __syncthreads();
    {
        const int d = tid >> 8, tau = (tid >> 4) & 15, h = tid & 15; float acc[16];
#pragma unroll
        for (int hp = 0; hp < 16; ++hp) acc[hp] = 0.f;
#pragma unroll 2
        for (int pp = 0; pp < 64; ++pp) { const f32x2 c = Cc[(d * 16 + h) * 64 + pp], w = pw[tau * 128 + d * 64 + pp]; const float tx = c.x * w.x - c.y * w.y, ty = c.x * w.y + c.y * w.x;
#pragma unroll
            for (int hp = 0; hp < 16; ++hp) { const f32x2 bb = Bb[(d * 64 + pp) * 16 + hp]; acc[hp] += tx * bb.x - ty * bb.y; } }
#pragma unroll
        for (int hp = 0; hp < 16; ++hp) Kt[(d * 16 + tau) * 256 + h * 16 + hp] = acc[hp];
    }
    __syncthreads();
    bf16_t* Wy = (bf16_t*)(p.ws + WS_WY) + (size_t)g * 256 * 512;
#pragma unroll 1
    for (int idx = tid; idx < 256 * 256; idx += 512) {
        const int np = idx >> 8, k0 = (idx & 255) * 2;
        const int bj = (np >> 7) & 1, wc = (np >> 5) & 3, n = (np >> 4) & 1, fq = (np >> 2) & 3, j = np & 3, i = wc * 4 + fq, h = 8 * bj + 4 * n + j;
        float v[2];
#pragma unroll
        for (int kk = 0; kk < 2; ++kk) { const int k = k0 + kk;
            if (k < 256) { const int s = k >> 4, hp = k & 15;
                if (s < i) v[kk] = Kt[(i - s) * 256 + h * 16 + hp]; else if (s > i) v[kk] = Kt[(16 + (s - i)) * 256 + h * 16 + hp];
                else v[kk] = Kt[h * 16 + hp] + Kt[16 * 256 + h * 16 + hp] + (h == hp ? dsk[h] : 0.f);
            } else { const int kc = k - 256, d = kc >> 7, pp = (kc >> 1) & 63, ri = kc & 1, e = d ? 16 - i : i + 1;
                const f32x2 c = Cc[(d * 16 + h) * 64 + pp], w = pw[e * 128 + d * 64 + pp]; v[kk] = ri ? -(c.x * w.y + c.y * w.x) : (c.x * w.x - c.y * w.y); } }
        *(unsigned*)(Wy + (size_t)np * 512 + k0) = cvtpk(v[0], v[1]);
    }
    bf16_t* Wsum = (bf16_t*)(p.ws + WS_WSUM) + (size_t)g * 256 * 256;
#pragma unroll 1
    for (int idx = tid; idx < 256 * 128; idx += 512) {
        const int r = idx >> 7, k0 = (idx & 127) * 2, d = r >> 7, pp = (r >> 1) & 63, ri = r & 1;
        float v[2];
#pragma unroll
        for (int kk = 0; kk < 2; ++kk) { const int k = k0 + kk, s = k >> 4, hp = k & 15, e = d ? s : 15 - s;
            const f32x2 w = pw[e * 128 + d * 64 + pp], bb = Bb[(d * 64 + pp) * 16 + hp]; v[kk] = ri ? (w.x * bb.y + w.y * bb.x) : (w.x * bb.x - w.y * bb.y); }
        *(unsigned*)(Wsum + (size_t)r * 256 + k0) = cvtpk(v[0], v[1]);
    }
}

#ifndef PRO_DBL
#define PRO_DBL 0
#endif
#define PRO_REP(b) for (int _pr = 0; _pr < 1 + ((PRO_DBL >> (b)) & 1); ++_pr)
__device__ __forceinline__ void phase_prologue(const P& p, LAS unsigned char* lds, int tid, int lane, int wid) {
    unsigned char* ws = p.ws;
    LAS float* cact = (LAS float*)lds;
    LAS float* red = (LAS float*)(lds + 16384);
    for (int i = tid; i < 4096; i += 512) { const float cv = p.c[i]; cact[i] = cv * sigmoid_f(cv); }
    __syncthreads();
    float* mod = (float*)(ws + WS_MOD);
    PRO_REP(0) for (int item = blockIdx.x; item < 192; item += gridDim.x) {
        const int l = item / 96, cb = item % 96, cg4 = tid & 31, rl = tid >> 5;
        const float* W = p.ada_w + (size_t)l * 2048 * 12288 + cb * 128 + cg4 * 4;
        f32x4 a0 = {0.f, 0.f, 0.f, 0.f}, a1 = {0.f, 0.f, 0.f, 0.f};
#pragma unroll 8
        for (int r = rl; r < 2048; r += 16) { const f32x4 w = *(const f32x4*)(W + (size_t)r * 12288); const float c0 = cact[r], c1 = cact[2048 + r]; a0 += w * c0; a1 += w * c1; }
        *(LAS f32x4*)(red + (rl * 32 + cg4) * 8) = a0; *(LAS f32x4*)(red + (rl * 32 + cg4) * 8 + 4) = a1;
        __syncthreads();
        if (tid < 256) { const int col = tid & 127, b = tid >> 7; float s = 0.f;
#pragma unroll
            for (int r2 = 0; r2 < 16; ++r2) s += red[(r2 * 32 + (col >> 2)) * 8 + b * 4 + (col & 3)];
            s += p.ada_b[l * 12288 + cb * 128 + col]; mod[(l * 2 + b) * 12288 + cb * 128 + col] = s; }
        __syncthreads();
    }
    PRO_REP(1) {
        LAS float* scr = (LAS float*)(lds + 32768 + wid * 8448);
        const int gw = blockIdx.x * 8 + wid, ngw = gridDim.x * 8;
        constexpr int I0 = 32 * 80, I1 = 32 * 64, I2 = 32 * 256, I3 = 64 * 64, NIT = I0 + I1 + I2 + I3;
        for (int it = gw; it < NIT; it += ngw) {
            int r = it;
            if (r < I0) { p0_transpose_item_f8(p.even_w_in, 2048, 2560, ws + WS_WINE, scr, r, lane, F8_WS); continue; } r -= I0;
            if (r < I1) { p0_transpose_item_f8(p.even_w_out, 2048, 2048, ws + WS_WOUTE, scr, r, lane, F8_WS); continue; } r -= I1;
            if (r < I2) { p0_transpose_item_f8(p.odd_w_in, 2048, 8192, ws + WS_WINO, scr, r, lane, F8_WS); continue; } r -= I2;
            p0_transpose_item_f8(p.odd_w_out, 4096, 2048, ws + WS_WOUTO, scr, r, lane, F8_WS);
        }
    }
    const long gtid = (long)blockIdx.x * 512 + tid, ngt = (long)gridDim.x * 512;
    PRO_REP(2) {
        const int gw = blockIdx.x * 8 + wid, ngw = gridDim.x * 8;
        float* psc = (float*)(ws + WS_PSC);
        for (int row0 = 4 * gw; row0 < 4 * 16384; row0 += 4 * ngw) {
            f32x4 v[4][8]; float am[4]; const float* src[4]; unsigned char* dst[4];
#pragma unroll
            for (int rr = 0; rr < 4; ++rr) { const int row = row0 + rr; const bool tv = row >= 2 * 16384; const int r = tv ? row - 2 * 16384 : row;
                const bool sl = tv ? PEER_SLICE_V : PEER_SLICE_U;
                src[rr] = (tv ? p.peer_v : p.peer_u) + (size_t)r * 2048; dst[rr] = ws + (tv ? WS_PV : WS_PU) + (size_t)r * PEER_ROWB;
#pragma unroll
                for (int j = 0; j < 8; ++j) v[rr][j] = *(const f32x4*)(src[rr] + (sl ? 4 * (lane + 64 * j) : 16 * lane + 1024 * (j >> 2) + 4 * (j & 3))); }
#pragma unroll
            for (int rr = 0; rr < 4; ++rr) { am[rr] = 0.f;
#pragma unroll
                for (int j = 0; j < 8; ++j) am[rr] = fmaxf(am[rr], fmaxf(fmaxf(fabsf(v[rr][j].x), fabsf(v[rr][j].y)), fmaxf(fabsf(v[rr][j].z), fabsf(v[rr][j].w))));
#pragma unroll
                for (int o = 32; o > 0; o >>= 1) am[rr] = fmaxf(am[rr], __shfl_xor(am[rr], o)); }
#pragma unroll
            for (int rr = 0; rr < 4; ++rr) { const int row = row0 + rr;
                const float sc = am[rr] > 0.f ? 7.5f / am[rr] : 1.0f;
                if (lane == 0) psc[row] = am[rr] > 0.f ? am[rr] * (1.0f / 7.5f) : 1.0f;
                f32x16 ev, od;
#pragma unroll
                for (int j = 0; j < 8; ++j) { const f32x4 t = v[rr][j] * sc; ev[2 * j] = t.x; od[2 * j] = t.y; ev[2 * j + 1] = t.z; od[2 * j + 1] = t.w; }
                const u32x6 q = __builtin_amdgcn_cvt_scalef32_2xpk16_fp6_f32(ev, od, 1.0f);
                const bool tv = row >= 2 * 16384; const int r = tv ? row - 2 * 16384 : row;
                if (!(tv ? PEER_SLICE_V : PEER_SLICE_U)) {
                    *(u32x4*)(dst[rr] + 16 * lane) = (u32x4){q[0], q[1], q[2], q[3]};
                    *(u32x2*)(dst[rr] + 1024 + 8 * lane) = (u32x2){q[4], q[5]};
                } else {
                    unsigned char* sb = ws + (tv ? WS_PV : WS_PU) + (size_t)(r >> 14) * 16384 * PEER_ROWB + (size_t)(r & 16383) * 192 + 12 * (lane >> 2) + 4 * (lane & 3);
                    const unsigned pc[8] = {q[0] & 0xFFFFFFu, (q[0] >> 24) | ((q[1] & 0xFFFFu) << 8), (q[1] >> 16) | ((q[2] & 0xFFu) << 16), q[2] >> 8,
                                            q[3] & 0xFFFFFFu, (q[3] >> 24) | ((q[4] & 0xFFFFu) << 8), (q[4] >> 16) | ((q[5] & 0xFFu) << 16), q[5] >> 8};
                    const int i8 = 8 * (lane & 3);
#pragma unroll
                    for (int j = 0; j < 8; ++j) { const unsigned nx = __builtin_amdgcn_update_dpp(0u, pc[j], 0xF9, 0xF, 0xF, true);
                        const unsigned d = (pc[j] >> i8) | (nx << (24 - i8));
                        if ((lane & 3) < 3) *(unsigned*)(sb + (size_t)j * 16384 * 192) = d; }
                } }
        }
    }
    PRO_REP(3) for (int g = (int)gridDim.x - 1 - (int)blockIdx.x; g < 64; g += gridDim.x) s5_gen_group(p, lds, g, tid);
    for (long i = gtid; i < 65536; i += ngt) { const int layer = (int)(i >> 15), half = (int)(i >> 14) & 1, r = (int)(i & 16383);
        ((bf16_t*)(ws + WS_KEYS))[i] = (bf16_t)f2bf_rne((half ? p.peer_k2 : p.peer_k1)[layer * 16384 + r]); }
    for (long i = gtid; i < 131072; i += ngt) ((bf16_t*)(ws + WS_WSB))[i] = (bf16_t)f2bf_rne(p.sgu_w[i]);
}

template <bool OUT8>
__device__ __forceinline__ void phase_adaln(const float* xin, void* hout_, const float* g, const float* shift, const float* scale, int gw, int ngw, int lane) {
    for (int b = 0; b < 2; ++b) {
        f32x4 A[8], Bc[8];
#pragma unroll
        for (int j = 0; j < 8; ++j) { const int c = 8 * lane + 512 * (j >> 1) + 4 * (j & 1);
            const f32x4 gv = *(const f32x4*)(g + c), sc = *(const f32x4*)(scale + b * 12288 + c); A[j] = gv * (sc + 1.0f); Bc[j] = *(const f32x4*)(shift + b * 12288 + c); }
#pragma unroll 1
        for (int row0 = b * 8192 + gw; row0 < (b + 1) * 8192; row0 += 4 * ngw) {
            f32x4 v[4][8];
#pragma unroll
            for (int k = 0; k < 4; ++k) { const int row = row0 + k * ngw < (b + 1) * 8192 ? row0 + k * ngw : row0; const float* xr = xin + (size_t)row * 2048 + 8 * lane;
#pragma unroll
                for (int j = 0; j < 8; ++j) v[k][j] = *(const f32x4*)(xr + 512 * (j >> 1) + 4 * (j & 1)); }
#pragma unroll
            for (int k = 0; k < 4; ++k) { const int row = row0 + k * ngw < (b + 1) * 8192 ? row0 + k * ngw : row0; float ss = 0.f;
#pragma unroll
                for (int j = 0; j < 8; ++j) ss += dot4(v[k][j], v[k][j]);
                ss = wave_sum(ss); const float rstd = rsqrtf(ss * (1.0f / 2048.0f) + 1e-6f);
                bf16_t* hr = (bf16_t*)hout_ + (size_t)row * 2048 + 8 * lane; unsigned char* hr8 = (unsigned char*)hout_ + (size_t)row * 2048 + 8 * lane;
#pragma unroll
                for (int j = 0; j < 4; ++j) { const f32x4 y0 = v[k][2 * j] * rstd * A[2 * j] + Bc[2 * j], y1 = v[k][2 * j + 1] * rstd * A[2 * j + 1] + Bc[2 * j + 1];
                    if (OUT8) { u32x2 o; o.x = pk_fp8x4(y0.x * F8_HS, y0.y * F8_HS, y0.z * F8_HS, y0.w * F8_HS); o.y = pk_fp8x4(y1.x * F8_HS, y1.y * F8_HS, y1.z * F8_HS, y1.w * F8_HS); *(u32x2*)(hr8 + 512 * j) = o; }
                    else { u32x4 o; o.x = cvtpk(y0.x, y0.y); o.y = cvtpk(y0.z, y0.w); o.z = cvtpk(y1.x, y1.y); o.w = cvtpk(y1.z, y1.w);
                    *(u32x4*)(hr + 512 * j) = o; } } }
        }
    }
}

__device__ __forceinline__ void phase_fold_wq(const P& p, LAS unsigned char* lds, int tid, int lane, int wid) {
    unsigned char* ws = p.ws; const float* mod = (const float*)(ws + WS_MOD);
    for (long i = (long)blockIdx.x * 512 + tid; i < 2 * 2 * 2048; i += (long)gridDim.x * 512) { const int l = (int)(i >> 12), b = (int)(i >> 11) & 1, c = (int)(i & 2047);
        float* ab = (float*)(ws + WS_ABT) + (size_t)(l * 2 + b) * 4096;
        ab[c] = p.norm_g[(l * 2 + 1) * 2048 + c] * (1.0f + mod[(size_t)(l * 2 + b) * 12288 + 4 * 2048 + c]); ab[2048 + c] = mod[(size_t)(l * 2 + b) * 12288 + 3 * 2048 + c]; }
    LAS float* scr = (LAS float*)(lds + wid * 8448);
    const int gw = blockIdx.x * 8 + wid, ngw = gridDim.x * 8;
    for (int it = gw; it < 2 * 2048; it += ngw) {
        const int l = it >> 11, item = it & 2047, kb = item >> 6, nb = item & 63, k0 = 64 * kb, n0 = 32 * nb;
        const float* W = p.peer_wq + (size_t)l * 2048 * 2048;
#pragma unroll 8
        for (int i = 0; i < 32; ++i) { const int kk = 2 * i + (lane >> 5); scr[kk * 33 + (lane & 31)] = W[(size_t)(k0 + kk) * 2048 + n0 + (lane & 31)]; }
        LDS_WAIT(); asm volatile("" ::: "memory");
        const int c = lane & 7;
#pragma unroll
        for (int b = 0; b < 2; ++b) {
            const float* mb = mod + (size_t)(l * 2 + b) * 12288; const float* ng = p.norm_g + (l * 2 + 1) * 2048;
            float A[8];
#pragma unroll
            for (int t = 0; t < 8; ++t) A[t] = ng[k0 + 8 * c + t] * (1.0f + mb[4 * 2048 + k0 + 8 * c + t]);
            unsigned char* WT = ws + WS_WQF + (size_t)(l * 2 + b) * 2048 * 2048;
#pragma unroll
            for (int t = 0; t < 8; ++t) A[t] *= F8_WS;
#pragma unroll
            for (int j = 0; j < 4; ++j) { const int n = (lane >> 3) + 8 * j; const LAS float* s = scr + (8 * c) * 33 + n;
                u32x2 o; o.x = pk_fp8x4(s[0 * 33] * A[0], s[1 * 33] * A[1], s[2 * 33] * A[2], s[3 * 33] * A[3]); o.y = pk_fp8x4(s[4 * 33] * A[4], s[5 * 33] * A[5], s[6 * 33] * A[6], s[7 * 33] * A[7]);
                *(u32x2*)(WT + (size_t)(n0 + n) * 2048 + k0 + 8 * c) = o; }
            { const int n = lane & 31, kh = lane >> 5; float acc = 0.f;
#pragma unroll 8
              for (int t = 0; t < 32; ++t) acc += scr[(32 * kh + t) * 33 + n] * mb[3 * 2048 + k0 + 32 * kh + t];
              acc += __shfl_xor(acc, 32);
              if (lane < 32) ((float*)(ws + WS_BIASP))[((size_t)(l * 2 + b) * 32 + kb) * 2048 + n0 + n] = acc; }
        }
        LDS_WAIT(); asm volatile("" ::: "memory");
    }
}

__device__ __forceinline__ void phase_bias_reduce(const P& p, int tid) {
    for (long i = (long)blockIdx.x * 512 + tid; i < 2 * 2 * 2048; i += (long)gridDim.x * 512) { const int lb = (int)(i >> 11), n = (int)(i & 2047); float acc = 0.f;
#pragma unroll 8
        for (int kb = 0; kb < 32; ++kb) acc += ((const float*)(p.ws + WS_BIASP))[((size_t)lb * 32 + kb) * 2048 + n];
        ((float*)(p.ws + WS_BIASQ))[i] = acc; }
}
__device__ __forceinline__ void phase_qkprep(const P& p, int gw, int ngw, int lane) {
    bf16_t* Q = (bf16_t*)(p.ws + WS_Q); bf16_t* K = (bf16_t*)(p.ws + WS_K);
    const int sub = lane >> 4, ll = lane & 15;
    float inv[4], gq[8], gk[8];
#pragma unroll
    for (int e = 0; e < 4; ++e) inv[e] = __builtin_amdgcn_exp2f(-(float)((4 * ll + e) & 31) * 0.41524101186092029f);
#pragma unroll
    for (int e = 0; e < 8; ++e) { gq[e] = p.q_g[8 * ll + e]; gk[e] = p.k_g[8 * ll + e]; }
#pragma unroll 2
    for (int it = gw; it < NTOK * 10 / 4; it += ngw) {
        const int hr = 4 * it + sub, token = hr / 10, hh = hr - token * 10;
        u32x4* ptr = hh < 8 ? (u32x4*)(Q + (size_t)token * 1024 + hh * 128 + 8 * ll) : (u32x4*)(K + (size_t)token * 256 + (hh - 8) * 128 + 8 * ll);
        const u32x4 w = *ptr;
        float x[8] = {bflo(w.x), bfhi(w.x), bflo(w.y), bfhi(w.y), bflo(w.z), bfhi(w.z), bflo(w.w), bfhi(w.w)};
        float ss = 0.f;
#pragma unroll
        for (int e = 0; e < 8; ++e) ss += x[e] * x[e];
        ss = row16_sum(ss);
        const float r = rsqrtf(ss * (1.0f / 128.0f) + 1e-6f);
        const int s = token & 8191; const float pos = (float)(ll < 8 ? (s >> 6) : (s & 63));
        unsigned o[4];
#pragma unroll
        for (int e = 0; e < 4; ++e) { const float x1 = x[2 * e] * r * (hh < 8 ? gq[2 * e] : gk[2 * e]), x2 = x[2 * e + 1] * r * (hh < 8 ? gq[2 * e + 1] : gk[2 * e + 1]);
            float sn, cs; sincos_rad(pos * inv[e], sn, cs); o[e] = cvtpk(x1 * cs - x2 * sn, x1 * sn + x2 * cs); }
        *ptr = (u32x4){o[0], o[1], o[2], o[3]};
    }
}

__device__ __forceinline__ void phase_s5scan(const P& p, LAS unsigned char* lds, int lane, int wid) {
    const f32x2* A16 = (const f32x2*)(p.ws + WS_S5A);
    LAS f32x2* agg = (LAS f32x2*)lds;
    for (int item = blockIdx.x; item < 256; item += gridDim.x) {
        const int b = item >> 7, g = (item >> 1) & 63, d = item & 1;
        const f32x2 a = A16[(d * 64 + g) * 64 + lane];
        const float* S = (const float*)(p.ws + WS_SS) + ((size_t)g * 1024 + b * 512) * 256 + d * 128 + 2 * lane;
        bf16_t* HIN = (bf16_t*)(p.ws + WS_AB) + ((size_t)g * 1024 + b * 512) * 512 + 256 + d * 128 + 2 * lane;
        const int sA = 2 * wid + (d ? 1 : 0), sB = 2 * wid + (d ? 0 : 1), ordA = d ? 15 - sA : sA;
        float ar = 0.f, ai = 0.f, br = 0.f, bi = 0.f;
#pragma unroll 16
        for (int k = 0; k < 32; ++k) { const int o = d ? 31 - k : k; const f32x2 va = *(const f32x2*)(S + (size_t)(32 * sA + o) * 256), vb = *(const f32x2*)(S + (size_t)(32 * sB + o) * 256);
            const float nar = a.x * ar - a.y * ai + va.x, nai = a.x * ai + a.y * ar + va.y, nbr = a.x * br - a.y * bi + vb.x, nbi = a.x * bi + a.y * br + vb.y; ar = nar; ai = nai; br = nbr; bi = nbi; }
        __syncthreads();
        agg[ordA * 64 + lane] = (f32x2){ar, ai}; agg[(ordA + 1) * 64 + lane] = (f32x2){br, bi};
        __syncthreads();
        float pr = a.x, pi = a.y;
#pragma unroll
        for (int q = 0; q < 5; ++q) { const float nr = pr * pr - pi * pi, ni = 2.f * pr * pi; pr = nr; pi = ni; }
        float cr = 0.f, ci = 0.f;
        for (int s2 = 0; s2 < ordA; ++s2) { const f32x2 v = agg[s2 * 64 + lane]; const float nr = pr * cr - pi * ci + v.x, ni = pr * ci + pi * cr + v.y; cr = nr; ci = ni; }
        const float dr = pr * cr - pi * ci + ar, di = pr * ci + pi * cr + ai;
        ar = cr; ai = ci; br = dr; bi = di;
#pragma unroll 16
        for (int k = 0; k < 32; ++k) { const int o = d ? 31 - k : k; const size_t ca = (size_t)(32 * sA + o), cb = (size_t)(32 * sB + o);
            *(unsigned*)(HIN + ca * 512) = cvtpk(ar, ai); *(unsigned*)(HIN + cb * 512) = cvtpk(br, bi);
            const f32x2 va = *(const f32x2*)(S + ca * 256), vb = *(const f32x2*)(S + cb * 256);
            const float nar = a.x * ar - a.y * ai + va.x, nai = a.x * ai + a.y * ar + va.y, nbr = a.x * br - a.y * bi + vb.x, nbi = a.x * bi + a.y * br + vb.y; ar = nar; ai = nai; br = nbr; bi = nbi; }
    }
}

__device__ __forceinline__ void phase_attn(const P& p, char* lds) {
    const bf16_t* Q = (const bf16_t*)(p.ws + WS_Q); const bf16_t* K = (const bf16_t*)(p.ws + WS_K); const bf16_t* V = (const bf16_t*)(p.ws + WS_V);
    unsigned char* CAT = p.ws + WS_CAT;
    const int G = gridDim.x, bx = blockIdx.x, vcu = (G % 8 == 0) ? (bx % 8) * (G / 8) + bx / 8 : bx;
    for (int unit = vcu; unit < 512; unit += G) {
        const int bk = unit >> 7, rem = unit & 127, b = bk >> 1, kvh = bk & 1, h = kvh * 4 + (rem >> 5), qb = rem & 31;
        attn::attn_dense_body<attn::bf16>((const attn::bf16*)(Q + (size_t)(b * 8192 + qb * 256) * 1024 + h * 128),
                                          (const attn::bf16*)(K + (size_t)(b * 8192) * 256 + kvh * 128), (const attn::bf16*)(V + (size_t)(b * 8192) * 256 + kvh * 128),
                                          CAT + (size_t)(b * 8192 + qb * 256) * 2048 + 1024 + h * 128, 8192, lds);
        __syncthreads();
    }
}

constexpr int SGU_VS = 136;
constexpr int SGU_HB = 71680;
constexpr int SGU_VNT = 0, SGU_STG = 128 * SGU_VS * 2, SGU_STAT = 2 * 128 * SGU_VS * 2, SGU_BS = SGU_STAT + 1024;
static_assert(SGU_BS + 512 <= SGU_HB && 2 * SGU_HB <= LDS_BYTES - 64 && SGU_HB % 16 == 0, "SGU LDS map");
__device__ __forceinline__ void phase_sgu(const P& p, LAS unsigned char* lds, int tid, int lane, int wid) {
    const int hb = wid >> 2, w4 = wid & 3, t256 = tid & 255;
    LAS unsigned char* base = lds + hb * SGU_HB;
    LAS bf16_t* vnT = (LAS bf16_t*)(base + SGU_VNT);
    LAS bf16_t* stg = (LAS bf16_t*)(base + SGU_STG);
    LAS f32x2* stats = (LAS f32x2*)(base + SGU_STAT);
    LAS float* bs = (LAS float*)(base + SGU_BS);
    const bf16_t* Z = (const bf16_t*)(p.ws + WS_Z); unsigned char* SG = p.ws + WS_SG;
    const bf16_t* Wsb = (const bf16_t*)(p.ws + WS_WSB);
    const int fr = lane & 15, fq = lane >> 4, wi = w4 & 1, wc = w4 >> 1, i0 = 64 * wi, c0 = 64 * wc;
    for (int up = blockIdx.x; up < 512; up += gridDim.x) {
        const int unit = 2 * up + hb, n = unit >> 3, g = unit & 7;
        __syncthreads();
        if (t256 < 128) { const f32x2* part = (const f32x2*)(p.ws + WS_LNST) + (size_t)(2 * g * 4) * NTOK + (n * 128 + t256); float s1 = 0.f, s2 = 0.f;
#pragma unroll
            for (int q = 0; q < 8; ++q) { const f32x2 a2 = part[(size_t)q * NTOK]; s1 += a2.x; s2 += a2.y; }
            const float mean = s1 * (1.0f / 512.0f), var = fmaxf(s2 * (1.0f / 512.0f) - mean * mean, 0.f); stats[t256] = (f32x2){mean, rsqrtf(var + 1e-6f)};
            bs[t256] = p.sgu_b[g * 128 + t256]; }
        bf16x8 Af[4][4];
#pragma unroll
        for (int m = 0; m < 4; ++m)
#pragma unroll
            for (int ks = 0; ks < 4; ++ks) Af[m][ks] = *(const bf16x8*)(Wsb + (size_t)(g * 128 + i0 + 16 * m + fr) * 128 + 32 * ks + 8 * fq);
#pragma unroll 1
        for (int qt = 0; qt < 4; ++qt) {
            const int chb = g * 512 + qt * 128;
            __syncthreads();
            { u32x4 T[8];
#pragma unroll
              for (int q = 0; q < 8; ++q) { const int pc = t256 + 256 * q, j = pc >> 4, ch = (pc & 15) * 8; T[q] = *(const u32x4*)(Z + ((size_t)(n * 16 + 8 + g) * 128 + j) * 512 + qt * 128 + ch); }
#pragma unroll
              for (int q = 0; q < 8; ++q) { const int pc = t256 + 256 * q, j = pc >> 4, ch = (pc & 15) * 8; *(LAS u32x4*)(stg + j * SGU_VS + ch) = T[q]; } }
            __syncthreads();
#pragma unroll 1
            for (int slab = 0; slab < 2; ++slab) {
                const int cc = slab * 64 + lane; const float lng = p.sgu_ln_g[chb + cc];
                const int cl = cc & 63, rp = (cc & ~63) + ((cl >> 2) & 3) * 16 + (cl >> 4) * 4 + (cl & 3);
#pragma unroll
                for (int jg = 0; jg < 4; ++jg) {
                    const int j0 = 32 * w4 + 8 * jg; float y[8];
#pragma unroll
                    for (int k = 0; k < 8; ++k) { const float xv = bflo((unsigned)stg[(j0 + k) * SGU_VS + cc]); const f32x2 st = stats[j0 + k]; y[k] = (xv - st.x) * st.y * lng; }
                    u32x4 o; o.x = cvtpk(y[0], y[1]); o.y = cvtpk(y[2], y[3]); o.z = cvtpk(y[4], y[5]); o.w = cvtpk(y[6], y[7]);
                    *(LAS u32x4*)(vnT + rp * SGU_VS + j0) = o;
                }
            }
            __syncthreads();
#pragma unroll 1
            for (int np = 0; np < 2; ++np) {
                u32x4 U[4];
#pragma unroll
                for (int m = 0; m < 4; ++m) U[m] = *(const u32x4*)(Z + ((size_t)(n * 16 + g) * 128 + i0 + 16 * m + fr) * 512 + qt * 128 + c0 + 16 * fq + 8 * np);
                f32x4 acc[4][2];
#pragma unroll
                for (int m = 0; m < 4; ++m)
#pragma unroll
                    for (int nn = 0; nn < 2; ++nn) acc[m][nn] = (f32x4){0.f, 0.f, 0.f, 0.f};
#pragma unroll
                for (int ks = 0; ks < 4; ++ks) {
                    bf16x8 Bf[2];
#pragma unroll
                    for (int nn = 0; nn < 2; ++nn) Bf[nn] = *(const LAS bf16x8*)(vnT + (c0 + 16 * (2 * np + nn) + fr) * SGU_VS + 32 * ks + 8 * fq);
#pragma unroll
                    for (int m = 0; m < 4; ++m)
#pragma unroll
                        for (int nn = 0; nn < 2; ++nn) acc[m][nn] = __builtin_amdgcn_mfma_f32_16x16x32_bf16(Bf[nn], Af[m][ks], acc[m][nn], 0, 0, 0);
                }
#pragma unroll
                for (int m = 0; m < 4; ++m) { const int i = i0 + 16 * m + fr; const float bi = bs[i]; const size_t tok = (size_t)(n * 128 + i);
                    const int cch = chb + c0 + 16 * fq + 8 * np;
                    const u32x4 u0 = U[m];
                    const f32x4 s0 = acc[m][0] + bi, s1 = acc[m][1] + bi;
                    u32x2 o;
                    o.x = pk_fp8x4(bflo(u0.x) * s0.x * F8_SGS, bfhi(u0.x) * s0.y * F8_SGS, bflo(u0.y) * s0.z * F8_SGS, bfhi(u0.y) * s0.w * F8_SGS);
                    o.y = pk_fp8x4(bflo(u0.z) * s1.x * F8_SGS, bfhi(u0.z) * s1.y * F8_SGS, bflo(u0.w) * s1.z * F8_SGS, bfhi(u0.w) * s1.w * F8_SGS);
                    *(u32x2*)(SG + tok * 4096 + cch) = o; }
            }
        }
    }
}
#define XB_TMO      128
#define XB_XCNT(j)  (256  + 64 * (j))
#define XB_XSUB(j)  (1280 + 64 * (j))
#define XB_XGEN(j)  (2304 + 64 * (j))
#define XB_TOP      3328
#define XB_TOPGEN   3392
#define XCD_BAR_WORDS 3456
#define XB_SPIN_CAP (1u << 22)

__device__ __forceinline__ unsigned xb_ld(unsigned* p)              { return __hip_atomic_load(p, __ATOMIC_RELAXED, __HIP_MEMORY_SCOPE_AGENT); }
__device__ __forceinline__ unsigned xb_add(unsigned* p, unsigned v) { return __hip_atomic_fetch_add(p, v, __ATOMIC_RELAXED, __HIP_MEMORY_SCOPE_AGENT); }
__device__ __forceinline__ unsigned xb_xcc_id() { return (unsigned)__builtin_amdgcn_s_getreg((3 << 11) | 20) & 0xFu; }
#define XB_SPIN(cond, bar) do { unsigned _sp = 0; while (cond) { __builtin_amdgcn_s_sleep(1); \
    if ((++_sp & 255u) == 0u) { if (xb_ld(&(bar)[XB_TMO])) break; if (_sp > XB_SPIN_CAP) { atomicAdd(&(bar)[XB_TMO], 1u); break; } } } } while (0)

struct XcdBarrier {
    unsigned* bar; unsigned x;
    volatile LAS unsigned* st;
};

__device__ __forceinline__ XcdBarrier xcd_barrier_post(unsigned* bar, volatile LAS unsigned* st) {
    XcdBarrier b; b.bar = bar; b.x = xb_xcc_id(); b.st = st;
    if (threadIdx.x == 0) st[2] = xb_add(&bar[XB_XCNT(b.x)], 1u);
    return b;
}
__device__ __forceinline__ void xcd_barrier_complete(unsigned* bar, unsigned x, unsigned& nloc, unsigned& nx) {
    const unsigned G = gridDim.x * gridDim.y * gridDim.z;
    unsigned sum, cnt, mine, sp = 0u;
    for (;;) {
        sum = 0u; cnt = 0u; mine = 0u;
#pragma unroll
        for (unsigned j = 0; j < 16; ++j) { const unsigned c = xb_ld(&bar[XB_XCNT(j)]); sum += c; cnt += (c > 0u) ? 1u : 0u; mine = (j == x) ? c : mine; }
        if (sum == G) break;
        __builtin_amdgcn_s_sleep(1);
        if ((++sp & 255u) == 0u) { if (xb_ld(&bar[XB_TMO])) break; if (sp > XB_SPIN_CAP) { atomicAdd(&bar[XB_TMO], 1u); break; } }
    }
    nloc = mine > 0u ? mine : 1u; nx = cnt > 0u ? cnt : 1u;
}

__device__ __forceinline__ void xcd_barrier(const XcdBarrier& b) {
    asm volatile("s_waitcnt vmcnt(0)" ::: "memory");
    __syncthreads();
    if (threadIdx.x == 0) {
        unsigned* bar = b.bar;
        __builtin_amdgcn_s_waitcnt(0);
        unsigned nloc = b.st[0], nx = b.st[1];
        if (nloc == 0u) { xcd_barrier_complete(bar, b.x, nloc, nx); b.st[0] = nloc; b.st[1] = nx; }
        const unsigned old = xb_add(&bar[XB_XSUB(b.x)], 1u);
        const unsigned gen = old / nloc;
        if (old + 1u == (gen + 1u) * nloc) {
            __builtin_amdgcn_fence(__ATOMIC_RELEASE, "agent");
            asm volatile("s_waitcnt vmcnt(0)" ::: "memory");
            const unsigned og = xb_add(&bar[XB_TOP], 1u);
            const unsigned tg = og / nx;
            if (og + 1u == (tg + 1u) * nx) xb_add(&bar[XB_TOPGEN], 1u);
            else XB_SPIN(xb_ld(&bar[XB_TOPGEN]) == tg, bar);
            __builtin_amdgcn_fence(__ATOMIC_ACQUIRE, "agent");
            xb_add(&bar[XB_XGEN(b.x)], 1u);
            asm volatile("s_waitcnt vmcnt(0)" ::: "memory");
        } else {
            XB_SPIN(xb_ld(&bar[XB_XGEN(b.x)]) == gen, bar);
            __builtin_amdgcn_fence(__ATOMIC_ACQUIRE, "agent");
            asm volatile("s_waitcnt vmcnt(0)" ::: "memory");
        }
    }
    __syncthreads();
}

__device__ __forceinline__ void ce_desc(float& a, float& b) { const float mx = fmaxf(a, b), mn = fminf(a, b); a = mx; b = mn; }
__device__ __forceinline__ void bitonic_sort16_desc(float (&a)[16]) {
#pragma unroll
    for (int k = 2; k <= 16; k <<= 1)
#pragma unroll
        for (int j = k >> 1; j > 0; j >>= 1)
#pragma unroll
            for (int i = 0; i < 16; ++i) { const int l = i ^ j; if (l > i) { if ((i & k) == 0) ce_desc(a[i], a[l]); else ce_desc(a[l], a[i]); } }
}
__device__ __forceinline__ void merge_top16(float (&V)[16], const float (&S)[16]) {
#pragma unroll
    for (int i = 0; i < 16; ++i) V[i] = fmaxf(V[i], S[15 - i]);
#pragma unroll
    for (int j = 8; j > 0; j >>= 1)
#pragma unroll
        for (int i = 0; i < 16; ++i) { const int l = i ^ j; if (l > i) ce_desc(V[i], V[l]); }
}
__device__ __forceinline__ float with_payload(float v, unsigned mask, unsigned pay) { return __uint_as_float((__float_as_uint(v) & ~mask) | pay); }

__device__ __forceinline__ void peer_topk_half(const bf16_t* qrow, const bf16_t* keys, int r32, int hi, float (&V)[16]) {
    bf16x8 qf[8];
#pragma unroll
    for (int ks = 0; ks < 8; ++ks) qf[ks] = *(const bf16x8*)(qrow + 16 * ks + 8 * hi);
#pragma unroll
    for (int k = 0; k < 16; ++k) V[k] = -INFINITY;
#pragma unroll 1
    for (int t = 0; t < 4; ++t) {
        f32x16 s = (f32x16){0.f, 0.f, 0.f, 0.f, 0.f, 0.f, 0.f, 0.f, 0.f, 0.f, 0.f, 0.f, 0.f, 0.f, 0.f, 0.f};
#pragma unroll
        for (int ks = 0; ks < 8; ++ks) { const bf16x8 kf = *(const bf16x8*)(keys + (size_t)(t * 32 + r32) * 128 + 16 * ks + 8 * hi);
            s = __builtin_amdgcn_mfma_f32_32x32x16_bf16(kf, qf[ks], s, 0, 0, 0); }
        float S[16];
#pragma unroll
        for (int r = 0; r < 16; ++r) S[r] = with_payload(s[r], 0x7Fu, (unsigned)(t * 32 + (r & 3) + 8 * (r >> 2) + 4 * hi));
        bitonic_sort16_desc(S); merge_top16(V, S);
    }
    float PVv[16];
#pragma unroll
    for (int k = 0; k < 16; ++k) { const auto r = __builtin_amdgcn_permlane32_swap(__float_as_uint(V[k]), __float_as_uint(V[k]), false, false); PVv[k] = (hi ? __uint_as_float(r[0]) : __uint_as_float(r[1])); }
    merge_top16(V, PVv);
}

__device__ __forceinline__ void phase_peer_s1(const P& p, int layer, LAS unsigned char* lds, int lane, int wid) {
    LAS int* idxL = (LAS int*)(lds + 65536 + wid * 8192);
    const bf16_t* QP = (const bf16_t*)(p.ws + WS_QP);
    const bf16_t* keys = (const bf16_t*)(p.ws + WS_KEYS) + (size_t)layer * 2 * 16384;
    const float* rowsq = (const float*)(p.ws + WS_ROWSQ) + (size_t)layer * 32 * NTOK; float* RSTD = (float*)(p.ws + WS_RSTD);
    int* EID = (int*)(p.ws + WS_EID); float* GATE = (float*)(p.ws + WS_GATE);
    const int r32 = lane & 31, hi = lane >> 5, gw = blockIdx.x * 8 + wid, ngw = gridDim.x * 8;
#pragma unroll 1
    for (int tq = gw; tq < NTOK / 4; tq += ngw) {
        {
            const bf16_t* qrow = QP + (size_t)(4 * tq + (r32 >> 3)) * 2048 + (r32 & 7) * 256;
            float v1[16], v2[16];
            peer_topk_half(qrow, keys, r32, hi, v1);
            peer_topk_half(qrow + 128, keys + 16384, r32, hi, v2);
#pragma unroll
            for (int k = 0; k < 16; ++k) { idxL[k * 64 + lane] = (int)(__float_as_uint(v1[k]) & 0x7Fu); idxL[(16 + k) * 64 + lane] = (int)(__float_as_uint(v2[k]) & 0x7Fu); }
            float SC[16], S2[16];
#pragma unroll
            for (int b2 = 0; b2 < 16; ++b2) SC[b2] = with_payload(v1[0] + v2[b2], 0xFFu, (unsigned)b2);
#pragma unroll
            for (int a = 1; a <= 4; ++a) {
#pragma unroll
                for (int b2 = 0; b2 < 16; ++b2) S2[b2] = ((a + 1) * (b2 + 1) <= 16) ? with_payload(v1[a] + v2[b2], 0xFFu, (unsigned)(a * 16 + b2)) : -INFINITY;
                merge_top16(SC, S2); }
#pragma unroll
            for (int a = 5; a <= 7; ++a) { S2[2 * (a - 5)] = with_payload(v1[a] + v2[0], 0xFFu, (unsigned)(a * 16)); S2[2 * (a - 5) + 1] = with_payload(v1[a] + v2[1], 0xFFu, (unsigned)(a * 16 + 1)); }
#pragma unroll
            for (int a = 8; a <= 15; ++a) S2[6 + (a - 8)] = with_payload(v1[a] + v2[0], 0xFFu, (unsigned)(a * 16));
            S2[14] = -INFINITY; S2[15] = -INFINITY;
            bitonic_sort16_desc(S2); merge_top16(SC, S2);
            float e[16], sum = 0.f;
#pragma unroll
            for (int k = 0; k < 16; ++k) { e[k] = __expf(SC[k] - SC[0]); sum += e[k]; }
            const float inv = 1.0f / sum;
            if (hi == 0) {
                u32x4 iw[4]; f32x4 gv[4];
#pragma unroll
                for (int k = 0; k < 16; ++k) { const unsigned pay = __float_as_uint(SC[k]) & 0xFFu;
                    iw[k >> 2][k & 3] = (unsigned)(idxL[(pay >> 4) * 64 + lane] * 128 + idxL[(16 + (pay & 15)) * 64 + lane]); gv[k >> 2][k & 3] = e[k] * inv; }
                const size_t gbase = (size_t)(4 * tq + (r32 >> 3)) * 128 + (r32 & 7) * 16;
#pragma unroll
                for (int k4 = 0; k4 < 4; ++k4) { *(u32x4*)(EID + gbase + 4 * k4) = iw[k4]; *(f32x4*)(GATE + gbase + 4 * k4) = gv[k4]; } }
        }
        {
            const int token = 4 * tq + (lane >> 4), w = lane & 15;
            const float sq = row16_sum(rowsq[(size_t)w * NTOK + token] + rowsq[(size_t)(w + 16) * NTOK + token]);
            if (w == 0) RSTD[token] = rsqrtf(sq * (1.0f / 2048.0f) + 1e-6f); }
    }
}

__device__ __forceinline__ float dot2bf(unsigned a, unsigned b, float acc) { return __builtin_amdgcn_fdot2_f32_bf16(__builtin_bit_cast(bf16x2v, a), __builtin_bit_cast(bf16x2v, b), acc, false); }
__device__ __forceinline__ void peer_partition(const P& p, int myrank, int& part, int& rank, int& nwg) {
    unsigned* bar = (unsigned*)(p.ws + WS_BAR); const unsigned x = xb_xcc_id(); unsigned mine = 0u; bool ok = true;
#pragma unroll
    for (unsigned j = 0; j < 16; ++j) { const unsigned cj = xb_ld(&bar[XB_XCNT(j)]); ok = ok && ((j < 8u) ? (cj > 0u) : (cj == 0u)); mine = (j == x) ? cj : mine; }
    if (ok) { part = (int)x; rank = myrank; nwg = (int)mine; } else { part = (int)blockIdx.x & 7; rank = (int)blockIdx.x >> 3; nwg = (int)gridDim.x >> 3; }
    part = __builtin_amdgcn_readfirstlane(part); rank = __builtin_amdgcn_readfirstlane(rank); nwg = __builtin_amdgcn_readfirstlane(nwg);
}
__device__ __forceinline__ void phase_peer_u(const P& p, int layer, LAS unsigned char* lds, int lane, int wid, int myrank) {
    LAS unsigned char* wl = lds + wid * 16384;
    int part, rank, nwg; peer_partition(p, myrank, part, rank, nwg);
    const unsigned char* PUS = p.ws + WS_PU + (size_t)layer * 16384 * PEER_ROWB + (size_t)part * 16384 * 192;
    const int* EID = (const int*)(p.ws + WS_EID);
    const unsigned char* HB = p.ws + WS_XB + 512 * part;
    const float* RSTD = (const float*)(p.ws + WS_RSTD);
    const float* ABs = (const float*)(p.ws + WS_ABT) + (size_t)layer * 2 * 4096 + 256 * part + 4 * lane;
    float* PACT = (float*)(p.ws + WS_PACT) + (size_t)part * NTOK * 128;
    const int g = lane >> 2, s = lane & 3, nb = NTOK / 8, stride = nwg * 8;
    int tb = rank * 8 + wid;
    if (tb >= nb) return;
    int e0[8], e1[8]; u32x2 hs[8]; float rs[8]; f32x4 Av, Bv;
#define PB_LOAD(TB) { _Pragma("unroll") for (int j = 0; j < 8; ++j) { const size_t t = (size_t)(TB) * 8 + j; e0[j] = EID[t * 128 + lane]; e1[j] = EID[t * 128 + 64 + lane]; hs[j] = *(const u32x2*)(HB + t * 4096 + 8 * lane); rs[j] = RSTD[t]; } \
        Av = *(const f32x4*)(ABs + ((TB) >> 10) * 4096); Bv = *(const f32x4*)(ABs + ((TB) >> 10) * 4096 + 2048); }
#define PB_STORE(BUF) _Pragma("unroll") for (int j = 0; j < 8; ++j) { LAS int* il = (LAS int*)(wl + (BUF) * 8192); il[j * 128 + lane] = e0[j]; il[j * 128 + 64 + lane] = e1[j]; \
        u32x2 hw; hw.x = cvtpk(bflo(hs[j].x) * rs[j] * Av.x + Bv.x, bfhi(hs[j].x) * rs[j] * Av.y + Bv.y); hw.y = cvtpk(bflo(hs[j].y) * rs[j] * Av.z + Bv.z, bfhi(hs[j].y) * rs[j] * Av.w + Bv.w); \
        *(LAS u32x2*)(wl + (BUF) * 8192 + 4096 + j * 512 + 8 * lane) = hw; }
#define PR_LOAD(SLOT, ID) { const unsigned char* ur = PUS + (size_t)(ID) * 192 + 48 * s; R[SLOT][0] = *(const u32x4*)ur; R[SLOT][1] = *(const u32x4*)(ur + 16); R[SLOT][2] = *(const u32x4*)(ur + 32); }
    PB_LOAD(tb) PB_STORE(0)
    u32x4 R[8][3];
    { LAS int* il = (LAS int*)wl;
#pragma unroll
      for (int q = 0; q < 8; ++q) { const int id = il[16 * q + g]; PR_LOAD(q, id) } }
    int bi = 0;
#pragma unroll 1
    for (; tb < nb; tb += stride, bi ^= 1) {
        { const int tbn = tb + stride < nb ? tb + stride : tb; PB_LOAD(tbn) }
#pragma unroll 1
        for (int j = 0; j < 8; ++j) {
            if (j == 7) { PB_STORE(bi ^ 1) }
            LAS int* nid = (j < 7) ? (LAS int*)(wl + bi * 8192) + (j + 1) * 128 : (LAS int*)(wl + (bi ^ 1) * 8192);
            LAS u32x4* hp = (LAS u32x4*)(wl + bi * 8192 + 4096 + j * 512 + s * 128);
            const u32x4 h0 = hp[0], h1 = hp[1], h2 = hp[2], h3 = hp[3], h4 = hp[4], h5 = hp[5], h6 = hp[6], h7 = hp[7];
            float acc[8];
#pragma unroll
            for (int it = 0; it < 8; ++it) {
                const u32x16 dw = __builtin_bit_cast(u32x16, __builtin_amdgcn_cvt_scalef32_pk32_bf16_fp6((u32x6){R[it][0].x, R[it][0].y, R[it][0].z, R[it][0].w, R[it][1].x, R[it][1].y}, 1.0f));
                const u32x16 dx = __builtin_bit_cast(u32x16, __builtin_amdgcn_cvt_scalef32_pk32_bf16_fp6((u32x6){R[it][1].z, R[it][1].w, R[it][2].x, R[it][2].y, R[it][2].z, R[it][2].w}, 1.0f));
                { const int idn = nid[16 * it + g]; PR_LOAD(it, idn) }
                float a0 = 0.f, a1 = 0.f;
                a0 = dot2bf(dw[0], h0.x, a0); a1 = dot2bf(dw[1], h0.y, a1); a0 = dot2bf(dw[2], h0.z, a0); a1 = dot2bf(dw[3], h0.w, a1);
                a0 = dot2bf(dw[4], h1.x, a0); a1 = dot2bf(dw[5], h1.y, a1); a0 = dot2bf(dw[6], h1.z, a0); a1 = dot2bf(dw[7], h1.w, a1);
                a0 = dot2bf(dw[8], h2.x, a0); a1 = dot2bf(dw[9], h2.y, a1); a0 = dot2bf(dw[10], h2.z, a0); a1 = dot2bf(dw[11], h2.w, a1);
                a0 = dot2bf(dw[12], h3.x, a0); a1 = dot2bf(dw[13], h3.y, a1); a0 = dot2bf(dw[14], h3.z, a0); a1 = dot2bf(dw[15], h3.w, a1);
                a0 = dot2bf(dx[0], h4.x, a0); a1 = dot2bf(dx[1], h4.y, a1); a0 = dot2bf(dx[2], h4.z, a0); a1 = dot2bf(dx[3], h4.w, a1);
                a0 = dot2bf(dx[4], h5.x, a0); a1 = dot2bf(dx[5], h5.y, a1); a0 = dot2bf(dx[6], h5.z, a0); a1 = dot2bf(dx[7], h5.w, a1);
                a0 = dot2bf(dx[8], h6.x, a0); a1 = dot2bf(dx[9], h6.y, a1); a0 = dot2bf(dx[10], h6.z, a0); a1 = dot2bf(dx[11], h6.w, a1);
                a0 = dot2bf(dx[12], h7.x, a0); a1 = dot2bf(dx[13], h7.y, a1); a0 = dot2bf(dx[14], h7.z, a0); a1 = dot2bf(dx[15], h7.w, a1);
                float v = a0 + a1;
                v += __uint_as_float(__builtin_amdgcn_update_dpp(0u, __float_as_uint(v), 0xB1, 0xF, 0xF, true));
                v += __uint_as_float(__builtin_amdgcn_update_dpp(0u, __float_as_uint(v), 0x4E, 0xF, 0xF, true));
                acc[it] = v;
            }
            if (s == 0) { float* pa = PACT + ((size_t)tb * 8 + j) * 128 + g;
#pragma unroll
                for (int it = 0; it < 8; ++it) pa[16 * it] = acc[it]; }
        }
    }
#undef PB_LOAD
#undef PB_STORE
#undef PR_LOAD
}

__device__ __forceinline__ void phase_peer_w(const P& p, int layer, int tid) {
    const int* EID = (const int*)(p.ws + WS_EID); const float* GATE = (const float*)(p.ws + WS_GATE); const float* PACT = (const float*)(p.ws + WS_PACT); float* PW = (float*)(p.ws + WS_PW);
    const float* PSU = (const float*)(p.ws + WS_PSC) + layer * 16384; const float* PSV = PSU + 2 * 16384;
#pragma unroll 2
    for (int i4 = (int)blockIdx.x * 512 + tid; i4 < NTOK * 128 / 4; i4 += (int)gridDim.x * 512) {
        const size_t i = (size_t)i4 * 4;
        const u32x4 id4 = *(const u32x4*)(EID + i); const f32x4 g4 = *(const f32x4*)(GATE + i);
        f32x4 a = (f32x4){0.f, 0.f, 0.f, 0.f};
#pragma unroll
        for (int x = 0; x < 8; ++x) a += *(const f32x4*)(PACT + (size_t)x * NTOK * 128 + i);
        f32x4 w;
#pragma unroll
        for (int e = 0; e < 4; ++e) { const int id = (int)id4[e]; w[e] = gelu_t(a[e] * PSU[id]) * g4[e] * PSV[id]; }
        *(f32x4*)(PW + i) = w;
    }
}

__device__ __forceinline__ void phase_peer_vs(const P& p, int layer, LAS unsigned char* lds, int lane, int wid, int myrank) {
    LAS unsigned char* wl = lds + wid * 16384;
    int part, rank, nwg; peer_partition(p, myrank, part, rank, nwg);
    const unsigned char* PVS = p.ws + WS_PV + (size_t)layer * 16384 * PEER_ROWB + (size_t)part * 16384 * 192;
    const int* EID = (const int*)(p.ws + WS_EID); const float* PW = (const float*)(p.ws + WS_PW);
    unsigned char* PO = p.ws + WS_PO + 512 * part;
    const int g = lane >> 3, s = lane & 7, nb = NTOK / 8, stride = nwg * 8;
    const bool b3 = (lane & 8) != 0;
    int tb = rank * 8 + wid;
    if (tb >= nb) return;
    int e0[8], e1[8]; float w0[8], w1[8];
#define PB_LOAD(TB) _Pragma("unroll") for (int j = 0; j < 8; ++j) { const size_t t = (size_t)(TB) * 8 + j; e0[j] = EID[t * 128 + lane]; e1[j] = EID[t * 128 + 64 + lane]; w0[j] = PW[t * 128 + lane]; w1[j] = PW[t * 128 + 64 + lane]; }
#define PB_STORE(BUF) _Pragma("unroll") for (int j = 0; j < 8; ++j) { LAS int* il = (LAS int*)(wl + (BUF) * 8192); LAS float* fl = (LAS float*)(wl + (BUF) * 8192 + 4096); il[j * 128 + lane] = e0[j]; il[j * 128 + 64 + lane] = e1[j]; fl[j * 128 + lane] = w0[j]; fl[j * 128 + 64 + lane] = w1[j]; }
#define PR_LOAD(SLOT, ID) { const unsigned char* vr = PVS + (size_t)(ID) * 192 + 24 * s; R[SLOT][0] = *(const u32x2*)vr; R[SLOT][1] = *(const u32x2*)(vr + 8); R[SLOT][2] = *(const u32x2*)(vr + 16); }
    PB_LOAD(tb) PB_STORE(0)
    u32x2 R[8][3];
    { LAS int* il = (LAS int*)wl;
#pragma unroll
      for (int q = 0; q < 8; ++q) { const int id = il[8 * q + g]; PR_LOAD(q, id) } }
    int bi = 0;
#pragma unroll 1
    for (; tb < nb; tb += stride, bi ^= 1) {
        { const int tbn = tb + stride < nb ? tb + stride : tb; PB_LOAD(tbn) }
#pragma unroll 1
        for (int j = 0; j < 8; ++j) {
            if (j == 7) { PB_STORE(bi ^ 1) }
            LAS int* ids = (LAS int*)(wl + bi * 8192) + j * 128;
            LAS int* nid = (j < 7) ? ids + 128 : (LAS int*)(wl + (bi ^ 1) * 8192);
            LAS float* wv = (LAS float*)(wl + bi * 8192 + 4096) + j * 128;
            h16x2 o2[16];
#pragma unroll
            for (int k = 0; k < 16; ++k) o2[k] = (h16x2){(_Float16)0.f, (_Float16)0.f};
#pragma unroll
            for (int it = 0; it < 16; ++it) {
                const int sl = it & 7;
                const h16x32 d = __builtin_amdgcn_cvt_scalef32_pk32_f16_fp6((u32x6){R[sl][0].x, R[sl][0].y, R[sl][1].x, R[sl][1].y, R[sl][2].x, R[sl][2].y}, 1.0f);
                { const int idn = (it < 8) ? ids[8 * (it + 8) + g] : nid[8 * (it - 8) + g]; PR_LOAD(sl, idn) }
                const _Float16 wh = (_Float16)wv[8 * it + g]; const h16x2 w2 = (h16x2){wh, wh};
#pragma unroll
                for (int k = 0; k < 16; ++k) o2[k] = __builtin_elementwise_fma(w2, (h16x2){d[2 * k], d[2 * k + 1]}, o2[k]);
            }
            h16x2 t8[8], t4[4]; float res[4];
#pragma unroll
            for (int k = 0; k < 8; ++k) { const auto r = __builtin_amdgcn_permlane32_swap(__builtin_bit_cast(unsigned, o2[k]), __builtin_bit_cast(unsigned, o2[8 + k]), false, false);
                unsigned ra = r[0], rb = r[1]; asm volatile("" : "+v"(ra), "+v"(rb)); t8[k] = __builtin_bit_cast(h16x2, ra) + __builtin_bit_cast(h16x2, rb); }
#pragma unroll
            for (int k = 0; k < 4; ++k) { const auto r = __builtin_amdgcn_permlane16_swap(__builtin_bit_cast(unsigned, t8[k]), __builtin_bit_cast(unsigned, t8[4 + k]), false, false);
                unsigned ra = r[0], rb = r[1]; asm volatile("" : "+v"(ra), "+v"(rb)); t4[k] = __builtin_bit_cast(h16x2, ra) + __builtin_bit_cast(h16x2, rb); }
#pragma unroll
            for (int k = 0; k < 2; ++k) { const unsigned lo = __builtin_bit_cast(unsigned, t4[k]), hi = __builtin_bit_cast(unsigned, t4[2 + k]); const unsigned mine = b3 ? hi : lo, send = b3 ? lo : hi;
                const h16x2 rr = __builtin_bit_cast(h16x2, mine) + __builtin_bit_cast(h16x2, (unsigned)__builtin_amdgcn_update_dpp(0u, send, 0x128, 0xF, 0xF, true));
                res[2 * k] = (float)rr.x; res[2 * k + 1] = (float)rr.y; }
            u32x2 ow; ow.x = cvtpk(res[0], res[1]); ow.y = cvtpk(res[2], res[3]);
            *(u32x2*)(PO + ((size_t)tb * 8 + j) * 4096 + 64 * s + 8 * g) = ow;
        }
    }
#undef PB_LOAD
#undef PB_STORE
#undef PR_LOAD
}

template <bool FINAL>
__device__ __forceinline__ void phase_peer_norm(const P& p, int layer, int lane, int wid) {
    bf16_t* XB = (bf16_t*)(p.ws + WS_XB);
    const bf16_t* PO = (const bf16_t*)(p.ws + WS_PO);
    const float* mod = (const float*)(p.ws + WS_MOD);
    float* X = p.out;
    const int gw = blockIdx.x * 8 + wid, ngw = gridDim.x * 8;
    u32x4 pw[4], xw[4];
#define PN_LOAD(T, PWV, XWV) { const bf16_t* por = PO + (size_t)(T) * 2048 + 16 * lane; const bf16_t* xbl = XB + (size_t)(T) * 2048 + 16 * lane; \
        _Pragma("unroll") for (int j = 0; j < 4; ++j) { PWV[j] = *(const u32x4*)(por + 1024 * (j >> 1) + 8 * (j & 1)); XWV[j] = *(const u32x4*)(xbl + 1024 * (j >> 1) + 8 * (j & 1)); } }
    if (gw < NTOK) PN_LOAD(gw, pw, xw)
#pragma unroll 1
    for (int token = gw; token < NTOK; token += ngw) {
        const int b = token >> 13;
        u32x4 pwn[4], xwn[4];
        { const int tn = token + ngw < NTOK ? token + ngw : token; PN_LOAD(tn, pwn, xwn) }
        float o[32];
#pragma unroll
        for (int j = 0; j < 4; ++j) { const u32x4 w = pw[j];
            o[8 * j + 0] = bflo(w.x); o[8 * j + 1] = bfhi(w.x); o[8 * j + 2] = bflo(w.y); o[8 * j + 3] = bfhi(w.y);
            o[8 * j + 4] = bflo(w.z); o[8 * j + 5] = bfhi(w.z); o[8 * j + 6] = bflo(w.w); o[8 * j + 7] = bfhi(w.w); }
        {
            const float* g2 = mod + (size_t)(layer * 2 + b) * 12288 + 5 * 2048 + 16 * lane;
            bf16_t* xbr = XB + (size_t)token * 2048 + 16 * lane; float* xr = X + (size_t)token * 2048 + 16 * lane;
            float xn[32], ss = 0.f;
#pragma unroll
            for (int jh = 0; jh < 2; ++jh) { const u32x4 w0 = xw[2 * jh], w1 = xw[2 * jh + 1];
                const float xi[16] = {bflo(w0.x), bfhi(w0.x), bflo(w0.y), bfhi(w0.y), bflo(w0.z), bfhi(w0.z), bflo(w0.w), bfhi(w0.w), bflo(w1.x), bfhi(w1.x), bflo(w1.y), bfhi(w1.y), bflo(w1.z), bfhi(w1.z), bflo(w1.w), bfhi(w1.w)};
#pragma unroll
                for (int q = 0; q < 4; ++q) { const f32x4 gg = *(const f32x4*)(g2 + 1024 * jh + 4 * q);
#pragma unroll
                    for (int e = 0; e < 4; ++e) { const float t = xi[4 * q + e] + gg[e] * o[16 * jh + 4 * q + e]; xn[16 * jh + 4 * q + e] = t; ss += t * t; } } }
            ss = wave_sum(ss); const float rstd = rsqrtf(ss * (1.0f / 2048.0f) + 1e-6f);
            if (FINAL) {
#pragma unroll
                for (int j = 0; j < 8; ++j) { const int off = 1024 * (j >> 2) + 4 * (j & 3); const f32x4 fg = *(const f32x4*)(p.final_g + 16 * lane + off);
                    f32x4 y;
#pragma unroll
                    for (int e = 0; e < 4; ++e) y[e] = xn[4 * j + e] * rstd * fg[e];
                    *(f32x4*)(xr + off) = y; }
            } else {
                const float* ng = p.norm_g + (size_t)((layer + 1) * 2 + 0) * 2048 + 16 * lane;
                const float* sh = mod + (size_t)((layer + 1) * 2 + b) * 12288 + 16 * lane; const float* sc = sh + 2048;
                unsigned char* hrow8 = p.ws + WS_H8 + (size_t)token * 2048 + 16 * lane;
#pragma unroll
                for (int jh = 0; jh < 2; ++jh) { float y[16];
#pragma unroll
                    for (int hq = 0; hq < 4; ++hq) { const int jj = 4 * jh + hq, off = 1024 * jh + 4 * hq; const f32x4 gv = *(const f32x4*)(ng + off), sv = *(const f32x4*)(sc + off), hv = *(const f32x4*)(sh + off);
                        f32x4 xo;
#pragma unroll
                        for (int e = 0; e < 4; ++e) { xo[e] = xn[4 * jj + e]; y[4 * hq + e] = (xo[e] * rstd * gv[e] * (1.0f + sv[e]) + hv[e]) * F8_HS; }
                        u32x2 xw; xw.x = cvtpk(xo[0], xo[1]); xw.y = cvtpk(xo[2], xo[3]); *(u32x2*)(xbr + off) = xw; }
                    u32x4 w; w.x = pk_fp8x4(y[0], y[1], y[2], y[3]); w.y = pk_fp8x4(y[4], y[5], y[6], y[7]); w.z = pk_fp8x4(y[8], y[9], y[10], y[11]); w.w = pk_fp8x4(y[12], y[13], y[14], y[15]);
                    *(u32x4*)(hrow8 + 1024 * jh) = w; }
            }
        }
#pragma unroll
        for (int j = 0; j < 4; ++j) { pw[j] = pwn[j]; xw[j] = xwn[j]; }
    }
#undef PN_LOAD
}

#ifndef PH_MASK
#define PH_MASK 0xFFFF
#endif
#define PH(b) if constexpr ((PH_MASK >> (b)) & 1)
#ifndef DBL_MASK
#define DBL_MASK 0
#endif
#define REP(b) for (int _r = 0; _r < 1 + ((DBL_MASK >> (b)) & 1); ++_r)
__device__ __forceinline__ int fresh_tid() { int t = threadIdx.x; asm volatile("" : "+v"(t)); return t; }
__device__ __forceinline__ P load_p() {
    typedef __attribute__((address_space(1))) float* gp;
    typedef const gp __attribute__((address_space(4)))* cq;
    cq q = (cq)__builtin_amdgcn_kernarg_segment_ptr(); asm volatile("" : "+s"(q));
    P r; float** d = (float**)&r;
#pragma unroll
    for (int i = 0; i < (int)(sizeof(P) / 8); ++i) d[i] = (float*)q[i];
    return r;
}
#define LP (load_p())
#define WSB (load_p().ws)
#define MODP ((const float*)(load_p().ws + WS_MOD))
#define HP ((bf16_t*)(load_p().ws + WS_H))
__global__ void __launch_bounds__(512, 2) mk_fwd(P p_arg) {
    extern __shared__ __attribute__((aligned(16))) unsigned char lds_raw[];
    LAS unsigned char* lds = (LAS unsigned char*)lds_raw;
    cg::grid_group grid = cg::this_grid();
    const int wid = __builtin_amdgcn_readfirstlane((int)threadIdx.x >> 6);
    const int gw = blockIdx.x * 8 + wid, ngw = gridDim.x * 8, G = gridDim.x;
    volatile LAS unsigned* xst = (volatile LAS unsigned*)(lds + LDS_BYTES - 64);
    if (threadIdx.x < 16) xst[threadIdx.x] = 0u;
    __syncthreads();
    const XcdBarrier xb = xcd_barrier_post((unsigned*)(load_p().ws + WS_BAR), xst);
#define TID (fresh_tid())
#define LANE (fresh_tid() & 63)

    REP(0) { PH(0) phase_prologue(LP, lds, TID, LANE, wid);
    grid.sync(); }
    REP(1) { PH(1) phase_adaln<true>(LP.x, WSB + WS_H8, LP.norm_g, MODP, MODP + 2048, gw, ngw, LANE);
    xcd_barrier(xb); }
    REP(2) { PH(2) {   pg8::Gemm g{(const bf16_t*)(WSB + WS_H8), (const bf16_t*)(WSB + WS_WINE), NTOK, 2560, 1024, 1024, 1024, 0, 0}; pg8::StaticOrder S; S.init(NTOK, 2560, G, (int)blockIdx.x);
        pg8::EpiEvenSplit E{1.0f / (F8_HS * F8_WS), WSB};
        pg8::gemm_phase<pg8::EpiEvenSplit, pg8::StaticOrder, true, true, true>(lds, g, S, E); }
    xcd_barrier(xb); }
    PH(3) { phase_qkprep(LP, gw, ngw, LANE); phase_fold_wq(LP, lds, TID, LANE, wid); __syncthreads(); }
    REP(4) { PH(4) {
        pg8::Gemm g{(const bf16_t*)(WSB + WS_AB), (const bf16_t*)(WSB + WS_WSUM), 1024, 256, 256, 512, 256, (size_t)1024 * 512, (size_t)256 * 256};
        pg8::BatchOrder S{4, 256, G, (int)blockIdx.x}; pg8::EpiF32B E{(float*)(WSB + WS_SS), 256, (size_t)1024 * 256};
        pg8::gemm_phase<pg8::EpiF32B, pg8::BatchOrder, false, false>(lds, g, S, E); }
    xcd_barrier(xb); }
    REP(5) { PH(5) { phase_s5scan(LP, lds, LANE, wid); phase_bias_reduce(LP, TID); }
    xcd_barrier(xb); }
    REP(13) { PH(13) {
        pg8::Gemm g{(const bf16_t*)(WSB + WS_AB), (const bf16_t*)(WSB + WS_WY), 1024, 256, 512, 512, 512, (size_t)1024 * 512, (size_t)256 * 512};
        LAS float* wl = (LAS float*)(lds + 131072);
        { const int un = (int)blockIdx.x;
            const int tid = TID; __syncthreads();
            if (tid < 256) wl[tid] = LP.glu_w[(un >> 2) * 256 + tid]; else if (tid < 272) wl[tid] = LP.glu_b[(un >> 2) * 16 + tid - 256];
            __syncthreads();
            pg8::BatchOrder S{4, un + 1, 256, un}; pg8::EpiS5Glu E{WSB + WS_CAT, wl};
            pg8::gemm_phase<pg8::EpiS5Glu, pg8::BatchOrder, false, false>(lds, g, S, E); }
        __syncthreads(); } }
    REP(6) { PH(6) phase_attn(LP, (char*)lds_raw);
    xcd_barrier(xb); }
    REP(7) { PH(7) {   pg8::Gemm g{(const bf16_t*)(WSB + WS_CAT), (const bf16_t*)(WSB + WS_WOUTE), NTOK, 2048, 1024, 1024, 1024, 0, 0}; pg8::StaticOrder S; S.init(NTOK, 2048, G, (int)blockIdx.x);
        pg8::EpiResidB<true> E{LP.x, (bf16_t*)(WSB + WS_XB), MODP + 2 * 2048, (float*)(WSB + WS_ROWSQ), WSB + WS_X8, 1.0f / (F8_CS * F8_WS)};
        pg8::gemm_phase<pg8::EpiResidB<true>, pg8::StaticOrder, true, true, true>(lds, g, S, E); }
    xcd_barrier(xb); }
    REP(8) { PH(8) {   pg8::Gemm g{(const bf16_t*)(WSB + WS_X8), (const bf16_t*)(WSB + WS_WQF), NTOK, 2048, 1024, 1024, 1024, 0, (size_t)2048 * 1024}; pg8::StaticOrder S; S.init(NTOK, 2048, G, (int)blockIdx.x); S.pbs = 5;
        pg8::EpiQ E{(bf16_t*)(WSB + WS_QP), (const float*)(WSB + WS_ROWSQ), (const float*)(WSB + WS_BIASQ), 1.0f / (F8_XS * F8_WS)};
        pg8::gemm_phase<pg8::EpiQ, pg8::StaticOrder, true, true, true>(lds, g, S, E); }
    xcd_barrier(xb); }
    REP(16) { PH(9) phase_peer_s1(LP, 0, lds, LANE, wid); }
    xcd_barrier(xb);
    REP(17) { PH(9) phase_peer_u(LP, 0, lds, LANE, wid, (int)xst[2]); }
    xcd_barrier(xb);
    REP(18) { PH(9) phase_peer_w(LP, 0, TID); }
    xcd_barrier(xb);
    REP(19) { PH(9) phase_peer_vs(LP, 0, lds, LANE, wid, (int)xst[2]); }
    xcd_barrier(xb);
    PH(9) phase_peer_norm<false>(LP, 0, LANE, wid);
    xcd_barrier(xb);
    REP(10) { PH(10) {   pg8::Gemm g{(const bf16_t*)(WSB + WS_H8), (const bf16_t*)(WSB + WS_WINO), NTOK, 8192, 1024, 1024, 1024, 0, 0}; pg8::StaticOrder S; S.init(NTOK, 8192, G, (int)blockIdx.x);
        pg8::EpiBf16T<1> E{(bf16_t*)(WSB + WS_Z), 8192, 1.0f / (F8_HS * F8_WS), (float*)(WSB + WS_LNST)};
        pg8::gemm_phase<pg8::EpiBf16T<1>, pg8::StaticOrder, true, true, true>(lds, g, S, E); }
    xcd_barrier(xb); }
    REP(11) { PH(11) phase_sgu(LP, lds, TID, LANE, wid);
    xcd_barrier(xb); }
    PH(12) {   pg8::Gemm g{(const bf16_t*)(WSB + WS_SG), (const bf16_t*)(WSB + WS_WOUTO), NTOK, 2048, 2048, 2048, 2048, 0, 0}; pg8::StaticOrder S; S.init(NTOK, 2048, G, (int)blockIdx.x);
        pg8::EpiResidB<false> E{nullptr, (bf16_t*)(WSB + WS_XB), MODP + 2 * 12288 + 2 * 2048, (float*)(WSB + WS_ROWSQ) + (size_t)32 * NTOK, WSB + WS_X8, 1.0f / (F8_SGS * F8_WS)};
        pg8::gemm_phase<pg8::EpiResidB<false>, pg8::StaticOrder, true, true, true>(lds, g, S, E); }
    xcd_barrier(xb);
    REP(8) { PH(8) {   pg8::Gemm g{(const bf16_t*)(WSB + WS_X8), (const bf16_t*)(WSB + WS_WQF) + (size_t)2 * 2048 * 1024, NTOK, 2048, 1024, 1024, 1024, 0, (size_t)2048 * 1024}; pg8::StaticOrder S; S.init(NTOK, 2048, G, (int)blockIdx.x); S.pbs = 5;
        pg8::EpiQ E{(bf16_t*)(WSB + WS_QP), (const float*)(WSB + WS_ROWSQ) + (size_t)32 * NTOK, (const float*)(WSB + WS_BIASQ) + 2 * 2048, 1.0f / (F8_XS * F8_WS)};
        pg8::gemm_phase<pg8::EpiQ, pg8::StaticOrder, true, true, true>(lds, g, S, E); }
    xcd_barrier(xb); }
    REP(16) { PH(9) phase_peer_s1(LP, 1, lds, LANE, wid); }
    xcd_barrier(xb);
    REP(17) { PH(9) phase_peer_u(LP, 1, lds, LANE, wid, (int)xst[2]); }
    xcd_barrier(xb);
    REP(18) { PH(9) phase_peer_w(LP, 1, TID); }
    xcd_barrier(xb);
    REP(19) { PH(9) phase_peer_vs(LP, 1, lds, LANE, wid, (int)xst[2]); }
    xcd_barrier(xb);
    PH(9) phase_peer_norm<true>(LP, 1, LANE, wid);
}

#undef LP
#undef WSB
#undef MODP
#undef HP
extern "C" void kernel_launch(void* const* d_in, const int* in_sizes, int n_in, void* d_out, int out_size, void* d_ws, size_t ws_size, hipStream_t stream) {
    static int grid = 0;
    if (grid == 0) {
        if (n_in != 30 || out_size != NTOK * DMODEL || ws_size < WS_END) { fprintf(stderr, "kernel_launch: unexpected shapes (n_in %d out %d ws %zu, need ws >= %zu)\n", n_in, out_size, ws_size, (size_t)WS_END); grid = -1; return; }
        int dev = 0, cus = 0, per_cu = 0;
        (void)hipGetDevice(&dev); (void)hipDeviceGetAttribute(&cus, hipDeviceAttributeMultiprocessorCount, dev);
        if (hipFuncSetAttribute((const void*)mk_fwd, hipFuncAttributeMaxDynamicSharedMemorySize, LDS_BYTES) != hipSuccess) { fprintf(stderr, "kernel_launch: hipFuncSetAttribute failed\n"); grid = -1; return; }
        if (hipOccupancyMaxActiveBlocksPerMultiprocessor(&per_cu, (const void*)mk_fwd, 512, LDS_BYTES) != hipSuccess || per_cu < 1) { fprintf(stderr, "kernel_launch: occupancy query says %d\n", per_cu); (void)hipGetLastError(); per_cu = 1; }
        grid = cus;
        if (grid > cus * per_cu) grid = cus * per_cu;
        if (grid != 256) { fprintf(stderr, "kernel_launch: this kernel is laid out for a 256-CU device (got %d workgroups)\n", grid); grid = -1; return; }
    }
    if (grid < 0) return;
    if (hipMemsetAsync((char*)d_ws + WS_BAR, 0, 16384, stream) != hipSuccess) { fprintf(stderr, "kernel_launch: hipMemsetAsync failed\n"); return; }
    P p{};
    const float** pf = (const float**)&p;
    for (int i = 0; i < 30; ++i) pf[i] = (const float*)d_in[i];
    p.out = (float*)d_out; p.ws = (unsigned char*)d_ws;
    void* args[] = {&p};
    hipError_t e = hipLaunchCooperativeKernel((const void*)mk_fwd, dim3(grid), dim3(512), args, LDS_BYTES, stream);
    if (e != hipSuccess) fprintf(stderr, "kernel_launch: cooperative launch failed: %s (grid %d)\n", hipGetErrorString(e), grid);
}
```

```cpp
#include <hip/hip_runtime.h>
#include <hip/hip_cooperative_groups.h>
#include <hip/hip_bf16.h>
#include <cstdio>
#include <cstdint>
namespace cg = cooperative_groups;

__device__ __forceinline__ int lane_id_v() { int l; asm volatile("v_mbcnt_lo_u32_b32 %0, -1, 0\n\tv_mbcnt_hi_u32_b32 %0, -1, %0" : "=v"(l)); return l; }

namespace pg8 {
#define PG8_LAS __attribute__((address_space(3)))
typedef unsigned short bf16_t;
typedef short bf16x8 __attribute__((ext_vector_type(8)));
typedef float f32x4 __attribute__((ext_vector_type(4)));
typedef unsigned u32x4 __attribute__((ext_vector_type(4)));
constexpr int BM = 256, BK = 64, HALF = 128, HTB = HALF * BK * 2  , STAGE_BYTES = 8 * HTB, NXCD = 8, WGM = 8;

__host__ __device__ __forceinline__ int lds_byte(int r, int c) { const int st = (r >> 4) * 2 + (c >> 5), rr = r & 15, cc = c & 31, ob = rr * 64 + cc * 2; return st * 1024 + (ob ^ (((ob >> 9) & 1) << 5)); }
__host__ __device__ __forceinline__ void stage_rc(int b, int& R, int& C) { const int st = b / 1024, sb = b % 1024, swz = sb ^ (((sb >> 9) & 1) << 5); R = (st >> 1) * 16 + swz / 64; C = (st & 1) * 32 + (swz % 64) / 2; }
__host__ __device__ __forceinline__ int perm32(int rho) { const int n = rho >> 4, i = rho & 15; return 8 * (i >> 2) + 4 * n + (i & 3); }

struct Unit { int pm, pn, pb; };
struct Gemm { const bf16_t* A; const bf16_t* Bt; int M, N, K; int lda, ldb; size_t bsA, bsB; };

struct StaticOrder {
    int nM, nN, nwg, G, c, pbs;
    __host__ __device__ void init(int M, int N, int G_, int c_) { nM = M / BM; nN = N / BM; nwg = nM * nN; G = G_; c = c_; pbs = -1; }
    __host__ __device__ bool next(int i, Unit& u) const {
        const long L = (long)i * G + c; if (L >= nwg) return false;
        int wgid = (int)L; { const int q = nwg / NXCD, r = nwg % NXCD, xcd = wgid % NXCD, off = wgid / NXCD; wgid = (xcd < r ? xcd * (q + 1) : r * (q + 1) + (xcd - r) * q) + off; }
        const int nig = WGM * nN, gid = wgid / nig, fm = gid * WGM, gsz = (nM - fm) < WGM ? (nM - fm) : WGM;
        u.pm = fm + ((wgid % nig) % gsz); u.pn = (wgid % nig) / gsz; u.pb = pbs >= 0 ? (u.pm >> pbs) : 0; return true;
    }
    __device__ __forceinline__ void a_ready(const Unit&) const {}
    __device__ __forceinline__ void done(const Unit&) const {}
};

__device__ __forceinline__ unsigned cvt_pk_bf16(float lo, float hi) { unsigned r; asm volatile("v_cvt_pk_bf16_f32 %0, %1, %2" : "=v"(r) : "v"(lo), "v"(hi)); return r; }
typedef float f32x2 __attribute__((ext_vector_type(2)));

typedef int i32x8 __attribute__((ext_vector_type(8)));
typedef int i32x4v __attribute__((ext_vector_type(4)));
__device__ __forceinline__ void pg8_mfma_f8(f32x4& c, const i32x8& a, const i32x8& b, int sc) {
    asm("s_nop 1\n\tv_mfma_f32_16x16x128_f8f6f4 %0, %1, %2, %0" : "+v"(c) : "v"(a), "v"(b)); (void)sc; }
__device__ __forceinline__ void pg8_mfma_f8_drain(f32x4 (&acc)[2][2][4][2]) {
#pragma unroll
    for (int a = 0; a < 2; ++a)
#pragma unroll
        for (int b = 0; b < 2; ++b) {
            if (a == 0 && b == 0) asm volatile("s_nop 15\n\ts_nop 15" : "+v"(acc[a][b][0][0]), "+v"(acc[a][b][0][1]), "+v"(acc[a][b][1][0]), "+v"(acc[a][b][1][1]), "+v"(acc[a][b][2][0]), "+v"(acc[a][b][2][1]), "+v"(acc[a][b][3][0]), "+v"(acc[a][b][3][1]));
            else asm volatile("" : "+v"(acc[a][b][0][0]), "+v"(acc[a][b][0][1]), "+v"(acc[a][b][1][0]), "+v"(acc[a][b][1][1]), "+v"(acc[a][b][2][0]), "+v"(acc[a][b][2][1]), "+v"(acc[a][b][3][0]), "+v"(acc[a][b][3][1])); }
}
__device__ __forceinline__ i32x8 pg8_cat(bf16x8 a, bf16x8 b) { return __builtin_shufflevector(__builtin_bit_cast(i32x4v, a), __builtin_bit_cast(i32x4v, b), 0, 1, 2, 3, 4, 5, 6, 7); }
template <class Epi, class Sched, bool ALIGN_EPI = false, bool SP2 = false, bool F8 = false>
__device__ __forceinline__ void gemm_phase(PG8_LAS unsigned char* lds, const Gemm g, const Sched& S, const Epi& E) {
    int tid_o = threadIdx.x; asm volatile("" : "+v"(tid_o)); const int tid = tid_o, wid = __builtin_amdgcn_readfirstlane(tid >> 6), lane = tid & 63, wr = wid >> 2, wc = wid & 3, fr = lane & 15, fq = lane >> 4;
    const int K = g.K, nt = K / BK;
    unsigned voffA[2], voffB[2];
#pragma unroll
    for (int i = 0; i < 2; ++i) { int R, C; stage_rc(tid * 16 + i * 8192, R, C); const int Rb = Epi::PERM ? ((R & ~31) + perm32(R & 31)) : R;
        voffA[i] = (unsigned)(R * g.lda + C) * 2u; voffB[i] = (unsigned)(Rb * g.ldb + C) * 2u; }
    const size_t kstep = (size_t)(BK * 2);
    const size_t hstepA = (size_t)HALF * g.lda * 2, hstepB = (size_t)HALF * g.ldb * 2;
    const size_t tstepA = 2 * hstepA, tstepB = 2 * hstepB;
    const unsigned ldsw = (unsigned)wid * 1024u;
    const int aoff = lds_byte(wr * 64 + fr, fq * 8), boff = lds_byte(wc * 32 + fr, fq * 8);
#define PG8_SA(b, h) (((b) * 2 + (h)) * HTB)
#define PG8_SB(b, h) ((4 + (b) * 2 + (h)) * HTB)
#define PG8_STAGE(bufoff, gbase, voff) do { _Pragma("unroll") for (int _i = 0; _i < 2; ++_i) \
        __builtin_amdgcn_global_load_lds((const unsigned*)((const char*)(gbase) + (voff)[_i]), (PG8_LAS unsigned*)(lds + (bufoff) + ldsw + _i * 8192), 16, 0, 0); } while (0)
#define PG8_LDA(dst, b, h) do { _Pragma("unroll") for (int m = 0; m < 4; ++m) { dst[m].lo = *(const PG8_LAS i32x4v*)(lds + PG8_SA(b, h) + aoff + m * 2048); dst[m].hi = *(const PG8_LAS i32x4v*)(lds + PG8_SA(b, h) + aoff + m * 2048 + 1024); } } while (0)
#define PG8_LDB(dst, b, h) do { _Pragma("unroll") for (int n = 0; n < 2; ++n) { dst[n].lo = *(const PG8_LAS i32x4v*)(lds + PG8_SB(b, h) + boff + n * 2048); dst[n].hi = *(const PG8_LAS i32x4v*)(lds + PG8_SB(b, h) + boff + n * 2048 + 1024); } } while (0)
#define PG8_MMA(ai, bj, At, Bt) do { __builtin_amdgcn_s_setprio(1); \
        if constexpr (F8) { _Pragma("unroll") for (int m = 0; m < 4; ++m) _Pragma("unroll") for (int n = 0; n < 2; ++n) pg8_mfma_f8(acc[ai][bj][m][n], Bt[n], At[m], f8scale); } \
        else { _Pragma("unroll") for (int m = 0; m < 4; ++m) _Pragma("unroll") for (int n = 0; n < 2; ++n) { \
            const i32x4v b_lo = Bt[n].lo, b_hi = Bt[n].hi, a_lo = At[m].lo, a_hi = At[m].hi;     \
            acc[ai][bj][m][n] = __builtin_amdgcn_mfma_f32_16x16x32_bf16(__builtin_bit_cast(bf16x8, b_lo), __builtin_bit_cast(bf16x8, a_lo), acc[ai][bj][m][n], 0, 0, 0); \
            acc[ai][bj][m][n] = __builtin_amdgcn_mfma_f32_16x16x32_bf16(__builtin_bit_cast(bf16x8, b_hi), __builtin_bit_cast(bf16x8, a_hi), acc[ai][bj][m][n], 0, 0, 0); } } \
        __builtin_amdgcn_s_setprio(0); } while (0)
#define PG8_WAIT_V(n) asm volatile("s_waitcnt vmcnt(" #n ")" ::: "memory")
#define PG8_WAIT_L(n) asm volatile("s_waitcnt lgkmcnt(" #n ")" ::: "memory")
#define PG8_BAR __builtin_amdgcn_s_barrier()
#define PG8_SCHED __builtin_amdgcn_sched_barrier(0)
    Unit cur, nxt; int ui = 0;
    if (!S.next(0, cur)) return;
    f32x4 acc[2][2][4][2];
#pragma unroll
    for (int a = 0; a < 2; ++a)
#pragma unroll
        for (int b = 0; b < 2; ++b)
#pragma unroll
            for (int m = 0; m < 4; ++m)
#pragma unroll
                for (int n = 0; n < 2; ++n) acc[a][b][m][n] = (f32x4){0.f, 0.f, 0.f, 0.f};
    int f8scale = 0x7f7f7f7f; asm volatile("" : "+v"(f8scale));
    i32x8 At[4], B0[2], B1[2];
    const char* cA = (const char*)(g.A + (size_t)cur.pb * g.bsA) + (size_t)cur.pm * tstepA; const char* cB = (const char*)(g.Bt + (size_t)cur.pb * g.bsB) + (size_t)cur.pn * tstepB;
    S.a_ready(cur);
    if constexpr (SP2) {
        PG8_STAGE(PG8_SB(0, 0), cB, voffB); PG8_STAGE(PG8_SB(0, 1), cB + hstepB, voffB); PG8_STAGE(PG8_SA(0, 0), cA, voffA); PG8_STAGE(PG8_SA(0, 1), cA + hstepA, voffA);
        if (wr == 1) PG8_BAR;
        PG8_WAIT_V(2); PG8_BAR;
        PG8_STAGE(PG8_SB(1, 0), cB + kstep, voffB); PG8_STAGE(PG8_SA(1, 0), cA + kstep, voffA); PG8_STAGE(PG8_SB(1, 1), cB + hstepB + kstep, voffB);
        PG8_WAIT_V(6); PG8_BAR;
    } else {
        PG8_STAGE(PG8_SB(0, 0), cB, voffB); PG8_STAGE(PG8_SA(0, 0), cA, voffA); PG8_STAGE(PG8_SB(0, 1), cB + hstepB, voffB); PG8_STAGE(PG8_SA(0, 1), cA + hstepA, voffA);
        if (wr == 1) PG8_BAR;
        PG8_WAIT_V(4); PG8_BAR;
        PG8_STAGE(PG8_SB(1, 0), cB + kstep, voffB); PG8_STAGE(PG8_SA(1, 0), cA + kstep, voffA); PG8_STAGE(PG8_SB(1, 1), cB + hstepB + kstep, voffB);
        PG8_WAIT_V(6); PG8_BAR;
    }
    for (;;) {
        const bool has_next = S.next(ui + 1, nxt);
        const char* nA = has_next ? (const char*)(g.A + (size_t)nxt.pb * g.bsA) + (size_t)nxt.pm * tstepA : cA; const char* nB = has_next ? (const char*)(g.Bt + (size_t)nxt.pb * g.bsB) + (size_t)nxt.pn * tstepB : cB;
        for (int t = 0; t < nt; t += 2) {
            const bool last = (t == nt - 2);
            const char* a1 = cA + (size_t)(t + 1) * kstep;
            const char* a2 = last ? nA : cA + (size_t)(t + 2) * kstep; const char* b2 = last ? nB : cB + (size_t)(t + 2) * kstep;
            const char* a3 = a2 + kstep; const char* b3 = b2 + kstep;
            if (last && has_next) S.a_ready(nxt);
            if constexpr (SP2) {
            PG8_LDB(B0, 0, 0); PG8_LDB(B1, 0, 1); PG8_SCHED; PG8_LDA(At, 0, 0); PG8_STAGE(PG8_SA(1, 1), a1 + hstepA, voffA);
            PG8_WAIT_V(8); PG8_WAIT_L(0); PG8_BAR; PG8_MMA(0, 0, At, B0); PG8_MMA(0, 1, At, B1); PG8_BAR; PG8_SCHED;
            PG8_LDA(At, 0, 1); PG8_STAGE(PG8_SB(0, 0), b2, voffB); PG8_STAGE(PG8_SB(0, 1), b2 + hstepB, voffB); PG8_STAGE(PG8_SA(0, 0), a2, voffA);
            PG8_WAIT_V(8); PG8_WAIT_L(0); PG8_BAR; PG8_MMA(1, 0, At, B0); PG8_MMA(1, 1, At, B1); PG8_BAR; PG8_SCHED;
            PG8_LDB(B0, 1, 0); PG8_LDB(B1, 1, 1); PG8_SCHED; PG8_LDA(At, 1, 0); PG8_STAGE(PG8_SA(0, 1), a2 + hstepA, voffA);
            PG8_WAIT_V(8); PG8_WAIT_L(0); PG8_BAR; PG8_MMA(0, 0, At, B0); PG8_MMA(0, 1, At, B1); PG8_BAR; PG8_SCHED;
            PG8_LDA(At, 1, 1); PG8_STAGE(PG8_SB(1, 0), b3, voffB); PG8_STAGE(PG8_SB(1, 1), b3 + hstepB, voffB); PG8_STAGE(PG8_SA(1, 0), a3, voffA);
            PG8_WAIT_V(8); PG8_WAIT_L(0); PG8_BAR; PG8_MMA(1, 0, At, B0); PG8_MMA(1, 1, At, B1); PG8_BAR; PG8_SCHED;
            } else {
            PG8_LDB(B0, 0, 0); PG8_SCHED; PG8_LDA(At, 0, 0); PG8_STAGE(PG8_SA(1, 1), a1 + hstepA, voffA);
            PG8_WAIT_L(8); PG8_BAR; PG8_WAIT_L(0); PG8_MMA(0, 0, At, B0); PG8_BAR; PG8_SCHED;
            PG8_LDB(B1, 0, 1); PG8_STAGE(PG8_SB(0, 0), b2, voffB);
            PG8_BAR; PG8_WAIT_L(0); PG8_MMA(0, 1, At, B1); PG8_BAR;
            PG8_LDA(At, 0, 1); PG8_STAGE(PG8_SA(0, 0), a2, voffA);
            PG8_BAR; PG8_WAIT_L(0); PG8_MMA(1, 0, At, B0); PG8_BAR; PG8_SCHED;
            PG8_STAGE(PG8_SB(0, 1), b2 + hstepB, voffB);
            PG8_WAIT_V(6); PG8_BAR; PG8_MMA(1, 1, At, B1); PG8_BAR;
            PG8_LDB(B0, 1, 0); PG8_SCHED; PG8_LDA(At, 1, 0); PG8_STAGE(PG8_SA(0, 1), a2 + hstepA, voffA);
            PG8_WAIT_L(8); PG8_BAR; PG8_WAIT_L(0); PG8_MMA(0, 0, At, B0); PG8_BAR; PG8_SCHED;
            PG8_LDB(B1, 1, 1); PG8_STAGE(PG8_SB(1, 0), b3, voffB);
            PG8_BAR; PG8_WAIT_L(0); PG8_MMA(0, 1, At, B1); PG8_BAR;
            PG8_LDA(At, 1, 1); PG8_STAGE(PG8_SA(1, 0), a3, voffA);
            PG8_BAR; PG8_WAIT_L(0); PG8_MMA(1, 0, At, B0); PG8_BAR; PG8_SCHED;
            PG8_STAGE(PG8_SB(1, 1), b3 + hstepB, voffB);
            PG8_WAIT_V(6); PG8_BAR; PG8_MMA(1, 1, At, B1); PG8_BAR;
            }
        }
        if constexpr (ALIGN_EPI) { if (wr == 0) PG8_BAR; }
        if constexpr (F8) pg8_mfma_f8_drain(acc);
        if constexpr (!Epi::AFTER_DRAIN) { E(acc, cur, wr, wc, fr, fq); S.done(cur); }
        if (!has_next) break;
#pragma unroll
        for (int a = 0; a < 2; ++a)
#pragma unroll
            for (int b = 0; b < 2; ++b)
#pragma unroll
                for (int m = 0; m < 4; ++m)
#pragma unroll
                    for (int n = 0; n < 2; ++n) acc[a][b][m][n] = (f32x4){0.f, 0.f, 0.f, 0.f};
        cur = nxt; cA = nA; cB = nB; ++ui;
        if constexpr (ALIGN_EPI) { if (wr == 1) PG8_BAR; }
    }
    PG8_WAIT_V(0);
    if constexpr (!ALIGN_EPI) { if (wr == 0) PG8_BAR; }
    PG8_BAR;
    if constexpr (Epi::AFTER_DRAIN) { E.fused(acc, cur, wr, wc, fr, fq, lds, wid, lane); S.done(cur); }
#undef PG8_SA
#undef PG8_SB
#undef PG8_STAGE
#undef PG8_LDA
#undef PG8_LDB
#undef PG8_MMA
#undef PG8_WAIT_V
#undef PG8_WAIT_L
#undef PG8_BAR
#undef PG8_SCHED
}
}
namespace attn {
using bf16 = __hip_bfloat16;
constexpr int   D = 128, NW = 8, QBLK = 32, KVBLK = 64;
constexpr float SCALE = 0.088388347648318440f;
constexpr float THR = 8.f;
constexpr int SDEPTH = 2;
constexpr int LDQ = 1024, LDK = 256, LDO = 2048;
constexpr size_t SHM_V = KVBLK * D * 2, SHM_K = KVBLK * D * 2, SHM_ATTN = 2 * SHM_V + 2 * SHM_K + NW * 64 * 4;
using bf16x8 = __attribute__((ext_vector_type(8))) short;
using s16x4  = __attribute__((ext_vector_type(4))) short;
using f32x16 = __attribute__((ext_vector_type(16))) float;
using f32x8  = __attribute__((ext_vector_type(8))) float;
using u32x4  = __attribute__((ext_vector_type(4))) unsigned;
#define KSWZ(row, colB) ((row) * 256 + ((colB) ^ (((row) & 7) << 4)))
#define SBAR() __builtin_amdgcn_sched_barrier(0)
__device__ __forceinline__ int crow(int r, int hi) { return (r & 3) + 8 * (r >> 2) + 4 * hi; }
__device__ __forceinline__ unsigned cvtpk(float lo, float hi) {
  unsigned r; asm volatile("v_cvt_pk_bf16_f32 %0, %1, %2" : "=v"(r) : "v"(lo), "v"(hi)); return r;
}
template <typename TIn> struct Stage;
template <> struct Stage<bf16>  { using T = bf16x8;
  __device__ static __forceinline__ T ld8(const bf16* p) { return *reinterpret_cast<const bf16x8*>(p); }
  __device__ static __forceinline__ bf16x8 tobf(T x) { return x; } };
template <> struct Stage<float> { using T = f32x8;
  __device__ static __forceinline__ T ld8(const float* p) { return *reinterpret_cast<const f32x8*>(p); }
  __device__ static __forceinline__ bf16x8 tobf(T x) {
    u32x4 w = {cvtpk(x[0], x[1]), cvtpk(x[2], x[3]), cvtpk(x[4], x[5]), cvtpk(x[6], x[7])}; return *reinterpret_cast<bf16x8*>(&w); } };

__device__ __forceinline__ void partialSM(f32x16& p0, f32x16& p1, float& m_reg, float& mn, float& alpha) {
  constexpr float C = SCALE * 1.4426950408889634f;
  float pmax = p0[0]; for (int r = 1; r < 16; ++r) pmax = fmaxf(pmax, p0[r]); for (int r = 0; r < 16; ++r) pmax = fmaxf(pmax, p1[r]);
  { auto rr = __builtin_amdgcn_permlane32_swap(__float_as_uint(pmax), __float_as_uint(pmax), false, false);
    pmax = fmaxf(__uint_as_float(rr[0]), __uint_as_float(rr[1])); }
  if (__builtin_expect(__all(pmax - m_reg <= THR / SCALE), 1)) { mn = m_reg; alpha = 1.f; }
  else { mn = fmaxf(m_reg, pmax); alpha = __builtin_amdgcn_exp2f((m_reg - mn) * C); m_reg = mn; }
  float mnC = -mn * C;
  for (int r = 0; r < 16; ++r) p0[r] = fmaf(p0[r], C, mnC); for (int r = 0; r < 16; ++r) p1[r] = fmaf(p1[r], C, mnC);
  for (int r = 0; r < 16; ++r) p0[r] = __builtin_amdgcn_exp2f(p0[r]);
}
__device__ __forceinline__ void finishSM(f32x16& p0, f32x16& p1, float alpha, float& l_reg, bf16x8& pa0, bf16x8& pa1, bf16x8& pa2, bf16x8& pa3) {
  for (int r = 0; r < 16; ++r) p1[r] = __builtin_amdgcn_exp2f(p1[r]);
  float ps = 0; for (int r = 0; r < 16; ++r) ps += p0[r]; for (int r = 0; r < 16; ++r) ps += p1[r];
  { auto rr = __builtin_amdgcn_permlane32_swap(__float_as_uint(ps), __float_as_uint(ps), false, false);
    ps = __uint_as_float(rr[0]) + __uint_as_float(rr[1]); }
  l_reg = l_reg * alpha + ps;
#define PK4(P, BASE, OUT) do { unsigned a0 = cvtpk(P[BASE + 0], P[BASE + 1]), a1 = cvtpk(P[BASE + 2], P[BASE + 3]);   \
    unsigned b0 = cvtpk(P[BASE + 4], P[BASE + 5]), b1 = cvtpk(P[BASE + 6], P[BASE + 7]);                              \
    auto r0 = __builtin_amdgcn_permlane32_swap(a0, b0, false, false); auto r1 = __builtin_amdgcn_permlane32_swap(a1, b1, false, false); \
    u32x4 w = {r0[0], r1[0], r0[1], r1[1]}; OUT = *reinterpret_cast<bf16x8*>(&w); } while (0)
  PK4(p0, 0, pa0); PK4(p0, 8, pa1); PK4(p1, 0, pa2); PK4(p1, 8, pa3);
#undef PK4
}
__device__ __forceinline__ void qkt(f32x16& p0, f32x16& p1, const bf16* Ks, const bf16x8* qr, int r32, int hi) {
  p0 = f32x16{}; p1 = f32x16{};
  for (int d0 = 0; d0 < 8; ++d0) { int cb = (d0 * 16 + hi * 8) * 2;
    bf16x8 b0 = *reinterpret_cast<const bf16x8*>((const char*)Ks + KSWZ(r32, cb));
    bf16x8 b1 = *reinterpret_cast<const bf16x8*>((const char*)Ks + KSWZ(32 + r32, cb));
    p0 = __builtin_amdgcn_mfma_f32_32x32x16_bf16(b0, qr[d0], p0, 0, 0, 0);
    p1 = __builtin_amdgcn_mfma_f32_32x32x16_bf16(b1, qr[d0], p1, 0, 0, 0); }
}
__device__ __forceinline__ int v_st(int k, int c) { const int kk = (k & ~0xC) | ((k & 4) << 1) | ((k & 8) >> 1); return ((kk >> 3) * 4 + (c >> 5)) * 512 + ((kk & 7) * 32 + (c & 31)) * 2; }
__device__ __forceinline__ int v_rd_base(int lane) { return ((lane & 3) << 3) | (((lane >> 2) & 3) << 6) | (((lane >> 4) & 1) << 5) | (((lane >> 5) & 1) << 8); }
constexpr int v_rd_off(int d0, int ks, int half) { return d0 * 512 + ks * 4096 + half * 2048; }
template <int OFF> __device__ __forceinline__ s16x4 tr_read(int vb) {
  s16x4 r; asm volatile("ds_read_b64_tr_b16 %0, %1 offset:%2" : "=&v"(r) : "v"(vb), "i"(OFF) : "memory"); return r;
}
template <int D0> __device__ __forceinline__ void pv_one(f32x16& od, int vb, bf16x8 pa0, bf16x8 pa1, bf16x8 pa2, bf16x8 pa3) {
  const s16x4 l0 = tr_read<v_rd_off(D0, 0, 0)>(vb), h0 = tr_read<v_rd_off(D0, 0, 1)>(vb), l1 = tr_read<v_rd_off(D0, 1, 0)>(vb), h1 = tr_read<v_rd_off(D0, 1, 1)>(vb);
  const s16x4 l2 = tr_read<v_rd_off(D0, 2, 0)>(vb), h2 = tr_read<v_rd_off(D0, 2, 1)>(vb), l3 = tr_read<v_rd_off(D0, 3, 0)>(vb), h3 = tr_read<v_rd_off(D0, 3, 1)>(vb);
  asm volatile("s_waitcnt lgkmcnt(0)" ::: "memory"); SBAR();
#define PK(L, H) (bf16x8){L[0], L[1], L[2], L[3], H[0], H[1], H[2], H[3]}
  od = __builtin_amdgcn_mfma_f32_32x32x16_bf16(pa0, PK(l0, h0), od, 0, 0, 0);
  od = __builtin_amdgcn_mfma_f32_32x32x16_bf16(pa1, PK(l1, h1), od, 0, 0, 0);
  od = __builtin_amdgcn_mfma_f32_32x32x16_bf16(pa2, PK(l2, h2), od, 0, 0, 0);
  od = __builtin_amdgcn_mfma_f32_32x32x16_bf16(pa3, PK(l3, h3), od, 0, 0, 0);
#undef PK
}
__device__ __forceinline__ void pv_d0(f32x16* o, int vb, bf16x8 pa0, bf16x8 pa1, bf16x8 pa2, bf16x8 pa3) {
  pv_one<0>(o[0], vb, pa0, pa1, pa2, pa3); pv_one<1>(o[1], vb, pa0, pa1, pa2, pa3); pv_one<2>(o[2], vb, pa0, pa1, pa2, pa3); pv_one<3>(o[3], vb, pa0, pa1, pa2, pa3);
}

template <typename TQ>
__device__ __forceinline__ void attn_dense_body(const TQ* __restrict__ Qb, const bf16* __restrict__ Kh, const bf16* __restrict__ Vh,
                                                unsigned char* __restrict__ Ob, int seq, char* lds) {
  using St = Stage<bf16>; using SQ = Stage<TQ>;
  int tid_o = threadIdx.x; asm volatile("" : "+v"(tid_o)); const int tid = tid_o, wid = tid >> 6, lane = tid & 63, r32 = lane & 31, hi = lane >> 5;
  bf16* V_lds = (bf16*)lds; bf16* K_lds = (bf16*)(lds + 2 * SHM_V);
  float* ws = (float*)(lds + 2 * SHM_V + 2 * SHM_K) + wid * 64; float* li_l = ws; float* al_l = ws + 32;
  float m_reg = -1e30f, l_reg = 0; f32x16 o[4] = {}; bf16x8 qr[8];
  const TQ* Qw = Qb + (long)(wid * QBLK + r32) * LDQ + hi * 8;
#pragma unroll
  for (int d0 = 0; d0 < 8; ++d0) qr[d0] = SQ::tobf(SQ::ld8(Qw + d0 * 16));
  const int sr = tid >> 4, sc = (tid & 15) * 8, vst0 = v_st(sr, sc), vst1 = v_st(32 + sr, sc);
  const int vb0 = (int)(uintptr_t)V_lds + v_rd_base(lane);
  struct { typename St::T vs0, vs1, ks0, ks1; } sr_[SDEPTH];
#define SLOAD(i, k0) do { sr_[i].vs0 = St::ld8(&Vh[(long)((k0) + sr) * LDK + sc]); sr_[i].vs1 = St::ld8(&Vh[(long)((k0) + 32 + sr) * LDK + sc]); \
    sr_[i].ks0 = St::ld8(&Kh[(long)((k0) + sr) * LDK + sc]); sr_[i].ks1 = St::ld8(&Kh[(long)((k0) + 32 + sr) * LDK + sc]); } while (0)
#define SWRITE(b, i) do { *(bf16x8*)((char*)V_lds + (b) * SHM_V + vst0) = St::tobf(sr_[i].vs0);          \
    *(bf16x8*)((char*)V_lds + (b) * SHM_V + vst1) = St::tobf(sr_[i].vs1); int kc = sc * 2;               \
    *(bf16x8*)((char*)K_lds + (b) * SHM_K + KSWZ(sr, kc)) = St::tobf(sr_[i].ks0);                       \
    *(bf16x8*)((char*)K_lds + (b) * SHM_K + KSWZ(32 + sr, kc)) = St::tobf(sr_[i].ks1); } while (0)
#define SWAIT() do { if constexpr (SDEPTH == 2) asm volatile("s_waitcnt vmcnt(4)" ::: "memory"); else asm volatile("s_waitcnt vmcnt(0)" ::: "memory"); } while (0)
#define RESC(a) do { if (__any((a) < 1.f)) { if (hi == 0) al_l[r32] = (a); asm volatile("s_waitcnt lgkmcnt(0)" ::: "memory"); \
    for (int d = 0; d < 4; ++d) for (int r = 0; r < 16; ++r) o[d][r] *= al_l[crow(r, hi)]; } } while (0)
  f32x16 pA0, pA1, pB0, pB1; float mnA, mnB, alA, alB; bf16x8 pa0, pa1, pa2, pa3; const int NT = seq / KVBLK;
  constexpr int SE = 0, SO = SDEPTH - 1;
  SLOAD(SE, 0); asm volatile("s_waitcnt vmcnt(0)" ::: "memory"); SWRITE(0, SE); __syncthreads();
  qkt(pA0, pA1, K_lds, qr, r32, hi); partialSM(pA0, pA1, m_reg, mnA, alA);
  SLOAD(SO, KVBLK); if constexpr (SDEPTH == 2) { if (2 < NT) SLOAD(SE, 2 * KVBLK); }
  SWAIT(); SWRITE(1, SO); __syncthreads();
  for (int j = 1; j + 1 < NT; j += 2) {
    SBAR(); qkt(pB0, pB1, (bf16*)((char*)K_lds + SHM_K), qr, r32, hi);
    finishSM(pA0, pA1, alA, l_reg, pa0, pa1, pa2, pa3); SBAR();
    SLOAD(SO, (j + SDEPTH) * KVBLK); SBAR();
    pv_d0(o, vb0, pa0, pa1, pa2, pa3); partialSM(pB0, pB1, m_reg, mnB, alB);
    __syncthreads(); SWAIT(); SWRITE(0, SE);
    RESC(alB); __syncthreads();
    SBAR(); qkt(pA0, pA1, K_lds, qr, r32, hi);
    finishSM(pB0, pB1, alB, l_reg, pa0, pa1, pa2, pa3); SBAR();
    if (SDEPTH == 1 || j + 3 < NT) SLOAD(SE, (j + 1 + SDEPTH) * KVBLK); SBAR();
    pv_d0(o, vb0 + (int)SHM_V, pa0, pa1, pa2, pa3); partialSM(pA0, pA1, m_reg, mnA, alA);
    __syncthreads(); SWAIT(); SWRITE(1, SO);
    RESC(alA); __syncthreads();
  }
  SBAR(); qkt(pB0, pB1, (bf16*)((char*)K_lds + SHM_K), qr, r32, hi);
  finishSM(pA0, pA1, alA, l_reg, pa0, pa1, pa2, pa3); SBAR();
  pv_d0(o, vb0, pa0, pa1, pa2, pa3); partialSM(pB0, pB1, m_reg, mnB, alB);
  __syncthreads(); RESC(alB);
  finishSM(pB0, pB1, alB, l_reg, pa0, pa1, pa2, pa3); SBAR();
  pv_d0(o, vb0 + (int)SHM_V, pa0, pa1, pa2, pa3);
  if (hi == 0) li_l[r32] = l_reg; asm volatile("s_waitcnt lgkmcnt(0)" ::: "memory");
  float rli[16];
#pragma unroll
  for (int r = 0; r < 16; ++r) rli[r] = __builtin_amdgcn_rcpf(li_l[crow(r, hi)]);
  unsigned char* Ow = Ob + (long)(wid * QBLK) * LDO;
#pragma unroll
  for (int r = 0; r < 16; ++r) { int orow = crow(r, hi);
    for (int d0 = 0; d0 < 4; ++d0) Ow[(long)orow * LDO + d0 * 32 + r32] = (unsigned char)(__builtin_amdgcn_cvt_pk_fp8_f32(__builtin_amdgcn_fmed3f(o[d0][r] * rli[r] * 16.0f, -440.f, 440.f), 0.f, 0, false) & 0xff); }
#undef SLOAD
#undef SWRITE
#undef SWAIT
#undef RESC
}
#undef KSWZ
#undef SBAR
}

#define LAS __attribute__((address_space(3)))
typedef unsigned short bf16_t;
typedef short bf16x8 __attribute__((ext_vector_type(8)));
typedef float f32x4 __attribute__((ext_vector_type(4)));
typedef float f32x2 __attribute__((ext_vector_type(2)));
typedef float f32x16 __attribute__((ext_vector_type(16)));
typedef unsigned u32x4 __attribute__((ext_vector_type(4)));
typedef unsigned u32x2 __attribute__((ext_vector_type(2)));

constexpr int NTOK = 16384, DMODEL = 2048, SEQL = 8192;
constexpr size_t MiB = 1u << 20;
constexpr size_t WS_MOD = 0;
constexpr size_t WS_BAR = 512 * 1024;
constexpr size_t WS_S5A = 1 * MiB;
constexpr size_t WS_LNST = 296 * MiB;
constexpr size_t WS_ABT = 2 * MiB;
constexpr size_t WS_BIASQ = 2 * MiB + 64 * 1024;
constexpr size_t WS_ROWSQ = 336 * MiB;
constexpr size_t WS_BIASP = 340 * MiB;
constexpr size_t WS_WQF = 304 * MiB;
constexpr size_t WS_KEYS = 4 * MiB;
constexpr size_t WS_WSB = 5 * MiB;
constexpr size_t WS_WINE = 6 * MiB;
constexpr size_t WS_WOUTE = 16 * MiB;
constexpr size_t WS_WINO = 24 * MiB;
constexpr size_t WS_WOUTO = 56 * MiB;
constexpr size_t WS_WQ = 72 * MiB;
constexpr size_t WS_PU = 88 * MiB;
constexpr size_t WS_PV = 152 * MiB;
constexpr size_t WS_PSC = 5 * MiB + 512 * 1024;
constexpr int PEER_ROWB = 1536;
constexpr bool PEER_SLICE_U = true, PEER_SLICE_V = true;
typedef unsigned u32x6 __attribute__((ext_vector_type(6)));
typedef float f32x16 __attribute__((ext_vector_type(16)));
typedef float f32x32 __attribute__((ext_vector_type(32)));
typedef _Float16 h16x2 __attribute__((ext_vector_type(2)));
typedef _Float16 h16x32 __attribute__((ext_vector_type(32)));
constexpr size_t WS_WY = 216 * MiB;
constexpr size_t WS_WSUM = 232 * MiB;
constexpr size_t WS_H8 = 256 * MiB;
constexpr size_t WS_H = 344 * MiB;
constexpr size_t WS_XB = WS_H;
constexpr size_t WS_TMP = 408 * MiB;
constexpr size_t WS_AB = WS_TMP  , WS_Q = WS_TMP + 64 * MiB, WS_K = WS_TMP + 96 * MiB, WS_V = WS_TMP + 104 * MiB,
                 WS_SS = WS_TMP + 112 * MiB  , WS_CAT = WS_TMP + 176 * MiB;
constexpr size_t WS_Z = WS_TMP, WS_SG = WS_TMP + 256 * MiB;
constexpr size_t WS_QP = WS_TMP;
constexpr size_t WS_X8 = WS_TMP + 64 * MiB;
constexpr size_t WS_RSTD = WS_TMP + 64 * MiB;
constexpr size_t WS_EID = WS_TMP + 128 * MiB;
constexpr size_t WS_GATE = WS_TMP + 136 * MiB;
constexpr size_t WS_PW = WS_TMP + 144 * MiB;
constexpr size_t WS_PO = WS_TMP + 152 * MiB;
constexpr size_t WS_PACT = WS_TMP + 216 * MiB;
typedef unsigned u32x16 __attribute__((ext_vector_type(16)));
typedef __bf16 bf16x2v __attribute__((ext_vector_type(2)));
constexpr size_t WS_END = WS_TMP + 384 * MiB;
constexpr int LDS_BYTES = 147456;

struct P {
    const float *x, *c, *ada_w, *ada_b, *norm_g, *even_w_in, *even_w_out, *lam_re, *lam_im, *log_dt, *b_re, *b_im, *c_re, *c_im, *s5_d, *glu_w, *glu_b,
        *q_g, *k_g, *odd_w_in, *odd_w_out, *sgu_ln_g, *sgu_w, *sgu_b, *peer_wq, *peer_k1, *peer_k2, *peer_u, *peer_v, *final_g;
    float* out; unsigned char* ws;
};

__device__ __forceinline__ unsigned cvtpk(float lo, float hi) { unsigned r; asm("v_cvt_pk_bf16_f32 %0, %1, %2" : "=v"(r) : "v"(lo), "v"(hi)); return r; }
__device__ __forceinline__ unsigned pk_fp8x4(float a, float b, float c, float d) {
    a = __builtin_amdgcn_fmed3f(a, -440.f, 440.f); b = __builtin_amdgcn_fmed3f(b, -440.f, 440.f); c = __builtin_amdgcn_fmed3f(c, -440.f, 440.f); d = __builtin_amdgcn_fmed3f(d, -440.f, 440.f);
    int w = 0; w = __builtin_amdgcn_cvt_pk_fp8_f32(a, b, w, false); w = __builtin_amdgcn_cvt_pk_fp8_f32(c, d, w, true); return (unsigned)w; }
constexpr float F8_WS = 64.0f, F8_HS = 8.0f, F8_SGS = 8.0f, F8_CS = 16.0f, F8_XS = 8.0f;
__device__ __forceinline__ float bflo(unsigned w) { return __uint_as_float(w << 16); }
__device__ __forceinline__ float bfhi(unsigned w) { return __uint_as_float(w & 0xffff0000u); }
__device__ __forceinline__ float wave_sum(float v) {
    v += __uint_as_float(__builtin_amdgcn_update_dpp(0u, __float_as_uint(v), 0xB1, 0xF, 0xF, true));
    v += __uint_as_float(__builtin_amdgcn_update_dpp(0u, __float_as_uint(v), 0x4E, 0xF, 0xF, true));
    v += __uint_as_float(__builtin_amdgcn_update_dpp(0u, __float_as_uint(v), 0x141, 0xF, 0xF, true));
    v += __uint_as_float(__builtin_amdgcn_update_dpp(0u, __float_as_uint(v), 0x140, 0xF, 0xF, true));
    { const auto r = __builtin_amdgcn_permlane16_swap(__float_as_uint(v), __float_as_uint(v), false, false); v = __uint_as_float(r[0]) + __uint_as_float(r[1]); }
    { const auto r = __builtin_amdgcn_permlane32_swap(__float_as_uint(v), __float_as_uint(v), false, false); v = __uint_as_float(r[0]) + __uint_as_float(r[1]); }
    return v;
}
__device__ __forceinline__ float row16_sum(float v) {
    v += __uint_as_float(__builtin_amdgcn_update_dpp(0u, __float_as_uint(v), 0xB1, 0xF, 0xF, true));
    v += __uint_as_float(__builtin_amdgcn_update_dpp(0u, __float_as_uint(v), 0x4E, 0xF, 0xF, true));
    v += __uint_as_float(__builtin_amdgcn_update_dpp(0u, __float_as_uint(v), 0x141, 0xF, 0xF, true));
    v += __uint_as_float(__builtin_amdgcn_update_dpp(0u, __float_as_uint(v), 0x140, 0xF, 0xF, true));
    return v;
}
__device__ __forceinline__ float xrow_sum(float v) {
    { const auto r = __builtin_amdgcn_permlane16_swap(__float_as_uint(v), __float_as_uint(v), false, false); v = __uint_as_float(r[0]) + __uint_as_float(r[1]); }
    { const auto r = __builtin_amdgcn_permlane32_swap(__float_as_uint(v), __float_as_uint(v), false, false); v = __uint_as_float(r[0]) + __uint_as_float(r[1]); }
    return v;
}
__device__ __forceinline__ float sigmoid_f(float x) { return __builtin_amdgcn_rcpf(1.f + __expf(-x)); }
__device__ __forceinline__ float gelu_t(float x) { const float u = 0.7978845608028654f * (x + 0.044715f * x * x * x); return x * __builtin_amdgcn_rcpf(1.f + __expf(-2.f * u)); }
__device__ __forceinline__ void sincos_rad(float ang, float& sn, float& cs) {
    float rev = ang * 0.15915494309189535f; rev = rev - floorf(rev);
    sn = __builtin_amdgcn_sinf(rev); cs = __builtin_amdgcn_cosf(rev);
}
__device__ __forceinline__ float dot4(f32x4 a, f32x4 b) { return (a.x * b.x + a.y * b.y) + (a.z * b.z + a.w * b.w); }
#define LDS_WAIT() asm volatile("s_waitcnt lgkmcnt(0)" ::: "memory")

namespace pg8 {
constexpr int NTOK_ = 16384;
struct EpiEvenSplit {
    static constexpr bool PERM = true, AFTER_DRAIN = false;
    float ds; unsigned char* wsb;
    __device__ __forceinline__ void operator()(const f32x4 (&acc)[2][2][4][2], const Unit& u, int wr, int wc, int fr, int fq) const {
        { const int l_ = lane_id_v(); fr = l_ & 15; fq = l_ >> 4; }
        const int row0 = u.pm * BM + wr * 64 + fr; const int pn = u.pn;
        bf16_t* const UA = (bf16_t*)(wsb + WS_AB);
        if (pn < 4) {
#pragma unroll
            for (int ai = 0; ai < 2; ++ai)
#pragma unroll
                for (int m = 0; m < 4; ++m) { const int t = row0 + ai * HALF + m * 16;
#pragma unroll
                    for (int bj = 0; bj < 2; ++bj) { const int c = pn * 256 + bj * HALF + wc * 32 + 8 * fq; const f32x4 v0 = acc[ai][bj][m][0] * ds, v1 = acc[ai][bj][m][1] * ds;
                        u32x4 w; w.x = cvt_pk_bf16(v0[0], v0[1]); w.y = cvt_pk_bf16(v0[2], v0[3]); w.z = cvt_pk_bf16(v1[0], v1[1]); w.w = cvt_pk_bf16(v1[2], v1[3]);
                        *(u32x4*)(UA + ((size_t)(c >> 4) * 1024 + (t >> 4)) * 512 + (t & 15) * 16 + (c & 15)) = w; } }
            return;
        }
        bf16_t* base; int ldc, colt;
        if (pn < 8) { base = (bf16_t*)(wsb + WS_Q); ldc = 1024; colt = (pn - 4) * 256; } else { base = (bf16_t*)(wsb + (pn == 8 ? WS_K : WS_V)); ldc = 256; colt = 0; }
        const int col0 = colt + wc * 32 + 8 * fq;
#pragma unroll
        for (int ai = 0; ai < 2; ++ai)
#pragma unroll
            for (int m = 0; m < 4; ++m) { bf16_t* rowp = base + (size_t)(row0 + ai * HALF + m * 16) * ldc + col0;
#pragma unroll
                for (int bj = 0; bj < 2; ++bj) { const f32x4 v0 = acc[ai][bj][m][0] * ds, v1 = acc[ai][bj][m][1] * ds;
                    u32x4 w; w.x = cvt_pk_bf16(v0[0], v0[1]); w.y = cvt_pk_bf16(v0[2], v0[3]); w.z = cvt_pk_bf16(v1[0], v1[1]); w.w = cvt_pk_bf16(v1[2], v1[3]);
                    *(u32x4*)(rowp + bj * HALF) = w; } }
    }
};
template <int ACT> struct EpiBf16T {
    static constexpr bool PERM = true, AFTER_DRAIN = false;
    bf16_t* O; int ldc; float ds; float* lnst;
    __device__ __forceinline__ void operator()(const f32x4 (&acc)[2][2][4][2], const Unit& u, int wr, int wc, int fr, int fq) const {
        { const int l_ = lane_id_v(); fr = l_ & 15; fq = l_ >> 4; }
        const int row0 = u.pm * BM + wr * 64 + fr, col0 = u.pn * BM + wc * 32 + 8 * fq;
        const bool do_st = (ACT == 1) && lnst != nullptr && u.pn >= 16;
#pragma unroll
        for (int ai = 0; ai < 2; ++ai)
#pragma unroll
            for (int m = 0; m < 4; ++m) { const int trow = row0 + ai * HALF + m * 16;
                bf16_t* rowp = (ACT == 1) ? O + ((size_t)((trow >> 7) * 16 + (col0 >> 9)) * 128 + (trow & 127)) * 512 + (col0 & 511) : O + (size_t)trow * ldc + col0; float s1 = 0.f, s2 = 0.f;
#pragma unroll
                for (int bj = 0; bj < 2; ++bj) { f32x4 v0 = acc[ai][bj][m][0] * ds, v1 = acc[ai][bj][m][1] * ds;
                    if (ACT == 1) {
#pragma unroll
                        for (int e = 0; e < 4; ++e) { v0[e] = gelu_t(v0[e]); v1[e] = gelu_t(v1[e]); s1 += v0[e] + v1[e]; s2 += v0[e] * v0[e] + v1[e] * v1[e]; } }
                    u32x4 w; w.x = cvt_pk_bf16(v0[0], v0[1]); w.y = cvt_pk_bf16(v0[2], v0[3]); w.z = cvt_pk_bf16(v1[0], v1[1]); w.w = cvt_pk_bf16(v1[2], v1[3]);
                    *(u32x4*)(rowp + bj * HALF) = w; }
                if (ACT == 1) { if (do_st) {
                    s1 = xrow_sum(s1); s2 = xrow_sum(s2);
                    if (fq == 0) *(f32x2*)(lnst + ((size_t)((u.pn - 16) * 4 + wc) * NTOK_ + (row0 + ai * HALF + m * 16)) * 2) = (f32x2){s1, s2}; } }
            }
    }
};
struct EpiResid {
    static constexpr bool PERM = false, AFTER_DRAIN = false;
    const float* xin; float* xout; const float* gate; float ds;
    __device__ __forceinline__ void operator()(const f32x4 (&acc)[2][2][4][2], const Unit& u, int wr, int wc, int fr, int fq) const {
        { const int l_ = lane_id_v(); fr = l_ & 15; fq = l_ >> 4; }
        const int row0 = u.pm * BM + wr * 64 + fr, col0 = u.pn * BM + wc * 32 + 4 * fq;
        const float* gp = gate + (size_t)((u.pm * BM) >> 13) * 12288 + col0;
        f32x4 gv[2][2];
#pragma unroll
        for (int bj = 0; bj < 2; ++bj)
#pragma unroll
            for (int n = 0; n < 2; ++n) gv[bj][n] = *(const f32x4*)(gp + bj * HALF + n * 16) * ds;
#pragma unroll
        for (int ai = 0; ai < 2; ++ai)
#pragma unroll
            for (int m = 0; m < 4; ++m) { const size_t off = (size_t)(row0 + ai * HALF + m * 16) * 2048 + col0;
#pragma unroll
                for (int bj = 0; bj < 2; ++bj)
#pragma unroll
                    for (int n = 0; n < 2; ++n) { const f32x4 xi = *(const f32x4*)(xin + off + bj * HALF + n * 16);
                        *(f32x4*)(xout + off + bj * HALF + n * 16) = xi + gv[bj][n] * acc[ai][bj][m][n]; } }
    }
};
struct EpiF32B {
    static constexpr bool PERM = false, AFTER_DRAIN = false;
    float* C; int ldc; size_t bs;
    __device__ __forceinline__ void operator()(const f32x4 (&acc)[2][2][4][2], const Unit& u, int wr, int wc, int fr, int fq) const {
        { const int l_ = lane_id_v(); fr = l_ & 15; fq = l_ >> 4; }
        char* base = (char*)(C + (size_t)u.pb * bs + (size_t)(u.pm * BM) * ldc);
        const unsigned off0 = (unsigned)((wr * 64 + fr) * ldc + u.pn * BM + wc * 32 + 4 * fq) * 4u;
#pragma unroll
        for (int ai = 0; ai < 2; ++ai)
#pragma unroll
            for (int m = 0; m < 4; ++m) { const unsigned off = off0 + (unsigned)((ai * HALF + m * 16) * ldc) * 4u;
#pragma unroll
                for (int bj = 0; bj < 2; ++bj)
#pragma unroll
                    for (int n = 0; n < 2; ++n) *(f32x4*)(base + off + (bj * HALF + n * 16) * 4) = acc[ai][bj][m][n]; }
    }
};
struct EpiS5Glu {
    static constexpr bool PERM = false, AFTER_DRAIN = false;
    unsigned char* CAT; const PG8_LAS float* wl;
    __device__ __forceinline__ void operator()(const f32x4 (&acc)[2][2][4][2], const Unit& u, int wr, int wc, int fr, int fq) const {
        { const int l_ = lane_id_v(); fr = l_ & 15; fq = l_ >> 4; }
        const int g = u.pb;
#pragma unroll
        for (int ai = 0; ai < 2; ++ai)
#pragma unroll
            for (int m = 0; m < 4; ++m) {
                const int chunk = u.pm * BM + ai * HALF + wr * 64 + m * 16 + fr, token = chunk * 16 + wc * 4 + fq;
                float y[16];
#pragma unroll
                for (int bj = 0; bj < 2; ++bj)
#pragma unroll
                    for (int n = 0; n < 2; ++n)
#pragma unroll
                        for (int j = 0; j < 4; ++j) y[8 * bj + 4 * n + j] = gelu_t(acc[ai][bj][m][n][j]);
                f32x4 z[4];
#pragma unroll
                for (int kq = 0; kq < 4; ++kq) z[kq] = *(const PG8_LAS f32x4*)(wl + 256 + 4 * kq);
#pragma unroll
                for (int h = 0; h < 16; ++h)
#pragma unroll
                    for (int kq = 0; kq < 4; ++kq) z[kq] += *(const PG8_LAS f32x4*)(wl + h * 16 + 4 * kq) * y[h];
                float o[16];
#pragma unroll
                for (int k = 0; k < 16; ++k) o[k] = y[k] * sigmoid_f(z[k >> 2][k & 3]);
                u32x4 w; w.x = pk_fp8x4(o[0] * F8_CS, o[1] * F8_CS, o[2] * F8_CS, o[3] * F8_CS); w.y = pk_fp8x4(o[4] * F8_CS, o[5] * F8_CS, o[6] * F8_CS, o[7] * F8_CS);
                w.z = pk_fp8x4(o[8] * F8_CS, o[9] * F8_CS, o[10] * F8_CS, o[11] * F8_CS); w.w = pk_fp8x4(o[12] * F8_CS, o[13] * F8_CS, o[14] * F8_CS, o[15] * F8_CS);
                *(u32x4*)(CAT + (size_t)token * 2048 + g * 16) = w;
                asm volatile("" ::: "memory");
            }
    }
};
template <bool FIRST> struct EpiResidB {
    static constexpr bool PERM = true, AFTER_DRAIN = false;
    const float* xin; bf16_t* xb; const float* gate; float* rowsq; unsigned char* x8; float ds;
    __device__ __forceinline__ void operator()(const f32x4 (&acc)[2][2][4][2], const Unit& u, int wr, int wc, int fr, int fq) const {
        { const int l_ = lane_id_v(); fr = l_ & 15; fq = l_ >> 4; }
        const int row0 = u.pm * BM + wr * 64 + fr, col0 = u.pn * BM + wc * 32 + 8 * fq;
        const float* gp = gate + (size_t)((u.pm * BM) >> 13) * 12288 + col0; float* const rq = rowsq;
        f32x4 gv[2][2];
#pragma unroll
        for (int bj = 0; bj < 2; ++bj)
#pragma unroll
            for (int n = 0; n < 2; ++n) gv[bj][n] = *(const f32x4*)(gp + bj * HALF + n * 4) * ds;
#pragma unroll
        for (int ai = 0; ai < 2; ++ai) {
            f32x4 xi[4][2][2];
#pragma unroll
            for (int m = 0; m < 4; ++m) { const size_t off = (size_t)(row0 + ai * HALF + m * 16) * 2048 + col0;
#pragma unroll
                for (int bj = 0; bj < 2; ++bj) {
                    if (FIRST) { xi[m][bj][0] = *(const f32x4*)(xin + off + bj * HALF); xi[m][bj][1] = *(const f32x4*)(xin + off + bj * HALF + 4); }
                    else { const u32x4 w = *(const u32x4*)(xb + off + bj * HALF);
                        xi[m][bj][0] = (f32x4){__uint_as_float(w.x << 16), __uint_as_float(w.x & 0xffff0000u), __uint_as_float(w.y << 16), __uint_as_float(w.y & 0xffff0000u)};
                        xi[m][bj][1] = (f32x4){__uint_as_float(w.z << 16), __uint_as_float(w.z & 0xffff0000u), __uint_as_float(w.w << 16), __uint_as_float(w.w & 0xffff0000u)}; } } }
            asm volatile("" ::: "memory");
#pragma unroll
            for (int m = 0; m < 4; ++m) { const int row = row0 + ai * HALF + m * 16; const size_t off = (size_t)row * 2048 + col0; float ss = 0.f;
#pragma unroll
                for (int bj = 0; bj < 2; ++bj) { const f32x4 x0 = xi[m][bj][0] + gv[bj][0] * acc[ai][bj][m][0], x1 = xi[m][bj][1] + gv[bj][1] * acc[ai][bj][m][1];
                    ss += ((x0[0] * x0[0] + x0[1] * x0[1]) + (x0[2] * x0[2] + x0[3] * x0[3])) + ((x1[0] * x1[0] + x1[1] * x1[1]) + (x1[2] * x1[2] + x1[3] * x1[3]));
                    u32x4 o; o.x = cvt_pk_bf16(x0[0], x0[1]); o.y = cvt_pk_bf16(x0[2], x0[3]); o.z = cvt_pk_bf16(x1[0], x1[1]); o.w = cvt_pk_bf16(x1[2], x1[3]); *(u32x4*)(xb + off + bj * HALF) = o;
                    u32x2 o8; o8.x = pk_fp8x4(x0[0] * F8_XS, x0[1] * F8_XS, x0[2] * F8_XS, x0[3] * F8_XS); o8.y = pk_fp8x4(x1[0] * F8_XS, x1[1] * F8_XS, x1[2] * F8_XS, x1[3] * F8_XS); *(u32x2*)(x8 + off + bj * HALF) = o8; }
                ss = xrow_sum(ss);
                if (fq == 0) rq[(size_t)(u.pn * 4 + wc) * NTOK_ + row] = ss; }
        }
    }
};
struct EpiQ {
    static constexpr bool PERM = true, AFTER_DRAIN = false;
    bf16_t* O; const float* rowsq; const float* bias; float ds;
    __device__ __forceinline__ void operator()(const f32x4 (&acc)[2][2][4][2], const Unit& u, int wr, int wc, int fr, int fq) const {
        { const int l_ = lane_id_v(); fr = l_ & 15; fq = l_ >> 4; }
        const int row0 = u.pm * BM + wr * 64 + fr, col0 = u.pn * BM + wc * 32 + 8 * fq;
        const float* bp = bias + (size_t)((u.pm * BM) >> 13) * 2048 + col0;
        f32x4 bv[2][2];
#pragma unroll
        for (int bj = 0; bj < 2; ++bj)
#pragma unroll
            for (int n = 0; n < 2; ++n) bv[bj][n] = *(const f32x4*)(bp + bj * HALF + 4 * n);
        float rstd[2][4];
#pragma unroll
        for (int ai = 0; ai < 2; ++ai)
#pragma unroll
            for (int m = 0; m < 4; ++m) { const int row = row0 + ai * HALF + m * 16; float sq = 0.f;
#pragma unroll
                for (int t = 0; t < 8; ++t) sq += rowsq[(size_t)(fq * 8 + t) * NTOK_ + row];
                rstd[ai][m] = rsqrtf(xrow_sum(sq) * (1.0f / 2048.0f) + 1e-6f) * ds; }
#pragma unroll
        for (int ai = 0; ai < 2; ++ai)
#pragma unroll
            for (int m = 0; m < 4; ++m) { const int row = row0 + ai * HALF + m * 16; bf16_t* rowp = O + (size_t)row * 2048 + col0;
#pragma unroll
                for (int bj = 0; bj < 2; ++bj) { const f32x4 v0 = acc[ai][bj][m][0] * rstd[ai][m] + bv[bj][0], v1 = acc[ai][bj][m][1] * rstd[ai][m] + bv[bj][1];
                    u32x4 w; w.x = cvt_pk_bf16(v0[0], v0[1]); w.y = cvt_pk_bf16(v0[2], v0[3]); w.z = cvt_pk_bf16(v1[0], v1[1]); w.w = cvt_pk_bf16(v1[2], v1[3]);
                    *(u32x4*)(rowp + bj * HALF) = w; } }
    }
};
struct BatchOrder {
    int nM, nU, G, c;
    __device__ __forceinline__ bool next(int i, Unit& u) const { const int L = i * G + c; if (L >= nU) return false; u.pb = L / nM; u.pm = L % nM; u.pn = 0; return true; }
    __device__ __forceinline__ void a_ready(const Unit&) const {}
    __device__ __forceinline__ void done(const Unit&) const {}
};
}

__device__ __forceinline__ unsigned f2bf_rne(float f) { unsigned u = __builtin_bit_cast(unsigned, f); return (u + 0x7fffu + ((u >> 16) & 1u)) >> 16; }
__device__ __forceinline__ unsigned pk2(float lo, float hi) { return f2bf_rne(lo) | (f2bf_rne(hi) << 16); }
__device__ __forceinline__ void p0_transpose_item(const float* W, int K, int N, bf16_t* WT, LAS float* scr, int item, int lane) {
    const int nblk = N / 32, kb = item / nblk, nb = item % nblk, k0 = 64 * kb, n0 = 32 * nb;
#pragma unroll 8
    for (int i = 0; i < 32; ++i) { const int kk = 2 * i + (lane >> 5); scr[kk * 33 + (lane & 31)] = W[(size_t)(k0 + kk) * N + n0 + (lane & 31)]; }
    LDS_WAIT(); asm volatile("" ::: "memory");
    const int c = lane & 7;
#pragma unroll
    for (int j = 0; j < 4; ++j) { const int n = (lane >> 3) + 8 * j; const LAS float* s = scr + (8 * c) * 33 + n;
        u32x4 o; o.x = pk2(s[0 * 33], s[1 * 33]); o.y = pk2(s[2 * 33], s[3 * 33]); o.z = pk2(s[4 * 33], s[5 * 33]); o.w = pk2(s[6 * 33], s[7 * 33]);
        *(u32x4*)(WT + (size_t)(n0 + n) * K + k0 + 8 * c) = o; }
    LDS_WAIT(); asm volatile("" ::: "memory");
}

__device__ __forceinline__ void p0_transpose_item_f8(const float* W, int K, int N, unsigned char* WT, LAS float* scr, int item, int lane, float sc) {
    const int nblk = N / 32, kb = item / nblk, nb = item % nblk, k0 = 64 * kb, n0 = 32 * nb;
#pragma unroll 8
    for (int i = 0; i < 32; ++i) { const int kk = 2 * i + (lane >> 5); scr[kk * 33 + (lane & 31)] = W[(size_t)(k0 + kk) * N + n0 + (lane & 31)] * sc; }
    LDS_WAIT(); asm volatile("" ::: "memory");
    const int c = lane & 7;
#pragma unroll
    for (int j = 0; j < 4; ++j) { const int n = (lane >> 3) + 8 * j; const LAS float* s = scr + (8 * c) * 33 + n;
        u32x2 o; o.x = pk_fp8x4(s[0 * 33], s[1 * 33], s[2 * 33], s[3 * 33]); o.y = pk_fp8x4(s[4 * 33], s[5 * 33], s[6 * 33], s[7 * 33]);
        *(u32x2*)(WT + (size_t)(n0 + n) * K + k0 + 8 * c) = o; }
    LDS_WAIT(); asm volatile("" ::: "memory");
}

__device__ __forceinline__ void s5_gen_group(const P& p, LAS unsigned char* lds, int g, int tid) {
    LAS f32x2* pw = (LAS f32x2*)lds;
    LAS f32x2* Cc = (LAS f32x2*)(lds + 17408);
    LAS f32x2* Bb = (LAS f32x2*)(lds + 17408 + 16384);
    LAS float* Kt = (LAS float*)(lds + 17408 + 32768);
    LAS float* dsk = (LAS float*)(lds + 17408 + 65536);
    __syncthreads();
    if (tid < 128) {
        const int d = tid >> 6, pp = tid & 63, dgp = (d * 64 + g) * 64 + pp;
        const float lr = fminf(p.lam_re[dgp], -1e-4f), li = p.lam_im[dgp], dt = __expf(p.log_dt[d * 64 + g]);
        const float lrdt = lr * dt, ang = li * dt;
#pragma unroll 1
        for (int e = 0; e <= 16; ++e) { const float mag = __expf((float)e * lrdt); float sn, cs; sincos_rad((float)e * ang, sn, cs); pw[e * 128 + tid] = (f32x2){mag * cs, mag * sn}; }
        const f32x2 a1 = pw[128 + tid]; const float abr = a1.x, abi = a1.y;
        const float den = lr * lr + li * li, nr = abr - 1.0f;
        const float cre = (nr * lr + abi * li) / den, cim = (abi * lr - nr * li) / den;
        ((f32x2*)(p.ws + WS_S5A))[dgp] = pw[16 * 128 + tid];
#pragma unroll 4
        for (int h = 0; h < 16; ++h) { const float br = p.b_re[dgp * 16 + h], bi = p.b_im[dgp * 16 + h]; Bb[(d * 64 + pp) * 16 + h] = (f32x2){cre * br - cim * bi, cre * bi + cim * br}; }
    }
    for (int i = tid; i < 2048; i += 512) { const int d = i >> 10, h = (i >> 6) & 15, pp = i & 63; const size_t src = ((size_t)(d * 64 + g) * 16 + h) * 64 + pp; Cc[i] = (f32x2){p.c_re[src], p.c_im[src]}; }
    if (tid < 16) dsk[tid] = p.s5_d[g * 16 + tid];
    __syncthreads();
    {
        const int d = tid >> 8, tau = (tid >> 4) & 15, h = tid & 15; float acc[16];
#pragma unroll
        for (int hp = 0; hp < 16; ++hp) acc[hp] = 0.f;
#pragma unroll 2
        for (int pp = 0; pp < 64; ++pp) { const f32x2 c = Cc[(d * 16 + h) * 64 + pp], w = pw[tau * 128 + d * 64 + pp]; const float tx = c.x * w.x - c.y * w.y, ty = c.x * w.y + c.y * w.x;
#pragma unroll
            for (int hp = 0; hp < 16; ++hp) { const f32x2 bb = Bb[(d * 64 + pp) * 16 + hp]; acc[hp] += tx * bb.x - ty * bb.y; } }
#pragma unroll
        for (int hp = 0; hp < 16; ++hp) Kt[(d * 16 + tau) * 256 + h * 16 + hp] = acc[hp];
    }
    __syncthreads();
    bf16_t* Wy = (bf16_t*)(p.ws + WS_WY) + (size_t)g * 256 * 512;
#pragma unroll 1
    for (int idx = tid; idx < 256 * 256; idx += 512) {
        const int np = idx >> 8, k0 = (idx & 255) * 2;
        const int bj = (np >> 7) & 1, wc = (np >> 5) & 3, n = (np >> 4) & 1, fq = (np >> 2) & 3, j = np & 3, i = wc * 4 + fq, h = 8 * bj + 4 * n + j;
        float v[2];
#pragma unroll
        for (int kk = 0; kk < 2; ++kk) { const int k = k0 + kk;
            if (k < 256) { const int s = k >> 4, hp = k & 15;
                if (s < i) v[kk] = Kt[(i - s) * 256 + h * 16 + hp]; else if (s > i) v[kk] = Kt[(16 + (s - i)) * 256 + h * 16 + hp];
                else v[kk] = Kt[h * 16 + hp] + Kt[16 * 256 + h * 16 + hp] + (h == hp ? dsk[h] : 0.f);
            } else { const int kc = k - 256, d = kc >> 7, pp = (kc >> 1) & 63, ri = kc & 1, e = d ? 16 - i : i + 1;
                const f32x2 c = Cc[(d * 16 + h) * 64 + pp], w = pw[e * 128 + d * 64 + pp]; v[kk] = ri ? -(c.x * w.y + c.y * w.x) : (c.x * w.x - c.y * w.y); } }
        *(unsigned*)(Wy + (size_t)np * 512 + k0) = cvtpk(v[0], v[1]);
    }
    bf16_t* Wsum = (bf16_t*)(p.ws + WS_WSUM) + (size_t)g * 256 * 256;
#pragma unroll 1
    for (int idx = tid; idx < 256 * 128; idx += 512) {
        const int r = idx >> 7, k0 = (idx & 127) * 2, d = r >> 7, pp = (r >> 1) & 63, ri = r & 1;
        float v[2];
#pragma unroll
        for (int kk = 0; kk < 2; ++kk) { const int k = k0 + kk, s = k >> 4, hp = k & 15, e = d ? s : 15 - s;
            const f32x2 w = pw[e * 128 + d * 64 + pp], bb = Bb[(d * 64 + pp) * 16 + hp]; v[kk] = ri ? (w.x * bb.y + w.y * bb.x) : (w.x * bb.x - w.y * bb.y); }
        *(unsigned*)(Wsum + (size_t)r * 256 + k0) = cvtpk(v[0], v[1]);
    }
}

#ifndef PRO_DBL
#define PRO_DBL 0
#endif
#define PRO_REP(b) for (int _pr = 0; _pr < 1 + ((PRO_DBL >> (b)) & 1); ++_pr)
__device__ __forceinline__ void phase_prologue(const P& p, LAS unsigned char* lds, int tid, int lane, int wid) {
    unsigned char* ws = p.ws;
    LAS float* cact = (LAS float*)lds;
    LAS float* red = (LAS float*)(lds + 16384);
    for (int i = tid; i < 4096; i += 512) { const float cv = p.c[i]; cact[i] = cv * sigmoid_f(cv); }
    __syncthreads();
    float* mod = (float*)(ws + WS_MOD);
    PRO_REP(0) for (int item = blockIdx.x; item < 192; item += gridDim.x) {
        const int l = item / 96, cb = item % 96, cg4 = tid & 31, rl = tid >> 5;
        const float* W = p.ada_w + (size_t)l * 2048 * 12288 + cb * 128 + cg4 * 4;
        f32x4 a0 = {0.f, 0.f, 0.f, 0.f}, a1 = {0.f, 0.f, 0.f, 0.f};
#pragma unroll 8
        for (int r = rl; r < 2048; r += 16) { const f32x4 w = *(const f32x4*)(W + (size_t)r * 12288); const float c0 = cact[r], c1 = cact[2048 + r]; a0 += w * c0; a1 += w * c1; }
        *(LAS f32x4*)(red + (rl * 32 + cg4) * 8) = a0; *(LAS f32x4*)(red + (rl * 32 + cg4) * 8 + 4) = a1;
        __syncthreads();
        if (tid < 256) { const int col = tid & 127, b = tid >> 7; float s = 0.f;
#pragma unroll
            for (int r2 = 0; r2 < 16; ++r2) s += red[(r2 * 32 + (col >> 2)) * 8 + b * 4 + (col & 3)];
            s += p.ada_b[l * 12288 + cb * 128 + col]; mod[(l * 2 + b) * 12288 + cb * 128 + col] = s; }
        __syncthreads();
    }
    PRO_REP(1) {
        LAS float* scr = (LAS float*)(lds + 32768 + wid * 8448);
        const int gw = blockIdx.x * 8 + wid, ngw = gridDim.x * 8;
        constexpr int I0 = 32 * 80, I1 = 32 * 64, I2 = 32 * 256, I3 = 64 * 64, NIT = I0 + I1 + I2 + I3;
        for (int it = gw; it < NIT; it += ngw) {
            int r = it;
            if (r < I0) { p0_transpose_item_f8(p.even_w_in, 2048, 2560, ws + WS_WINE, scr, r, lane, F8_WS); continue; } r -= I0;
            if (r < I1) { p0_transpose_item_f8(p.even_w_out, 2048, 2048, ws + WS_WOUTE, scr, r, lane, F8_WS); continue; } r -= I1;
            if (r < I2) { p0_transpose_item_f8(p.odd_w_in, 2048, 8192, ws + WS_WINO, scr, r, lane, F8_WS); continue; } r -= I2;
            p0_transpose_item_f8(p.odd_w_out, 4096, 2048, ws + WS_WOUTO, scr, r, lane, F8_WS);
        }
    }
    const long gtid = (long)blockIdx.x * 512 + tid, ngt = (long)gridDim.x * 512;
    PRO_REP(2) {
        const int gw = blockIdx.x * 8 + wid, ngw = gridDim.x * 8;
        float* psc = (float*)(ws + WS_PSC);
        for (int row0 = 4 * gw; row0 < 4 * 16384; row0 += 4 * ngw) {
            f32x4 v[4][8]; float am[4]; const float* src[4]; unsigned char* dst[4];
#pragma unroll
            for (int rr = 0; rr < 4; ++rr) { const int row = row0 + rr; const bool tv = row >= 2 * 16384; const int r = tv ? row - 2 * 16384 : row;
                const bool sl = tv ? PEER_SLICE_V : PEER_SLICE_U;
                src[rr] = (tv ? p.peer_v : p.peer_u) + (size_t)r * 2048; dst[rr] = ws + (tv ? WS_PV : WS_PU) + (size_t)r * PEER_ROWB;
#pragma unroll
                for (int j = 0; j < 8; ++j) v[rr][j] = *(const f32x4*)(src[rr] + (sl ? 4 * (lane + 64 * j) : 16 * lane + 1024 * (j >> 2) + 4 * (j & 3))); }
#pragma unroll
            for (int rr = 0; rr < 4; ++rr) { am[rr] = 0.f;
#pragma unroll
                for (int j = 0; j < 8; ++j) am[rr] = fmaxf(am[rr], fmaxf(fmaxf(fabsf(v[rr][j].x), fabsf(v[rr][j].y)), fmaxf(fabsf(v[rr][j].z), fabsf(v[rr][j].w))));
#pragma unroll
                for (int o = 32; o > 0; o >>= 1) am[rr] = fmaxf(am[rr], __shfl_xor(am[rr], o)); }
#pragma unroll
            for (int rr = 0; rr < 4; ++rr) { const int row = row0 + rr;
                const float sc = am[rr] > 0.f ? 7.5f / am[rr] : 1.0f;
                if (lane == 0) psc[row] = am[rr] > 0.f ? am[rr] * (1.0f / 7.5f) : 1.0f;
                f32x16 ev, od;
#pragma unroll
                for (int j = 0; j < 8; ++j) { const f32x4 t = v[rr][j] * sc; ev[2 * j] = t.x; od[2 * j] = t.y; ev[2 * j + 1] = t.z; od[2 * j + 1] = t.w; }
                const u32x6 q = __builtin_amdgcn_cvt_scalef32_2xpk16_fp6_f32(ev, od, 1.0f);
                const bool tv = row >= 2 * 16384; const int r = tv ? row - 2 * 16384 : row;
                if (!(tv ? PEER_SLICE_V : PEER_SLICE_U)) {
                    *(u32x4*)(dst[rr] + 16 * lane) = (u32x4){q[0], q[1], q[2], q[3]};
                    *(u32x2*)(dst[rr] + 1024 + 8 * lane) = (u32x2){q[4], q[5]};
                } else {
                    unsigned char* sb = ws + (tv ? WS_PV : WS_PU) + (size_t)(r >> 14) * 16384 * PEER_ROWB + (size_t)(r & 16383) * 192 + 12 * (lane >> 2) + 4 * (lane & 3);
                    const unsigned pc[8] = {q[0] & 0xFFFFFFu, (q[0] >> 24) | ((q[1] & 0xFFFFu) << 8), (q[1] >> 16) | ((q[2] & 0xFFu) << 16), q[2] >> 8,
                                            q[3] & 0xFFFFFFu, (q[3] >> 24) | ((q[4] & 0xFFFFu) << 8), (q[4] >> 16) | ((q[5] & 0xFFu) << 16), q[5] >> 8};
                    const int i8 = 8 * (lane & 3);
#pragma unroll
                    for (int j = 0; j < 8; ++j) { const unsigned nx = __builtin_amdgcn_update_dpp(0u, pc[j], 0xF9, 0xF, 0xF, true);
                        const unsigned d = (pc[j] >> i8) | (nx << (24 - i8));
                        if ((lane & 3) < 3) *(unsigned*)(sb + (size_t)j * 16384 * 192) = d; }
                } }
        }
    }
    PRO_REP(3) for (int g = (int)gridDim.x - 1 - (int)blockIdx.x; g < 64; g += gridDim.x) s5_gen_group(p, lds, g, tid);
    for (long i = gtid; i < 65536; i += ngt) { const int layer = (int)(i >> 15), half = (int)(i >> 14) & 1, r = (int)(i & 16383);
        ((bf16_t*)(ws + WS_KEYS))[i] = (bf16_t)f2bf_rne((half ? p.peer_k2 : p.peer_k1)[layer * 16384 + r]); }
    for (long i = gtid; i < 131072; i += ngt) ((bf16_t*)(ws + WS_WSB))[i] = (bf16_t)f2bf_rne(p.sgu_w[i]);
}

template <bool OUT8>
__device__ __forceinline__ void phase_adaln(const float* xin, void* hout_, const float* g, const float* shift, const float* scale, int gw, int ngw, int lane) {
    for (int b = 0; b < 2; ++b) {
        f32x4 A[8], Bc[8];
#pragma unroll
        for (int j = 0; j < 8; ++j) { const int c = 8 * lane + 512 * (j >> 1) + 4 * (j & 1);
            const f32x4 gv = *(const f32x4*)(g + c), sc = *(const f32x4*)(scale + b * 12288 + c); A[j] = gv * (sc + 1.0f); Bc[j] = *(const f32x4*)(shift + b * 12288 + c); }
#pragma unroll 1
        for (int row0 = b * 8192 + gw; row0 < (b + 1) * 8192; row0 += 4 * ngw) {
            f32x4 v[4][8];
#pragma unroll
            for (int k = 0; k < 4; ++k) { const int row = row0 + k * ngw < (b + 1) * 8192 ? row0 + k * ngw : row0; const float* xr = xin + (size_t)row * 2048 + 8 * lane;
#pragma unroll
                for (int j = 0; j < 8; ++j) v[k][j] = *(const f32x4*)(xr + 512 * (j >> 1) + 4 * (j & 1)); }
#pragma unroll
            for (int k = 0; k < 4; ++k) { const int row = row0 + k * ngw < (b + 1) * 8192 ? row0 + k * ngw : row0; float ss = 0.f;
#pragma unroll
                for (int j = 0; j < 8; ++j) ss += dot4(v[k][j], v[k][j]);
                ss = wave_sum(ss); const float rstd = rsqrtf(ss * (1.0f / 2048.0f) + 1e-6f);
                bf16_t* hr = (bf16_t*)hout_ + (size_t)row * 2048 + 8 * lane; unsigned char* hr8 = (unsigned char*)hout_ + (size_t)row * 2048 + 8 * lane;
#pragma unroll
                for (int j = 0; j < 4; ++j) { const f32x4 y0 = v[k][2 * j] * rstd * A[2 * j] + Bc[2 * j], y1 = v[k][2 * j + 1] * rstd * A[2 * j + 1] + Bc[2 * j + 1];
                    if (OUT8) { u32x2 o; o.x = pk_fp8x4(y0.x * F8_HS, y0.y * F8_HS, y0.z * F8_HS, y0.w * F8_HS); o.y = pk_fp8x4(y1.x * F8_HS, y1.y * F8_HS, y1.z * F8_HS, y1.w * F8_HS); *(u32x2*)(hr8 + 512 * j) = o; }
                    else { u32x4 o; o.x = cvtpk(y0.x, y0.y); o.y = cvtpk(y0.z, y0.w); o.z = cvtpk(y1.x, y1.y); o.w = cvtpk(y1.z, y1.w);
                    *(u32x4*)(hr + 512 * j) = o; } } }
        }
    }
}

__device__ __forceinline__ void phase_fold_wq(const P& p, LAS unsigned char* lds, int tid, int lane, int wid) {
    unsigned char* ws = p.ws; const float* mod = (const float*)(ws + WS_MOD);
    for (long i = (long)blockIdx.x * 512 + tid; i < 2 * 2 * 2048; i += (long)gridDim.x * 512) { const int l = (int)(i >> 12), b = (int)(i >> 11) & 1, c = (int)(i & 2047);
        float* ab = (float*)(ws + WS_ABT) + (size_t)(l * 2 + b) * 4096;
        ab[c] = p.norm_g[(l * 2 + 1) * 2048 + c] * (1.0f + mod[(size_t)(l * 2 + b) * 12288 + 4 * 2048 + c]); ab[2048 + c] = mod[(size_t)(l * 2 + b) * 12288 + 3 * 2048 + c]; }
    LAS float* scr = (LAS float*)(lds + wid * 8448);
    const int gw = blockIdx.x * 8 + wid, ngw = gridDim.x * 8;
    for (int it = gw; it < 2 * 2048; it += ngw) {
        const int l = it >> 11, item = it & 2047, kb = item >> 6, nb = item & 63, k0 = 64 * kb, n0 = 32 * nb;
        const float* W = p.peer_wq + (size_t)l * 2048 * 2048;
#pragma unroll 8
        for (int i = 0; i < 32; ++i) { const int kk = 2 * i + (lane >> 5); scr[kk * 33 + (lane & 31)] = W[(size_t)(k0 + kk) * 2048 + n0 + (lane & 31)]; }
        LDS_WAIT(); asm volatile("" ::: "memory");
        const int c = lane & 7;
#pragma unroll
        for (int b = 0; b < 2; ++b) {
            const float* mb = mod + (size_t)(l * 2 + b) * 12288; const float* ng = p.norm_g + (l * 2 + 1) * 2048;
            float A[8];
#pragma unroll
            for (int t = 0; t < 8; ++t) A[t] = ng[k0 + 8 * c + t] * (1.0f + mb[4 * 2048 + k0 + 8 * c + t]);
            unsigned char* WT = ws + WS_WQF + (size_t)(l * 2 + b) * 2048 * 2048;
#pragma unroll
            for (int t = 0; t < 8; ++t) A[t] *= F8_WS;
#pragma unroll
            for (int j = 0; j < 4; ++j) { const int n = (lane >> 3) + 8 * j; const LAS float* s = scr + (8 * c) * 33 + n;
                u32x2 o; o.x = pk_fp8x4(s[0 * 33] * A[0], s[1 * 33] * A[1], s[2 * 33] * A[2], s[3 * 33] * A[3]); o.y = pk_fp8x4(s[4 * 33] * A[4], s[5 * 33] * A[5], s[6 * 33] * A[6], s[7 * 33] * A[7]);
                *(u32x2*)(WT + (size_t)(n0 + n) * 2048 + k0 + 8 * c) = o; }
            { const int n = lane & 31, kh = lane >> 5; float acc = 0.f;
#pragma unroll 8
              for (int t = 0; t < 32; ++t) acc += scr[(32 * kh + t) * 33 + n] * mb[3 * 2048 + k0 + 32 * kh + t];
              acc += __shfl_xor(acc, 32);
              if (lane < 32) ((float*)(ws + WS_BIASP))[((size_t)(l * 2 + b) * 32 + kb) * 2048 + n0 + n] = acc; }
        }
        LDS_WAIT(); asm volatile("" ::: "memory");
    }
}

__device__ __forceinline__ void phase_bias_reduce(const P& p, int tid) {
    for (long i = (long)blockIdx.x * 512 + tid; i < 2 * 2 * 2048; i += (long)gridDim.x * 512) { const int lb = (int)(i >> 11), n = (int)(i & 2047); float acc = 0.f;
#pragma unroll 8
        for (int kb = 0; kb < 32; ++kb) acc += ((const float*)(p.ws + WS_BIASP))[((size_t)lb * 32 + kb) * 2048 + n];
        ((float*)(p.ws + WS_BIASQ))[i] = acc; }
}
__device__ __forceinline__ void phase_qkprep(const P& p, int gw, int ngw, int lane) {
    bf16_t* Q = (bf16_t*)(p.ws + WS_Q); bf16_t* K = (bf16_t*)(p.ws + WS_K);
    const int sub = lane >> 4, ll = lane & 15;
    float inv[4], gq[8], gk[8];
#pragma unroll
    for (int e = 0; e < 4; ++e) inv[e] = __builtin_amdgcn_exp2f(-(float)((4 * ll + e) & 31) * 0.41524101186092029f);
#pragma unroll
    for (int e = 0; e < 8; ++e) { gq[e] = p.q_g[8 * ll + e]; gk[e] = p.k_g[8 * ll + e]; }
#pragma unroll 2
    for (int it = gw; it < NTOK * 10 / 4; it += ngw) {
        const int hr = 4 * it + sub, token = hr / 10, hh = hr - token * 10;
        u32x4* ptr = hh < 8 ? (u32x4*)(Q + (size_t)token * 1024 + hh * 128 + 8 * ll) : (u32x4*)(K + (size_t)token * 256 + (hh - 8) * 128 + 8 * ll);
        const u32x4 w = *ptr;
        float x[8] = {bflo(w.x), bfhi(w.x), bflo(w.y), bfhi(w.y), bflo(w.z), bfhi(w.z), bflo(w.w), bfhi(w.w)};
        float ss = 0.f;
#pragma unroll
        for (int e = 0; e < 8; ++e) ss += x[e] * x[e];
        ss = row16_sum(ss);
        const float r = rsqrtf(ss * (1.0f / 128.0f) + 1e-6f);
        const int s = token & 8191; const float pos = (float)(ll < 8 ? (s >> 6) : (s & 63));
        unsigned o[4];
#pragma unroll
        for (int e = 0; e < 4; ++e) { const float x1 = x[2 * e] * r * (hh < 8 ? gq[2 * e] : gk[2 * e]), x2 = x[2 * e + 1] * r * (hh < 8 ? gq[2 * e + 1] : gk[2 * e + 1]);
            float sn, cs; sincos_rad(pos * inv[e], sn, cs); o[e] = cvtpk(x1 * cs - x2 * sn, x1 * sn + x2 * cs); }
        *ptr = (u32x4){o[0], o[1], o[2], o[3]};
    }
}

__device__ __forceinline__ void phase_s5scan(const P& p, LAS unsigned char* lds, int lane, int wid) {
    const f32x2* A16 = (const f32x2*)(p.ws + WS_S5A);
    LAS f32x2* agg = (LAS f32x2*)lds;
    for (int item = blockIdx.x; item < 256; item += gridDim.x) {
        const int b = item >> 7, g = (item >> 1) & 63, d = item & 1;
        const f32x2 a = A16[(d * 64 + g) * 64 + lane];
        const float* S = (const float*)(p.ws + WS_SS) + ((size_t)g * 1024 + b * 512) * 256 + d * 128 + 2 * lane;
        bf16_t* HIN = (bf16_t*)(p.ws + WS_AB) + ((size_t)g * 1024 + b * 512) * 512 + 256 + d * 128 + 2 * lane;
        const int sA = 2 * wid + (d ? 1 : 0), sB = 2 * wid + (d ? 0 : 1), ordA = d ? 15 - sA : sA;
        float ar = 0.f, ai = 0.f, br = 0.f, bi = 0.f;
#pragma unroll 16
        for (int k = 0; k < 32; ++k) { const int o = d ? 31 - k : k; const f32x2 va = *(const f32x2*)(S + (size_t)(32 * sA + o) * 256), vb = *(const f32x2*)(S + (size_t)(32 * sB + o) * 256);
            const float nar = a.x * ar - a.y * ai + va.x, nai = a.x * ai + a.y * ar + va.y, nbr = a.x * br - a.y * bi + vb.x, nbi = a.x * bi + a.y * br + vb.y; ar = nar; ai = nai; br = nbr; bi = nbi; }
        __syncthreads();
        agg[ordA * 64 + lane] = (f32x2){ar, ai}; agg[(ordA + 1) * 64 + lane] = (f32x2){br, bi};
        __syncthreads();
        float pr = a.x, pi = a.y;
#pragma unroll
        for (int q = 0; q < 5; ++q) { const float nr = pr * pr - pi * pi, ni = 2.f * pr * pi; pr = nr; pi = ni; }
        float cr = 0.f, ci = 0.f;
        for (int s2 = 0; s2 < ordA; ++s2) { const f32x2 v = agg[s2 * 64 + lane]; const float nr = pr * cr - pi * ci + v.x, ni = pr * ci + pi * cr + v.y; cr = nr; ci = ni; }
        const float dr = pr * cr - pi * ci + ar, di = pr * ci + pi * cr + ai;
        ar = cr; ai = ci; br = dr; bi = di;
#pragma unroll 16
        for (int k = 0; k < 32; ++k) { const int o = d ? 31 - k : k; const size_t ca = (size_t)(32 * sA + o), cb = (size_t)(32 * sB + o);
            *(unsigned*)(HIN + ca * 512) = cvtpk(ar, ai); *(unsigned*)(HIN + cb * 512) = cvtpk(br, bi);
            const f32x2 va = *(const f32x2*)(S + ca * 256), vb = *(const f32x2*)(S + cb * 256);
            const float nar = a.x * ar - a.y * ai + va.x, nai = a.x * ai + a.y * ar + va.y, nbr = a.x * br - a.y * bi + vb.x, nbi = a.x * bi + a.y * br + vb.y; ar = nar; ai = nai; br = nbr; bi = nbi; }
    }
}

__device__ __forceinline__ void phase_attn(const P& p, char* lds) {
    const bf16_t* Q = (const bf16_t*)(p.ws + WS_Q); const bf16_t* K = (const bf16_t*)(p.ws + WS_K); const bf16_t* V = (const bf16_t*)(p.ws + WS_V);
    unsigned char* CAT = p.ws + WS_CAT;
    const int G = gridDim.x, bx = blockIdx.x, vcu = (G % 8 == 0) ? (bx % 8) * (G / 8) + bx / 8 : bx;
    for (int unit = vcu; unit < 512; unit += G) {
        const int bk = unit >> 7, rem = unit & 127, b = bk >> 1, kvh = bk & 1, h = kvh * 4 + (rem >> 5), qb = rem & 31;
        attn::attn_dense_body<attn::bf16>((const attn::bf16*)(Q + (size_t)(b * 8192 + qb * 256) * 1024 + h * 128),
                                          (const attn::bf16*)(K + (size_t)(b * 8192) * 256 + kvh * 128), (const attn::bf16*)(V + (size_t)(b * 8192) * 256 + kvh * 128),
                                          CAT + (size_t)(b * 8192 + qb * 256) * 2048 + 1024 + h * 128, 8192, lds);
        __syncthreads();
    }
}

constexpr int SGU_VS = 136;
constexpr int SGU_HB = 71680;
constexpr int SGU_VNT = 0, SGU_STG = 128 * SGU_VS * 2, SGU_STAT = 2 * 128 * SGU_VS * 2, SGU_BS = SGU_STAT + 1024;
static_assert(SGU_BS + 512 <= SGU_HB && 2 * SGU_HB <= LDS_BYTES - 64 && SGU_HB % 16 == 0, "SGU LDS map");
__device__ __forceinline__ void phase_sgu(const P& p, LAS unsigned char* lds, int tid, int lane, int wid) {
    const int hb = wid >> 2, w4 = wid & 3, t256 = tid & 255;
    LAS unsigned char* base = lds + hb * SGU_HB;
    LAS bf16_t* vnT = (LAS bf16_t*)(base + SGU_VNT);
    LAS bf16_t* stg = (LAS bf16_t*)(base + SGU_STG);
    LAS f32x2* stats = (LAS f32x2*)(base + SGU_STAT);
    LAS float* bs = (LAS float*)(base + SGU_BS);
    const bf16_t* Z = (const bf16_t*)(p.ws + WS_Z); unsigned char* SG = p.ws + WS_SG;
    const bf16_t* Wsb = (const bf16_t*)(p.ws + WS_WSB);
    const int fr = lane & 15, fq = lane >> 4, wi = w4 & 1, wc = w4 >> 1, i0 = 64 * wi, c0 = 64 * wc;
    for (int up = blockIdx.x; up < 512; up += gridDim.x) {
        const int unit = 2 * up + hb, n = unit >> 3, g = unit & 7;
        __syncthreads();
        if (t256 < 128) { const f32x2* part = (const f32x2*)(p.ws + WS_LNST) + (size_t)(2 * g * 4) * NTOK + (n * 128 + t256); float s1 = 0.f, s2 = 0.f;
#pragma unroll
            for (int q = 0; q < 8; ++q) { const f32x2 a2 = part[(size_t)q * NTOK]; s1 += a2.x; s2 += a2.y; }
            const float mean = s1 * (1.0f / 512.0f), var = fmaxf(s2 * (1.0f / 512.0f) - mean * mean, 0.f); stats[t256] = (f32x2){mean, rsqrtf(var + 1e-6f)};
            bs[t256] = p.sgu_b[g * 128 + t256]; }
        bf16x8 Af[4][4];
#pragma unroll
        for (int m = 0; m < 4; ++m)
#pragma unroll
            for (int ks = 0; ks < 4; ++ks) Af[m][ks] = *(const bf16x8*)(Wsb + (size_t)(g * 128 + i0 + 16 * m + fr) * 128 + 32 * ks + 8 * fq);
#pragma unroll 1
        for (int qt = 0; qt < 4; ++qt) {
            const int chb = g * 512 + qt * 128;
            __syncthreads();
            { u32x4 T[8];
#pragma unroll
              for (int q = 0; q < 8; ++q) { const int pc = t256 + 256 * q, j = pc >> 4, ch = (pc & 15) * 8; T[q] = *(const u32x4*)(Z + ((size_t)(n * 16 + 8 + g) * 128 + j) * 512 + qt * 128 + ch); }
#pragma unroll
              for (int q = 0; q < 8; ++q) { const int pc = t256 + 256 * q, j = pc >> 4, ch = (pc & 15) * 8; *(LAS u32x4*)(stg + j * SGU_VS + ch) = T[q]; } }
            __syncthreads();
#pragma unroll 1
            for (int slab = 0; slab < 2; ++slab) {
                const int cc = slab * 64 + lane; const float lng = p.sgu_ln_g[chb + cc];
                const int cl = cc & 63, rp = (cc & ~63) + ((cl >> 2) & 3) * 16 + (cl >> 4) * 4 + (cl & 3);
#pragma unroll
                for (int jg = 0; jg < 4; ++jg) {
                    const int j0 = 32 * w4 + 8 * jg; float y[8];
#pragma unroll
                    for (int k = 0; k < 8; ++k) { const float xv = bflo((unsigned)stg[(j0 + k) * SGU_VS + cc]); const f32x2 st = stats[j0 + k]; y[k] = (xv - st.x) * st.y * lng; }
                    u32x4 o; o.x = cvtpk(y[0], y[1]); o.y = cvtpk(y[2], y[3]); o.z = cvtpk(y[4], y[5]); o.w = cvtpk(y[6], y[7]);
                    *(LAS u32x4*)(vnT + rp * SGU_VS + j0) = o;
                }
            }
            __syncthreads();
#pragma unroll 1
            for (int np = 0; np < 2; ++np) {
                u32x4 U[4];
#pragma unroll
                for (int m = 0; m < 4; ++m) U[m] = *(const u32x4*)(Z + ((size_t)(n * 16 + g) * 128 + i0 + 16 * m + fr) * 512 + qt * 128 + c0 + 16 * fq + 8 * np);
                f32x4 acc[4][2];
#pragma unroll
                for (int m = 0; m < 4; ++m)
#pragma unroll
                    for (int nn = 0; nn < 2; ++nn) acc[m][nn] = (f32x4){0.f, 0.f, 0.f, 0.f};
#pragma unroll
                for (int ks = 0; ks < 4; ++ks) {
                    bf16x8 Bf[2];
#pragma unroll
                    for (int nn = 0; nn < 2; ++nn) Bf[nn] = *(const LAS bf16x8*)(vnT + (c0 + 16 * (2 * np + nn) + fr) * SGU_VS + 32 * ks + 8 * fq);
#pragma unroll
                    for (int m = 0; m < 4; ++m)
#pragma unroll
                        for (int nn = 0; nn < 2; ++nn) acc[m][nn] = __builtin_amdgcn_mfma_f32_16x16x32_bf16(Bf[nn], Af[m][ks], acc[m][nn], 0, 0, 0);
                }
#pragma unroll
                for (int m = 0; m < 4; ++m) { const int i = i0 + 16 * m + fr; const float bi = bs[i]; const size_t tok = (size_t)(n * 128 + i);
                    const int cch = chb + c0 + 16 * fq + 8 * np;
                    const u32x4 u0 = U[m];
                    const f32x4 s0 = acc[m][0] + bi, s1 = acc[m][1] + bi;
                    u32x2 o;
                    o.x = pk_fp8x4(bflo(u0.x) * s0.x * F8_SGS, bfhi(u0.x) * s0.y * F8_SGS, bflo(u0.y) * s0.z * F8_SGS, bfhi(u0.y) * s0.w * F8_SGS);
                    o.y = pk_fp8x4(bflo(u0.z) * s1.x * F8_SGS, bfhi(u0.z) * s1.y * F8_SGS, bflo(u0.w) * s1.z * F8_SGS, bfhi(u0.w) * s1.w * F8_SGS);
                    *(u32x2*)(SG + tok * 4096 + cch) = o; }
            }
        }
    }
}
#define XB_TMO      128
#define XB_XCNT(j)  (256  + 64 * (j))
#define XB_XSUB(j)  (1280 + 64 * (j))
#define XB_XGEN(j)  (2304 + 64 * (j))
#define XB_TOP      3328
#define XB_TOPGEN   3392
#define XCD_BAR_WORDS 3456
#define XB_SPIN_CAP (1u << 22)

__device__ __forceinline__ unsigned xb_ld(unsigned* p)              { return __hip_atomic_load(p, __ATOMIC_RELAXED, __HIP_MEMORY_SCOPE_AGENT); }
__device__ __forceinline__ unsigned xb_add(unsigned* p, unsigned v) { return __hip_atomic_fetch_add(p, v, __ATOMIC_RELAXED, __HIP_MEMORY_SCOPE_AGENT); }
__device__ __forceinline__ unsigned xb_xcc_id() { return (unsigned)__builtin_amdgcn_s_getreg((3 << 11) | 20) & 0xFu; }
#define XB_SPIN(cond, bar) do { unsigned _sp = 0; while (cond) { __builtin_amdgcn_s_sleep(1); \
    if ((++_sp & 255u) == 0u) { if (xb_ld(&(bar)[XB_TMO])) break; if (_sp > XB_SPIN_CAP) { atomicAdd(&(bar)[XB_TMO], 1u); break; } } } } while (0)

struct XcdBarrier {
    unsigned* bar; unsigned x;
    volatile LAS unsigned* st;
};

__device__ __forceinline__ XcdBarrier xcd_barrier_post(unsigned* bar, volatile LAS unsigned* st) {
    XcdBarrier b; b.bar = bar; b.x = xb_xcc_id(); b.st = st;
    if (threadIdx.x == 0) st[2] = xb_add(&bar[XB_XCNT(b.x)], 1u);
    return b;
}
__device__ __forceinline__ void xcd_barrier_complete(unsigned* bar, unsigned x, unsigned& nloc, unsigned& nx) {
    const unsigned G = gridDim.x * gridDim.y * gridDim.z;
    unsigned sum, cnt, mine, sp = 0u;
    for (;;) {
        sum = 0u; cnt = 0u; mine = 0u;
#pragma unroll
        for (unsigned j = 0; j < 16; ++j) { const unsigned c = xb_ld(&bar[XB_XCNT(j)]); sum += c; cnt += (c > 0u) ? 1u : 0u; mine = (j == x) ? c : mine; }
        if (sum == G) break;
        __builtin_amdgcn_s_sleep(1);
        if ((++sp & 255u) == 0u) { if (xb_ld(&bar[XB_TMO])) break; if (sp > XB_SPIN_CAP) { atomicAdd(&bar[XB_TMO], 1u); break; } }
    }
    nloc = mine > 0u ? mine : 1u; nx = cnt > 0u ? cnt : 1u;
}

__device__ __forceinline__ void xcd_barrier(const XcdBarrier& b) {
    asm volatile("s_waitcnt vmcnt(0)" ::: "memory");
    __syncthreads();
    if (threadIdx.x == 0) {
        unsigned* bar = b.bar;
        __builtin_amdgcn_s_waitcnt(0);
        unsigned nloc = b.st[0], nx = b.st[1];
        if (nloc == 0u) { xcd_barrier_complete(bar, b.x, nloc, nx); b.st[0] = nloc; b.st[1] = nx; }
        const unsigned old = xb_add(&bar[XB_XSUB(b.x)], 1u);
        const unsigned gen = old / nloc;
        if (old + 1u == (gen + 1u) * nloc) {
            __builtin_amdgcn_fence(__ATOMIC_RELEASE, "agent");
            asm volatile("s_waitcnt vmcnt(0)" ::: "memory");
            const unsigned og = xb_add(&bar[XB_TOP], 1u);
            const unsigned tg = og / nx;
            if (og + 1u == (tg + 1u) * nx) xb_add(&bar[XB_TOPGEN], 1u);
            else XB_SPIN(xb_ld(&bar[XB_TOPGEN]) == tg, bar);
            __builtin_amdgcn_fence(__ATOMIC_ACQUIRE, "agent");
            xb_add(&bar[XB_XGEN(b.x)], 1u);
            asm volatile("s_waitcnt vmcnt(0)" ::: "memory");
        } else {
            XB_SPIN(xb_ld(&bar[XB_XGEN(b.x)]) == gen, bar);
            __builtin_amdgcn_fence(__ATOMIC_ACQUIRE, "agent");
            asm volatile("s_waitcnt vmcnt(0)" ::: "memory");
        }
    }
    __syncthreads();
}

__device__ __forceinline__ void ce_desc(float& a, float& b) { const float mx = fmaxf(a, b), mn = fminf(a, b); a = mx; b = mn; }
__device__ __forceinline__ void bitonic_sort16_desc(float (&a)[16]) {
#pragma unroll
    for (int k = 2; k <= 16; k <<= 1)
#pragma unroll
        for (int j = k >> 1; j > 0; j >>= 1)
#pragma unroll
            for (int i = 0; i < 16; ++i) { const int l = i ^ j; if (l > i) { if ((i & k) == 0) ce_desc(a[i], a[l]); else ce_desc(a[l], a[i]); } }
}
__device__ __forceinline__ void merge_top16(float (&V)[16], const float (&S)[16]) {
#pragma unroll
    for (int i = 0; i < 16; ++i) V[i] = fmaxf(V[i], S[15 - i]);
#pragma unroll
    for (int j = 8; j > 0; j >>= 1)
#pragma unroll
        for (int i = 0; i < 16; ++i) { const int l = i ^ j; if (l > i) ce_desc(V[i], V[l]); }
}
__device__ __forceinline__ float with_payload(float v, unsigned mask, unsigned pay) { return __uint_as_float((__float_as_uint(v) & ~mask) | pay); }

__device__ __forceinline__ void peer_topk_half(const bf16_t* qrow, const bf16_t* keys, int r32, int hi, float (&V)[16]) {
    bf16x8 qf[8];
#pragma unroll
    for (int ks = 0; ks < 8; ++ks) qf[ks] = *(const bf16x8*)(qrow + 16 * ks + 8 * hi);
#pragma unroll
    for (int k = 0; k < 16; ++k) V[k] = -INFINITY;
#pragma unroll 1
    for (int t = 0; t < 4; ++t) {
        f32x16 s = (f32x16){0.f, 0.f, 0.f, 0.f, 0.f, 0.f, 0.f, 0.f, 0.f, 0.f, 0.f, 0.f, 0.f, 0.f, 0.f, 0.f};
#pragma unroll
        for (int ks = 0; ks < 8; ++ks) { const bf16x8 kf = *(const bf16x8*)(keys + (size_t)(t * 32 + r32) * 128 + 16 * ks + 8 * hi);
            s = __builtin_amdgcn_mfma_f32_32x32x16_bf16(kf, qf[ks], s, 0, 0, 0); }
        float S[16];
#pragma unroll
        for (int r = 0; r < 16; ++r) S[r] = with_payload(s[r], 0x7Fu, (unsigned)(t * 32 + (r & 3) + 8 * (r >> 2) + 4 * hi));
        bitonic_sort16_desc(S); merge_top16(V, S);
    }
    float PVv[16];
#pragma unroll
    for (int k = 0; k < 16; ++k) { const auto r = __builtin_amdgcn_permlane32_swap(__float_as_uint(V[k]), __float_as_uint(V[k]), false, false); PVv[k] = (hi ? __uint_as_float(r[0]) : __uint_as_float(r[1])); }
    merge_top16(V, PVv);
}

__device__ __forceinline__ void phase_peer_s1(const P& p, int layer, LAS unsigned char* lds, int lane, int wid) {
    LAS int* idxL = (LAS int*)(lds + 65536 + wid * 8192);
    const bf16_t* QP = (const bf16_t*)(p.ws + WS_QP);
    const bf16_t* keys = (const bf16_t*)(p.ws + WS_KEYS) + (size_t)layer * 2 * 16384;
    const float* rowsq = (const float*)(p.ws + WS_ROWSQ) + (size_t)layer * 32 * NTOK; float* RSTD = (float*)(p.ws + WS_RSTD);
    int* EID = (int*)(p.ws + WS_EID); float* GATE = (float*)(p.ws + WS_GATE);
    const int r32 = lane & 31, hi = lane >> 5, gw = blockIdx.x * 8 + wid, ngw = gridDim.x * 8;
#pragma unroll 1
    for (int tq = gw; tq < NTOK / 4; tq += ngw) {
        {
            const bf16_t* qrow = QP + (size_t)(4 * tq + (r32 >> 3)) * 2048 + (r32 & 7) * 256;
            float v1[16], v2[16];
            peer_topk_half(qrow, keys, r32, hi, v1);
            peer_topk_half(qrow + 128, keys + 16384, r32, hi, v2);
#pragma unroll
            for (int k = 0; k < 16; ++k) { idxL[k * 64 + lane] = (int)(__float_as_uint(v1[k]) & 0x7Fu); idxL[(16 + k) * 64 + lane] = (int)(__float_as_uint(v2[k]) & 0x7Fu); }
            float SC[16], S2[16];
#pragma unroll
            for (int b2 = 0; b2 < 16; ++b2) SC[b2] = with_payload(v1[0] + v2[b2], 0xFFu, (unsigned)b2);
#pragma unroll
            for (int a = 1; a <= 4; ++a) {
#pragma unroll
                for (int b2 = 0; b2 < 16; ++b2) S2[b2] = ((a + 1) * (b2 + 1) <= 16) ? with_payload(v1[a] + v2[b2], 0xFFu, (unsigned)(a * 16 + b2)) : -INFINITY;
                merge_top16(SC, S2); }
#pragma unroll
            for (int a = 5; a <= 7; ++a) { S2[2 * (a - 5)] = with_payload(v1[a] + v2[0], 0xFFu, (unsigned)(a * 16)); S2[2 * (a - 5) + 1] = with_payload(v1[a] + v2[1], 0xFFu, (unsigned)(a * 16 + 1)); }
#pragma unroll
            for (int a = 8; a <= 15; ++a) S2[6 + (a - 8)] = with_payload(v1[a] + v2[0], 0xFFu, (unsigned)(a * 16));
            S2[14] = -INFINITY; S2[15] = -INFINITY;
            bitonic_sort16_desc(S2); merge_top16(SC, S2);
            float e[16], sum = 0.f;
#pragma unroll
            for (int k = 0; k < 16; ++k) { e[k] = __expf(SC[k] - SC[0]); sum += e[k]; }
            const float inv = 1.0f / sum;
            if (hi == 0) {
                u32x4 iw[4]; f32x4 gv[4];
#pragma unroll
                for (int k = 0; k < 16; ++k) { const unsigned pay = __float_as_uint(SC[k]) & 0xFFu;
                    iw[k >> 2][k & 3] = (unsigned)(idxL[(pay >> 4) * 64 + lane] * 128 + idxL[(16 + (pay & 15)) * 64 + lane]); gv[k >> 2][k & 3] = e[k] * inv; }
                const size_t gbase = (size_t)(4 * tq + (r32 >> 3)) * 128 + (r32 & 7) * 16;
#pragma unroll
                for (int k4 = 0; k4 < 4; ++k4) { *(u32x4*)(EID + gbase + 4 * k4) = iw[k4]; *(f32x4*)(GATE + gbase + 4 * k4) = gv[k4]; } }
        }
        {
            const int token = 4 * tq + (lane >> 4), w = lane & 15;
            const float sq = row16_sum(rowsq[(size_t)w * NTOK + token] + rowsq[(size_t)(w + 16) * NTOK + token]);
            if (w == 0) RSTD[token] = rsqrtf(sq * (1.0f / 2048.0f) + 1e-6f); }
    }
}

__device__ __forceinline__ float dot2bf(unsigned a, unsigned b, float acc) { return __builtin_amdgcn_fdot2_f32_bf16(__builtin_bit_cast(bf16x2v, a), __builtin_bit_cast(bf16x2v, b), acc, false); }
__device__ __forceinline__ void peer_partition(const P& p, int myrank, int& part, int& rank, int& nwg) {
    unsigned* bar = (unsigned*)(p.ws + WS_BAR); const unsigned x = xb_xcc_id(); unsigned mine = 0u; bool ok = true;
#pragma unroll
    for (unsigned j = 0; j < 16; ++j) { const unsigned cj = xb_ld(&bar[XB_XCNT(j)]); ok = ok && ((j < 8u) ? (cj > 0u) : (cj == 0u)); mine = (j == x) ? cj : mine; }
    if (ok) { part = (int)x; rank = myrank; nwg = (int)mine; } else { part = (int)blockIdx.x & 7; rank = (int)blockIdx.x >> 3; nwg = (int)gridDim.x >> 3; }
    part = __builtin_amdgcn_readfirstlane(part); rank = __builtin_amdgcn_readfirstlane(rank); nwg = __builtin_amdgcn_readfirstlane(nwg);
}
__device__ __forceinline__ void phase_peer_u(const P& p, int layer, LAS unsigned char* lds, int lane, int wid, int myrank) {
    LAS unsigned char* wl = lds + wid * 16384;
    int part, rank, nwg; peer_partition(p, myrank, part, rank, nwg);
    const unsigned char* PUS = p.ws + WS_PU + (size_t)layer * 16384 * PEER_ROWB + (size_t)part * 16384 * 192;
    const int* EID = (const int*)(p.ws + WS_EID);
    const unsigned char* HB = p.ws + WS_XB + 512 * part;
    const float* RSTD = (const float*)(p.ws + WS_RSTD);
    const float* ABs = (const float*)(p.ws + WS_ABT) + (size_t)layer * 2 * 4096 + 256 * part + 4 * lane;
    float* PACT = (float*)(p.ws + WS_PACT) + (size_t)part * NTOK * 128;
    const int g = lane >> 2, s = lane & 3, nb = NTOK / 8, stride = nwg * 8;
    int tb = rank * 8 + wid;
    if (tb >= nb) return;
    int e0[8], e1[8]; u32x2 hs[8]; float rs[8]; f32x4 Av, Bv;
#define PB_LOAD(TB) { _Pragma("unroll") for (int j = 0; j < 8; ++j) { const size_t t = (size_t)(TB) * 8 + j; e0[j] = EID[t * 128 + lane]; e1[j] = EID[t * 128 + 64 + lane]; hs[j] = *(const u32x2*)(HB + t * 4096 + 8 * lane); rs[j] = RSTD[t]; } \
        Av = *(const f32x4*)(ABs + ((TB) >> 10) * 4096); Bv = *(const f32x4*)(ABs + ((TB) >> 10) * 4096 + 2048); }
#define PB_STORE(BUF) _Pragma("unroll") for (int j = 0; j < 8; ++j) { LAS int* il = (LAS int*)(wl + (BUF) * 8192); il[j * 128 + lane] = e0[j]; il[j * 128 + 64 + lane] = e1[j]; \
        u32x2 hw; hw.x = cvtpk(bflo(hs[j].x) * rs[j] * Av.x + Bv.x, bfhi(hs[j].x) * rs[j] * Av.y + Bv.y); hw.y = cvtpk(bflo(hs[j].y) * rs[j] * Av.z + Bv.z, bfhi(hs[j].y) * rs[j] * Av.w + Bv.w); \
        *(LAS u32x2*)(wl + (BUF) * 8192 + 4096 + j * 512 + 8 * lane) = hw; }
#define PR_LOAD(SLOT, ID) { const unsigned char* ur = PUS + (size_t)(ID) * 192 + 48 * s; R[SLOT][0] = *(const u32x4*)ur; R[SLOT][1] = *(const u32x4*)(ur + 16); R[SLOT][2] = *(const u32x4*)(ur + 32); }
    PB_LOAD(tb) PB_STORE(0)
    u32x4 R[8][3];
    { LAS int* il = (LAS int*)wl;
#pragma unroll
      for (int q = 0; q < 8; ++q) { const int id = il[16 * q + g]; PR_LOAD(q, id) } }
    int bi = 0;
#pragma unroll 1
    for (; tb < nb; tb += stride, bi ^= 1) {
        { const int tbn = tb + stride < nb ? tb + stride : tb; PB_LOAD(tbn) }
#pragma unroll 1
        for (int j = 0; j < 8; ++j) {
            if (j == 7) { PB_STORE(bi ^ 1) }
            LAS int* nid = (j < 7) ? (LAS int*)(wl + bi * 8192) + (j + 1) * 128 : (LAS int*)(wl + (bi ^ 1) * 8192);
            LAS u32x4* hp = (LAS u32x4*)(wl + bi * 8192 + 4096 + j * 512 + s * 128);
            const u32x4 h0 = hp[0], h1 = hp[1], h2 = hp[2], h3 = hp[3], h4 = hp[4], h5 = hp[5], h6 = hp[6], h7 = hp[7];
            float acc[8];
#pragma unroll
            for (int it = 0; it < 8; ++it) {
                const u32x16 dw = __builtin_bit_cast(u32x16, __builtin_amdgcn_cvt_scalef32_pk32_bf16_fp6((u32x6){R[it][0].x, R[it][0].y, R[it][0].z, R[it][0].w, R[it][1].x, R[it][1].y}, 1.0f));
                const u32x16 dx = __builtin_bit_cast(u32x16, __builtin_amdgcn_cvt_scalef32_pk32_bf16_fp6((u32x6){R[it][1].z, R[it][1].w, R[it][2].x, R[it][2].y, R[it][2].z, R[it][2].w}, 1.0f));
                { const int idn = nid[16 * it + g]; PR_LOAD(it, idn) }
                float a0 = 0.f, a1 = 0.f;
                a0 = dot2bf(dw[0], h0.x, a0); a1 = dot2bf(dw[1], h0.y, a1); a0 = dot2bf(dw[2], h0.z, a0); a1 = dot2bf(dw[3], h0.w, a1);
                a0 = dot2bf(dw[4], h1.x, a0); a1 = dot2bf(dw[5], h1.y, a1); a0 = dot2bf(dw[6], h1.z, a0); a1 = dot2bf(dw[7], h1.w, a1);
                a0 = dot2bf(dw[8], h2.x, a0); a1 = dot2bf(dw[9], h2.y, a1); a0 = dot2bf(dw[10], h2.z, a0); a1 = dot2bf(dw[11], h2.w, a1);
                a0 = dot2bf(dw[12], h3.x, a0); a1 = dot2bf(dw[13], h3.y, a1); a0 = dot2bf(dw[14], h3.z, a0); a1 = dot2bf(dw[15], h3.w, a1);
                a0 = dot2bf(dx[0], h4.x, a0); a1 = dot2bf(dx[1], h4.y, a1); a0 = dot2bf(dx[2], h4.z, a0); a1 = dot2bf(dx[3], h4.w, a1);
                a0 = dot2bf(dx[4], h5.x, a0); a1 = dot2bf(dx[5], h5.y, a1); a0 = dot2bf(dx[6], h5.z, a0); a1 = dot2bf(dx[7], h5.w, a1);
                a0 = dot2bf(dx[8], h6.x, a0); a1 = dot2bf(dx[9], h6.y, a1); a0 = dot2bf(dx[10], h6.z, a0); a1 = dot2bf(dx[11], h6.w, a1);
                a0 = dot2bf(dx[12], h7.x, a0); a1 = dot2bf(dx[13], h7.y, a1); a0 = dot2bf(dx[14], h7.z, a0); a1 = dot2bf(dx[15], h7.w, a1);
                float v = a0 + a1;
                v += __uint_as_float(__builtin_amdgcn_update_dpp(0u, __float_as_uint(v), 0xB1, 0xF, 0xF, true));
                v += __uint_as_float(__builtin_amdgcn_update_dpp(0u, __float_as_uint(v), 0x4E, 0xF, 0xF, true));
                acc[it] = v;
            }
            if (s == 0) { float* pa = PACT + ((size_t)tb * 8 + j) * 128 + g;
#pragma unroll
                for (int it = 0; it < 8; ++it) pa[16 * it] = acc[it]; }
        }
    }
#undef PB_LOAD
#undef PB_STORE
#undef PR_LOAD
}

__device__ __forceinline__ void phase_peer_w(const P& p, int layer, int tid) {
    const int* EID = (const int*)(p.ws + WS_EID); const float* GATE = (const float*)(p.ws + WS_GATE); const float* PACT = (const float*)(p.ws + WS_PACT); float* PW = (float*)(p.ws + WS_PW);
    const float* PSU = (const float*)(p.ws + WS_PSC) + layer * 16384; const float* PSV = PSU + 2 * 16384;
#pragma unroll 2
    for (int i4 = (int)blockIdx.x * 512 + tid; i4 < NTOK * 128 / 4; i4 += (int)gridDim.x * 512) {
        const size_t i = (size_t)i4 * 4;
        const u32x4 id4 = *(const u32x4*)(EID + i); const f32x4 g4 = *(const f32x4*)(GATE + i);
        f32x4 a = (f32x4){0.f, 0.f, 0.f, 0.f};
#pragma unroll
        for (int x = 0; x < 8; ++x) a += *(const f32x4*)(PACT + (size_t)x * NTOK * 128 + i);
        f32x4 w;
#pragma unroll
        for (int e = 0; e < 4; ++e) { const int id = (int)id4[e]; w[e] = gelu_t(a[e] * PSU[id]) * g4[e] * PSV[id]; }
        *(f32x4*)(PW + i) = w;
    }
}

__device__ __forceinline__ void phase_peer_vs(const P& p, int layer, LAS unsigned char* lds, int lane, int wid, int myrank) {
    LAS unsigned char* wl = lds + wid * 16384;
    int part, rank, nwg; peer_partition(p, myrank, part, rank, nwg);
    const unsigned char* PVS = p.ws + WS_PV + (size_t)layer * 16384 * PEER_ROWB + (size_t)part * 16384 * 192;
    const int* EID = (const int*)(p.ws + WS_EID); const float* PW = (const float*)(p.ws + WS_PW);
    unsigned char* PO = p.ws + WS_PO + 512 * part;
    const int g = lane >> 3, s = lane & 7, nb = NTOK / 8, stride = nwg * 8;
    const bool b3 = (lane & 8) != 0;
    int tb = rank * 8 + wid;
    if (tb >= nb) return;
    int e0[8], e1[8]; float w0[8], w1[8];
#define PB_LOAD(TB) _Pragma("unroll") for (int j = 0; j < 8; ++j) { const size_t t = (size_t)(TB) * 8 + j; e0[j] = EID[t * 128 + lane]; e1[j] = EID[t * 128 + 64 + lane]; w0[j] = PW[t * 128 + lane]; w1[j] = PW[t * 128 + 64 + lane]; }
#define PB_STORE(BUF) _Pragma("unroll") for (int j = 0; j < 8; ++j) { LAS int* il = (LAS int*)(wl + (BUF) * 8192); LAS float* fl = (LAS float*)(wl + (BUF) * 8192 + 4096); il[j * 128 + lane] = e0[j]; il[j * 128 + 64 + lane] = e1[j]; fl[j * 128 + lane] = w0[j]; fl[j * 128 + 64 + lane] = w1[j]; }
#define PR_LOAD(SLOT, ID) { const unsigned char* vr = PVS + (size_t)(ID) * 192 + 24 * s; R[SLOT][0] = *(const u32x2*)vr; R[SLOT][1] = *(const u32x2*)(vr + 8); R[SLOT][2] = *(const u32x2*)(vr + 16); }
    PB_LOAD(tb) PB_STORE(0)
    u32x2 R[8][3];
    { LAS int* il = (LAS int*)wl;
#pragma unroll
      for (int q = 0; q < 8; ++q) { const int id = il[8 * q + g]; PR_LOAD(q, id) } }
    int bi = 0;
#pragma unroll 1
    for (; tb < nb; tb += stride, bi ^= 1) {
        { const int tbn = tb + stride < nb ? tb + stride : tb; PB_LOAD(tbn) }
#pragma unroll 1
        for (int j = 0; j < 8; ++j) {
            if (j == 7) { PB_STORE(bi ^ 1) }
            LAS int* ids = (LAS int*)(wl + bi * 8192) + j * 128;
            LAS int* nid = (j < 7) ? ids + 128 : (LAS int*)(wl + (bi ^ 1) * 8192);
            LAS float* wv = (LAS float*)(wl + bi * 8192 + 4096) + j * 128;
            h16x2 o2[16];
#pragma unroll
            for (int k = 0; k < 16; ++k) o2[k] = (h16x2){(_Float16)0.f, (_Float16)0.f};
#pragma unroll
            for (int it = 0; it < 16; ++it) {
                const int sl = it & 7;
                const h16x32 d = __builtin_amdgcn_cvt_scalef32_pk32_f16_fp6((u32x6){R[sl][0].x, R[sl][0].y, R[sl][1].x, R[sl][1].y, R[sl][2].x, R[sl][2].y}, 1.0f);
                { const int idn = (it < 8) ? ids[8 * (it + 8) + g] : nid[8 * (it - 8) + g]; PR_LOAD(sl, idn) }
                const _Float16 wh = (_Float16)wv[8 * it + g]; const h16x2 w2 = (h16x2){wh, wh};
#pragma unroll
                for (int k = 0; k < 16; ++k) o2[k] = __builtin_elementwise_fma(w2, (h16x2){d[2 * k], d[2 * k + 1]}, o2[k]);
            }
            h16x2 t8[8], t4[4]; float res[4];
#pragma unroll
            for (int k = 0; k < 8; ++k) { const auto r = __builtin_amdgcn_permlane32_swap(__builtin_bit_cast(unsigned, o2[k]), __builtin_bit_cast(unsigned, o2[8 + k]), false, false);
                unsigned ra = r[0], rb = r[1]; asm volatile("" : "+v"(ra), "+v"(rb)); t8[k] = __builtin_bit_cast(h16x2, ra) + __builtin_bit_cast(h16x2, rb); }
#pragma unroll
            for (int k = 0; k < 4; ++k) { const auto r = __builtin_amdgcn_permlane16_swap(__builtin_bit_cast(unsigned, t8[k]), __builtin_bit_cast(unsigned, t8[4 + k]), false, false);
                unsigned ra = r[0], rb = r[1]; asm volatile("" : "+v"(ra), "+v"(rb)); t4[k] = __builtin_bit_cast(h16x2, ra) + __builtin_bit_cast(h16x2, rb); }
#pragma unroll
            for (int k = 0; k < 2; ++k) { const unsigned lo = __builtin_bit_cast(unsigned, t4[k]), hi = __builtin_bit_cast(unsigned, t4[2 + k]); const unsigned mine = b3 ? hi : lo, send = b3 ? lo : hi;
                const h16x2 rr = __builtin_bit_cast(h16x2, mine) + __builtin_bit_cast(h16x2, (unsigned)__builtin_amdgcn_update_dpp(0u, send, 0x128, 0xF, 0xF, true));
                res[2 * k] = (float)rr.x; res[2 * k + 1] = (float)rr.y; }
            u32x2 ow; ow.x = cvtpk(res[0], res[1]); ow.y = cvtpk(res[2], res[3]);
            *(u32x2*)(PO + ((size_t)tb * 8 + j) * 4096 + 64 * s + 8 * g) = ow;
        }
    }
#undef PB_LOAD
#undef PB_STORE
#undef PR_LOAD
}

template <bool FINAL>
__device__ __forceinline__ void phase_peer_norm(const P& p, int layer, int lane, int wid) {
    bf16_t* XB = (bf16_t*)(p.ws + WS_XB);
    const bf16_t* PO = (const bf16_t*)(p.ws + WS_PO);
    const float* mod = (const float*)(p.ws + WS_MOD);
    float* X = p.out;
    const int gw = blockIdx.x * 8 + wid, ngw = gridDim.x * 8;
    u32x4 pw[4], xw[4];
#define PN_LOAD(T, PWV, XWV) { const bf16_t* por = PO + (size_t)(T) * 2048 + 16 * lane; const bf16_t* xbl = XB + (size_t)(T) * 2048 + 16 * lane; \
        _Pragma("unroll") for (int j = 0; j < 4; ++j) { PWV[j] = *(const u32x4*)(por + 1024 * (j >> 1) + 8 * (j & 1)); XWV[j] = *(const u32x4*)(xbl + 1024 * (j >> 1) + 8 * (j & 1)); } }
    if (gw < NTOK) PN_LOAD(gw, pw, xw)
#pragma unroll 1
    for (int token = gw; token < NTOK; token += ngw) {
        const int b = token >> 13;
        u32x4 pwn[4], xwn[4];
        { const int tn = token + ngw < NTOK ? token + ngw : token; PN_LOAD(tn, pwn, xwn) }
        float o[32];
#pragma unroll
        for (int j = 0; j < 4; ++j) { const u32x4 w = pw[j];
            o[8 * j + 0] = bflo(w.x); o[8 * j + 1] = bfhi(w.x); o[8 * j + 2] = bflo(w.y); o[8 * j + 3] = bfhi(w.y);
            o[8 * j + 4] = bflo(w.z); o[8 * j + 5] = bfhi(w.z); o[8 * j + 6] = bflo(w.w); o[8 * j + 7] = bfhi(w.w); }
        {
            const float* g2 = mod + (size_t)(layer * 2 + b) * 12288 + 5 * 2048 + 16 * lane;
            bf16_t* xbr = XB + (size_t)token * 2048 + 16 * lane; float* xr = X + (size_t)token * 2048 + 16 * lane;
            float xn[32], ss = 0.f;
#pragma unroll
            for (int jh = 0; jh < 2; ++jh) { const u32x4 w0 = xw[2 * jh], w1 = xw[2 * jh + 1];
                const float xi[16] = {bflo(w0.x), bfhi(w0.x), bflo(w0.y), bfhi(w0.y), bflo(w0.z), bfhi(w0.z), bflo(w0.w), bfhi(w0.w), bflo(w1.x), bfhi(w1.x), bflo(w1.y), bfhi(w1.y), bflo(w1.z), bfhi(w1.z), bflo(w1.w), bfhi(w1.w)};
#pragma unroll
                for (int q = 0; q < 4; ++q) { const f32x4 gg = *(const f32x4*)(g2 + 1024 * jh + 4 * q);
#pragma unroll
                    for (int e = 0; e < 4; ++e) { const float t = xi[4 * q + e] + gg[e] * o[16 * jh + 4 * q + e]; xn[16 * jh + 4 * q + e] = t; ss += t * t; } } }
            ss = wave_sum(ss); const float rstd = rsqrtf(ss * (1.0f / 2048.0f) + 1e-6f);
            if (FINAL) {
#pragma unroll
                for (int j = 0; j < 8; ++j) { const int off = 1024 * (j >> 2) + 4 * (j & 3); const f32x4 fg = *(const f32x4*)(p.final_g + 16 * lane + off);
                    f32x4 y;
#pragma unroll
                    for (int e = 0; e < 4; ++e) y[e] = xn[4 * j + e] * rstd * fg[e];
                    *(f32x4*)(xr + off) = y; }
            } else {
                const float* ng = p.norm_g + (size_t)((layer + 1) * 2 + 0) * 2048 + 16 * lane;
                const float* sh = mod + (size_t)((layer + 1) * 2 + b) * 12288 + 16 * lane; const float* sc = sh + 2048;
                unsigned char* hrow8 = p.ws + WS_H8 + (size_t)token * 2048 + 16 * lane;
#pragma unroll
                for (int jh = 0; jh < 2; ++jh) { float y[16];
#pragma unroll
                    for (int hq = 0; hq < 4; ++hq) { const int jj = 4 * jh + hq, off = 1024 * jh + 4 * hq; const f32x4 gv = *(const f32x4*)(ng + off), sv = *(const f32x4*)(sc + off), hv = *(const f32x4*)(sh + off);
                        f32x4 xo;
#pragma unroll
                        for (int e = 0; e < 4; ++e) { xo[e] = xn[4 * jj + e]; y[4 * hq + e] = (xo[e] * rstd * gv[e] * (1.0f + sv[e]) + hv[e]) * F8_HS; }
                        u32x2 xw; xw.x = cvtpk(xo[0], xo[1]); xw.y = cvtpk(xo[2], xo[3]); *(u32x2*)(xbr + off) = xw; }
                    u32x4 w; w.x = pk_fp8x4(y[0], y[1], y[2], y[3]); w.y = pk_fp8x4(y[4], y[5], y[6], y[7]); w.z = pk_fp8x4(y[8], y[9], y[10], y[11]); w.w = pk_fp8x4(y[12], y[13], y[14], y[15]);
                    *(u32x4*)(hrow8 + 1024 * jh) = w; }
            }
        }
#pragma unroll
        for (int j = 0; j < 4; ++j) { pw[j] = pwn[j]; xw[j] = xwn[j]; }
    }
#undef PN_LOAD
}

#ifndef PH_MASK
#define PH_MASK 0xFFFF
#endif
#define PH(b) if constexpr ((PH_MASK >> (b)) & 1)
#ifndef DBL_MASK
#define DBL_MASK 0
#endif
#define REP(b) for (int _r = 0; _r < 1 + ((DBL_MASK >> (b)) & 1); ++_r)
__device__ __forceinline__ int fresh_tid() { int t = threadIdx.x; asm volatile("" : "+v"(t)); return t; }
__device__ __forceinline__ P load_p() {
    typedef __attribute__((address_space(1))) float* gp;
    typedef const gp __attribute__((address_space(4)))* cq;
    cq q = (cq)__builtin_amdgcn_kernarg_segment_ptr(); asm volatile("" : "+s"(q));
    P r; float** d = (float**)&r;
#pragma unroll
    for (int i = 0; i < (int)(sizeof(P) / 8); ++i) d[i] = (float*)q[i];
    return r;
}
#define LP (load_p())
#define WSB (load_p().ws)
#define MODP ((const float*)(load_p().ws + WS_MOD))
#define HP ((bf16_t*)(load_p().ws + WS_H))
__global__ void __launch_bounds__(512, 2) mk_fwd(P p_arg) {
    extern __shared__ __attribute__((aligned(16))) unsigned char lds_raw[];
    LAS unsigned char* lds = (LAS unsigned char*)lds_raw;
    cg::grid_group grid = cg::this_grid();
    const int wid = __builtin_amdgcn_readfirstlane((int)threadIdx.x >> 6);
    const int gw = blockIdx.x * 8 + wid, ngw = gridDim.x * 8, G = gridDim.x;
    volatile LAS unsigned* xst = (volatile LAS unsigned*)(lds + LDS_BYTES - 64);
    if (threadIdx.x < 16) xst[threadIdx.x] = 0u;
    __syncthreads();
    const XcdBarrier xb = xcd_barrier_post((unsigned*)(load_p().ws + WS_BAR), xst);
#define TID (fresh_tid())
#define LANE (fresh_tid() & 63)

    REP(0) { PH(0) phase_prologue(LP, lds, TID, LANE, wid);
    grid.sync(); }
    REP(1) { PH(1) phase_adaln<true>(LP.x, WSB + WS_H8, LP.norm_g, MODP, MODP + 2048, gw, ngw, LANE);
    xcd_barrier(xb); }
    REP(2) { PH(2) {   pg8::Gemm g{(const bf16_t*)(WSB + WS_H8), (const bf16_t*)(WSB + WS_WINE), NTOK, 2560, 1024, 1024, 1024, 0, 0}; pg8::StaticOrder S; S.init(NTOK, 2560, G, (int)blockIdx.x);
        pg8::EpiEvenSplit E{1.0f / (F8_HS * F8_WS), WSB};
        pg8::gemm_phase<pg8::EpiEvenSplit, pg8::StaticOrder, true, true, true>(lds, g, S, E); }
    xcd_barrier(xb); }
    PH(3) { phase_qkprep(LP, gw, ngw, LANE); phase_fold_wq(LP, lds, TID, LANE, wid); __syncthreads(); }
    REP(4) { PH(4) {
        pg8::Gemm g{(const bf16_t*)(WSB + WS_AB), (const bf16_t*)(WSB + WS_WSUM), 1024, 256, 256, 512, 256, (size_t)1024 * 512, (size_t)256 * 256};
        pg8::BatchOrder S{4, 256, G, (int)blockIdx.x}; pg8::EpiF32B E{(float*)(WSB + WS_SS), 256, (size_t)1024 * 256};
        pg8::gemm_phase<pg8::EpiF32B, pg8::BatchOrder, false, false>(lds, g, S, E); }
    xcd_barrier(xb); }
    REP(5) { PH(5) { phase_s5scan(LP, lds, LANE, wid); phase_bias_reduce(LP, TID); }
    xcd_barrier(xb); }
    REP(13) { PH(13) {
        pg8::Gemm g{(const bf16_t*)(WSB + WS_AB), (const bf16_t*)(WSB + WS_WY), 1024, 256, 512, 512, 512, (size_t)1024 * 512, (size_t)256 * 512};
        LAS float* wl = (LAS float*)(lds + 131072);
        { const int un = (int)blockIdx.x;
            const int tid = TID; __syncthreads();
            if (tid < 256) wl[tid] = LP.glu_w[(un >> 2) * 256 + tid]; else if (tid < 272) wl[tid] = LP.glu_b[(un >> 2) * 16 + tid - 256];
            __syncthreads();
            pg8::BatchOrder S{4, un + 1, 256, un}; pg8::EpiS5Glu E{WSB + WS_CAT, wl};
            pg8::gemm_phase<pg8::EpiS5Glu, pg8::BatchOrder, false, false>(lds, g, S, E); }
        __syncthreads(); } }
    REP(6) { PH(6) phase_attn(LP, (char*)lds_raw);
    xcd_barrier(xb); }
    REP(7) { PH(7) {   pg8::Gemm g{(const bf16_t*)(WSB + WS_CAT), (const bf16_t*)(WSB + WS_WOUTE), NTOK, 2048, 1024, 1024, 1024, 0, 0}; pg8::StaticOrder S; S.init(NTOK, 2048, G, (int)blockIdx.x);
        pg8::EpiResidB<true> E{LP.x, (bf16_t*)(WSB + WS_XB), MODP + 2 * 2048, (float*)(WSB + WS_ROWSQ), WSB + WS_X8, 1.0f / (F8_CS * F8_WS)};
        pg8::gemm_phase<pg8::EpiResidB<true>, pg8::StaticOrder, true, true, true>(lds, g, S, E); }
    xcd_barrier(xb); }
    REP(8) { PH(8) {   pg8::Gemm g{(const bf16_t*)(WSB + WS_X8), (const bf16_t*)(WSB + WS_WQF), NTOK, 2048, 1024, 1024, 1024, 0, (size_t)2048 * 1024}; pg8::StaticOrder S; S.init(NTOK, 2048, G, (int)blockIdx.x); S.pbs = 5;
        pg8::EpiQ E{(bf16_t*)(WSB + WS_QP), (const float*)(WSB + WS_ROWSQ), (const float*)(WSB + WS_BIASQ), 1.0f / (F8_XS * F8_WS)};
        pg8::gemm_phase<pg8::EpiQ, pg8::StaticOrder, true, true, true>(lds, g, S, E); }
    xcd_barrier(xb); }
    REP(16) { PH(9) phase_peer_s1(LP, 0, lds, LANE, wid); }
    xcd_barrier(xb);
    REP(17) { PH(9) phase_peer_u(LP, 0, lds, LANE, wid, (int)xst[2]); }
    xcd_barrier(xb);
    REP(18) { PH(9) phase_peer_w(LP, 0, TID); }
    xcd_barrier(xb);
    REP(19) { PH(9) phase_peer_vs(LP, 0, lds, LANE, wid, (int)xst[2]); }
    xcd_barrier(xb);
    PH(9) phase_peer_norm<false>(LP, 0, LANE, wid);
    xcd_barrier(xb);
    REP(10) { PH(10) {   pg8::Gemm g{(const bf16_t*)(WSB + WS_H8), (const bf16_t*)(WSB + WS_WINO), NTOK, 8192, 1024, 1024, 1024, 0, 0}; pg8::StaticOrder S; S.init(NTOK, 8192, G, (int)blockIdx.x);
        pg8::EpiBf16T<1> E{(bf16_t*)(WSB + WS_Z), 8192, 1.0f / (F8_HS * F8_WS), (float*)(WSB + WS_LNST)};
        pg8::gemm_phase<pg8::EpiBf16T<1>, pg8::StaticOrder, true, true, true>(lds, g, S, E); }
    xcd_barrier(xb); }
    REP(11) { PH(11) phase_sgu(LP, lds, TID, LANE, wid);
    xcd_barrier(xb); }
    PH(12) {   pg8::Gemm g{(const bf16_t*)(WSB + WS_SG), (const bf16_t*)(WSB + WS_WOUTO), NTOK, 2048, 2048, 2048, 2048, 0, 0}; pg8::StaticOrder S; S.init(NTOK, 2048, G, (int)blockIdx.x);
        pg8::EpiResidB<false> E{nullptr, (bf16_t*)(WSB + WS_XB), MODP + 2 * 12288 + 2 * 2048, (float*)(WSB + WS_ROWSQ) + (size_t)32 * NTOK, WSB + WS_X8, 1.0f / (F8_SGS * F8_WS)};
        pg8::gemm_phase<pg8::EpiResidB<false>, pg8::StaticOrder, true, true, true>(lds, g, S, E); }
    xcd_barrier(xb);
    REP(8) { PH(8) {   pg8::Gemm g{(const bf16_t*)(WSB + WS_X8), (const bf16_t*)(WSB + WS_WQF) + (size_t)2 * 2048 * 1024, NTOK, 2048, 1024, 1024, 1024, 0, (size_t)2048 * 1024}; pg8::StaticOrder S; S.init(NTOK, 2048, G, (int)blockIdx.x); S.pbs = 5;
        pg8::EpiQ E{(bf16_t*)(WSB + WS_QP), (const float*)(WSB + WS_ROWSQ) + (size_t)32 * NTOK, (const float*)(WSB + WS_BIASQ) + 2 * 2048, 1.0f / (F8_XS * F8_WS)};
        pg8::gemm_phase<pg8::EpiQ, pg8::StaticOrder, true, true, true>(lds, g, S, E); }
    xcd_barrier(xb); }
    REP(16) { PH(9) phase_peer_s1(LP, 1, lds, LANE, wid); }
    xcd_barrier(xb);
    REP(17) { PH(9) phase_peer_u(LP, 1, lds, LANE, wid, (int)xst[2]); }
    xcd_barrier(xb);
    REP(18) { PH(9) phase_peer_w(LP, 1, TID); }
    xcd_barrier(xb);
    REP(19) { PH(9) phase_peer_vs(LP, 1, lds, LANE, wid, (int)xst[2]); }
    xcd_barrier(xb);
    PH(9) phase_peer_norm<true>(LP, 1, LANE, wid);
}

#undef LP
#undef WSB
#undef MODP
#undef HP
extern "C" void kernel_launch(void* const* d_in, const int* in_sizes, int n_in, void* d_out, int out_size, void* d_ws, size_t ws_size, hipStream_t stream) {
    static int grid = 0;
    if (grid == 0) {
        if (n_in != 30 || out_size != NTOK * DMODEL || ws_size < WS_END) { fprintf(stderr, "kernel_launch: unexpected shapes (n_in %d out %d ws %zu, need ws >= %zu)\n", n_in, out_size, ws_size, (size_t)WS_END); grid = -1; return; }
        int dev = 0, cus = 0, per_cu = 0;
        (void)hipGetDevice(&dev); (void)hipDeviceGetAttribute(&cus, hipDeviceAttributeMultiprocessorCount, dev);
        if (hipFuncSetAttribute((const void*)mk_fwd, hipFuncAttributeMaxDynamicSharedMemorySize, LDS_BYTES) != hipSuccess) { fprintf(stderr, "kernel_launch: hipFuncSetAttribute failed\n"); grid = -1; return; }
        if (hipOccupancyMaxActiveBlocksPerMultiprocessor(&per_cu, (const void*)mk_fwd, 512, LDS_BYTES) != hipSuccess || per_cu < 1) { fprintf(stderr, "kernel_launch: occupancy query says %d\n", per_cu); (void)hipGetLastError(); per_cu = 1; }
        grid = cus;
        if (grid > cus * per_cu) grid = cus * per_cu;
        if (grid != 256) { fprintf(stderr, "kernel_launch: this kernel is laid out for a 256-CU device (got %d workgroups)\n", grid); grid = -1; return; }
    }
    if (grid < 0) return;
    if (hipMemsetAsync((char*)d_ws + WS_BAR, 0, 16384, stream) != hipSuccess) { fprintf(stderr, "kernel_launch: hipMemsetAsync failed\n"); return; }
    P p{};
    const float** pf = (const float**)&p;
    for (int i = 0; i < 30; ++i) pf[i] = (const float*)d_in[i];
    p.out = (float*)d_out; p.ws = (unsigned char*)d_ws;
    void* args[] = {&p};
    hipError_t e = hipLaunchCooperativeKernel((const void*)mk_fwd, dim3(grid), dim3(512), args, LDS_BYTES, stream);
    if (e != hipSuccess) fprintf(stderr, "kernel_launch: cooperative launch failed: %s (grid %d)\n", hipGetErrorString(e), grid);
}
```

```cpp
#include <hip/hip_runtime.h>
#include <hip/hip_cooperative_groups.h>
#include <hip/hip_bf16.h>
#include <cstdio>
#include <cstdint>
namespace cg = cooperative_groups;

__device__ __forceinline__ int lane_id_v() { int l; asm volatile("v_mbcnt_lo_u32_b32 %0, -1, 0\n\tv_mbcnt_hi_u32_b32 %0, -1, %0" : "=v"(l)); return l; }

namespace pg8 {
#define PG8_LAS __attribute__((address_space(3)))
typedef unsigned short bf16_t;
typedef short bf16x8 __attribute__((ext_vector_type(8)));
typedef float f32x4 __attribute__((ext_vector_type(4)));
typedef unsigned u32x4 __attribute__((ext_vector_type(4)));
constexpr int BM = 256, BK = 64, HALF = 128, HTB = HALF * BK * 2  , STAGE_BYTES = 8 * HTB, NXCD = 8, WGM = 8;

__host__ __device__ __forceinline__ int lds_byte(int r, int c) { const int st = (r >> 4) * 2 + (c >> 5), rr = r & 15, cc = c & 31, ob = rr * 64 + cc * 2; return st * 1024 + (ob ^ (((ob >> 9) & 1) << 5)); }
__host__ __device__ __forceinline__ void stage_rc(int b, int& R, int& C) { const int st = b / 1024, sb = b % 1024, swz = sb ^ (((sb >> 9) & 1) << 5); R = (st >> 1) * 16 + swz / 64; C = (st & 1) * 32 + (swz % 64) / 2; }
__host__ __device__ __forceinline__ int perm32(int rho) { const int n = rho >> 4, i = rho & 15; return 8 * (i >> 2) + 4 * n + (i & 3); }

struct Unit { int pm, pn, pb; };
struct Gemm { const bf16_t* A; const bf16_t* Bt; int M, N, K; int lda, ldb; size_t bsA, bsB; };

struct StaticOrder {
    int nM, nN, nwg, G, c, pbs;
    __host__ __device__ void init(int M, int N, int G_, int c_) { nM = M / BM; nN = N / BM; nwg = nM * nN; G = G_; c = c_; pbs = -1; }
    __host__ __device__ bool next(int i, Unit& u) const {
        const long L = (long)i * G + c; if (L >= nwg) return false;
        int wgid = (int)L; { const int q = nwg / NXCD, r = nwg % NXCD, xcd = wgid % NXCD, off = wgid / NXCD; wgid = (xcd < r ? xcd * (q + 1) : r * (q + 1) + (xcd - r) * q) + off; }
        const int nig = WGM * nN, gid = wgid / nig, fm = gid * WGM, gsz = (nM - fm) < WGM ? (nM - fm) : WGM;
        u.pm = fm + ((wgid % nig) % gsz); u.pn = (wgid % nig) / gsz; u.pb = pbs >= 0 ? (u.pm >> pbs) : 0; return true;
    }
    __device__ __forceinline__ void a_ready(const Unit&) const {}
    __device__ __forceinline__ void done(const Unit&) const {}
};

__device__ __forceinline__ unsigned cvt_pk_bf16(float lo, float hi) { unsigned r; asm volatile("v_cvt_pk_bf16_f32 %0, %1, %2" : "=v"(r) : "v"(lo), "v"(hi)); return r; }
typedef float f32x2 __attribute__((ext_vector_type(2)));

typedef int i32x8 __attribute__((ext_vector_type(8)));
typedef int i32x4v __attribute__((ext_vector_type(4)));
__device__ __forceinline__ void pg8_mfma_f8(f32x4& c, const i32x8& a, const i32x8& b, int sc) {
    asm("s_nop 1\n\tv_mfma_f32_16x16x128_f8f6f4 %0, %1, %2, %0" : "+v"(c) : "v"(a), "v"(b)); (void)sc; }
__device__ __forceinline__ void pg8_mfma_f8_drain(f32x4 (&acc)[2][2][4][2]) {
#pragma unroll
    for (int a = 0; a < 2; ++a)
#pragma unroll
        for (int b = 0; b < 2; ++b) {
            if (a == 0 && b == 0) asm volatile("s_nop 15\n\ts_nop 15" : "+v"(acc[a][b][0][0]), "+v"(acc[a][b][0][1]), "+v"(acc[a][b][1][0]), "+v"(acc[a][b][1][1]), "+v"(acc[a][b][2][0]), "+v"(acc[a][b][2][1]), "+v"(acc[a][b][3][0]), "+v"(acc[a][b][3][1]));
            else asm volatile("" : "+v"(acc[a][b][0][0]), "+v"(acc[a][b][0][1]), "+v"(acc[a][b][1][0]), "+v"(acc[a][b][1][1]), "+v"(acc[a][b][2][0]), "+v"(acc[a][b][2][1]), "+v"(acc[a][b][3][0]), "+v"(acc[a][b][3][1])); }
}
__device__ __forceinline__ i32x8 pg8_cat(bf16x8 a, bf16x8 b) { return __builtin_shufflevector(__builtin_bit_cast(i32x4v, a), __builtin_bit_cast(i32x4v, b), 0, 1, 2, 3, 4, 5, 6, 7); }
template <class Epi, class Sched, bool ALIGN_EPI = false, bool SP2 = false, bool F8 = false>
__device__ __forceinline__ void gemm_phase(PG8_LAS unsigned char* lds, const Gemm g, const Sched& S, const Epi& E) {
    int tid_o = threadIdx.x; asm volatile("" : "+v"(tid_o)); const int tid = tid_o, wid = __builtin_amdgcn_readfirstlane(tid >> 6), lane = tid & 63, wr = wid >> 2, wc = wid & 3, fr = lane & 15, fq = lane >> 4;
    const int K = g.K, nt = K / BK;
    unsigned voffA[2], voffB[2];
#pragma unroll
    for (int i = 0; i < 2; ++i) { int R, C; stage_rc(tid * 16 + i * 8192, R, C); const int Rb = Epi::PERM ? ((R & ~31) + perm32(R & 31)) : R;
        voffA[i] = (unsigned)(R * g.lda + C) * 2u; voffB[i] = (unsigned)(Rb * g.ldb + C) * 2u; }
    const size_t kstep = (size_t)(BK * 2);
    const size_t hstepA = (size_t)HALF * g.lda * 2, hstepB = (size_t)HALF * g.ldb * 2;
    const size_t tstepA = 2 * hstepA, tstepB = 2 * hstepB;
    const unsigned ldsw = (unsigned)wid * 1024u;
    const int aoff = lds_byte(wr * 64 + fr, fq * 8), boff = lds_byte(wc * 32 + fr, fq * 8);
#define PG8_SA(b, h) (((b) * 2 + (h)) * HTB)
#define PG8_SB(b, h) ((4 + (b) * 2 + (h)) * HTB)
#define PG8_STAGE(bufoff, gbase, voff) do { _Pragma("unroll") for (int _i = 0; _i < 2; ++_i) \
        __builtin_amdgcn_global_load_lds((const unsigned*)((const char*)(gbase) + (voff)[_i]), (PG8_LAS unsigned*)(lds + (bufoff) + ldsw + _i * 8192), 16, 0, 0); } while (0)
#define PG8_LDA(dst, b, h) do { _Pragma("unroll") for (int m = 0; m < 4; ++m) { dst[m].lo = *(const PG8_LAS i32x4v*)(lds + PG8_SA(b, h) + aoff + m * 2048); dst[m].hi = *(const PG8_LAS i32x4v*)(lds + PG8_SA(b, h) + aoff + m * 2048 + 1024); } } while (0)
#define PG8_LDB(dst, b, h) do { _Pragma("unroll") for (int n = 0; n < 2; ++n) { dst[n].lo = *(const PG8_LAS i32x4v*)(lds + PG8_SB(b, h) + boff + n * 2048); dst[n].hi = *(const PG8_LAS i32x4v*)(lds + PG8_SB(b, h) + boff + n * 2048 + 1024); } } while (0)
#define PG8_MMA(ai, bj, At, Bt) do { __builtin_amdgcn_s_setprio(1); \
        if constexpr (F8) { _Pragma("unroll") for (int m = 0; m < 4; ++m) _Pragma("unroll") for (int n = 0; n < 2; ++n) pg8_mfma_f8(acc[ai][bj][m][n], Bt[n], At[m], f8scale); } \
        else { _Pragma("unroll") for (int m = 0; m < 4; ++m) _Pragma("unroll") for (int n = 0; n < 2; ++n) { \
            const i32x4v b_lo = Bt[n].lo, b_hi = Bt[n].hi, a_lo = At[m].lo, a_hi = At[m].hi;     \
            acc[ai][bj][m][n] = __builtin_amdgcn_mfma_f32_16x16x32_bf16(__builtin_bit_cast(bf16x8, b_lo), __builtin_bit_cast(bf16x8, a_lo), acc[ai][bj][m][n], 0, 0, 0); \
            acc[ai][bj][m][n] = __builtin_amdgcn_mfma_f32_16x16x32_bf16(__builtin_bit_cast(bf16x8, b_hi), __builtin_bit_cast(bf16x8, a_hi), acc[ai][bj][m][n], 0, 0, 0); } } \
        __builtin_amdgcn_s_setprio(0); } while (0)
#define PG8_WAIT_V(n) asm volatile("s_waitcnt vmcnt(" #n ")" ::: "memory")
#define PG8_WAIT_L(n) asm volatile("s_waitcnt lgkmcnt(" #n ")" ::: "memory")
#define PG8_BAR __builtin_amdgcn_s_barrier()
#define PG8_SCHED __builtin_amdgcn_sched_barrier(0)
    Unit cur, nxt; int ui = 0;
    if (!S.next(0, cur)) return;
    f32x4 acc[2][2][4][2];
#pragma unroll
    for (int a = 0; a < 2; ++a)
#pragma unroll
        for (int b = 0; b < 2; ++b)
#pragma unroll
            for (int m = 0; m < 4; ++m)
#pragma unroll
                for (int n = 0; n < 2; ++n) acc[a][b][m][n] = (f32x4){0.f, 0.f, 0.f, 0.f};
    int f8scale = 0x7f7f7f7f; asm volatile("" : "+v"(f8scale));
    i32x8 At[4], B0[2], B1[2];
    const char* cA = (const char*)(g.A + (size_t)cur.pb * g.bsA) + (size_t)cur.pm * tstepA; const char* cB = (const char*)(g.Bt + (size_t)cur.pb * g.bsB) + (size_t)cur.pn * tstepB;
    S.a_ready(cur);
    if constexpr (SP2) {
        PG8_STAGE(PG8_SB(0, 0), cB, voffB); PG8_STAGE(PG8_SB(0, 1), cB + hstepB, voffB); PG8_STAGE(PG8_SA(0, 0), cA, voffA); PG8_STAGE(PG8_SA(0, 1), cA + hstepA, voffA);
        if (wr == 1) PG8_BAR;
        PG8_WAIT_V(2); PG8_BAR;
        PG8_STAGE(PG8_SB(1, 0), cB + kstep, voffB); PG8_STAGE(PG8_SA(1, 0), cA + kstep, voffA); PG8_STAGE(PG8_SB(1, 1), cB + hstepB + kstep, voffB);
        PG8_WAIT_V(6); PG8_BAR;
    } else {
        PG8_STAGE(PG8_SB(0, 0), cB, voffB); PG8_STAGE(PG8_SA(0, 0), cA, voffA); PG8_STAGE(PG8_SB(0, 1), cB + hstepB, voffB); PG8_STAGE(PG8_SA(0, 1), cA + hstepA, voffA);
        if (wr == 1) PG8_BAR;
        PG8_WAIT_V(4); PG8_BAR;
        PG8_STAGE(PG8_SB(1, 0), cB + kstep, voffB); PG8_STAGE(PG8_SA(1, 0), cA + kstep, voffA); PG8_STAGE(PG8_SB(1, 1), cB + hstepB + kstep, voffB);
        PG8_WAIT_V(6); PG8_BAR;
    }
    for (;;) {
        const bool has_next = S.next(ui + 1, nxt);
        const char* nA = has_next ? (const char*)(g.A + (size_t)nxt.pb * g.bsA) + (size_t)nxt.pm * tstepA : cA; const char* nB = has_next ? (const char*)(g.Bt + (size_t)nxt.pb * g.bsB) + (size_t)nxt.pn * tstepB : cB;
        for (int t = 0; t < nt; t += 2) {
            const bool last = (t == nt - 2);
            const char* a1 = cA + (size_t)(t + 1) * kstep;
            const char* a2 = last ? nA : cA + (size_t)(t + 2) * kstep; const char* b2 = last ? nB : cB + (size_t)(t + 2) * kstep;
            const char* a3 = a2 + kstep; const char* b3 = b2 + kstep;
            if (last && has_next) S.a_ready(nxt);
            if constexpr (SP2) {
            PG8_LDB(B0, 0, 0); PG8_LDB(B1, 0, 1); PG8_SCHED; PG8_LDA(At, 0, 0); PG8_STAGE(PG8_SA(1, 1), a1 + hstepA, voffA);
            PG8_WAIT_V(8); PG8_WAIT_L(0); PG8_BAR; PG8_MMA(0, 0, At, B0); PG8_MMA(0, 1, At, B1); PG8_BAR; PG8_SCHED;
            PG8_LDA(At, 0, 1); PG8_STAGE(PG8_SB(0, 0), b2, voffB); PG8_STAGE(PG8_SB(0, 1), b2 + hstepB, voffB); PG8_STAGE(PG8_SA(0, 0), a2, voffA);
            PG8_WAIT_V(8); PG8_WAIT_L(0); PG8_BAR; PG8_MMA(1, 0, At, B0); PG8_MMA(1, 1, At, B1); PG8_BAR; PG8_SCHED;
            PG8_LDB(B0, 1, 0); PG8_LDB(B1, 1, 1); PG8_SCHED; PG8_LDA(At, 1, 0); PG8_STAGE(PG8_SA(0, 1), a2 + hstepA, voffA);
            PG8_WAIT_V(8); PG8_WAIT_L(0); PG8_BAR; PG8_MMA(0, 0, At, B0); PG8_MMA(0, 1, At, B1); PG8_BAR; PG8_SCHED;
            PG8_LDA(At, 1, 1); PG8_STAGE(PG8_SB(1, 0), b3, voffB); PG8_STAGE(PG8_SB(1, 1), b3 + hstepB, voffB); PG8_STAGE(PG8_SA(1, 0), a3, voffA);
            PG8_WAIT_V(8); PG8_WAIT_L(0); PG8_BAR; PG8_MMA(1, 0, At, B0); PG8_MMA(1, 1, At, B1); PG8_BAR; PG8_SCHED;
            } else {
            PG8_LDB(B0, 0, 0); PG8_SCHED; PG8_LDA(At, 0, 0); PG8_STAGE(PG8_SA(1, 1), a1 + hstepA, voffA);
            PG8_WAIT_L(8); PG8_BAR; PG8_WAIT_L(0); PG8_MMA(0, 0, At, B0); PG8_BAR; PG8_SCHED;
            PG8_LDB(B1, 0, 1); PG8_STAGE(PG8_SB(0, 0), b2, voffB);
            PG8_BAR; PG8_WAIT_L(0); PG8_MMA(0, 1, At, B1); PG8_BAR;
            PG8_LDA(At, 0, 1); PG8_STAGE(PG8_SA(0, 0), a2, voffA);
            PG8_BAR; PG8_WAIT_L(0); PG8_MMA(1, 0, At, B0); PG8_BAR; PG8_SCHED;
            PG8_STAGE(PG8_SB(0, 1), b2 + hstepB, voffB);
            PG8_WAIT_V(6); PG8_BAR; PG8_MMA(1, 1, At, B1); PG8_BAR;
            PG8_LDB(B0, 1, 0); PG8_SCHED; PG8_LDA(At, 1, 0); PG8_STAGE(PG8_SA(0, 1), a2 + hstepA, voffA);
            PG8_WAIT_L(8); PG8_BAR; PG8_WAIT_L(0); PG8_MMA(0, 0, At, B0); PG8_BAR; PG8_SCHED;
            PG8_LDB(B1, 1, 1); PG8_STAGE(PG8_SB(1, 0), b3, voffB);
            PG8_BAR; PG8_WAIT_L(0); PG8_MMA(0, 1, At, B1); PG8_BAR;
            PG8_LDA(At, 1, 1); PG8_STAGE(PG8_SA(1, 0), a3, voffA);
            PG8_BAR; PG8_WAIT_L(0); PG8_MMA(1, 0, At, B0); PG8_BAR; PG8_SCHED;
            PG8_STAGE(PG8_SB(1, 1), b3 + hstepB, voffB);
            PG8_WAIT_V(6); PG8_BAR; PG8_MMA(1, 1, At, B1); PG8_BAR;
            }
        }
        if constexpr (ALIGN_EPI) { if (wr == 0) PG8_BAR; }
        if constexpr (F8) pg8_mfma_f8_drain(acc);
        if constexpr (!Epi::AFTER_DRAIN) { E(acc, cur, wr, wc, fr, fq); S.done(cur); }
        if (!has_next) break;
#pragma unroll
        for (int a = 0; a < 2; ++a)
#pragma unroll
            for (int b = 0; b < 2; ++b)
#pragma unroll
                for (int m = 0; m < 4; ++m)
#pragma unroll
                    for (int n = 0; n < 2; ++n) acc[a][b][m][n] = (f32x4){0.f, 0.f, 0.f, 0.f};
        cur = nxt; cA = nA; cB = nB; ++ui;
        if constexpr (ALIGN_EPI) { if (wr == 1) PG8_BAR; }
    }
    PG8_WAIT_V(0);
    if constexpr (!ALIGN_EPI) { if (wr == 0) PG8_BAR; }
    PG8_BAR;
    if constexpr (Epi::AFTER_DRAIN) { E.fused(acc, cur, wr, wc, fr, fq, lds, wid, lane); S.done(cur); }
#undef PG8_SA
#undef PG8_SB
#undef PG8_STAGE
#undef PG8_LDA
#undef PG8_LDB
#undef PG8_MMA
#undef PG8_WAIT_V
#undef PG8_WAIT_L
#undef PG8_BAR
#undef PG8_SCHED
}
}
namespace attn {
using bf16 = __hip_bfloat16;
constexpr int   D = 128, NW = 8, QBLK = 32, KVBLK = 64;
constexpr float SCALE = 0.088388347648318440f;
constexpr float THR = 8.f;
constexpr int SDEPTH = 2;
constexpr int LDQ = 1024, LDK = 256, LDO = 2048;
constexpr size_t SHM_V = KVBLK * D * 2, SHM_K = KVBLK * D * 2, SHM_ATTN = 2 * SHM_V + 2 * SHM_K + NW * 64 * 4;
using bf16x8 = __attribute__((ext_vector_type(8))) short;
using s16x4  = __attribute__((ext_vector_type(4))) short;
using f32x16 = __attribute__((ext_vector_type(16))) float;
using f32x8  = __attribute__((ext_vector_type(8))) float;
using u32x4  = __attribute__((ext_vector_type(4))) unsigned;
#define KSWZ(row, colB) ((row) * 256 + ((colB) ^ (((row) & 7) << 4)))
#define SBAR() __builtin_amdgcn_sched_barrier(0)
__device__ __forceinline__ int crow(int r, int hi) { return (r & 3) + 8 * (r >> 2) + 4 * hi; }
__device__ __forceinline__ unsigned cvtpk(float lo, float hi) {
  unsigned r; asm volatile("v_cvt_pk_bf16_f32 %0, %1, %2" : "=v"(r) : "v"(lo), "v"(hi)); return r;
}
template <typename TIn> struct Stage;
template <> struct Stage<bf16>  { using T = bf16x8;
  __device__ static __forceinline__ T ld8(const bf16* p) { return *reinterpret_cast<const bf16x8*>(p); }
  __device__ static __forceinline__ bf16x8 tobf(T x) { return x; } };
template <> struct Stage<float> { using T = f32x8;
  __device__ static __forceinline__ T ld8(const float* p) { return *reinterpret_cast<const f32x8*>(p); }
  __device__ static __forceinline__ bf16x8 tobf(T x) {
    u32x4 w = {cvtpk(x[0], x[1]), cvtpk(x[2], x[3]), cvtpk(x[4], x[5]), cvtpk(x[6], x[7])}; return *reinterpret_cast<bf16x8*>(&w); } };

__device__ __forceinline__ void partialSM(f32x16& p0, f32x16& p1, float& m_reg, float& mn, float& alpha) {
  constexpr float C = SCALE * 1.4426950408889634f;
  float pmax = p0[0]; for (int r = 1; r < 16; ++r) pmax = fmaxf(pmax, p0[r]); for (int r = 0; r < 16; ++r) pmax = fmaxf(pmax, p1[r]);
  { auto rr = __builtin_amdgcn_permlane32_swap(__float_as_uint(pmax), __float_as_uint(pmax), false, false);
    pmax = fmaxf(__uint_as_float(rr[0]), __uint_as_float(rr[1])); }
  if (__builtin_expect(__all(pmax - m_reg <= THR / SCALE), 1)) { mn = m_reg; alpha = 1.f; }
  else { mn = fmaxf(m_reg, pmax); alpha = __builtin_amdgcn_exp2f((m_reg - mn) * C); m_reg = mn; }
  float mnC = -mn * C;
  for (int r = 0; r < 16; ++r) p0[r] = fmaf(p0[r], C, mnC); for (int r = 0; r < 16; ++r) p1[r] = fmaf(p1[r], C, mnC);
  for (int r = 0; r < 16; ++r) p0[r] = __builtin_amdgcn_exp2f(p0[r]);
}
__device__ __forceinline__ void finishSM(f32x16& p0, f32x16& p1, float alpha, float& l_reg, bf16x8& pa0, bf16x8& pa1, bf16x8& pa2, bf16x8& pa3) {
  for (int r = 0; r < 16; ++r) p1[r] = __builtin_amdgcn_exp2f(p1[r]);
  float ps = 0; for (int r = 0; r < 16; ++r) ps += p0[r]; for (int r = 0; r < 16; ++r) ps += p1[r];
  { auto rr = __builtin_amdgcn_permlane32_swap(__float_as_uint(ps), __float_as_uint(ps), false, false);
    ps = __uint_as_float(rr[0]) + __uint_as_float(rr[1]); }
  l_reg = l_reg * alpha + ps;
#define PK4(P, BASE, OUT) do { unsigned a0 = cvtpk(P[BASE + 0], P[BASE + 1]), a1 = cvtpk(P[BASE + 2], P[BASE + 3]);   \
    unsigned b0 = cvtpk(P[BASE + 4], P[BASE + 5]), b1 = cvtpk(P[BASE + 6], P[BASE + 7]);                              \
    auto r0 = __builtin_amdgcn_permlane32_swap(a0, b0, false, false); auto r1 = __builtin_amdgcn_permlane32_swap(a1, b1, false, false); \
    u32x4 w = {r0[0], r1[0], r0[1], r1[1]}; OUT = *reinterpret_cast<bf16x8*>(&w); } while (0)
  PK4(p0, 0, pa0); PK4(p0, 8, pa1); PK4(p1, 0, pa2); PK4(p1, 8, pa3);
#undef PK4
}
__device__ __forceinline__ void qkt(f32x16& p0, f32x16& p1, const bf16* Ks, const bf16x8* qr, int r32, int hi) {
  p0 = f32x16{}; p1 = f32x16{};
  for (int d0 = 0; d0 < 8; ++d0) { int cb = (d0 * 16 + hi * 8) * 2;
    bf16x8 b0 = *reinterpret_cast<const bf16x8*>((const char*)Ks + KSWZ(r32, cb));
    bf16x8 b1 = *reinterpret_cast<const bf16x8*>((const char*)Ks + KSWZ(32 + r32, cb));
    p0 = __builtin_amdgcn_mfma_f32_32x32x16_bf16(b0, qr[d0], p0, 0, 0, 0);
    p1 = __builtin_amdgcn_mfma_f32_32x32x16_bf16(b1, qr[d0], p1, 0, 0, 0); }
}
__device__ __forceinline__ int v_st(int k, int c) { const int kk = (k & ~0xC) | ((k & 4) << 1) | ((k & 8) >> 1); return ((kk >> 3) * 4 + (c >> 5)) * 512 + ((kk & 7) * 32 + (c & 31)) * 2; }
__device__ __forceinline__ int v_rd_base(int lane) { return ((lane & 3) << 3) | (((lane >> 2) & 3) << 6) | (((lane >> 4) & 1) << 5) | (((lane >> 5) & 1) << 8); }
constexpr int v_rd_off(int d0, int ks, int half) { return d0 * 512 + ks * 4096 + half * 2048; }
template <int OFF> __device__ __forceinline__ s16x4 tr_read(int vb) {
  s16x4 r; asm volatile("ds_read_b64_tr_b16 %0, %1 offset:%2" : "=&v"(r) : "v"(vb), "i"(OFF) : "memory"); return r;
}
template <int D0> __device__ __forceinline__ void pv_one(f32x16& od, int vb, bf16x8 pa0, bf16x8 pa1, bf16x8 pa2, bf16x8 pa3) {
  const s16x4 l0 = tr_read<v_rd_off(D0, 0, 0)>(vb), h0 = tr_read<v_rd_off(D0, 0, 1)>(vb), l1 = tr_read<v_rd_off(D0, 1, 0)>(vb), h1 = tr_read<v_rd_off(D0, 1, 1)>(vb);
  const s16x4 l2 = tr_read<v_rd_off(D0, 2, 0)>(vb), h2 = tr_read<v_rd_off(D0, 2, 1)>(vb), l3 = tr_read<v_rd_off(D0, 3, 0)>(vb), h3 = tr_read<v_rd_off(D0, 3, 1)>(vb);
  asm volatile("s_waitcnt lgkmcnt(0)" ::: "memory"); SBAR();
#define PK(L, H) (bf16x8){L[0], L[1], L[2], L[3], H[0], H[1], H[2], H[3]}
  od = __builtin_amdgcn_mfma_f32_32x32x16_bf16(pa0, PK(l0, h0), od, 0, 0, 0);
  od = __builtin_amdgcn_mfma_f32_32x32x16_bf16(pa1, PK(l1, h1), od, 0, 0, 0);
  od = __builtin_amdgcn_mfma_f32_32x32x16_bf16(pa2, PK(l2, h2), od, 0, 0, 0);
  od = __builtin_amdgcn_mfma_f32_32x32x16_bf16(pa3, PK(l3, h3), od, 0, 0, 0);
#undef PK
}
__device__ __forceinline__ void pv_d0(f32x16* o, int vb, bf16x8 pa0, bf16x8 pa1, bf16x8 pa2, bf16x8 pa3) {
  pv_one<0>(o[0], vb, pa0, pa1, pa2, pa3); pv_one<1>(o[1], vb, pa0, pa1, pa2, pa3); pv_one<2>(o[2], vb, pa0, pa1, pa2, pa3); pv_one<3>(o[3], vb, pa0, pa1, pa2, pa3);
}

template <typename TQ>
__device__ __forceinline__ void attn_dense_body(const TQ* __restrict__ Qb, const bf16* __restrict__ Kh, const bf16* __restrict__ Vh,
                                                unsigned char* __restrict__ Ob, int seq, char* lds) {
  using St = Stage<bf16>; using SQ = Stage<TQ>;
  int tid_o = threadIdx.x; asm volatile("" : "+v"(tid_o)); const int tid = tid_o, wid = tid >> 6, lane = tid & 63, r32 = lane & 31, hi = lane >> 5;
  bf16* V_lds = (bf16*)lds; bf16* K_lds = (bf16*)(lds + 2 * SHM_V);
  float* ws = (float*)(lds + 2 * SHM_V + 2 * SHM_K) + wid * 64; float* li_l = ws; float* al_l = ws + 32;
  float m_reg = -1e30f, l_reg = 0; f32x16 o[4] = {}; bf16x8 qr[8];
  const TQ* Qw = Qb + (long)(wid * QBLK + r32) * LDQ + hi * 8;
#pragma unroll
  for (int d0 = 0; d0 < 8; ++d0) qr[d0] = SQ::tobf(SQ::ld8(Qw + d0 * 16));
  const int sr = tid >> 4, sc = (tid & 15) * 8, vst0 = v_st(sr, sc), vst1 = v_st(32 + sr, sc);
  const int vb0 = (int)(uintptr_t)V_lds + v_rd_base(lane);
  struct { typename St::T vs0, vs1, ks0, ks1; } sr_[SDEPTH];
#define SLOAD(i, k0) do { sr_[i].vs0 = St::ld8(&Vh[(long)((k0) + sr) * LDK + sc]); sr_[i].vs1 = St::ld8(&Vh[(long)((k0) + 32 + sr) * LDK + sc]); \
    sr_[i].ks0 = St::ld8(&Kh[(long)((k0) + sr) * LDK + sc]); sr_[i].ks1 = St::ld8(&Kh[(long)((k0) + 32 + sr) * LDK + sc]); } while (0)
#define SWRITE(b, i) do { *(bf16x8*)((char*)V_lds + (b) * SHM_V + vst0) = St::tobf(sr_[i].vs0);          \
    *(bf16x8*)((char*)V_lds + (b) * SHM_V + vst1) = St::tobf(sr_[i].vs1); int kc = sc * 2;               \
    *(bf16x8*)((char*)K_lds + (b) * SHM_K + KSWZ(sr, kc)) = St::tobf(sr_[i].ks0);                       \
    *(bf16x8*)((char*)K_lds + (b) * SHM_K + KSWZ(32 + sr, kc)) = St::tobf(sr_[i].ks1); } while (0)
#define SWAIT() do { if constexpr (SDEPTH == 2) asm volatile("s_waitcnt vmcnt(4)" ::: "memory"); else asm volatile("s_waitcnt vmcnt(0)" ::: "memory"); } while (0)
#define RESC(a) do { if (__any((a) < 1.f)) { if (hi == 0) al_l[r32] = (a); asm volatile("s_waitcnt lgkmcnt(0)" ::: "memory"); \
    for (int d = 0; d < 4; ++d) for (int r = 0; r < 16; ++r) o[d][r] *= al_l[crow(r, hi)]; } } while (0)
  f32x16 pA0, pA1, pB0, pB1; float mnA, mnB, alA, alB; bf16x8 pa0, pa1, pa2, pa3; const int NT = seq / KVBLK;
  constexpr int SE = 0, SO = SDEPTH - 1;
  SLOAD(SE, 0); asm volatile("s_waitcnt vmcnt(0)" ::: "memory"); SWRITE(0, SE); __syncthreads();
  qkt(pA0, pA1, K_lds, qr, r32, hi); partialSM(pA0, pA1, m_reg, mnA, alA);
  SLOAD(SO, KVBLK); if constexpr (SDEPTH == 2) { if (2 < NT) SLOAD(SE, 2 * KVBLK); }
  SWAIT(); SWRITE(1, SO); __syncthreads();
  for (int j = 1; j + 1 < NT; j += 2) {
    SBAR(); qkt(pB0, pB1, (bf16*)((char*)K_lds + SHM_K), qr, r32, hi);
    finishSM(pA0, pA1, alA, l_reg, pa0, pa1, pa2, pa3); SBAR();
    SLOAD(SO, (j + SDEPTH) * KVBLK); SBAR();
    pv_d0(o, vb0, pa0, pa1, pa2, pa3); partialSM(pB0, pB1, m_reg, mnB, alB);
    __syncthreads(); SWAIT(); SWRITE(0, SE);
    RESC(alB); __syncthreads();
    SBAR(); qkt(pA0, pA1, K_lds, qr, r32, hi);
    finishSM(pB0, pB1, alB, l_reg, pa0, pa1, pa2, pa3); SBAR();
    if (SDEPTH == 1 || j + 3 < NT) SLOAD(SE, (j + 1 + SDEPTH) * KVBLK); SBAR();
    pv_d0(o, vb0 + (int)SHM_V, pa0, pa1, pa2, pa3); partialSM(pA0, pA1, m_reg, mnA, alA);
    __syncthreads(); SWAIT(); SWRITE(1, SO);
    RESC(alA); __syncthreads();
  }
  SBAR(); qkt(pB0, pB1, (bf16*)((char*)K_lds + SHM_K), qr, r32, hi);
  finishSM(pA0, pA1, alA, l_reg, pa0, pa1, pa2, pa3); SBAR();
  pv_d0(o, vb0, pa0, pa1, pa2, pa3); partialSM(pB0, pB1, m_reg, mnB, alB);
  __syncthreads(); RESC(alB);
  finishSM(pB0, pB1, alB, l_reg, pa0, pa1, pa2, pa3); SBAR();
  pv_d0(o, vb0 + (int)SHM_V, pa0, pa1, pa2, pa3);
  if (hi == 0) li_l[r32] = l_reg; asm volatile("s_waitcnt lgkmcnt(0)" ::: "memory");
  float rli[16];
#pragma unroll
  for (int r = 0; r < 16; ++r) rli[r] = __builtin_amdgcn_rcpf(li_l[crow(r, hi)]);
  unsigned char* Ow = Ob + (long)(wid * QBLK) * LDO;
#pragma unroll
  for (int r = 0; r < 16; ++r) { int orow = crow(r, hi);
    for (int d0 = 0; d0 < 4; ++d0) Ow[(long)orow * LDO + d0 * 32 + r32] = (unsigned char)(__builtin_amdgcn_cvt_pk_fp8_f32(__builtin_amdgcn_fmed3f(o[d0][r] * rli[r] * 16.0f, -440.f, 440.f), 0.f, 0, false) & 0xff); }
#undef SLOAD
#undef SWRITE
#undef SWAIT
#undef RESC
}
#undef KSWZ
#undef SBAR
}

#define LAS __attribute__((address_space(3)))
typedef unsigned short bf16_t;
typedef short bf16x8 __attribute__((ext_vector_type(8)));
typedef float f32x4 __attribute__((ext_vector_type(4)));
typedef float f32x2 __attribute__((ext_vector_type(2)));
typedef float f32x16 __attribute__((ext_vector_type(16)));
typedef unsigned u32x4 __attribute__((ext_vector_type(4)));
typedef unsigned u32x2 __attribute__((ext_vector_type(2)));

constexpr int NTOK = 16384, DMODEL = 2048, SEQL = 8192;
constexpr size_t MiB = 1u << 20;
constexpr size_t WS_MOD = 0;
constexpr size_t WS_BAR = 512 * 1024;
constexpr size_t WS_S5A = 1 * MiB;
constexpr size_t WS_LNST = 296 * MiB;
constexpr size_t WS_ABT = 2 * MiB;
constexpr size_t WS_BIASQ = 2 * MiB + 64 * 1024;
constexpr size_t WS_ROWSQ = 336 * MiB;
constexpr size_t WS_BIASP = 340 * MiB;
constexpr size_t WS_WQF = 304 * MiB;
constexpr size_t WS_KEYS = 4 * MiB;
constexpr size_t WS_WSB = 5 * MiB;
constexpr size_t WS_WINE = 6 * MiB;
constexpr size_t WS_WOUTE = 16 * MiB;
constexpr size_t WS_WINO = 24 * MiB;
constexpr size_t WS_WOUTO = 56 * MiB;
constexpr size_t WS_WQ = 72 * MiB;
constexpr size_t WS_PU = 88 * MiB;
constexpr size_t WS_PV = 152 * MiB;
constexpr size_t WS_PSC = 5 * MiB + 512 * 1024;
constexpr int PEER_ROWB = 1536;
constexpr bool PEER_SLICE_U = true, PEER_SLICE_V = true;
typedef unsigned u32x6 __attribute__((ext_vector_type(6)));
typedef float f32x16 __attribute__((ext_vector_type(16)));
typedef float f32x32 __attribute__((ext_vector_type(32)));
typedef _Float16 h16x2 __attribute__((ext_vector_type(2)));
typedef _Float16 h16x32 __attribute__((ext_vector_type(32)));
constexpr size_t WS_WY = 216 * MiB;
constexpr size_t WS_WSUM = 232 * MiB;
constexpr size_t WS_H8 = 256 * MiB;
constexpr size_t WS_H = 344 * MiB;
constexpr size_t WS_XB = WS_H;
constexpr size_t WS_TMP = 408 * MiB;
constexpr size_t WS_AB = WS_TMP  , WS_Q = WS_TMP + 64 * MiB, WS_K = WS_TMP + 96 * MiB, WS_V = WS_TMP + 104 * MiB,
                 WS_SS = WS_TMP + 112 * MiB  , WS_CAT = WS_TMP + 176 * MiB;
constexpr size_t WS_Z = WS_TMP, WS_SG = WS_TMP + 256 * MiB;
constexpr size_t WS_QP = WS_TMP;
constexpr size_t WS_X8 = WS_TMP + 64 * MiB;
constexpr size_t WS_RSTD = WS_TMP + 64 * MiB;
constexpr size_t WS_EID = WS_TMP + 128 * MiB;
constexpr size_t WS_GATE = WS_TMP + 136 * MiB;
constexpr size_t WS_PW = WS_TMP + 144 * MiB;
constexpr size_t WS_PO = WS_TMP + 152 * MiB;
constexpr size_t WS_PACT = WS_TMP + 216 * MiB;
typedef unsigned u32x16 __attribute__((ext_vector_type(16)));
typedef __bf16 bf16x2v __attribute__((ext_vector_type(2)));
constexpr size_t WS_END = WS_TMP + 384 * MiB;
constexpr int LDS_BYTES = 147456;

struct P {
    const float *x, *c, *ada_w, *ada_b, *norm_g, *even_w_in, *even_w_out, *lam_re, *lam_im, *log_dt, *b_re, *b_im, *c_re, *c_im, *s5_d, *glu_w, *glu_b,
        *q_g, *k_g, *odd_w_in, *odd_w_out, *sgu_ln_g, *sgu_w, *sgu_b, *peer_wq, *peer_k1, *peer_k2, *peer_u, *peer_v, *final_g;
    float* out; unsigned char* ws;
};

__device__ __forceinline__ unsigned cvtpk(float lo, float hi) { unsigned r; asm("v_cvt_pk_bf16_f32 %0, %1, %2" : "=v"(r) : "v"(lo), "v"(hi)); return r; }
__device__ __forceinline__ unsigned pk_fp8x4(float a, float b, float c, float d) {
    a = __builtin_amdgcn_fmed3f(a, -440.f, 440.f); b = __builtin_amdgcn_fmed3f(b, -440.f, 440.f); c = __builtin_amdgcn_fmed3f(c, -440.f, 440.f); d = __builtin_amdgcn_fmed3f(d, -440.f, 440.f);
    int w = 0; w = __builtin_amdgcn_cvt_pk_fp8_f32(a, b, w, false); w = __builtin_amdgcn_cvt_pk_fp8_f32(c, d, w, true); return (unsigned)w; }
constexpr float F8_WS = 64.0f, F8_HS = 8.0f, F8_SGS = 8.0f, F8_CS = 16.0f, F8_XS = 8.0f;
__device__ __forceinline__ float bflo(unsigned w) { return __uint_as_float(w << 16); }
__device__ __forceinline__ float bfhi(unsigned w) { return __uint_as_float(w & 0xffff0000u); }
__device__ __forceinline__ float wave_sum(float v) {
    v += __uint_as_float(__builtin_amdgcn_update_dpp(0u, __float_as_uint(v), 0xB1, 0xF, 0xF, true));
    v += __uint_as_float(__builtin_amdgcn_update_dpp(0u, __float_as_uint(v), 0x4E, 0xF, 0xF, true));
    v += __uint_as_float(__builtin_amdgcn_update_dpp(0u, __float_as_uint(v), 0x141, 0xF, 0xF, true));
    v += __uint_as_float(__builtin_amdgcn_update_dpp(0u, __float_as_uint(v), 0x140, 0xF, 0xF, true));
    { const auto r = __builtin_amdgcn_permlane16_swap(__float_as_uint(v), __float_as_uint(v), false, false); v = __uint_as_float(r[0]) + __uint_as_float(r[1]); }
    { const auto r = __builtin_amdgcn_permlane32_swap(__float_as_uint(v), __float_as_uint(v), false, false); v = __uint_as_float(r[0]) + __uint_as_float(r[1]); }
    return v;
}
__device__ __forceinline__ float row16_sum(float v) {
    v += __uint_as_float(__builtin_amdgcn_update_dpp(0u, __float_as_uint(v), 0xB1, 0xF, 0xF, true));
    v += __uint_as_float(__builtin_amdgcn_update_dpp(0u, __float_as_uint(v), 0x4E, 0xF, 0xF, true));
    v += __uint_as_float(__builtin_amdgcn_update_dpp(0u, __float_as_uint(v), 0x141, 0xF, 0xF, true));
    v += __uint_as_float(__builtin_amdgcn_update_dpp(0u, __float_as_uint(v), 0x140, 0xF, 0xF, true));
    return v;
}
__device__ __forceinline__ float xrow_sum(float v) {
    { const auto r = __builtin_amdgcn_permlane16_swap(__float_as_uint(v), __float_as_uint(v), false, false); v = __uint_as_float(r[0]) + __uint_as_float(r[1]); }
    { const auto r = __builtin_amdgcn_permlane32_swap(__float_as_uint(v), __float_as_uint(v), false, false); v = __uint_as_float(r[0]) + __uint_as_float(r[1]); }
    return v;
}
__device__ __forceinline__ float sigmoid_f(float x) { return __builtin_amdgcn_rcpf(1.f + __expf(-x)); }
__device__ __forceinline__ float gelu_t(float x) { const float u = 0.7978845608028654f * (x + 0.044715f * x * x * x); return x * __builtin_amdgcn_rcpf(1.f + __expf(-2.f * u)); }
__device__ __forceinline__ void sincos_rad(float ang, float& sn, float& cs) {
    float rev = ang * 0.15915494309189535f; rev = rev - floorf(rev);
    sn = __builtin_amdgcn_sinf(rev); cs = __builtin_amdgcn_cosf(rev);
}
__device__ __forceinline__ float dot4(f32x4 a, f32x4 b) { return (a.x * b.x + a.y * b.y) + (a.z * b.z + a.w * b.w); }
#define LDS_WAIT() asm volatile("s_waitcnt lgkmcnt(0)" ::: "memory")

namespace pg8 {
constexpr int NTOK_ = 16384;
struct EpiEvenSplit {
    static constexpr bool PERM = true, AFTER_DRAIN = false;
    float ds; unsigned char* wsb;
    __device__ __forceinline__ void operator()(const f32x4 (&acc)[2][2][4][2], const Unit& u, int wr, int wc, int fr, int fq) const {
        { const int l_ = lane_id_v(); fr = l_ & 15; fq = l_ >> 4; }
        const int row0 = u.pm * BM + wr * 64 + fr; const int pn = u.pn;
        bf16_t* const UA = (bf16_t*)(wsb + WS_AB);
        if (pn < 4) {
#pragma unroll
            for (int ai = 0; ai < 2; ++ai)
#pragma unroll
                for (int m = 0; m < 4; ++m) { const int t = row0 + ai * HALF + m * 16;
#pragma unroll
                    for (int bj = 0; bj < 2; ++bj) { const int c = pn * 256 + bj * HALF + wc * 32 + 8 * fq; const f32x4 v0 = acc[ai][bj][m][0] * ds, v1 = acc[ai][bj][m][1] * ds;
                        u32x4 w; w.x = cvt_pk_bf16(v0[0], v0[1]); w.y = cvt_pk_bf16(v0[2], v0[3]); w.z = cvt_pk_bf16(v1[0], v1[1]); w.w = cvt_pk_bf16(v1[2], v1[3]);
                        *(u32x4*)(UA + ((size_t)(c >> 4) * 1024 + (t >> 4)) * 512 + (t & 15) * 16 + (c & 15)) = w; } }
            return;
        }
        bf16_t* base; int ldc, colt;
        if (pn < 8) { base = (bf16_t*)(wsb + WS_Q); ldc = 1024; colt = (pn - 4) * 256; } else { base = (bf16_t*)(wsb + (pn == 8 ? WS_K : WS_V)); ldc = 256; colt = 0; }
        const int col0 = colt + wc * 32 + 8 * fq;
#pragma unroll
        for (int ai = 0; ai < 2; ++ai)
#pragma unroll
            for (int m = 0; m < 4; ++m) { bf16_t* rowp = base + (size_t)(row0 + ai * HALF + m * 16) * ldc + col0;
#pragma unroll
                for (int bj = 0; bj < 2; ++bj) { const f32x4 v0 = acc[ai][bj][m][0] * ds, v1 = acc[ai][bj][m][1] * ds;
                    u32x4 w; w.x = cvt_pk_bf16(v0[0], v0[1]); w.y = cvt_pk_bf16(v0[2], v0[3]); w.z = cvt_pk_bf16(v1[0], v1[1]); w.w = cvt_pk_bf16(v1[2], v1[3]);
                    *(u32x4*)(rowp + bj * HALF) = w; } }
    }
};
template <int ACT> struct EpiBf16T {
    static constexpr bool PERM = true, AFTER_DRAIN = false;
    bf16_t* O; int ldc; float ds; float* lnst;
    __device__ __forceinline__ void operator()(const f32x4 (&acc)[2][2][4][2], const Unit& u, int wr, int wc, int fr, int fq) const {
        { const int l_ = lane_id_v(); fr = l_ & 15; fq = l_ >> 4; }
        const int row0 = u.pm * BM + wr * 64 + fr, col0 = u.pn * BM + wc * 32 + 8 * fq;
        const bool do_st = (ACT == 1) && lnst != nullptr && u.pn >= 16;
#pragma unroll
        for (int ai = 0; ai < 2; ++ai)
#pragma unroll
            for (int m = 0; m < 4; ++m) { const int trow = row0 + ai * HALF + m * 16;
                bf16_t* rowp = (ACT == 1) ? O + ((size_t)((trow >> 7) * 16 + (col0 >> 9)) * 128 + (trow & 127)) * 512 + (col0 & 511) : O + (size_t)trow * ldc + col0; float s1 = 0.f, s2 = 0.f;
#pragma unroll
                for (int bj = 0; bj < 2; ++bj) { f32x4 v0 = acc[ai][bj][m][0] * ds, v1 = acc[ai][bj][m][1] * ds;
                    if (ACT == 1) {
#pragma unroll
                        for (int e = 0; e < 4; ++e) { v0[e] = gelu_t(v0[e]); v1[e] = gelu_t(v1[e]); s1 += v0[e] + v1[e]; s2 += v0[e] * v0[e] + v1[e] * v1[e]; } }
                    u32x4 w; w.x = cvt_pk_bf16(v0[0], v0[1]); w.y = cvt_pk_bf16(v0[2], v0[3]); w.z = cvt_pk_bf16(v1[0], v1[1]); w.w = cvt_pk_bf16(v1[2], v1[3]);
                    *(u32x4*)(rowp + bj * HALF) = w; }
                if (ACT == 1) { if (do_st) {
                    s1 = xrow_sum(s1); s2 = xrow_sum(s2);
                    if (fq == 0) *(f32x2*)(lnst + ((size_t)((u.pn - 16) * 4 + wc) * NTOK_ + (row0 + ai * HALF + m * 16)) * 2) = (f32x2){s1, s2}; } }
            }
    }
};
struct EpiResid {
    static constexpr bool PERM = false, AFTER_DRAIN = false;
    const float* xin; float* xout; const float* gate; float ds;
    __device__ __forceinline__ void operator()(const f32x4 (&acc)[2][2][4][2], const Unit& u, int wr, int wc, int fr, int fq) const {
        { const int l_ = lane_id_v(); fr = l_ & 15; fq = l_ >> 4; }
        const int row0 = u.pm * BM + wr * 64 + fr, col0 = u.pn * BM + wc * 32 + 4 * fq;
        const float* gp = gate + (size_t)((u.pm * BM) >> 13) * 12288 + col0;
        f32x4 gv[2][2];
#pragma unroll
        for (int bj = 0; bj < 2; ++bj)
#pragma unroll
            for (int n = 0; n < 2; ++n) gv[bj][n] = *(const f32x4*)(gp + bj * HALF + n * 16) * ds;
#pragma unroll
        for (int ai = 0; ai < 2; ++ai)
#pragma unroll
            for (int m = 0; m < 4; ++m) { const size_t off = (size_t)(row0 + ai * HALF + m * 16) * 2048 + col0;
#pragma unroll
                for (int bj = 0; bj < 2; ++bj)
#pragma unroll
                    for (int n = 0; n < 2; ++n) { const f32x4 xi = *(const f32x4*)(xin + off + bj * HALF + n * 16);
                        *(f32x4*)(xout + off + bj * HALF + n * 16) = xi + gv[bj][n] * acc[ai][bj][m][n]; } }
    }
};
struct EpiF32B {
    static constexpr bool PERM = false, AFTER_DRAIN = false;
    float* C; int ldc; size_t bs;
    __device__ __forceinline__ void operator()(const f32x4 (&acc)[2][2][4][2], const Unit& u, int wr, int wc, int fr, int fq) const {
        { const int l_ = lane_id_v(); fr = l_ & 15; fq = l_ >> 4; }
        char* base = (char*)(C + (size_t)u.pb * bs + (size_t)(u.pm * BM) * ldc);
        const unsigned off0 = (unsigned)((wr * 64 + fr) * ldc + u.pn * BM + wc * 32 + 4 * fq) * 4u;
#pragma unroll
        for (int ai = 0; ai < 2; ++ai)
#pragma unroll
            for (int m = 0; m < 4; ++m) { const unsigned off = off0 + (unsigned)((ai * HALF + m * 16) * ldc) * 4u;
#pragma unroll
                for (int bj = 0; bj < 2; ++bj)
#pragma unroll
                    for (int n = 0; n < 2; ++n) *(f32x4*)(base + off + (bj * HALF + n * 16) * 4) = acc[ai][bj][m][n]; }
    }
};
struct EpiS5Glu {
    static constexpr bool PERM = false, AFTER_DRAIN = false;
    unsigned char* CAT; const PG8_LAS float* wl;
    __device__ __forceinline__ void operator()(const f32x4 (&acc)[2][2][4][2], const Unit& u, int wr, int wc, int fr, int fq) const {
        { const int l_ = lane_id_v(); fr = l_ & 15; fq = l_ >> 4; }
        const int g = u.pb;
#pragma unroll
        for (int ai = 0; ai < 2; ++ai)
#pragma unroll
            for (int m = 0; m < 4; ++m) {
                const int chunk = u.pm * BM + ai * HALF + wr * 64 + m * 16 + fr, token = chunk * 16 + wc * 4 + fq;
                float y[16];
#pragma unroll
                for (int bj = 0; bj < 2; ++bj)
#pragma unroll
                    for (int n = 0; n < 2; ++n)
#pragma unroll
                        for (int j = 0; j < 4; ++j) y[8 * bj + 4 * n + j] = gelu_t(acc[ai][bj][m][n][j]);
                f32x4 z[4];
#pragma unroll
                for (int kq = 0; kq < 4; ++kq) z[kq] = *(const PG8_LAS f32x4*)(wl + 256 + 4 * kq);
#pragma unroll
                for (int h = 0; h < 16; ++h)
#pragma unroll
                    for (int kq = 0; kq < 4; ++kq) z[kq] += *(const PG8_LAS f32x4*)(wl + h * 16 + 4 * kq) * y[h];
                float o[16];
#pragma unroll
                for (int k = 0; k < 16; ++k) o[k] = y[k] * sigmoid_f(z[k >> 2][k & 3]);
                u32x4 w; w.x = pk_fp8x4(o[0] * F8_CS, o[1] * F8_CS, o[2] * F8_CS, o[3] * F8_CS); w.y = pk_fp8x4(o[4] * F8_CS, o[5] * F8_CS, o[6] * F8_CS, o[7] * F8_CS);
                w.z = pk_fp8x4(o[8] * F8_CS, o[9] * F8_CS, o[10] * F8_CS, o[11] * F8_CS); w.w = pk_fp8x4(o[12] * F8_CS, o[13] * F8_CS, o[14] * F8_CS, o[15] * F8_CS);
                *(u32x4*)(CAT + (size_t)token * 2048 + g * 16) = w;
                asm volatile("" ::: "memory");
            }
    }
};
template <bool FIRST> struct EpiResidB {
    static constexpr bool PERM = true, AFTER_DRAIN = false;
    const float* xin; bf16_t* xb; const float* gate; float* rowsq; unsigned char* x8; float ds;
    __device__ __forceinline__ void operator()(const f32x4 (&acc)[2][2][4][2], const Unit& u, int wr, int wc, int fr, int fq) const {
        { const int l_ = lane_id_v(); fr = l_ & 15; fq = l_ >> 4; }
        const int row0 = u.pm * BM + wr * 64 + fr, col0 = u.pn * BM + wc * 32 + 8 * fq;
        const float* gp = gate + (size_t)((u.pm * BM) >> 13) * 12288 + col0; float* const rq = rowsq;
        f32x4 gv[2][2];
#pragma unroll
        for (int bj = 0; bj < 2; ++bj)
#pragma unroll
            for (int n = 0; n < 2; ++n) gv[bj][n] = *(const f32x4*)(gp + bj * HALF + n * 4) * ds;
#pragma unroll
        for (int ai = 0; ai < 2; ++ai) {
            f32x4 xi[4][2][2];
#pragma unroll
            for (int m = 0; m < 4; ++m) { const size_t off = (size_t)(row0 + ai * HALF + m * 16) * 2048 + col0;
#pragma unroll
                for (int bj = 0; bj < 2; ++bj) {
                    if (FIRST) { xi[m][bj][0] = *(const f32x4*)(xin + off + bj * HALF); xi[m][bj][1] = *(const f32x4*)(xin + off + bj * HALF + 4); }
                    else { const u32x4 w = *(const u32x4*)(xb + off + bj * HALF);
                        xi[m][bj][0] = (f32x4){__uint_as_float(w.x << 16), __uint_as_float(w.x & 0xffff0000u), __uint_as_float(w.y << 16), __uint_as_float(w.y & 0xffff0000u)};
                        xi[m][bj][1] = (f32x4){__uint_as_float(w.z << 16), __uint_as_float(w.z & 0xffff0000u), __uint_as_float(w.w << 16), __uint_as_float(w.w & 0xffff0000u)}; } } }
            asm volatile("" ::: "memory");
#pragma unroll
            for (int m = 0; m < 4; ++m) { const int row = row0 + ai * HALF + m * 16; const size_t off = (size_t)row * 2048 + col0; float ss = 0.f;
#pragma unroll
                for (int bj = 0; bj < 2; ++bj) { const f32x4 x0 = xi[m][bj][0] + gv[bj][0] * acc[ai][bj][m][0], x1 = xi[m][bj][1] + gv[bj][1] * acc[ai][bj][m][1];
                    ss += ((x0[0] * x0[0] + x0[1] * x0[1]) + (x0[2] * x0[2] + x0[3] * x0[3])) + ((x1[0] * x1[0] + x1[1] * x1[1]) + (x1[2] * x1[2] + x1[3] * x1[3]));
                    u32x4 o; o.x = cvt_pk_bf16(x0[0], x0[1]); o.y = cvt_pk_bf16(x0[2], x0[3]); o.z = cvt_pk_bf16(x1[0], x1[1]); o.w = cvt_pk_bf16(x1[2], x1[3]); *(u32x4*)(xb + off + bj * HALF) = o;
                    u32x2 o8; o8.x = pk_fp8x4(x0[0] * F8_XS, x0[1] * F8_XS, x0[2] * F8_XS, x0[3] * F8_XS); o8.y = pk_fp8x4(x1[0] * F8_XS, x1[1] * F8_XS, x1[2] * F8_XS, x1[3] * F8_XS); *(u32x2*)(x8 + off + bj * HALF) = o8; }
                ss = xrow_sum(ss);
                if (fq == 0) rq[(size_t)(u.pn * 4 + wc) * NTOK_ + row] = ss; }
        }
    }
};
struct EpiQ {
    static constexpr bool PERM = true, AFTER_DRAIN = false;
    bf16_t* O; const float* rowsq; const float* bias; float ds;
    __device__ __forceinline__ void operator()(const f32x4 (&acc)[2][2][4][2], const Unit& u, int wr, int wc, int fr, int fq) const {
        { const int l_ = lane_id_v(); fr = l_ & 15; fq = l_ >> 4; }
        const int row0 = u.pm * BM + wr * 64 + fr, col0 = u.pn * BM + wc * 32 + 8 * fq;
        const float* bp = bias + (size_t)((u.pm * BM) >> 13) * 2048 + col0;
        f32x4 bv[2][2];
#pragma unroll
        for (int bj = 0; bj < 2; ++bj)
#pragma unroll
            for (int n = 0; n < 2; ++n) bv[bj][n] = *(const f32x4*)(bp + bj * HALF + 4 * n);
        float rstd[2][4];
#pragma unroll
        for (int ai = 0; ai < 2; ++ai)
#pragma unroll
            for (int m = 0; m < 4; ++m) { const int row = row0 + ai * HALF + m * 16; float sq = 0.f;
#pragma unroll
                for (int t = 0; t < 8; ++t) sq += rowsq[(size_t)(fq * 8 + t) * NTOK_ + row];
                rstd[ai][m] = rsqrtf(xrow_sum(sq) * (1.0f / 2048.0f) + 1e-6f) * ds; }
#pragma unroll
        for (int ai = 0; ai < 2; ++ai)
#pragma unroll
            for (int m = 0; m < 4; ++m) { const int row = row0 + ai * HALF + m * 16; bf16_t* rowp = O + (size_t)row * 2048 + col0;
#pragma unroll
                for (int bj = 0; bj < 2; ++bj) { const f32x4 v0 = acc[ai][bj][m][0] * rstd[ai][m] + bv[bj][0], v1 = acc[ai][bj][m][1] * rstd[ai][m] + bv[bj][1];
                    u32x4 w; w.x = cvt_pk_bf16(v0[0], v0[1]); w.y = cvt_pk_bf16(v0[2], v0[3]); w.z = cvt_pk_bf16(v1[0], v1[1]); w.w = cvt_pk_bf16(v1[2], v1[3]);
                    *(u32x4*)(rowp + bj * HALF) = w; } }
    }
};
struct BatchOrder {
    int nM, nU, G, c;
    __device__ __forceinline__ bool next(int i, Unit& u) const { const int L = i * G + c; if (L >= nU) return false; u.pb = L / nM; u.pm = L % nM; u.pn = 0; return true; }
    __device__ __forceinline__ void a_ready(const Unit&) const {}
    __device__ __forceinline__ void done(const Unit&) const {}
};
}

__device__ __forceinline__ unsigned f2bf_rne(float f) { unsigned u = __builtin_bit_cast(unsigned, f); return (u + 0x7fffu + ((u >> 16) & 1u)) >> 16; }
__device__ __forceinline__ unsigned pk2(float lo, float hi) { return f2bf_rne(lo) | (f2bf_rne(hi) << 16); }
__device__ __forceinline__ void p0_transpose_item(const float* W, int K, int N, bf16_t* WT, LAS float* scr, int item, int lane) {
    const int nblk = N / 32, kb = item / nblk, nb = item % nblk, k0 = 64 * kb, n0 = 32 * nb;
#pragma unroll 8
    for (int i = 0; i < 32; ++i) { const int kk = 2 * i + (lane >> 5); scr[kk * 33 + (lane & 31)] = W[(size_t)(k0 + kk) * N + n0 + (lane & 31)]; }
    LDS_WAIT(); asm volatile("" ::: "memory");
    const int c = lane & 7;
#pragma unroll
    for (int j = 0; j < 4; ++j) { const int n = (lane >> 3) + 8 * j; const LAS float* s = scr + (8 * c) * 33 + n;
        u32x4 o; o.x = pk2(s[0 * 33], s[1 * 33]); o.y = pk2(s[2 * 33], s[3 * 33]); o.z = pk2(s[4 * 33], s[5 * 33]); o.w = pk2(s[6 * 33], s[7 * 33]);
        *(u32x4*)(WT + (size_t)(n0 + n) * K + k0 + 8 * c) = o; }
    LDS_WAIT(); asm volatile("" ::: "memory");
}

__device__ __forceinline__ void p0_transpose_item_f8(const float* W, int K, int N, unsigned char* WT, LAS float* scr, int item, int lane, float sc) {
    const int nblk = N / 32, kb = item / nblk, nb = item % nblk, k0 = 64 * kb, n0 = 32 * nb;
#pragma unroll 8
    for (int i = 0; i < 32; ++i) { const int kk = 2 * i + (lane >> 5); scr[kk * 33 + (lane & 31)] = W[(size_t)(k0 + kk) * N + n0 + (lane & 31)] * sc; }
    LDS_WAIT(); asm volatile("" ::: "memory");
    const int c = lane & 7;
#pragma unroll
    for (int j = 0; j < 4; ++j) { const int n = (lane >> 3) + 8 * j; const LAS float* s = scr + (8 * c) * 33 + n;
        u32x2 o; o.x = pk_fp8x4(s[0 * 33], s[1 * 33], s[2 * 33], s[3 * 33]); o.y = pk_fp8x4(s[4 * 33], s[5 * 33], s[6 * 33], s[7 * 33]);
        *(u32x2*)(WT + (size_t)(n0 + n) * K + k0 + 8 * c) = o; }
    LDS_WAIT(); asm volatile("" ::: "memory");
}

__device__ __forceinline__ void s5_gen_group(const P& p, LAS unsigned char* lds, int g, int tid) {
    LAS f32x2* pw = (LAS f32x2*)lds;
    LAS f32x2* Cc = (LAS f32x2*)(lds + 17408);
    LAS f32x2* Bb = (LAS f32x2*)(lds + 17408 + 16384);
    LAS float* Kt = (LAS float*)(lds + 17408 + 32768);
    LAS float* dsk = (LAS float*)(lds + 17408 + 65536);
    __syncthreads();
    if (tid < 128) {
        const int d = tid >> 6, pp = tid & 63, dgp = (d * 64 + g) * 64 + pp;
        const float lr = fminf(p.lam_re[dgp], -1e-4f), li = p.lam_im[dgp], dt = __expf(p.log_dt[d * 64 + g]);
        const float lrdt = lr * dt, ang = li * dt;
#pragma unroll 1
        for (int e = 0; e <= 16; ++e) { const float mag = __expf((float)e * lrdt); float sn, cs; sincos_rad((float)e * ang, sn, cs); pw[e * 128 + tid] = (f32x2){mag * cs, mag * sn}; }
        const f32x2 a1 = pw[128 + tid]; const float abr = a1.x, abi = a1.y;
        const float den = lr * lr + li * li, nr = abr - 1.0f;
        const float cre = (nr * lr + abi * li) / den, cim = (abi * lr - nr * li) / den;
        ((f32x2*)(p.ws + WS_S5A))[dgp] = pw[16 * 128 + tid];
#pragma unroll 4
        for (int h = 0; h < 16; ++h) { const float br = p.b_re[dgp * 16 + h], bi = p.b_im[dgp * 16 + h]; Bb[(d * 64 + pp) * 16 + h] = (f32x2){cre * br - cim * bi, cre * bi + cim * br}; }
    }
    for (int i = tid; i < 2048; i += 512) { const int d = i >> 10, h = (i >> 6) & 15, pp = i & 63; const size_t src = ((size_t)(d * 64 + g) * 16 + h) * 64 + pp; Cc[i] = (f32x2){p.c_re[src], p.c_im[src]}; }
    if (tid < 16) dsk[tid] = p.s5_d[g * 16 + tid];
    __syncthreads();
    {
        const int d = tid >> 8, tau = (tid >> 4) & 15, h = tid & 15; float acc[16];
#pragma unroll
        for (int hp = 0; hp < 16; ++hp) acc[hp] = 0.f;
#pragma unroll 2
        for (int pp = 0; pp < 64; ++pp) { const f32x2 c = Cc[(d * 16 + h) * 64 + pp], w = pw[tau * 128 + d * 64 + pp]; const float tx = c.x * w.x - c.y * w.y, ty = c.x * w.y + c.y * w.x;
#pragma unroll
            for (int hp = 0; hp < 16; ++hp) { const f32x2 bb = Bb[(d * 64 + pp) * 16 + hp]; acc[hp] += tx * bb.x - ty * bb.y; } }
#pragma unroll
        for (int hp = 0; hp < 16; ++hp) Kt[(d * 16 + tau) * 256 + h * 16 + hp] = acc[hp];
    }
    __syncthreads();
    bf16_t* Wy = (bf16_t*)(p.ws + WS_WY) + (size_t)g * 256 * 512;
#pragma unroll 1
    for (int idx = tid; idx < 256 * 256; idx += 512) {
        const int np = idx >> 8, k0 = (idx & 255) * 2;
        const int bj = (np >> 7) & 1, wc = (np >> 5) & 3, n = (np >> 4) & 1, fq = (np >> 2) & 3, j = np & 3, i = wc * 4 + fq, h = 8 * bj + 4 * n + j;
        float v[2];
#pragma unroll
        for (int kk = 0; kk < 2; ++kk) { const int k = k0 + kk;
            if (k < 256) { const int s = k >> 4, hp = k & 15;
                if (s < i) v[kk] = Kt[(i - s) * 256 + h * 16 + hp]; else if (s > i) v[kk] = Kt[(16 + (s - i)) * 256 + h * 16 + hp];
                else v[kk] = Kt[h * 16 + hp] + Kt[16 * 256 + h * 16 + hp] + (h == hp ? dsk[h] : 0.f);
            } else { const int kc = k - 256, d = kc >> 7, pp = (kc >> 1) & 63, ri = kc & 1, e = d ? 16 - i : i + 1;
                const f32x2 c = Cc[(d * 16 + h) * 64 + pp], w = pw[e * 128 + d * 64 + pp]; v[kk] = ri ? -(c.x * w.y + c.y * w.x) : (c.x * w.x - c.y * w.y); } }
        *(unsigned*)(Wy + (size_t)np * 512 + k0) = cvtpk(v[0], v[1]);
    }
    bf16_t* Wsum = (bf16_t*)(p.ws + WS_WSUM) + (size_t)g * 256 * 256;
#pragma unroll 1
    for (int idx = tid; idx < 256 * 128; idx += 512) {
        const int r = idx >> 7, k0 = (idx & 127) * 2, d = r >> 7, pp = (r >> 1) & 63, ri = r & 1;
        float v[2];
#pragma unroll
        for (int kk = 0; kk < 2; ++kk) { const int k = k0 + kk, s = k >> 4, hp = k & 15, e = d ? s : 15 - s;
            const f32x2 w = pw[e * 128 + d * 64 + pp], bb = Bb[(d * 64 + pp) * 16 + hp]; v[kk] = ri ? (w.x * bb.y + w.y * bb.x) : (w.x * bb.x - w.y * bb.y); }
        *(unsigned*)(Wsum + (size_t)r * 256 + k0) = cvtpk(v[0], v[1]);
    }
}

#ifndef PRO_DBL
#define PRO_DBL 0
#endif
#define PRO_REP(b) for (int _pr = 0; _pr < 1 + ((PRO_DBL >> (b)) & 1); ++_pr)
__device__ __forceinline__ void phase_prologue(const P& p, LAS unsigned char* lds, int tid, int lane, int wid) {
    unsigned char* ws = p.ws;
    LAS float* cact = (LAS float*)lds;
    LAS float* red = (LAS float*)(lds + 16384);
    for (int i = tid; i < 4096; i += 512) { const float cv = p.c[i]; cact[i] = cv * sigmoid_f(cv); }
    __syncthreads();
    float* mod = (float*)(ws + WS_MOD);
    PRO_REP(0) for (int item = blockIdx.x; item < 192; item += gridDim.x) {
        const int l = item / 96, cb = item % 96, cg4 = tid & 31, rl = tid >> 5;
        const float* W = p.ada_w + (size_t)l * 2048 * 12288 + cb * 128 + cg4 * 4;
        f32x4 a0 = {0.f, 0.f, 0.f, 0.f}, a1 = {0.f, 0.f, 0.f, 0.f};
#pragma unroll 8
        for (int r = rl; r < 2048; r += 16) { const f32x4 w = *(const f32x4*)(W + (size_t)r * 12288); const float c0 = cact[r], c1 = cact[2048 + r]; a0 += w * c0; a1 += w * c1; }
        *(LAS f32x4*)(red + (rl * 32 + cg4) * 8) = a0; *(LAS f32x4*)(red + (rl * 32 + cg4) * 8 + 4) = a1;
        __syncthreads();
        if (tid < 256) { const int col = tid & 127, b = tid >> 7; float s = 0.f;
#pragma unroll
            for (int r2 = 0; r2 < 16; ++r2) s += red[(r2 * 32 + (col >> 2)) * 8 + b * 4 + (col & 3)];
            s += p.ada_b[l * 12288 + cb * 128 + col]; mod[(l * 2 + b) * 12288 + cb * 128 + col] = s; }
        __syncthreads();
    }
    PRO_REP(1) {
        LAS float* scr = (LAS float*)(lds + 32768 + wid * 8448);
        const int gw = blockIdx.x * 8 + wid, ngw = gridDim.x * 8;
        constexpr int I0 = 32 * 80, I1 = 32 * 64, I2 = 32 * 256, I3 = 64 * 64, NIT = I0 + I1 + I2 + I3;
        for (int it = gw; it < NIT; it += ngw) {
            int r = it;
            if (r < I0) { p0_transpose_item_f8(p.even_w_in, 2048, 2560, ws + WS_WINE, scr, r, lane, F8_WS); continue; } r -= I0;
            if (r < I1) { p0_transpose_item_f8(p.even_w_out, 2048, 2048, ws + WS_WOUTE, scr, r, lane, F8_WS); continue; } r -= I1;
            if (r < I2) { p0_transpose_item_f8(p.odd_w_in, 2048, 8192, ws + WS_WINO, scr, r, lane, F8_WS); continue; } r -= I2;
            p0_transpose_item_f8(p.odd_w_out, 4096, 2048, ws + WS_WOUTO, scr, r, lane, F8_WS);
        }
    }
    const long gtid = (long)blockIdx.x * 512 + tid, ngt = (long)gridDim.x * 512;
    PRO_REP(2) {
        const int gw = blockIdx.x * 8 + wid, ngw = gridDim.x * 8;
        float* psc = (float*)(ws + WS_PSC);
        for (int row0 = 4 * gw; row0 < 4 * 16384; row0 += 4 * ngw) {
            f32x4 v[4][8]; float am[4]; const float* src[4]; unsigned char* dst[4];
#pragma unroll
            for (int rr = 0; rr < 4; ++rr) { const int row = row0 + rr; const bool tv = row >= 2 * 16384; const int r = tv ? row - 2 * 16384 : row;
                const bool sl = tv ? PEER_SLICE_V : PEER_SLICE_U;
                src[rr] = (tv ? p.peer_v : p.peer_u) + (size_t)r * 2048; dst[rr] = ws + (tv ? WS_PV : WS_PU) + (size_t)r * PEER_ROWB;
#pragma unroll
                for (int j = 0; j < 8; ++j) v[rr][j] = *(const f32x4*)(src[rr] + (sl ? 4 * (lane + 64 * j) : 16 * lane + 1024 * (j >> 2) + 4 * (j & 3))); }
#pragma unroll
            for (int rr = 0; rr < 4; ++rr) { am[rr] = 0.f;
#pragma unroll
                for (int j = 0; j < 8; ++j) am[rr] = fmaxf(am[rr], fmaxf(fmaxf(fabsf(v[rr][j].x), fabsf(v[rr][j].y)), fmaxf(fabsf(v[rr][j].z), fabsf(v[rr][j].w))));
#pragma unroll
                for (int o = 32; o > 0; o >>= 1) am[rr] = fmaxf(am[rr], __shfl_xor(am[rr], o)); }
#pragma unroll
            for (int rr = 0; rr < 4; ++rr) { const int row = row0 + rr;
                const float sc = am[rr] > 0.f ? 7.5f / am[rr] : 1.0f;
                if (lane == 0) psc[row] = am[rr] > 0.f ? am[rr] * (1.0f / 7.5f) : 1.0f;
                f32x16 ev, od;
#pragma unroll
                for (int j = 0; j < 8; ++j) { const f32x4 t = v[rr][j] * sc; ev[2 * j] = t.x; od[2 * j] = t.y; ev[2 * j + 1] = t.z; od[2 * j + 1] = t.w; }
                const u32x6 q = __builtin_amdgcn_cvt_scalef32_2xpk16_fp6_f32(ev, od, 1.0f);
                const bool tv = row >= 2 * 16384; const int r = tv ? row - 2 * 16384 : row;
                if (!(tv ? PEER_SLICE_V : PEER_SLICE_U)) {
                    *(u32x4*)(dst[rr] + 16 * lane) = (u32x4){q[0], q[1], q[2], q[3]};
                    *(u32x2*)(dst[rr] + 1024 + 8 * lane) = (u32x2){q[4], q[5]};
                } else {
                    unsigned char* sb = ws + (tv ? WS_PV : WS_PU) + (size_t)(r >> 14) * 16384 * PEER_ROWB + (size_t)(r & 16383) * 192 + 12 * (lane >> 2) + 4 * (lane & 3);
                    const unsigned pc[8] = {q[0] & 0xFFFFFFu, (q[0] >> 24) | ((q[1] & 0xFFFFu) << 8), (q[1] >> 16) | ((q[2] & 0xFFu) << 16), q[2] >> 8,
                                            q[3] & 0xFFFFFFu, (q[3] >> 24) | ((q[4] & 0xFFFFu) << 8), (q[4] >> 16) | ((q[5] & 0xFFu) << 16), q[5] >> 8};
                    const int i8 = 8 * (lane & 3);
#pragma unroll
                    for (int j = 0; j < 8; ++j) { const unsigned nx = __builtin_amdgcn_update_dpp(0u, pc[j], 0xF9, 0xF, 0xF, true);
                        const unsigned d = (pc[j] >> i8) | (nx << (24 - i8));
                        if ((lane & 3) < 3) *(unsigned*)(sb + (size_t)j * 16384 * 192) = d; }
                } }
        }
    }
    PRO_REP(3) for (int g = (int)gridDim.x - 1 - (int)blockIdx.x; g < 64; g += gridDim.x) s5_gen_group(p, lds, g, tid);
    for (long i = gtid; i < 65536; i += ngt) { const int layer = (int)(i >> 15), half = (int)(i >> 14) & 1, r = (int)(i & 16383);
        ((bf16_t*)(ws + WS_KEYS))[i] = (bf16_t)f2bf_rne((half ? p.peer_k2 : p.peer_k1)[layer * 16384 + r]); }
    for (long i = gtid; i < 131072; i += ngt) ((bf16_t*)(ws + WS_WSB))[i] = (bf16_t)f2bf_rne(p.sgu_w[i]);
}

template <bool OUT8>
__device__ __forceinline__ void phase_adaln(const float* xin, void* hout_, const float* g, const float* shift, const float* scale, int gw, int ngw, int lane) {
    for (int b = 0; b < 2; ++b) {
        f32x4 A[8], Bc[8];
#pragma unroll
        for (int j = 0; j < 8; ++j) { const int c = 8 * lane + 512 * (j >> 1) + 4 * (j & 1);
            const f32x4 gv = *(const f32x4*)(g + c), sc = *(const f32x4*)(scale + b * 12288 + c); A[j] = gv * (sc + 1.0f); Bc[j] = *(const f32x4*)(shift + b * 12288 + c); }
#pragma unroll 1
        for (int row0 = b * 8192 + gw; row0 < (b + 1) * 8192; row0 += 4 * ngw) {
            f32x4 v[4][8];
#pragma unroll
            for (int k = 0; k < 4; ++k) { const int row = row0 + k * ngw < (b + 1) * 8192 ? row0 + k * ngw : row0; const float* xr = xin + (size_t)row * 2048 + 8 * lane;
#pragma unroll
                for (int j = 0; j < 8; ++j) v[k][j] = *(const f32x4*)(xr + 512 * (j >> 1) + 4 * (j & 1)); }
#pragma unroll
            for (int k = 0; k < 4; ++k) { const int row = row0 + k * ngw < (b + 1) * 8192 ? row0 + k * ngw : row0; float ss = 0.f;
#pragma unroll
                for (int j = 0; j < 8; ++j) ss += dot4(v[k][j], v[k][j]);
                ss = wave_sum(ss); const float rstd = rsqrtf(ss * (1.0f / 2048.0f) + 1e-6f);
                bf16_t* hr = (bf16_t*)hout_ + (size_t)row * 2048 + 8 * lane; unsigned char* hr8 = (unsigned char*)hout_ + (size_t)row * 2048 + 8 * lane;
#pragma unroll
                for (int j = 0; j < 4; ++j) { const f32x4 y0 = v[k][2 * j] * rstd * A[2 * j] + Bc[2 * j], y1 = v[k][2 * j + 1] * rstd * A[2 * j + 1] + Bc[2 * j + 1];
                    if (OUT8) { u32x2 o; o.x = pk_fp8x4(y0.x * F8_HS, y0.y * F8_HS, y0.z * F8_HS, y0.w * F8_HS); o.y = pk_fp8x4(y1.x * F8_HS, y1.y * F8_HS, y1.z * F8_HS, y1.w * F8_HS); *(u32x2*)(hr8 + 512 * j) = o; }
                    else { u32x4 o; o.x = cvtpk(y0.x, y0.y); o.y = cvtpk(y0.z, y0.w); o.z = cvtpk(y1.x, y1.y); o.w = cvtpk(y1.z, y1.w);
                    *(u32x4*)(hr + 512 * j) = o; } } }
        }
    }
}

__device__ __forceinline__ void phase_fold_wq(const P& p, LAS unsigned char* lds, int tid, int lane, int wid) {
    unsigned char* ws = p.ws; const float* mod = (const float*)(ws + WS_MOD);
    for (long i = (long)blockIdx.x * 512 + tid; i < 2 * 2 * 2048; i += (long)gridDim.x * 512) { const int l = (int)(i >> 12), b = (int)(i >> 11) & 1, c = (int)(i & 2047);
        float* ab = (float*)(ws + WS_ABT) + (size_t)(l * 2 + b) * 4096;
        ab[c] = p.norm_g[(l * 2 + 1) * 2048 + c] * (1.0f + mod[(size_t)(l * 2 + b) * 12288 + 4 * 2048 + c]); ab[2048 + c] = mod[(size_t)(l * 2 + b) * 12288 + 3 * 2048 + c]; }
    LAS float* scr = (LAS float*)(lds + wid * 8448);
    const int gw = blockIdx.x * 8 + wid, ngw = gridDim.x * 8;
    for (int it = gw; it < 2 * 2048; it += ngw) {
        const int l = it >> 11, item = it & 2047, kb = item >> 6, nb = item & 63, k0 = 64 * kb, n0 = 32 * nb;
        const float* W = p.peer_wq + (size_t)l * 2048 * 2048;
#pragma unroll 8
        for (int i = 0; i < 32; ++i) { const int kk = 2 * i + (lane >> 5); scr[kk * 33 + (lane & 31)] = W[(size_t)(k0 + kk) * 2048 + n0 + (lane & 31)]; }
        LDS_WAIT(); asm volatile("" ::: "memory");
        const int c = lane & 7;
#pragma unroll
        for (int b = 0; b < 2; ++b) {
            const float* mb = mod + (size_t)(l * 2 + b) * 12288; const float* ng = p.norm_g + (l * 2 + 1) * 2048;
            float A[8];
#pragma unroll
            for (int t = 0; t < 8; ++t) A[t] = ng[k0 + 8 * c + t] * (1.0f + mb[4 * 2048 + k0 + 8 * c + t]);
            unsigned char* WT = ws + WS_WQF + (size_t)(l * 2 + b) * 2048 * 2048;
#pragma unroll
            for (int t = 0; t < 8; ++t) A[t] *= F8_WS;
#pragma unroll
            for (int j = 0; j < 4; ++j) { const int n = (lane >> 3) + 8 * j; const LAS float* s = scr + (8 * c) * 33 + n;
                u32x2 o; o.x = pk_fp8x4(s[0 * 33] * A[0], s[1 * 33] * A[1], s[2 * 33] * A[2], s[3 * 33] * A[3]); o.y = pk_fp8x4(s[4 * 33] * A[4], s[5 * 33] * A[5], s[6 * 33] * A[6], s[7 * 33] * A[7]);
                *(u32x2*)(WT + (size_t)(n0 + n) * 2048 + k0 + 8 * c) = o; }
            { const int n = lane & 31, kh = lane >> 5; float acc = 0.f;
#pragma unroll 8
              for (int t = 0; t < 32; ++t) acc += scr[(32 * kh + t) * 33 + n] * mb[3 * 2048 + k0 + 32 * kh + t];
              acc += __shfl_xor(acc, 32);
              if (lane < 32) ((float*)(ws + WS_BIASP))[((size_t)(l * 2 + b) * 32 + kb) * 2048 + n0 + n] = acc; }
        }
        LDS_WAIT(); asm volatile("" ::: "memory");
    }
}

__device__ __forceinline__ void phase_bias_reduce(const P& p, int tid) {
    for (long i = (long)blockIdx.x * 512 + tid; i < 2 * 2 * 2048; i += (long)gridDim.x * 512) { const int lb = (int)(i >> 11), n = (int)(i & 2047); float acc = 0.f;
#pragma unroll 8
        for (int kb = 0; kb < 32; ++kb) acc += ((const float*)(p.ws + WS_BIASP))[((size_t)lb * 32 + kb) * 2048 + n];
        ((float*)(p.ws + WS_BIASQ))[i] = acc; }
}
__device__ __forceinline__ void phase_qkprep(const P& p, int gw, int ngw, int lane) {
    bf16_t* Q = (bf16_t*)(p.ws + WS_Q); bf16_t* K = (bf16_t*)(p.ws + WS_K);
    const int sub = lane >> 4, ll = lane & 15;
    float inv[4], gq[8], gk[8];
#pragma unroll
    for (int e = 0; e < 4; ++e) inv[e] = __builtin_amdgcn_exp2f(-(float)((4 * ll + e) & 31) * 0.41524101186092029f);
#pragma unroll
    for (int e = 0; e < 8; ++e) { gq[e] = p.q_g[8 * ll + e]; gk[e] = p.k_g[8 * ll + e]; }
#pragma unroll 2
    for (int it = gw; it < NTOK * 10 / 4; it += ngw) {
        const int hr = 4 * it + sub, token = hr / 10, hh = hr - token * 10;
        u32x4* ptr = hh < 8 ? (u32x4*)(Q + (size_t)token * 1024 + hh * 128 + 8 * ll) : (u32x4*)(K + (size_t)token * 256 + (hh - 8) * 128 + 8 * ll);
        const u32x4 w = *ptr;
        float x[8] = {bflo(w.x), bfhi(w.x), bflo(w.y), bfhi(w.y), bflo(w.z), bfhi(w.z), bflo(w.w), bfhi(w.w)};
        float ss = 0.f;
#pragma unroll
        for (int e = 0; e < 8; ++e) ss += x[e] * x[e];
        ss = row16_sum(ss);
        const float r = rsqrtf(ss * (1.0f / 128.0f) + 1e-6f);
        const int s = token & 8191; const float pos = (float)(ll < 8 ? (s >> 6) : (s & 63));
        unsigned o[4];
#pragma unroll
        for (int e = 0; e < 4; ++e) { const float x1 = x[2 * e] * r * (hh < 8 ? gq[2 * e] : gk[2 * e]), x2 = x[2 * e + 1] * r * (hh < 8 ? gq[2 * e + 1] : gk[2 * e + 1]);
            float sn, cs; sincos_rad(pos * inv[e], sn, cs); o[e] = cvtpk(x1 * cs - x2 * sn, x1 * sn + x2 * cs); }
        *ptr = (u32x4){o[0], o[1], o[2], o[3]};
    }
}

__device__ __forceinline__ void phase_s5scan(const P& p, LAS unsigned char* lds, int lane, int wid) {
    const f32x2* A16 = (const f32x2*)(p.ws + WS_S5A);
    LAS f32x2* agg = (LAS f32x2*)lds;
    for (int item = blockIdx.x; item < 256; item += gridDim.x) {
        const int b = item >> 7, g = (item >> 1) & 63, d = item & 1;
        const f32x2 a = A16[(d * 64 + g) * 64 + lane];
        const float* S = (const float*)(p.ws + WS_SS) + ((size_t)g * 1024 + b * 512) * 256 + d * 128 + 2 * lane;
        bf16_t* HIN = (bf16_t*)(p.ws + WS_AB) + ((size_t)g * 1024 + b * 512) * 512 + 256 + d * 128 + 2 * lane;
        const int sA = 2 * wid + (d ? 1 : 0), sB = 2 * wid + (d ? 0 : 1), ordA = d ? 15 - sA : sA;
        float ar = 0.f, ai = 0.f, br = 0.f, bi = 0.f;
#pragma unroll 16
        for (int k = 0; k < 32; ++k) { const int o = d ? 31 - k : k; const f32x2 va = *(const f32x2*)(S + (size_t)(32 * sA + o) * 256), vb = *(const f32x2*)(S + (size_t)(32 * sB + o) * 256);
            const float nar = a.x * ar - a.y * ai + va.x, nai = a.x * ai + a.y * ar + va.y, nbr = a.x * br - a.y * bi + vb.x, nbi = a.x * bi + a.y * br + vb.y; ar = nar; ai = nai; br = nbr; bi = nbi; }
        __syncthreads();
        agg[ordA * 64 + lane] = (f32x2){ar, ai}; agg[(ordA + 1) * 64 + lane] = (f32x2){br, bi};
        __syncthreads();
        float pr = a.x, pi = a.y;
#pragma unroll
        for (int q = 0; q < 5; ++q) { const float nr = pr * pr - pi * pi, ni = 2.f * pr * pi; pr = nr; pi = ni; }
        float cr = 0.f, ci = 0.f;
        for (int s2 = 0; s2 < ordA; ++s2) { const f32x2 v = agg[s2 * 64 + lane]; const float nr = pr * cr - pi * ci + v.x, ni = pr * ci + pi * cr + v.y; cr = nr; ci = ni; }
        const float dr = pr * cr - pi * ci + ar, di = pr * ci + pi * cr + ai;
        ar = cr; ai = ci; br = dr; bi = di;
#pragma unroll 16
        for (int k = 0; k < 32; ++k) { const int o = d ? 31 - k : k; const size_t ca = (size_t)(32 * sA + o), cb = (size_t)(32 * sB + o);
            *(unsigned*)(HIN + ca * 512) = cvtpk(ar, ai); *(unsigned*)(HIN + cb * 512) = cvtpk(br, bi);
            const f32x2 va = *(const f32x2*)(S + ca * 256), vb = *(const f32x2*)(S + cb * 256);
            const float nar = a.x * ar - a.y * ai + va.x, nai = a.x * ai + a.y * ar + va.y, nbr = a.x * br - a.y * bi + vb.x, nbi = a.x * bi + a.y * br + vb.y; ar = nar; ai = nai; br = nbr; bi = nbi; }
    }
}

__device__ __forceinline__ void phase_attn(const P& p, char* lds) {
    const bf16_t* Q = (const bf16_t*)(p.ws + WS_Q); const bf16_t* K = (const bf16_t*)(p.ws + WS_K); const bf16_t* V = (const bf16_t*)(p.ws + WS_V);
    unsigned char* CAT = p.ws + WS_CAT;
    const int G = gridDim.x, bx = blockIdx.x, vcu = (G % 8 == 0) ? (bx % 8) * (G / 8) + bx / 8 : bx;
    for (int unit = vcu; unit < 512; unit += G) {
        const int bk = unit >> 7, rem = unit & 127, b = bk >> 1, kvh = bk & 1, h = kvh * 4 + (rem >> 5), qb = rem & 31;
        attn::attn_dense_body<attn::bf16>((const attn::bf16*)(Q + (size_t)(b * 8192 + qb * 256) * 1024 + h * 128),
                                          (const attn::bf16*)(K + (size_t)(b * 8192) * 256 + kvh * 128), (const attn::bf16*)(V + (size_t)(b * 8192) * 256 + kvh * 128),
                                          CAT + (size_t)(b * 8192 + qb * 256) * 2048 + 1024 + h * 128, 8192, lds);
        __syncthreads();
    }
}

constexpr int SGU_VS = 136;
constexpr int SGU_HB = 71680;
constexpr int SGU_VNT = 0, SGU_STG = 128 * SGU_VS * 2, SGU_STAT = 2 * 128 * SGU_VS * 2, SGU_BS = SGU_STAT + 1024;
static_assert(SGU_BS + 512 <= SGU_HB && 2 * SGU_HB <= LDS_BYTES - 64 && SGU_HB % 16 == 0, "SGU LDS map");
__device__ __forceinline__ void phase_sgu(const P& p, LAS unsigned char* lds, int tid, int lane, int wid) {
    const int hb = wid >> 2, w4 = wid & 3, t256 = tid & 255;
    LAS unsigned char* base = lds + hb * SGU_HB;
    LAS bf16_t* vnT = (LAS bf16_t*)(base + SGU_VNT);
    LAS bf16_t* stg = (LAS bf16_t*)(base + SGU_STG);
    LAS f32x2* stats = (LAS f32x2*)(base + SGU_STAT);
    LAS float* bs = (LAS float*)(base + SGU_BS);
    const bf16_t* Z = (const bf16_t*)(p.ws + WS_Z); unsigned char* SG = p.ws + WS_SG;
    const bf16_t* Wsb = (const bf16_t*)(p.ws + WS_WSB);
    const int fr = lane & 15, fq = lane >> 4, wi = w4 & 1, wc = w4 >> 1, i0 = 64 * wi, c0 = 64 * wc;
    for (int up = blockIdx.x; up < 512; up += gridDim.x) {
        const int unit = 2 * up + hb, n = unit >> 3, g = unit & 7;
        __syncthreads();
        if (t256 < 128) { const f32x2* part = (const f32x2*)(p.ws + WS_LNST) + (size_t)(2 * g * 4) * NTOK + (n * 128 + t256); float s1 = 0.f, s2 = 0.f;
#pragma unroll
            for (int q = 0; q < 8; ++q) { const f32x2 a2 = part[(size_t)q * NTOK]; s1 += a2.x; s2 += a2.y; }
            const float mean = s1 * (1.0f / 512.0f), var = fmaxf(s2 * (1.0f / 512.0f) - mean * mean, 0.f); stats[t256] = (f32x2){mean, rsqrtf(var + 1e-6f)};
            bs[t256] = p.sgu_b[g * 128 + t256]; }
        bf16x8 Af[4][4];
#pragma unroll
        for (int m = 0; m < 4; ++m)
#pragma unroll
            for (int ks = 0; ks < 4; ++ks) Af[m][ks] = *(const bf16x8*)(Wsb + (size_t)(g * 128 + i0 + 16 * m + fr) * 128 + 32 * ks + 8 * fq);
#pragma unroll 1
        for (int qt = 0; qt < 4; ++qt) {
            const int chb = g * 512 + qt * 128;
            __syncthreads();
            { u32x4 T[8];
#pragma unroll
              for (int q = 0; q < 8; ++q) { const int pc = t256 + 256 * q, j = pc >> 4, ch = (pc & 15) * 8; T[q] = *(const u32x4*)(Z + ((size_t)(n * 16 + 8 + g) * 128 + j) * 512 + qt * 128 + ch); }
#pragma unroll
              for (int q = 0; q < 8; ++q) { const int pc = t256 + 256 * q, j = pc >> 4, ch = (pc & 15) * 8; *(LAS u32x4*)(stg + j * SGU_VS + ch) = T[q]; } }
            __syncthreads();
#pragma unroll 1
            for (int slab = 0; slab < 2; ++slab) {
                const int cc = slab * 64 + lane; const float lng = p.sgu_ln_g[chb + cc];
                const int cl = cc & 63, rp = (cc & ~63) + ((cl >> 2) & 3) * 16 + (cl >> 4) * 4 + (cl & 3);
#pragma unroll
                for (int jg = 0; jg < 4; ++jg) {
                    const int j0 = 32 * w4 + 8 * jg; float y[8];
#pragma unroll
                    for (int k = 0; k < 8; ++k) { const float xv = bflo((unsigned)stg[(j0 + k) * SGU_VS + cc]); const f32x2 st = stats[j0 + k]; y[k] = (xv - st.x) * st.y * lng; }
                    u32x4 o; o.x = cvtpk(y[0], y[1]); o.y = cvtpk(y[2], y[3]); o.z = cvtpk(y[4], y[5]); o.w = cvtpk(y[6], y[7]);
                    *(LAS u32x4*)(vnT + rp * SGU_VS + j0) = o;
                }
            }
            __syncthreads();
#pragma unroll 1
            for (int np = 0; np < 2; ++np) {
                u32x4 U[4];
#pragma unroll
                for (int m = 0; m < 4; ++m) U[m] = *(const u32x4*)(Z + ((size_t)(n * 16 + g) * 128 + i0 + 16 * m + fr) * 512 + qt * 128 + c0 + 16 * fq + 8 * np);
                f32x4 acc[4][2];
#pragma unroll
                for (int m = 0; m < 4; ++m)
#pragma unroll
                    for (int nn = 0; nn < 2; ++nn) acc[m][nn] = (f32x4){0.f, 0.f, 0.f, 0.f};
#pragma unroll
                for (int ks = 0; ks < 4; ++ks) {
                    bf16x8 Bf[2];
#pragma unroll
                    for (int nn = 0; nn < 2; ++nn) Bf[nn] = *(const LAS bf16x8*)(vnT + (c0 + 16 * (2 * np + nn) + fr) * SGU_VS + 32 * ks + 8 * fq);
#pragma unroll
                    for (int m = 0; m < 4; ++m)
#pragma unroll
                        for (int nn = 0; nn < 2; ++nn) acc[m][nn] = __builtin_amdgcn_mfma_f32_16x16x32_bf16(Bf[nn], Af[m][ks], acc[m][nn], 0, 0, 0);
                }
#pragma unroll
                for (int m = 0; m < 4; ++m) { const int i = i0 + 16 * m + fr; const float bi = bs[i]; const size_t tok = (size_t)(n * 128 + i);
                    const int cch = chb + c0 + 16 * fq + 8 * np;
                    const u32x4 u0 = U[m];
                    const f32x4 s0 = acc[m][0] + bi, s1 = acc[m][1] + bi;
                    u32x2 o;
                    o.x = pk_fp8x4(bflo(u0.x) * s0.x * F8_SGS, bfhi(u0.x) * s0.y * F8_SGS, bflo(u0.y) * s0.z * F8_SGS, bfhi(u0.y) * s0.w * F8_SGS);
                    o.y = pk_fp8x4(bflo(u0.z) * s1.x * F8_SGS, bfhi(u0.z) * s1.y * F8_SGS, bflo(u0.w) * s1.z * F8_SGS, bfhi(u0.w) * s1.w * F8_SGS);
                    *(u32x2*)(SG + tok * 4096 + cch) = o; }
            }
        }
    }
}
#define XB_TMO      128
#define XB_XCNT(j)  (256  + 64 * (j))
#define XB_XSUB(j)  (1280 + 64 * (j))
#define XB_XGEN(j)  (2304 + 64 * (j))
#define XB_TOP      3328
#define XB_TOPGEN   3392
#define XCD_BAR_WORDS 3456
#define XB_SPIN_CAP (1u << 22)

__device__ __forceinline__ unsigned xb_ld(unsigned* p)              { return __hip_atomic_load(p, __ATOMIC_RELAXED, __HIP_MEMORY_SCOPE_AGENT); }
__device__ __forceinline__ unsigned xb_add(unsigned* p, unsigned v) { return __hip_atomic_fetch_add(p, v, __ATOMIC_RELAXED, __HIP_MEMORY_SCOPE_AGENT); }
__device__ __forceinline__ unsigned xb_xcc_id() { return (unsigned)__builtin_amdgcn_s_getreg((3 << 11) | 20) & 0xFu; }
#define XB_SPIN(cond, bar) do { unsigned _sp = 0; while (cond) { __builtin_amdgcn_s_sleep(1); \
    if ((++_sp & 255u) == 0u) { if (xb_ld(&(bar)[XB_TMO])) break; if (_sp > XB_SPIN_CAP) { atomicAdd(&(bar)[XB_TMO], 1u); break; } } } } while (0)

struct XcdBarrier {
    unsigned* bar; unsigned x;
    volatile LAS unsigned* st;
};

__device__ __forceinline__ XcdBarrier xcd_barrier_post(unsigned* bar, volatile LAS unsigned* st) {
    XcdBarrier b; b.bar = bar; b.x = xb_xcc_id(); b.st = st;
    if (threadIdx.x == 0) st[2] = xb_add(&bar[XB_XCNT(b.x)], 1u);
    return b;
}
__device__ __forceinline__ void xcd_barrier_complete(unsigned* bar, unsigned x, unsigned& nloc, unsigned& nx) {
    const unsigned G = gridDim.x * gridDim.y * gridDim.z;
    unsigned sum, cnt, mine, sp = 0u;
    for (;;) {
        sum = 0u; cnt = 0u; mine = 0u;
#pragma unroll
        for (unsigned j = 0; j < 16; ++j) { const unsigned c = xb_ld(&bar[XB_XCNT(j)]); sum += c; cnt += (c > 0u) ? 1u : 0u; mine = (j == x) ? c : mine; }
        if (sum == G) break;
        __builtin_amdgcn_s_sleep(1);
        if ((++sp & 255u) == 0u) { if (xb_ld(&bar[XB_TMO])) break; if (sp > XB_SPIN_CAP) { atomicAdd(&bar[XB_TMO], 1u); break; } }
    }
    nloc = mine > 0u ? mine : 1u; nx = cnt > 0u ? cnt : 1u;
}

__device__ __forceinline__ void xcd_barrier(const XcdBarrier& b) {
    asm volatile("s_waitcnt vmcnt(0)" ::: "memory");
    __syncthreads();
    if (threadIdx.x == 0) {
        unsigned* bar = b.bar;
        __builtin_amdgcn_s_waitcnt(0);
        unsigned nloc = b.st[0], nx = b.st[1];
        if (nloc == 0u) { xcd_barrier_complete(bar, b.x, nloc, nx); b.st[0] = nloc; b.st[1] = nx; }
        const unsigned old = xb_add(&bar[XB_XSUB(b.x)], 1u);
        const unsigned gen = old / nloc;
        if (old + 1u == (gen + 1u) * nloc) {
            __builtin_amdgcn_fence(__ATOMIC_RELEASE, "agent");
            asm volatile("s_waitcnt vmcnt(0)" ::: "memory");
            const unsigned og = xb_add(&bar[XB_TOP], 1u);
            const unsigned tg = og / nx;
            if (og + 1u == (tg + 1u) * nx) xb_add(&bar[XB_TOPGEN], 1u);
            else XB_SPIN(xb_ld(&bar[XB_TOPGEN]) == tg, bar);
            __builtin_amdgcn_fence(__ATOMIC_ACQUIRE, "agent");
            xb_add(&bar[XB_XGEN(b.x)], 1u);
            asm volatile("s_waitcnt vmcnt(0)" ::: "memory");
        } else {
            XB_SPIN(xb_ld(&bar[XB_XGEN(b.x)]) == gen, bar);
            __builtin_amdgcn_fence(__ATOMIC_ACQUIRE, "agent");
            asm volatile("s_waitcnt vmcnt(0)" ::: "memory");
        }
    }
    __syncthreads();
}

__device__ __forceinline__ void ce_desc(float& a, float& b) { const float mx = fmaxf(a, b), mn = fminf(a, b); a = mx; b = mn; }
__device__ __forceinline__ void bitonic_sort16_desc(float (&a)[16]) {
#pragma unroll
    for (int k = 2; k <= 16; k <<= 1)
#pragma unroll
        for (int j = k >> 1; j > 0; j >>= 1)
#pragma unroll
            for (int i = 0; i < 16; ++i) { const int l = i ^ j; if (l > i) { if ((i & k) == 0) ce_desc(a[i], a[l]); else ce_desc(a[l], a[i]); } }
}
__device__ __forceinline__ void merge_top16(float (&V)[16], const float (&S)[16]) {
#pragma unroll
    for (int i = 0; i < 16; ++i) V[i] = fmaxf(V[i], S[15 - i]);
#pragma unroll
    for (int j = 8; j > 0; j >>= 1)
#pragma unroll
        for (int i = 0; i < 16; ++i) { const int l = i ^ j; if (l > i) ce_desc(V[i], V[l]); }
}
__device__ __forceinline__ float with_payload(float v, unsigned mask, unsigned pay) { return __uint_as_float((__float_as_uint(v) & ~mask) | pay); }

__device__ __forceinline__ void peer_topk_half(const bf16_t* qrow, const bf16_t* keys, int r32, int hi, float (&V)[16]) {
    bf16x8 qf[8];
#pragma unroll
    for (int ks = 0; ks < 8; ++ks) qf[ks] = *(const bf16x8*)(qrow + 16 * ks + 8 * hi);
#pragma unroll
    for (int k = 0; k < 16; ++k) V[k] = -INFINITY;
#pragma unroll 1
    for (int t = 0; t < 4; ++t) {
        f32x16 s = (f32x16){0.f, 0.f, 0.f, 0.f, 0.f, 0.f, 0.f, 0.f, 0.f, 0.f, 0.f, 0.f, 0.f, 0.f, 0.f, 0.f};
#pragma unroll
        for (int ks = 0; ks < 8; ++ks) { const bf16x8 kf = *(const bf16x8*)(keys + (size_t)(t * 32 + r32) * 128 + 16 * ks + 8 * hi);
            s = __builtin_amdgcn_mfma_f32_32x32x16_bf16(kf, qf[ks], s, 0, 0, 0); }
        float S[16];
#pragma unroll
        for (int r = 0; r < 16; ++r) S[r] = with_payload(s[r], 0x7Fu, (unsigned)(t * 32 + (r & 3) + 8 * (r >> 2) + 4 * hi));
        bitonic_sort16_desc(S); merge_top16(V, S);
    }
    float PVv[16];
#pragma unroll
    for (int k = 0; k < 16; ++k) { const auto r = __builtin_amdgcn_permlane32_swap(__float_as_uint(V[k]), __float_as_uint(V[k]), false, false); PVv[k] = (hi ? __uint_as_float(r[0]) : __uint_as_float(r[1])); }
    merge_top16(V, PVv);
}

__device__ __forceinline__ void phase_peer_s1(const P& p, int layer, LAS unsigned char* lds, int lane, int wid) {
    LAS int* idxL = (LAS int*)(lds + 65536 + wid * 8192);
    const bf16_t* QP = (const bf16_t*)(p.ws + WS_QP);
    const bf16_t* keys = (const bf16_t*)(p.ws + WS_KEYS) + (size_t)layer * 2 * 16384;
    const float* rowsq = (const float*)(p.ws + WS_ROWSQ) + (size_t)layer * 32 * NTOK; float* RSTD = (float*)(p.ws + WS_RSTD);
    int* EID = (int*)(p.ws + WS_EID); float* GATE = (float*)(p.ws + WS_GATE);
    const int r32 = lane & 31, hi = lane >> 5, gw = blockIdx.x * 8 + wid, ngw = gridDim.x * 8;
#pragma unroll 1
    for (int tq = gw; tq < NTOK / 4; tq += ngw) {
        {
            const bf16_t* qrow = QP + (size_t)(4 * tq + (r32 >> 3)) * 2048 + (r32 & 7) * 256;
            float v1[16], v2[16];
            peer_topk_half(qrow, keys, r32, hi, v1);
            peer_topk_half(qrow + 128, keys + 16384, r32, hi, v2);
#pragma unroll
            for (int k = 0; k < 16; ++k) { idxL[k * 64 + lane] = (int)(__float_as_uint(v1[k]) & 0x7Fu); idxL[(16 + k) * 64 + lane] = (int)(__float_as_uint(v2[k]) & 0x7Fu); }
            float SC[16], S2[16];
#pragma unroll
            for (int b2 = 0; b2 < 16; ++b2) SC[b2] = with_payload(v1[0] + v2[b2], 0xFFu, (unsigned)b2);
#pragma unroll
            for (int a = 1; a <= 4; ++a) {
#pragma unroll
                for (int b2 = 0; b2 < 16; ++b2) S2[b2] = ((a + 1) * (b2 + 1) <= 16) ? with_payload(v1[a] + v2[b2], 0xFFu, (unsigned)(a * 16 + b2)) : -INFINITY;
                merge_top16(SC, S2); }
#pragma unroll
            for (int a = 5; a <= 7; ++a) { S2[2 * (a - 5)] = with_payload(v1[a] + v2[0], 0xFFu, (unsigned)(a * 16)); S2[2 * (a - 5) + 1] = with_payload(v1[a] + v2[1], 0xFFu, (unsigned)(a * 16 + 1)); }
#pragma unroll
            for (int a = 8; a <= 15; ++a) S2[6 + (a - 8)] = with_payload(v1[a] + v2[0], 0xFFu, (unsigned)(a * 16));
            S2[14] = -INFINITY; S2[15] = -INFINITY;
            bitonic_sort16_desc(S2); merge_top16(SC, S2);
            float e[16], sum = 0.f;
#pragma unroll
            for (int k = 0; k < 16; ++k) { e[k] = __expf(SC[k] - SC[0]); sum += e[k]; }
            const float inv = 1.0f / sum;
            if (hi == 0) {
                u32x4 iw[4]; f32x4 gv[4];
#pragma unroll
                for (int k = 0; k < 16; ++k) { const unsigned pay = __float_as_uint(SC[k]) & 0xFFu;
                    iw[k >> 2][k & 3] = (unsigned)(idxL[(pay >> 4) * 64 + lane] * 128 + idxL[(16 + (pay & 15)) * 64 + lane]); gv[k >> 2][k & 3] = e[k] * inv; }
                const size_t gbase = (size_t)(4 * tq + (r32 >> 3)) * 128 + (r32 & 7) * 16;
#pragma unroll
                for (int k4 = 0; k4 < 4; ++k4) { *(u32x4*)(EID + gbase + 4 * k4) = iw[k4]; *(f32x4*)(GATE + gbase + 4 * k4) = gv[k4]; } }
        }
        {
            const int token = 4 * tq + (lane >> 4), w = lane & 15;
            const float sq = row16_sum(rowsq[(size_t)w * NTOK + token] + rowsq[(size_t)(w + 16) * NTOK + token]);
            if (w == 0) RSTD[token] = rsqrtf(sq * (1.0f / 2048.0f) + 1e-6f); }
    }
}

__device__ __forceinline__ float dot2bf(unsigned a, unsigned b, float acc) { return __builtin_amdgcn_fdot2_f32_bf16(__builtin_bit_cast(bf16x2v, a), __builtin_bit_cast(bf16x2v, b), acc, false); }
__device__ __forceinline__ void peer_partition(const P& p, int myrank, int& part, int& rank, int& nwg) {
    unsigned* bar = (unsigned*)(p.ws + WS_BAR); const unsigned x = xb_xcc_id(); unsigned mine = 0u; bool ok = true;
#pragma unroll
    for (unsigned j = 0; j < 16; ++j) { const unsigned cj = xb_ld(&bar[XB_XCNT(j)]); ok = ok && ((j < 8u) ? (cj > 0u) : (cj == 0u)); mine = (j == x) ? cj : mine; }
    if (ok) { part = (int)x; rank = myrank; nwg = (int)mine; } else { part = (int)blockIdx.x & 7; rank = (int)blockIdx.x >> 3; nwg = (int)gridDim.x >> 3; }
    part = __builtin_amdgcn_readfirstlane(part); rank = __builtin_amdgcn_readfirstlane(rank); nwg = __builtin_amdgcn_readfirstlane(nwg);
}
__device__ __forceinline__ void phase_peer_u(const P& p, int layer, LAS unsigned char* lds, int lane, int wid, int myrank) {
    LAS unsigned char* wl = lds + wid * 16384;
    int part, rank, nwg; peer_partition(p, myrank, part, rank, nwg);
    const unsigned char* PUS = p.ws + WS_PU + (size_t)layer * 16384 * PEER_ROWB + (size_t)part * 16384 * 192;
    const int* EID = (const int*)(p.ws + WS_EID);
    const unsigned char* HB = p.ws + WS_XB + 512 * part;
    const float* RSTD = (const float*)(p.ws + WS_RSTD);
    const float* ABs = (const float*)(p.ws + WS_ABT) + (size_t)layer * 2 * 4096 + 256 * part + 4 * lane;
    float* PACT = (float*)(p.ws + WS_PACT) + (size_t)part * NTOK * 128;
    const int g = lane >> 2, s = lane & 3, nb = NTOK / 8, stride = nwg * 8;
    int tb = rank * 8 + wid;
    if (tb >= nb) return;
    int e0[8], e1[8]; u32x2 hs[8]; float rs[8]; f32x4 Av, Bv;
#define PB_LOAD(TB) { _Pragma("unroll") for (int j = 0; j < 8; ++j) { const size_t t = (size_t)(TB) * 8 + j; e0[j] = EID[t * 128 + lane]; e1[j] = EID[t * 128 + 64 + lane]; hs[j] = *(const u32x2*)(HB + t * 4096 + 8 * lane); rs[j] = RSTD[t]; } \
        Av = *(const f32x4*)(ABs + ((TB) >> 10) * 4096); Bv = *(const f32x4*)(ABs + ((TB) >> 10) * 4096 + 2048); }
#define PB_STORE(BUF) _Pragma("unroll") for (int j = 0; j < 8; ++j) { LAS int* il = (LAS int*)(wl + (BUF) * 8192); il[j * 128 + lane] = e0[j]; il[j * 128 + 64 + lane] = e1[j]; \
        u32x2 hw; hw.x = cvtpk(bflo(hs[j].x) * rs[j] * Av.x + Bv.x, bfhi(hs[j].x) * rs[j] * Av.y + Bv.y); hw.y = cvtpk(bflo(hs[j].y) * rs[j] * Av.z + Bv.z, bfhi(hs[j].y) * rs[j] * Av.w + Bv.w); \
        *(LAS u32x2*)(wl + (BUF) * 8192 + 4096 + j * 512 + 8 * lane) = hw; }
#define PR_LOAD(SLOT, ID) { const unsigned char* ur = PUS + (size_t)(ID) * 192 + 48 * s; R[SLOT][0] = *(const u32x4*)ur; R[SLOT][1] = *(const u32x4*)(ur + 16); R[SLOT][2] = *(const u32x4*)(ur + 32); }
    PB_LOAD(tb) PB_STORE(0)
    u32x4 R[8][3];
    { LAS int* il = (LAS int*)wl;
#pragma unroll
      for (int q = 0; q < 8; ++q) { const int id = il[16 * q + g]; PR_LOAD(q, id) } }
    int bi = 0;
#pragma unroll 1
    for (; tb < nb; tb += stride, bi ^= 1) {
        { const int tbn = tb + stride < nb ? tb + stride : tb; PB_LOAD(tbn) }
#pragma unroll 1
        for (int j = 0; j < 8; ++j) {
            if (j == 7) { PB_STORE(bi ^ 1) }
            LAS int* nid = (j < 7) ? (LAS int*)(wl + bi * 8192) + (j + 1) * 128 : (LAS int*)(wl + (bi ^ 1) * 8192);
            LAS u32x4* hp = (LAS u32x4*)(wl + bi * 8192 + 4096 + j * 512 + s * 128);
            const u32x4 h0 = hp[0], h1 = hp[1], h2 = hp[2], h3 = hp[3], h4 = hp[4], h5 = hp[5], h6 = hp[6], h7 = hp[7];
            float acc[8];
#pragma unroll
            for (int it = 0; it < 8; ++it) {
                const u32x16 dw = __builtin_bit_cast(u32x16, __builtin_amdgcn_cvt_scalef32_pk32_bf16_fp6((u32x6){R[it][0].x, R[it][0].y, R[it][0].z, R[it][0].w, R[it][1].x, R[it][1].y}, 1.0f));
                const u32x16 dx = __builtin_bit_cast(u32x16, __builtin_amdgcn_cvt_scalef32_pk32_bf16_fp6((u32x6){R[it][1].z, R[it][1].w, R[it][2].x, R[it][2].y, R[it][2].z, R[it][2].w}, 1.0f));
                { const int idn = nid[16 * it + g]; PR_LOAD(it, idn) }
                float a0 = 0.f, a1 = 0.f;
                a0 = dot2bf(dw[0], h0.x, a0); a1 = dot2bf(dw[1], h0.y, a1); a0 = dot2bf(dw[2], h0.z, a0); a1 = dot2bf(dw[3], h0.w, a1);
                a0 = dot2bf(dw[4], h1.x, a0); a1 = dot2bf(dw[5], h1.y, a1); a0 = dot2bf(dw[6], h1.z, a0); a1 = dot2bf(dw[7], h1.w, a1);
                a0 = dot2bf(dw[8], h2.x, a0); a1 = dot2bf(dw[9], h2.y, a1); a0 = dot2bf(dw[10], h2.z, a0); a1 = dot2bf(dw[11], h2.w, a1);
                a0 = dot2bf(dw[12], h3.x, a0); a1 = dot2bf(dw[13], h3.y, a1); a0 = dot2bf(dw[14], h3.z, a0); a1 = dot2bf(dw[15], h3.w, a1);
                a0 = dot2bf(dx[0], h4.x, a0); a1 = dot2bf(dx[1], h4.y, a1); a0 = dot2bf(dx[2], h4.z, a0); a1 = dot2bf(dx[3], h4.w, a1);
                a0 = dot2bf(dx[4], h5.x, a0); a1 = dot2bf(dx[5], h5.y, a1); a0 = dot2bf(dx[6], h5.z, a0); a1 = dot2bf(dx[7], h5.w, a1);
                a0 = dot2bf(dx[8], h6.x, a0); a1 = dot2bf(dx[9], h6.y, a1); a0 = dot2bf(dx[10], h6.z, a0); a1 = dot2bf(dx[11], h6.w, a1);
                a0 = dot2bf(dx[12], h7.x, a0); a1 = dot2bf(dx[13], h7.y, a1); a0 = dot2bf(dx[14], h7.z, a0); a1 = dot2bf(dx[15], h7.w, a1);
                float v = a0 + a1;
                v += __uint_as_float(__builtin_amdgcn_update_dpp(0u, __float_as_uint(v), 0xB1, 0xF, 0xF, true));
                v += __uint_as_float(__builtin_amdgcn_update_dpp(0u, __float_as_uint(v), 0x4E, 0xF, 0xF, true));
                acc[it] = v;
            }
            if (s == 0) { float* pa = PACT + ((size_t)tb * 8 + j) * 128 + g;
#pragma unroll
                for (int it = 0; it < 8; ++it) pa[16 * it] = acc[it]; }
        }
    }
#undef PB_LOAD
#undef PB_STORE
#undef PR_LOAD
}

__device__ __forceinline__ void phase_peer_w(const P& p, int layer, int tid) {
    const int* EID = (const int*)(p.ws + WS_EID); const float* GATE = (const float*)(p.ws + WS_GATE); const float* PACT = (const float*)(p.ws + WS_PACT); float* PW = (float*)(p.ws + WS_PW);
    const float* PSU = (const float*)(p.ws + WS_PSC) + layer * 16384; const float* PSV = PSU + 2 * 16384;
#pragma unroll 2
    for (int i4 = (int)blockIdx.x * 512 + tid; i4 < NTOK * 128 / 4; i4 += (int)gridDim.x * 512) {
        const size_t i = (size_t)i4 * 4;
        const u32x4 id4 = *(const u32x4*)(EID + i); const f32x4 g4 = *(const f32x4*)(GATE + i);
        f32x4 a = (f32x4){0.f, 0.f, 0.f, 0.f};
#pragma unroll
        for (int x = 0; x < 8; ++x) a += *(const f32x4*)(PACT + (size_t)x * NTOK * 128 + i);
        f32x4 w;
#pragma unroll
        for (int e = 0; e < 4; ++e) { const int id = (int)id4[e]; w[e] = gelu_t(a[e] * PSU[id]) * g4[e] * PSV[id]; }
        *(f32x4*)(PW + i) = w;
    }
}

__device__ __forceinline__ void phase_peer_vs(const P& p, int layer, LAS unsigned char* lds, int lane, int wid, int myrank) {
    LAS unsigned char* wl = lds + wid * 16384;
    int part, rank, nwg; peer_partition(p, myrank, part, rank, nwg);
    const unsigned char* PVS = p.ws + WS_PV + (size_t)layer * 16384 * PEER_ROWB + (size_t)part * 16384 * 192;
    const int* EID = (const int*)(p.ws + WS_EID); const float* PW = (const float*)(p.ws + WS_PW);
    unsigned char* PO = p.ws + WS_PO + 512 * part;
    const int g = lane >> 3, s = lane & 7, nb = NTOK / 8, stride = nwg * 8;
    const bool b3 = (lane & 8) != 0;
    int tb = rank * 8 + wid;
    if (tb >= nb) return;
    int e0[8], e1[8]; float w0[8], w1[8];
#define PB_LOAD(TB) _Pragma("unroll") for (int j = 0; j < 8; ++j) { const size_t t = (size_t)(TB) * 8 + j; e0[j] = EID[t * 128 + lane]; e1[j] = EID[t * 128 + 64 + lane]; w0[j] = PW[t * 128 + lane]; w1[j] = PW[t * 128 + 64 + lane]; }
#define PB_STORE(BUF) _Pragma("unroll") for (int j = 0; j < 8; ++j) { LAS int* il = (LAS int*)(wl + (BUF) * 8192); LAS float* fl = (LAS float*)(wl + (BUF) * 8192 + 4096); il[j * 128 + lane] = e0[j]; il[j * 128 + 64 + lane] = e1[j]; fl[j * 128 + lane] = w0[j]; fl[j * 128 + 64 + lane] = w1[j]; }
#define PR_LOAD(SLOT, ID) { const unsigned char* vr = PVS + (size_t)(ID) * 192 + 24 * s; R[SLOT][0] = *(const u32x2*)vr; R[SLOT][1] = *(const u32x2*)(vr + 8); R[SLOT][2] = *(const u32x2*)(vr + 16); }
    PB_LOAD(tb) PB_STORE(0)
    u32x2 R[8][3];
    { LAS int* il = (LAS int*)wl;
#pragma unroll
      for (int q = 0; q < 8; ++q) { const int id = il[8 * q + g]; PR_LOAD(q, id) } }
    int bi = 0;
#pragma unroll 1
    for (; tb < nb; tb += stride, bi ^= 1) {
        { const int tbn = tb + stride < nb ? tb + stride : tb; PB_LOAD(tbn) }
#pragma unroll 1
        for (int j = 0; j < 8; ++j) {
            if (j == 7) { PB_STORE(bi ^ 1) }
            LAS int* ids = (LAS int*)(wl + bi * 8192) + j * 128;
            LAS int* nid = (j < 7) ? ids + 128 : (LAS int*)(wl + (bi ^ 1) * 8192);
            LAS float* wv = (LAS float*)(wl + bi * 8192 + 4096) + j * 128;
            h16x2 o2[16];
#pragma unroll
            for (int k = 0; k < 16; ++k) o2[k] = (h16x2){(_Float16)0.f, (_Float16)0.f};
#pragma unroll
            for (int it = 0; it < 16; ++it) {
                const int sl = it & 7;
                const h16x32 d = __builtin_amdgcn_cvt_scalef32_pk32_f16_fp6((u32x6){R[sl][0].x, R[sl][0].y, R[sl][1].x, R[sl][1].y, R[sl][2].x, R[sl][2].y}, 1.0f);
                { const int idn = (it < 8) ? ids[8 * (it + 8) + g] : nid[8 * (it - 8) + g]; PR_LOAD(sl, idn) }
                const _Float16 wh = (_Float16)wv[8 * it + g]; const h16x2 w2 = (h16x2){wh, wh};
#pragma unroll
                for (int k = 0; k < 16; ++k) o2[k] = __builtin_elementwise_fma(w2, (h16x2){d[2 * k], d[2 * k + 1]}, o2[k]);
            }
            h16x2 t8[8], t4[4]; float res[4];
#pragma unroll
            for (int k = 0; k < 8; ++k) { const auto r = __builtin_amdgcn_permlane32_swap(__builtin_bit_cast(unsigned, o2[k]), __builtin_bit_cast(unsigned, o2[8 + k]), false, false);
                unsigned ra = r[0], rb = r[1]; asm volatile("" : "+v"(ra), "+v"(rb)); t8[k] = __builtin_bit_cast(h16x2, ra) + __builtin_bit_cast(h16x2, rb); }
#pragma unroll
            for (int k = 0; k < 4; ++k) { const auto r = __builtin_amdgcn_permlane16_swap(__builtin_bit_cast(unsigned, t8[k]), __builtin_bit_cast(unsigned, t8[4 + k]), false, false);
                unsigned ra = r[0], rb = r[1]; asm volatile("" : "+v"(ra), "+v"(rb)); t4[k] = __builtin_bit_cast(h16x2, ra) + __builtin_bit_cast(h16x2, rb); }
#pragma unroll
            for (int k = 0; k < 2; ++k) { const unsigned lo = __builtin_bit_cast(unsigned, t4[k]), hi = __builtin_bit_cast(unsigned, t4[2 + k]); const unsigned mine = b3 ? hi : lo, send = b3 ? lo : hi;
                const h16x2 rr = __builtin_bit_cast(h16x2, mine) + __builtin_bit_cast(h16x2, (unsigned)__builtin_amdgcn_update_dpp(0u, send, 0x128, 0xF, 0xF, true));
                res[2 * k] = (float)rr.x; res[2 * k + 1] = (float)rr.y; }
            u32x2 ow; ow.x = cvtpk(res[0], res[1]); ow.y = cvtpk(res[2], res[3]);
            *(u32x2*)(PO + ((size_t)tb * 8 + j) * 4096 + 64 * s + 8 * g) = ow;
        }
    }
#undef PB_LOAD
#undef PB_STORE
#undef PR_LOAD
}

template <bool FINAL>
__device__ __forceinline__ void phase_peer_norm(const P& p, int layer, int lane, int wid) {
    bf16_t* XB = (bf16_t*)(p.ws + WS_XB);
    const bf16_t* PO = (const bf16_t*)(p.ws + WS_PO);
    const float* mod = (const float*)(p.ws + WS_MOD);
    float* X = p.out;
    const int gw = blockIdx.x * 8 + wid, ngw = gridDim.x * 8;
    u32x4 pw[4], xw[4];
#define PN_LOAD(T, PWV, XWV) { const bf16_t* por = PO + (size_t)(T) * 2048 + 16 * lane; const bf16_t* xbl = XB + (size_t)(T) * 2048 + 16 * lane; \
        _Pragma("unroll") for (int j = 0; j < 4; ++j) { PWV[j] = *(const u32x4*)(por + 1024 * (j >> 1) + 8 * (j & 1)); XWV[j] = *(const u32x4*)(xbl + 1024 * (j >> 1) + 8 * (j & 1)); } }
    if (gw < NTOK) PN_LOAD(gw, pw, xw)
    float G2[32], PA[32], PB[32]; int bcur = -1;
#pragma unroll 1
    for (int token = gw; token < NTOK; token += ngw) {
        const int b = token >> 13;
        if (b != bcur) { bcur = b;
            const float* g2 = mod + (size_t)(layer * 2 + b) * 12288 + 5 * 2048 + 16 * lane;
#pragma unroll
            for (int j = 0; j < 8; ++j) { const int off = 1024 * (j >> 2) + 4 * (j & 3); const f32x4 gg = *(const f32x4*)(g2 + off);
                G2[4 * j] = gg.x; G2[4 * j + 1] = gg.y; G2[4 * j + 2] = gg.z; G2[4 * j + 3] = gg.w;
                if (FINAL) { const f32x4 fg = *(const f32x4*)(p.final_g + 16 * lane + off); PA[4 * j] = fg.x; PA[4 * j + 1] = fg.y; PA[4 * j + 2] = fg.z; PA[4 * j + 3] = fg.w; PB[4 * j] = 0.f; PB[4 * j + 1] = 0.f; PB[4 * j + 2] = 0.f; PB[4 * j + 3] = 0.f; }
                else { const float* ng = p.norm_g + (size_t)((layer + 1) * 2 + 0) * 2048 + 16 * lane; const float* sh = mod + (size_t)((layer + 1) * 2 + b) * 12288 + 16 * lane; const float* sc = sh + 2048;
                    const f32x4 gv = *(const f32x4*)(ng + off), sv = *(const f32x4*)(sc + off), hv = *(const f32x4*)(sh + off);
#pragma unroll
                    for (int e = 0; e < 4; ++e) { PA[4 * j + e] = gv[e] * (1.0f + sv[e]) * F8_HS; PB[4 * j + e] = hv[e] * F8_HS; } } } }
        u32x4 pwn[4], xwn[4];
        { const int tn = token + ngw < NTOK ? token + ngw : token; PN_LOAD(tn, pwn, xwn) }
        float o[32];
#pragma unroll
        for (int j = 0; j < 4; ++j) { const u32x4 w = pw[j];
            o[8 * j + 0] = bflo(w.x); o[8 * j + 1] = bfhi(w.x); o[8 * j + 2] = bflo(w.y); o[8 * j + 3] = bfhi(w.y);
            o[8 * j + 4] = bflo(w.z); o[8 * j + 5] = bfhi(w.z); o[8 * j + 6] = bflo(w.w); o[8 * j + 7] = bfhi(w.w); }
        {
            bf16_t* xbr = XB + (size_t)token * 2048 + 16 * lane; float* xr = X + (size_t)token * 2048 + 16 * lane;
            float xn[32], ss = 0.f;
#pragma unroll
            for (int jh = 0; jh < 2; ++jh) { const u32x4 w0 = xw[2 * jh], w1 = xw[2 * jh + 1];
                const float xi[16] = {bflo(w0.x), bfhi(w0.x), bflo(w0.y), bfhi(w0.y), bflo(w0.z), bfhi(w0.z), bflo(w0.w), bfhi(w0.w), bflo(w1.x), bfhi(w1.x), bflo(w1.y), bfhi(w1.y), bflo(w1.z), bfhi(w1.z), bflo(w1.w), bfhi(w1.w)};
#pragma unroll
                for (int q = 0; q < 16; ++q) { const float t = xi[q] + G2[16 * jh + q] * o[16 * jh + q]; xn[16 * jh + q] = t; ss += t * t; } }
            ss = wave_sum(ss); const float rstd = rsqrtf(ss * (1.0f / 2048.0f) + 1e-6f);
            if (FINAL) {
#pragma unroll
                for (int j = 0; j < 8; ++j) { const int off = 1024 * (j >> 2) + 4 * (j & 3);
                    f32x4 y;
#pragma unroll
                    for (int e = 0; e < 4; ++e) y[e] = xn[4 * j + e] * rstd * PA[4 * j + e];
                    *(f32x4*)(xr + off) = y; }
            } else {
                unsigned char* hrow8 = p.ws + WS_H8 + (size_t)token * 2048 + 16 * lane;
#pragma unroll
                for (int jh = 0; jh < 2; ++jh) { float y[16];
#pragma unroll
                    for (int q = 0; q < 16; ++q) y[q] = xn[16 * jh + q] * rstd * PA[16 * jh + q] + PB[16 * jh + q];
#pragma unroll
                    for (int h2 = 0; h2 < 2; ++h2) { u32x4 xo4; xo4.x = cvtpk(xn[16 * jh + 8 * h2], xn[16 * jh + 8 * h2 + 1]); xo4.y = cvtpk(xn[16 * jh + 8 * h2 + 2], xn[16 * jh + 8 * h2 + 3]); xo4.z = cvtpk(xn[16 * jh + 8 * h2 + 4], xn[16 * jh + 8 * h2 + 5]); xo4.w = cvtpk(xn[16 * jh + 8 * h2 + 6], xn[16 * jh + 8 * h2 + 7]);
                        *(u32x4*)(xbr + 1024 * jh + 8 * h2) = xo4; }
                    u32x4 w; w.x = pk_fp8x4(y[0], y[1], y[2], y[3]); w.y = pk_fp8x4(y[4], y[5], y[6], y[7]); w.z = pk_fp8x4(y[8], y[9], y[10], y[11]); w.w = pk_fp8x4(y[12], y[13], y[14], y[15]);
                    *(u32x4*)(hrow8 + 1024 * jh) = w; }
            }
        }
#pragma unroll
        for (int j = 0; j < 4; ++j) { pw[j] = pwn[j]; xw[j] = xwn[j]; }
    }
#undef PN_LOAD
}

#ifndef PH_MASK
#define PH_MASK 0xFFFF
#endif
#define PH(b) if constexpr ((PH_MASK >> (b)) & 1)
#ifndef DBL_MASK
#define DBL_MASK 0
#endif
#define REP(b) for (int _r = 0; _r < 1 + ((DBL_MASK >> (b)) & 1); ++_r)
__device__ __forceinline__ int fresh_tid() { int t = threadIdx.x; asm volatile("" : "+v"(t)); return t; }
__device__ __forceinline__ P load_p() {
    typedef __attribute__((address_space(1))) float* gp;
    typedef const gp __attribute__((address_space(4)))* cq;
    cq q = (cq)__builtin_amdgcn_kernarg_segment_ptr(); asm volatile("" : "+s"(q));
    P r; float** d = (float**)&r;
#pragma unroll
    for (int i = 0; i < (int)(sizeof(P) / 8); ++i) d[i] = (float*)q[i];
    return r;
}
#define LP (load_p())
#define WSB (load_p().ws)
#define MODP ((const float*)(load_p().ws + WS_MOD))
#define HP ((bf16_t*)(load_p().ws + WS_H))
__global__ void __launch_bounds__(512, 2) mk_fwd(P p_arg) {
    extern __shared__ __attribute__((aligned(16))) unsigned char lds_raw[];
    LAS unsigned char* lds = (LAS unsigned char*)lds_raw;
    cg::grid_group grid = cg::this_grid();
    const int wid = __builtin_amdgcn_readfirstlane((int)threadIdx.x >> 6);
    const int gw = blockIdx.x * 8 + wid, ngw = gridDim.x * 8, G = gridDim.x;
    volatile LAS unsigned* xst = (volatile LAS unsigned*)(lds + LDS_BYTES - 64);
    if (threadIdx.x < 16) xst[threadIdx.x] = 0u;
    __syncthreads();
    const XcdBarrier xb = xcd_barrier_post((unsigned*)(load_p().ws + WS_BAR), xst);
#define TID (fresh_tid())
#define LANE (fresh_tid() & 63)

    REP(0) { PH(0) phase_prologue(LP, lds, TID, LANE, wid);
    grid.sync(); }
    REP(1) { PH(1) phase_adaln<true>(LP.x, WSB + WS_H8, LP.norm_g, MODP, MODP + 2048, gw, ngw, LANE);
    xcd_barrier(xb); }
    REP(2) { PH(2) {   pg8::Gemm g{(const bf16_t*)(WSB + WS_H8), (const bf16_t*)(WSB + WS_WINE), NTOK, 2560, 1024, 1024, 1024, 0, 0}; pg8::StaticOrder S; S.init(NTOK, 2560, G, (int)blockIdx.x);
        pg8::EpiEvenSplit E{1.0f / (F8_HS * F8_WS), WSB};
        pg8::gemm_phase<pg8::EpiEvenSplit, pg8::StaticOrder, true, true, true>(lds, g, S, E); }
    xcd_barrier(xb); }
    PH(3) { phase_qkprep(LP, gw, ngw, LANE); phase_fold_wq(LP, lds, TID, LANE, wid); __syncthreads(); }
    REP(4) { PH(4) {
        pg8::Gemm g{(const bf16_t*)(WSB + WS_AB), (const bf16_t*)(WSB + WS_WSUM), 1024, 256, 256, 512, 256, (size_t)1024 * 512, (size_t)256 * 256};
        pg8::BatchOrder S{4, 256, G, (int)blockIdx.x}; pg8::EpiF32B E{(float*)(WSB + WS_SS), 256, (size_t)1024 * 256};
        pg8::gemm_phase<pg8::EpiF32B, pg8::BatchOrder, false, false>(lds, g, S, E); }
    xcd_barrier(xb); }
    REP(5) { PH(5) { phase_s5scan(LP, lds, LANE, wid); phase_bias_reduce(LP, TID); }
    xcd_barrier(xb); }
    REP(13) { PH(13) {
        pg8::Gemm g{(const bf16_t*)(WSB + WS_AB), (const bf16_t*)(WSB + WS_WY), 1024, 256, 512, 512, 512, (size_t)1024 * 512, (size_t)256 * 512};
        LAS float* wl = (LAS float*)(lds + 131072);
        { const int un = (int)blockIdx.x;
            const int tid = TID; __syncthreads();
            if (tid < 256) wl[tid] = LP.glu_w[(un >> 2) * 256 + tid]; else if (tid < 272) wl[tid] = LP.glu_b[(un >> 2) * 16 + tid - 256];
            __syncthreads();
            pg8::BatchOrder S{4, un + 1, 256, un}; pg8::EpiS5Glu E{WSB + WS_CAT, wl};
            pg8::gemm_phase<pg8::EpiS5Glu, pg8::BatchOrder, false, false>(lds, g, S, E); }
        __syncthreads(); } }
    REP(6) { PH(6) phase_attn(LP, (char*)lds_raw);
    xcd_barrier(xb); }
    REP(7) { PH(7) {   pg8::Gemm g{(const bf16_t*)(WSB + WS_CAT), (const bf16_t*)(WSB + WS_WOUTE), NTOK, 2048, 1024, 1024, 1024, 0, 0}; pg8::StaticOrder S; S.init(NTOK, 2048, G, (int)blockIdx.x);
        pg8::EpiResidB<true> E{LP.x, (bf16_t*)(WSB + WS_XB), MODP + 2 * 2048, (float*)(WSB + WS_ROWSQ), WSB + WS_X8, 1.0f / (F8_CS * F8_WS)};
        pg8::gemm_phase<pg8::EpiResidB<true>, pg8::StaticOrder, true, true, true>(lds, g, S, E); }
    xcd_barrier(xb); }
    REP(8) { PH(8) {   pg8::Gemm g{(const bf16_t*)(WSB + WS_X8), (const bf16_t*)(WSB + WS_WQF), NTOK, 2048, 1024, 1024, 1024, 0, (size_t)2048 * 1024}; pg8::StaticOrder S; S.init(NTOK, 2048, G, (int)blockIdx.x); S.pbs = 5;
        pg8::EpiQ E{(bf16_t*)(WSB + WS_QP), (const float*)(WSB + WS_ROWSQ), (const float*)(WSB + WS_BIASQ), 1.0f / (F8_XS * F8_WS)};
        pg8::gemm_phase<pg8::EpiQ, pg8::StaticOrder, true, true, true>(lds, g, S, E); }
    xcd_barrier(xb); }
    REP(16) { PH(9) phase_peer_s1(LP, 0, lds, LANE, wid); }
    xcd_barrier(xb);
    REP(17) { PH(9) phase_peer_u(LP, 0, lds, LANE, wid, (int)xst[2]); }
    xcd_barrier(xb);
    REP(18) { PH(9) phase_peer_w(LP, 0, TID); }
    xcd_barrier(xb);
    REP(19) { PH(9) phase_peer_vs(LP, 0, lds, LANE, wid, (int)xst[2]); }
    xcd_barrier(xb);
    PH(9) phase_peer_norm<false>(LP, 0, LANE, wid);
    xcd_barrier(xb);
    REP(10) { PH(10) {   pg8::Gemm g{(const bf16_t*)(WSB + WS_H8), (const bf16_t*)(WSB + WS_WINO), NTOK, 8192, 1024, 1024, 1024, 0, 0}; pg8::StaticOrder S; S.init(NTOK, 8192, G, (int)blockIdx.x);
        pg8::EpiBf16T<1> E{(bf16_t*)(WSB + WS_Z), 8192, 1.0f / (F8_HS * F8_WS), (float*)(WSB + WS_LNST)};
        pg8::gemm_phase<pg8::EpiBf16T<1>, pg8::StaticOrder, true, true, true>(lds, g, S, E); }
    xcd_barrier(xb); }
    REP(11) { PH(11) phase_sgu(LP, lds, TID, LANE, wid);
    xcd_barrier(xb); }
    PH(12) {   pg8::Gemm g{(const bf16_t*)(WSB + WS_SG), (const bf16_t*)(WSB + WS_WOUTO), NTOK, 2048, 2048, 2048, 2048, 0, 0}; pg8::StaticOrder S; S.init(NTOK, 2048, G, (int)blockIdx.x);
        pg8::EpiResidB<false> E{nullptr, (bf16_t*)(WSB + WS_XB), MODP + 2 * 12288 + 2 * 2048, (float*)(WSB + WS_ROWSQ) + (size_t)32 * NTOK, WSB + WS_X8, 1.0f / (F8_SGS * F8_WS)};
        pg8::gemm_phase<pg8::EpiResidB<false>, pg8::StaticOrder, true, true, true>(lds, g, S, E); }
    xcd_barrier(xb);
    REP(8) { PH(8) {   pg8::Gemm g{(const bf16_t*)(WSB + WS_X8), (const bf16_t*)(WSB + WS_WQF) + (size_t)2 * 2048 * 1024, NTOK, 2048, 1024, 1024, 1024, 0, (size_t)2048 * 1024}; pg8::StaticOrder S; S.init(NTOK, 2048, G, (int)blockIdx.x); S.pbs = 5;
        pg8::EpiQ E{(bf16_t*)(WSB + WS_QP), (const float*)(WSB + WS_ROWSQ) + (size_t)32 * NTOK, (const float*)(WSB + WS_BIASQ) + 2 * 2048, 1.0f / (F8_XS * F8_WS)};
        pg8::gemm_phase<pg8::EpiQ, pg8::StaticOrder, true, true, true>(lds, g, S, E); }
    xcd_barrier(xb); }
    REP(16) { PH(9) phase_peer_s1(LP, 1, lds, LANE, wid); }
    xcd_barrier(xb);
    REP(17) { PH(9) phase_peer_u(LP, 1, lds, LANE, wid, (int)xst[2]); }
    xcd_barrier(xb);
    REP(18) { PH(9) phase_peer_w(LP, 1, TID); }
    xcd_barrier(xb);
    REP(19) { PH(9) phase_peer_vs(LP, 1, lds, LANE, wid, (int)xst[2]); }
    xcd_barrier(xb);
    PH(9) phase_peer_norm<true>(LP, 1, LANE, wid);
}

#undef LP
#undef WSB
#undef MODP
#undef HP
extern "C" void kernel_launch(void* const* d_in, const int* in_sizes, int n_in, void* d_out, int out_size, void* d_ws, size_t ws_size, hipStream_t stream) {
    static int grid = 0;
    if (grid == 0) {
        if (n_in != 30 || out_size != NTOK * DMODEL || ws_size < WS_END) { fprintf(stderr, "kernel_launch: unexpected shapes (n_in %d out %d ws %zu, need ws >= %zu)\n", n_in, out_size, ws_size, (size_t)WS_END); grid = -1; return; }
        int dev = 0, cus = 0, per_cu = 0;
        (void)hipGetDevice(&dev); (void)hipDeviceGetAttribute(&cus, hipDeviceAttributeMultiprocessorCount, dev);
        if (hipFuncSetAttribute((const void*)mk_fwd, hipFuncAttributeMaxDynamicSharedMemorySize, LDS_BYTES) != hipSuccess) { fprintf(stderr, "kernel_launch: hipFuncSetAttribute failed\n"); grid = -1; return; }
        if (hipOccupancyMaxActiveBlocksPerMultiprocessor(&per_cu, (const void*)mk_fwd, 512, LDS_BYTES) != hipSuccess || per_cu < 1) { fprintf(stderr, "kernel_launch: occupancy query says %d\n", per_cu); (void)hipGetLastError(); per_cu = 1; }
        grid = cus;
        if (grid > cus * per_cu) grid = cus * per_cu;
        if (grid != 256) { fprintf(stderr, "kernel_launch: this kernel is laid out for a 256-CU device (got %d workgroups)\n", grid); grid = -1; return; }
    }
    if (grid < 0) return;
    if (hipMemsetAsync((char*)d_ws + WS_BAR, 0, 16384, stream) != hipSuccess) { fprintf(stderr, "kernel_launch: hipMemsetAsync failed\n"); return; }
    P p{};
    const float** pf = (const float**)&p;
    for (int i = 0; i < 30; ++i) pf[i] = (const float*)d_in[i];
    p.out = (float*)d_out; p.ws = (unsigned char*)d_ws;
    void* args[] = {&p};
    hipError_t e = hipLaunchCooperativeKernel((const void*)mk_fwd, dim3(grid), dim3(512), args, LDS_BYTES, stream);
    if (e != hipSuccess) fprintf(stderr, "kernel_launch: cooperative launch failed: %s (grid %d)\n", hipGetErrorString(e), grid);
}
```

```cpp
#include <hip/hip_runtime.h>
#include <hip/hip_cooperative_groups.h>
#include <hip/hip_bf16.h>
#include <cstdio>
#include <cstdint>
namespace cg = cooperative_groups;

__device__ __forceinline__ int lane_id_v() { int l; asm volatile("v_mbcnt_lo_u32_b32 %0, -1, 0\n\tv_mbcnt_hi_u32_b32 %0, -1, %0" : "=v"(l)); return l; }

namespace pg8 {
#define PG8_LAS __attribute__((address_space(3)))
typedef unsigned short bf16_t;
typedef short bf16x8 __attribute__((ext_vector_type(8)));
typedef float f32x4 __attribute__((ext_vector_type(4)));
typedef unsigned u32x4 __attribute__((ext_vector_type(4)));
constexpr int BM = 256, BK = 64, HALF = 128, HTB = HALF * BK * 2  , STAGE_BYTES = 8 * HTB, NXCD = 8, WGM = 8;

__host__ __device__ __forceinline__ int lds_byte(int r, int c) { const int st = (r >> 4) * 2 + (c >> 5), rr = r & 15, cc = c & 31, ob = rr * 64 + cc * 2; return st * 1024 + (ob ^ (((ob >> 9) & 1) << 5)); }
__host__ __device__ __forceinline__ void stage_rc(int b, int& R, int& C) { const int st = b / 1024, sb = b % 1024, swz = sb ^ (((sb >> 9) & 1) << 5); R = (st >> 1) * 16 + swz / 64; C = (st & 1) * 32 + (swz % 64) / 2; }
__host__ __device__ __forceinline__ int perm32(int rho) { const int n = rho >> 4, i = rho & 15; return 8 * (i >> 2) + 4 * n + (i & 3); }

struct Unit { int pm, pn, pb; };
struct Gemm { const bf16_t* A; const bf16_t* Bt; int M, N, K; int lda, ldb; size_t bsA, bsB; };

struct StaticOrder {
    int nM, nN, nwg, G, c, pbs;
    __host__ __device__ void init(int M, int N, int G_, int c_) { nM = M / BM; nN = N / BM; nwg = nM * nN; G = G_; c = c_; pbs = -1; }
    __host__ __device__ bool next(int i, Unit& u) const {
        const long L = (long)i * G + c; if (L >= nwg) return false;
        int wgid = (int)L; { const int q = nwg / NXCD, r = nwg % NXCD, xcd = wgid % NXCD, off = wgid / NXCD; wgid = (xcd < r ? xcd * (q + 1) : r * (q + 1) + (xcd - r) * q) + off; }
        const int nig = WGM * nN, gid = wgid / nig, fm = gid * WGM, gsz = (nM - fm) < WGM ? (nM - fm) : WGM;
        u.pm = fm + ((wgid % nig) % gsz); u.pn = (wgid % nig) / gsz; u.pb = pbs >= 0 ? (u.pm >> pbs) : 0; return true;
    }
    __device__ __forceinline__ void a_ready(const Unit&) const {}
    __device__ __forceinline__ void done(const Unit&) const {}
};

__device__ __forceinline__ unsigned cvt_pk_bf16(float lo, float hi) { unsigned r; asm volatile("v_cvt_pk_bf16_f32 %0, %1, %2" : "=v"(r) : "v"(lo), "v"(hi)); return r; }
typedef float f32x2 __attribute__((ext_vector_type(2)));

typedef int i32x8 __attribute__((ext_vector_type(8)));
typedef int i32x4v __attribute__((ext_vector_type(4)));
__device__ __forceinline__ void pg8_mfma_f8(f32x4& c, const i32x8& a, const i32x8& b, int sc) {
    asm("s_nop 1\n\tv_mfma_f32_16x16x128_f8f6f4 %0, %1, %2, %0" : "+v"(c) : "v"(a), "v"(b)); (void)sc; }
__device__ __forceinline__ void pg8_mfma_f8_drain(f32x4 (&acc)[2][2][4][2]) {
#pragma unroll
    for (int a = 0; a < 2; ++a)
#pragma unroll
        for (int b = 0; b < 2; ++b) {
            if (a == 0 && b == 0) asm volatile("s_nop 15\n\ts_nop 15" : "+v"(acc[a][b][0][0]), "+v"(acc[a][b][0][1]), "+v"(acc[a][b][1][0]), "+v"(acc[a][b][1][1]), "+v"(acc[a][b][2][0]), "+v"(acc[a][b][2][1]), "+v"(acc[a][b][3][0]), "+v"(acc[a][b][3][1]));
            else asm volatile("" : "+v"(acc[a][b][0][0]), "+v"(acc[a][b][0][1]), "+v"(acc[a][b][1][0]), "+v"(acc[a][b][1][1]), "+v"(acc[a][b][2][0]), "+v"(acc[a][b][2][1]), "+v"(acc[a][b][3][0]), "+v"(acc[a][b][3][1])); }
}
__device__ __forceinline__ i32x8 pg8_cat(bf16x8 a, bf16x8 b) { return __builtin_shufflevector(__builtin_bit_cast(i32x4v, a), __builtin_bit_cast(i32x4v, b), 0, 1, 2, 3, 4, 5, 6, 7); }
template <class Epi, class Sched, bool ALIGN_EPI = false, bool SP2 = false, bool F8 = false>
__device__ __forceinline__ void gemm_phase(PG8_LAS unsigned char* lds, const Gemm g, const Sched& S, const Epi& E) {
    int tid_o = threadIdx.x; asm volatile("" : "+v"(tid_o)); const int tid = tid_o, wid = __builtin_amdgcn_readfirstlane(tid >> 6), lane = tid & 63, wr = wid >> 2, wc = wid & 3, fr = lane & 15, fq = lane >> 4;
    const int K = g.K, nt = K / BK;
    unsigned voffA[2], voffB[2];
#pragma unroll
    for (int i = 0; i < 2; ++i) { int R, C; stage_rc(tid * 16 + i * 8192, R, C); const int Rb = Epi::PERM ? ((R & ~31) + perm32(R & 31)) : R;
        voffA[i] = (unsigned)(R * g.lda + C) * 2u; voffB[i] = (unsigned)(Rb * g.ldb + C) * 2u; }
    const size_t kstep = (size_t)(BK * 2);
    const size_t hstepA = (size_t)HALF * g.lda * 2, hstepB = (size_t)HALF * g.ldb * 2;
    const size_t tstepA = 2 * hstepA, tstepB = 2 * hstepB;
    const unsigned ldsw = (unsigned)wid * 1024u;
    const int aoff = lds_byte(wr * 64 + fr, fq * 8), boff = lds_byte(wc * 32 + fr, fq * 8);
#define PG8_SA(b, h) (((b) * 2 + (h)) * HTB)
#define PG8_SB(b, h) ((4 + (b) * 2 + (h)) * HTB)
#define PG8_STAGE(bufoff, gbase, voff) do { _Pragma("unroll") for (int _i = 0; _i < 2; ++_i) \
        __builtin_amdgcn_global_load_lds((const unsigned*)((const char*)(gbase) + (voff)[_i]), (PG8_LAS unsigned*)(lds + (bufoff) + ldsw + _i * 8192), 16, 0, 0); } while (0)
#define PG8_LDA(dst, b, h) do { _Pragma("unroll") for (int m = 0; m < 4; ++m) { dst[m].lo = *(const PG8_LAS i32x4v*)(lds + PG8_SA(b, h) + aoff + m * 2048); dst[m].hi = *(const PG8_LAS i32x4v*)(lds + PG8_SA(b, h) + aoff + m * 2048 + 1024); } } while (0)
#define PG8_LDB(dst, b, h) do { _Pragma("unroll") for (int n = 0; n < 2; ++n) { dst[n].lo = *(const PG8_LAS i32x4v*)(lds + PG8_SB(b, h) + boff + n * 2048); dst[n].hi = *(const PG8_LAS i32x4v*)(lds + PG8_SB(b, h) + boff + n * 2048 + 1024); } } while (0)
#define PG8_MMA(ai, bj, At, Bt) do { __builtin_amdgcn_s_setprio(1); \
        if constexpr (F8) { _Pragma("unroll") for (int m = 0; m < 4; ++m) _Pragma("unroll") for (int n = 0; n < 2; ++n) pg8_mfma_f8(acc[ai][bj][m][n], Bt[n], At[m], f8scale); } \
        else { _Pragma("unroll") for (int m = 0; m < 4; ++m) _Pragma("unroll") for (int n = 0; n < 2; ++n) { \
            const i32x4v b_lo = Bt[n].lo, b_hi = Bt[n].hi, a_lo = At[m].lo, a_hi = At[m].hi;     \
            acc[ai][bj][m][n] = __builtin_amdgcn_mfma_f32_16x16x32_bf16(__builtin_bit_cast(bf16x8, b_lo), __builtin_bit_cast(bf16x8, a_lo), acc[ai][bj][m][n], 0, 0, 0); \
            acc[ai][bj][m][n] = __builtin_amdgcn_mfma_f32_16x16x32_bf16(__builtin_bit_cast(bf16x8, b_hi), __builtin_bit_cast(bf16x8, a_hi), acc[ai][bj][m][n], 0, 0, 0); } } \
        __builtin_amdgcn_s_setprio(0); } while (0)
#define PG8_WAIT_V(n) asm volatile("s_waitcnt vmcnt(" #n ")" ::: "memory")
#define PG8_WAIT_L(n) asm volatile("s_waitcnt lgkmcnt(" #n ")" ::: "memory")
#define PG8_BAR __builtin_amdgcn_s_barrier()
#define PG8_SCHED __builtin_amdgcn_sched_barrier(0)
    Unit cur, nxt; int ui = 0;
    if (!S.next(0, cur)) return;
    f32x4 acc[2][2][4][2];
#pragma unroll
    for (int a = 0; a < 2; ++a)
#pragma unroll
        for (int b = 0; b < 2; ++b)
#pragma unroll
            for (int m = 0; m < 4; ++m)
#pragma unroll
                for (int n = 0; n < 2; ++n) acc[a][b][m][n] = (f32x4){0.f, 0.f, 0.f, 0.f};
    int f8scale = 0x7f7f7f7f; asm volatile("" : "+v"(f8scale));
    i32x8 At[4], B0[2], B1[2];
    const char* cA = (const char*)(g.A + (size_t)cur.pb * g.bsA) + (size_t)cur.pm * tstepA; const char* cB = (const char*)(g.Bt + (size_t)cur.pb * g.bsB) + (size_t)cur.pn * tstepB;
    S.a_ready(cur);
    if constexpr (SP2) {
        PG8_STAGE(PG8_SB(0, 0), cB, voffB); PG8_STAGE(PG8_SB(0, 1), cB + hstepB, voffB); PG8_STAGE(PG8_SA(0, 0), cA, voffA); PG8_STAGE(PG8_SA(0, 1), cA + hstepA, voffA);
        if (wr == 1) PG8_BAR;
        PG8_WAIT_V(2); PG8_BAR;
        PG8_STAGE(PG8_SB(1, 0), cB + kstep, voffB); PG8_STAGE(PG8_SA(1, 0), cA + kstep, voffA); PG8_STAGE(PG8_SB(1, 1), cB + hstepB + kstep, voffB);
        PG8_WAIT_V(6); PG8_BAR;
    } else {
        PG8_STAGE(PG8_SB(0, 0), cB, voffB); PG8_STAGE(PG8_SA(0, 0), cA, voffA); PG8_STAGE(PG8_SB(0, 1), cB + hstepB, voffB); PG8_STAGE(PG8_SA(0, 1), cA + hstepA, voffA);
        if (wr == 1) PG8_BAR;
        PG8_WAIT_V(4); PG8_BAR;
        PG8_STAGE(PG8_SB(1, 0), cB + kstep, voffB); PG8_STAGE(PG8_SA(1, 0), cA + kstep, voffA); PG8_STAGE(PG8_SB(1, 1), cB + hstepB + kstep, voffB);
        PG8_WAIT_V(6); PG8_BAR;
    }
    for (;;) {
        const bool has_next = S.next(ui + 1, nxt);
        const char* nA = has_next ? (const char*)(g.A + (size_t)nxt.pb * g.bsA) + (size_t)nxt.pm * tstepA : cA; const char* nB = has_next ? (const char*)(g.Bt + (size_t)nxt.pb * g.bsB) + (size_t)nxt.pn * tstepB : cB;
        for (int t = 0; t < nt; t += 2) {
            const bool last = (t == nt - 2);
            const char* a1 = cA + (size_t)(t + 1) * kstep;
            const char* a2 = last ? nA : cA + (size_t)(t + 2) * kstep; const char* b2 = last ? nB : cB + (size_t)(t + 2) * kstep;
            const char* a3 = a2 + kstep; const char* b3 = b2 + kstep;
            if (last && has_next) S.a_ready(nxt);
            if constexpr (SP2) {
            PG8_LDB(B0, 0, 0); PG8_LDB(B1, 0, 1); PG8_SCHED; PG8_LDA(At, 0, 0); PG8_STAGE(PG8_SA(1, 1), a1 + hstepA, voffA);
            PG8_WAIT_V(8); PG8_WAIT_L(0); PG8_BAR; PG8_MMA(0, 0, At, B0); PG8_MMA(0, 1, At, B1); PG8_BAR; PG8_SCHED;
            PG8_LDA(At, 0, 1); PG8_STAGE(PG8_SB(0, 0), b2, voffB); PG8_STAGE(PG8_SB(0, 1), b2 + hstepB, voffB); PG8_STAGE(PG8_SA(0, 0), a2, voffA);
            PG8_WAIT_V(8); PG8_WAIT_L(0); PG8_BAR; PG8_MMA(1, 0, At, B0); PG8_MMA(1, 1, At, B1); PG8_BAR; PG8_SCHED;
            PG8_LDB(B0, 1, 0); PG8_LDB(B1, 1, 1); PG8_SCHED; PG8_LDA(At, 1, 0); PG8_STAGE(PG8_SA(0, 1), a2 + hstepA, voffA);
            PG8_WAIT_V(8); PG8_WAIT_L(0); PG8_BAR; PG8_MMA(0, 0, At, B0); PG8_MMA(0, 1, At, B1); PG8_BAR; PG8_SCHED;
            PG8_LDA(At, 1, 1); PG8_STAGE(PG8_SB(1, 0), b3, voffB); PG8_STAGE(PG8_SB(1, 1), b3 + hstepB, voffB); PG8_STAGE(PG8_SA(1, 0), a3, voffA);
            PG8_WAIT_V(8); PG8_WAIT_L(0); PG8_BAR; PG8_MMA(1, 0, At, B0); PG8_MMA(1, 1, At, B1); PG8_BAR; PG8_SCHED;
            } else {
            PG8_LDB(B0, 0, 0); PG8_SCHED; PG8_LDA(At, 0, 0); PG8_STAGE(PG8_SA(1, 1), a1 + hstepA, voffA);
            PG8_WAIT_L(8); PG8_BAR; PG8_WAIT_L(0); PG8_MMA(0, 0, At, B0); PG8_BAR; PG8_SCHED;
            PG8_LDB(B1, 0, 1); PG8_STAGE(PG8_SB(0, 0), b2, voffB);
            PG8_BAR; PG8_WAIT_L(0); PG8_MMA(0, 1, At, B1); PG8_BAR;
            PG8_LDA(At, 0, 1); PG8_STAGE(PG8_SA(0, 0), a2, voffA);
            PG8_BAR; PG8_WAIT_L(0); PG8_MMA(1, 0, At, B0); PG8_BAR; PG8_SCHED;
            PG8_STAGE(PG8_SB(0, 1), b2 + hstepB, voffB);
            PG8_WAIT_V(6); PG8_BAR; PG8_MMA(1, 1, At, B1); PG8_BAR;
            PG8_LDB(B0, 1, 0); PG8_SCHED; PG8_LDA(At, 1, 0); PG8_STAGE(PG8_SA(0, 1), a2 + hstepA, voffA);
            PG8_WAIT_L(8); PG8_BAR; PG8_WAIT_L(0); PG8_MMA(0, 0, At, B0); PG8_BAR; PG8_SCHED;
            PG8_LDB(B1, 1, 1); PG8_STAGE(PG8_SB(1, 0), b3, voffB);
            PG8_BAR; PG8_WAIT_L(0); PG8_MMA(0, 1, At, B1); PG8_BAR;
            PG8_LDA(At, 1, 1); PG8_STAGE(PG8_SA(1, 0), a3, voffA);
            PG8_BAR; PG8_WAIT_L(0); PG8_MMA(1, 0, At, B0); PG8_BAR; PG8_SCHED;
            PG8_STAGE(PG8_SB(1, 1), b3 + hstepB, voffB);
            PG8_WAIT_V(6); PG8_BAR; PG8_MMA(1, 1, At, B1); PG8_BAR;
            }
        }
        if constexpr (ALIGN_EPI) { if (wr == 0) PG8_BAR; }
        if constexpr (F8) pg8_mfma_f8_drain(acc);
        if constexpr (!Epi::AFTER_DRAIN) { E(acc, cur, wr, wc, fr, fq); S.done(cur); }
        if (!has_next) break;
#pragma unroll
        for (int a = 0; a < 2; ++a)
#pragma unroll
            for (int b = 0; b < 2; ++b)
#pragma unroll
                for (int m = 0; m < 4; ++m)
#pragma unroll
                    for (int n = 0; n < 2; ++n) acc[a][b][m][n] = (f32x4){0.f, 0.f, 0.f, 0.f};
        cur = nxt; cA = nA; cB = nB; ++ui;
        if constexpr (ALIGN_EPI) { if (wr == 1) PG8_BAR; }
    }
    PG8_WAIT_V(0);
    if constexpr (!ALIGN_EPI) { if (wr == 0) PG8_BAR; }
    PG8_BAR;
    if constexpr (Epi::AFTER_DRAIN) { E.fused(acc, cur, wr, wc, fr, fq, lds, wid, lane); S.done(cur); }
#undef PG8_SA
#undef PG8_SB
#undef PG8_STAGE
#undef PG8_LDA
#undef PG8_LDB
#undef PG8_MMA
#undef PG8_WAIT_V
#undef PG8_WAIT_L
#undef PG8_BAR
#undef PG8_SCHED
}
}
namespace attn {
using bf16 = __hip_bfloat16;
constexpr int   D = 128, NW = 8, QBLK = 32, KVBLK = 64;
constexpr float SCALE = 0.088388347648318440f;
constexpr float THR = 8.f;
constexpr int SDEPTH = 2;
constexpr int LDQ = 1024, LDK = 256, LDO = 2048;
constexpr size_t SHM_V = KVBLK * D * 2, SHM_K = KVBLK * D * 2, SHM_ATTN = 2 * SHM_V + 2 * SHM_K + NW * 64 * 4;
using bf16x8 = __attribute__((ext_vector_type(8))) short;
using s16x4  = __attribute__((ext_vector_type(4))) short;
using f32x16 = __attribute__((ext_vector_type(16))) float;
using f32x8  = __attribute__((ext_vector_type(8))) float;
using u32x4  = __attribute__((ext_vector_type(4))) unsigned;
#define KSWZ(row, colB) ((row) * 256 + ((colB) ^ (((row) & 7) << 4)))
#define SBAR() __builtin_amdgcn_sched_barrier(0)
__device__ __forceinline__ int crow(int r, int hi) { return (r & 3) + 8 * (r >> 2) + 4 * hi; }
__device__ __forceinline__ unsigned cvtpk(float lo, float hi) {
  unsigned r; asm volatile("v_cvt_pk_bf16_f32 %0, %1, %2" : "=v"(r) : "v"(lo), "v"(hi)); return r;
}
template <typename TIn> struct Stage;
template <> struct Stage<bf16>  { using T = bf16x8;
  __device__ static __forceinline__ T ld8(const bf16* p) { return *reinterpret_cast<const bf16x8*>(p); }
  __device__ static __forceinline__ bf16x8 tobf(T x) { return x; } };
template <> struct Stage<float> { using T = f32x8;
  __device__ static __forceinline__ T ld8(const float* p) { return *reinterpret_cast<const f32x8*>(p); }
  __device__ static __forceinline__ bf16x8 tobf(T x) {
    u32x4 w = {cvtpk(x[0], x[1]), cvtpk(x[2], x[3]), cvtpk(x[4], x[5]), cvtpk(x[6], x[7])}; return *reinterpret_cast<bf16x8*>(&w); } };

__device__ __forceinline__ void partialSM(f32x16& p0, f32x16& p1, float& m_reg, float& mn, float& alpha) {
  constexpr float C = SCALE * 1.4426950408889634f;
  float pmax = p0[0]; for (int r = 1; r < 16; ++r) pmax = fmaxf(pmax, p0[r]); for (int r = 0; r < 16; ++r) pmax = fmaxf(pmax, p1[r]);
  { auto rr = __builtin_amdgcn_permlane32_swap(__float_as_uint(pmax), __float_as_uint(pmax), false, false);
    pmax = fmaxf(__uint_as_float(rr[0]), __uint_as_float(rr[1])); }
  if (__builtin_expect(__all(pmax - m_reg <= THR / SCALE), 1)) { mn = m_reg; alpha = 1.f; }
  else { mn = fmaxf(m_reg, pmax); alpha = __builtin_amdgcn_exp2f((m_reg - mn) * C); m_reg = mn; }
  float mnC = -mn * C;
  for (int r = 0; r < 16; ++r) p0[r] = fmaf(p0[r], C, mnC); for (int r = 0; r < 16; ++r) p1[r] = fmaf(p1[r], C, mnC);
  for (int r = 0; r < 16; ++r) p0[r] = __builtin_amdgcn_exp2f(p0[r]);
}
__device__ __forceinline__ void finishSM(f32x16& p0, f32x16& p1, float alpha, float& l_reg, bf16x8& pa0, bf16x8& pa1, bf16x8& pa2, bf16x8& pa3) {
  for (int r = 0; r < 16; ++r) p1[r] = __builtin_amdgcn_exp2f(p1[r]);
  float ps = 0; for (int r = 0; r < 16; ++r) ps += p0[r]; for (int r = 0; r < 16; ++r) ps += p1[r];
  { auto rr = __builtin_amdgcn_permlane32_swap(__float_as_uint(ps), __float_as_uint(ps), false, false);
    ps = __uint_as_float(rr[0]) + __uint_as_float(rr[1]); }
  l_reg = l_reg * alpha + ps;
#define PK4(P, BASE, OUT) do { unsigned a0 = cvtpk(P[BASE + 0], P[BASE + 1]), a1 = cvtpk(P[BASE + 2], P[BASE + 3]);   \
    unsigned b0 = cvtpk(P[BASE + 4], P[BASE + 5]), b1 = cvtpk(P[BASE + 6], P[BASE + 7]);                              \
    auto r0 = __builtin_amdgcn_permlane32_swap(a0, b0, false, false); auto r1 = __builtin_amdgcn_permlane32_swap(a1, b1, false, false); \
    u32x4 w = {r0[0], r1[0], r0[1], r1[1]}; OUT = *reinterpret_cast<bf16x8*>(&w); } while (0)
  PK4(p0, 0, pa0); PK4(p0, 8, pa1); PK4(p1, 0, pa2); PK4(p1, 8, pa3);
#undef PK4
}
__device__ __forceinline__ void qkt(f32x16& p0, f32x16& p1, const bf16* Ks, const bf16x8* qr, int r32, int hi) {
  p0 = f32x16{}; p1 = f32x16{};
  for (int d0 = 0; d0 < 8; ++d0) { int cb = (d0 * 16 + hi * 8) * 2;
    bf16x8 b0 = *reinterpret_cast<const bf16x8*>((const char*)Ks + KSWZ(r32, cb));
    bf16x8 b1 = *reinterpret_cast<const bf16x8*>((const char*)Ks + KSWZ(32 + r32, cb));
    p0 = __builtin_amdgcn_mfma_f32_32x32x16_bf16(b0, qr[d0], p0, 0, 0, 0);
    p1 = __builtin_amdgcn_mfma_f32_32x32x16_bf16(b1, qr[d0], p1, 0, 0, 0); }
}
__device__ __forceinline__ int v_st(int k, int c) { const int kk = (k & ~0xC) | ((k & 4) << 1) | ((k & 8) >> 1); return ((kk >> 3) * 4 + (c >> 5)) * 512 + ((kk & 7) * 32 + (c & 31)) * 2; }
__device__ __forceinline__ int v_rd_base(int lane) { return ((lane & 3) << 3) | (((lane >> 2) & 3) << 6) | (((lane >> 4) & 1) << 5) | (((lane >> 5) & 1) << 8); }
constexpr int v_rd_off(int d0, int ks, int half) { return d0 * 512 + ks * 4096 + half * 2048; }
template <int OFF> __device__ __forceinline__ s16x4 tr_read(int vb) {
  s16x4 r; asm volatile("ds_read_b64_tr_b16 %0, %1 offset:%2" : "=&v"(r) : "v"(vb), "i"(OFF) : "memory"); return r;
}
template <int D0> __device__ __forceinline__ void pv_one(f32x16& od, int vb, bf16x8 pa0, bf16x8 pa1, bf16x8 pa2, bf16x8 pa3) {
  const s16x4 l0 = tr_read<v_rd_off(D0, 0, 0)>(vb), h0 = tr_read<v_rd_off(D0, 0, 1)>(vb), l1 = tr_read<v_rd_off(D0, 1, 0)>(vb), h1 = tr_read<v_rd_off(D0, 1, 1)>(vb);
  const s16x4 l2 = tr_read<v_rd_off(D0, 2, 0)>(vb), h2 = tr_read<v_rd_off(D0, 2, 1)>(vb), l3 = tr_read<v_rd_off(D0, 3, 0)>(vb), h3 = tr_read<v_rd_off(D0, 3, 1)>(vb);
  asm volatile("s_waitcnt lgkmcnt(0)" ::: "memory"); SBAR();
#define PK(L, H) (bf16x8){L[0], L[1], L[2], L[3], H[0], H[1], H[2], H[3]}
  od = __builtin_amdgcn_mfma_f32_32x32x16_bf16(pa0, PK(l0, h0), od, 0, 0, 0);
  od = __builtin_amdgcn_mfma_f32_32x32x16_bf16(pa1, PK(l1, h1), od, 0, 0, 0);
  od = __builtin_amdgcn_mfma_f32_32x32x16_bf16(pa2, PK(l2, h2), od, 0, 0, 0);
  od = __builtin_amdgcn_mfma_f32_32x32x16_bf16(pa3, PK(l3, h3), od, 0, 0, 0);
#undef PK
}
__device__ __forceinline__ void pv_d0(f32x16* o, int vb, bf16x8 pa0, bf16x8 pa1, bf16x8 pa2, bf16x8 pa3) {
  pv_one<0>(o[0], vb, pa0, pa1, pa2, pa3); pv_one<1>(o[1], vb, pa0, pa1, pa2, pa3); pv_one<2>(o[2], vb, pa0, pa1, pa2, pa3); pv_one<3>(o[3], vb, pa0, pa1, pa2, pa3);
}

template <typename TQ>
__device__ __forceinline__ void attn_dense_body(const TQ* __restrict__ Qb, const bf16* __restrict__ Kh, const bf16* __restrict__ Vh,
                                                unsigned char* __restrict__ Ob, int seq, char* lds) {
  using St = Stage<bf16>; using SQ = Stage<TQ>;
  int tid_o = threadIdx.x; asm volatile("" : "+v"(tid_o)); const int tid = tid_o, wid = tid >> 6, lane = tid & 63, r32 = lane & 31, hi = lane >> 5;
  bf16* V_lds = (bf16*)lds; bf16* K_lds = (bf16*)(lds + 2 * SHM_V);
  float* ws = (float*)(lds + 2 * SHM_V + 2 * SHM_K) + wid * 64; float* li_l = ws; float* al_l = ws + 32;
  float m_reg = -1e30f, l_reg = 0; f32x16 o[4] = {}; bf16x8 qr[8];
  const TQ* Qw = Qb + (long)(wid * QBLK + r32) * LDQ + hi * 8;
#pragma unroll
  for (int d0 = 0; d0 < 8; ++d0) qr[d0] = SQ::tobf(SQ::ld8(Qw + d0 * 16));
  const int sr = tid >> 4, sc = (tid & 15) * 8, vst0 = v_st(sr, sc), vst1 = v_st(32 + sr, sc);
  const int vb0 = (int)(uintptr_t)V_lds + v_rd_base(lane);
  struct { typename St::T vs0, vs1, ks0, ks1; } sr_[SDEPTH];
#define SLOAD(i, k0) do { sr_[i].vs0 = St::ld8(&Vh[(long)((k0) + sr) * LDK + sc]); sr_[i].vs1 = St::ld8(&Vh[(long)((k0) + 32 + sr) * LDK + sc]); \
    sr_[i].ks0 = St::ld8(&Kh[(long)((k0) + sr) * LDK + sc]); sr_[i].ks1 = St::ld8(&Kh[(long)((k0) + 32 + sr) * LDK + sc]); } while (0)
#define SWRITE(b, i) do { *(bf16x8*)((char*)V_lds + (b) * SHM_V + vst0) = St::tobf(sr_[i].vs0);          \
    *(bf16x8*)((char*)V_lds + (b) * SHM_V + vst1) = St::tobf(sr_[i].vs1); int kc = sc * 2;               \
    *(bf16x8*)((char*)K_lds + (b) * SHM_K + KSWZ(sr, kc)) = St::tobf(sr_[i].ks0);                       \
    *(bf16x8*)((char*)K_lds + (b) * SHM_K + KSWZ(32 + sr, kc)) = St::tobf(sr_[i].ks1); } while (0)
#define SWAIT() do { if constexpr (SDEPTH == 2) asm volatile("s_waitcnt vmcnt(4)" ::: "memory"); else asm volatile("s_waitcnt vmcnt(0)" ::: "memory"); } while (0)
#define RESC(a) do { if (__any((a) < 1.f)) { if (hi == 0) al_l[r32] = (a); asm volatile("s_waitcnt lgkmcnt(0)" ::: "memory"); \
    for (int d = 0; d < 4; ++d) for (int r = 0; r < 16; ++r) o[d][r] *= al_l[crow(r, hi)]; } } while (0)
  f32x16 pA0, pA1, pB0, pB1; float mnA, mnB, alA, alB; bf16x8 pa0, pa1, pa2, pa3; const int NT = seq / KVBLK;
  constexpr int SE = 0, SO = SDEPTH - 1;
  SLOAD(SE, 0); asm volatile("s_waitcnt vmcnt(0)" ::: "memory"); SWRITE(0, SE); __syncthreads();
  qkt(pA0, pA1, K_lds, qr, r32, hi); partialSM(pA0, pA1, m_reg, mnA, alA);
  SLOAD(SO, KVBLK); if constexpr (SDEPTH == 2) { if (2 < NT) SLOAD(SE, 2 * KVBLK); }
  SWAIT(); SWRITE(1, SO); __syncthreads();
  for (int j = 1; j + 1 < NT; j += 2) {
    SBAR(); qkt(pB0, pB1, (bf16*)((char*)K_lds + SHM_K), qr, r32, hi);
    finishSM(pA0, pA1, alA, l_reg, pa0, pa1, pa2, pa3); SBAR();
    SLOAD(SO, (j + SDEPTH) * KVBLK); SBAR();
    pv_d0(o, vb0, pa0, pa1, pa2, pa3); partialSM(pB0, pB1, m_reg, mnB, alB);
    __syncthreads(); SWAIT(); SWRITE(0, SE);
    RESC(alB); __syncthreads();
    SBAR(); qkt(pA0, pA1, K_lds, qr, r32, hi);
    finishSM(pB0, pB1, alB, l_reg, pa0, pa1, pa2, pa3); SBAR();
    if (SDEPTH == 1 || j + 3 < NT) SLOAD(SE, (j + 1 + SDEPTH) * KVBLK); SBAR();
    pv_d0(o, vb0 + (int)SHM_V, pa0, pa1, pa2, pa3); partialSM(pA0, pA1, m_reg, mnA, alA);
    __syncthreads(); SWAIT(); SWRITE(1, SO);
    RESC(alA); __syncthreads();
  }
  SBAR(); qkt(pB0, pB1, (bf16*)((char*)K_lds + SHM_K), qr, r32, hi);
  finishSM(pA0, pA1, alA, l_reg, pa0, pa1, pa2, pa3); SBAR();
  pv_d0(o, vb0, pa0, pa1, pa2, pa3); partialSM(pB0, pB1, m_reg, mnB, alB);
  __syncthreads(); RESC(alB);
  finishSM(pB0, pB1, alB, l_reg, pa0, pa1, pa2, pa3); SBAR();
  pv_d0(o, vb0 + (int)SHM_V, pa0, pa1, pa2, pa3);
  if (hi == 0) li_l[r32] = l_reg; asm volatile("s_waitcnt lgkmcnt(0)" ::: "memory");
  float rli[16];
#pragma unroll
  for (int r = 0; r < 16; ++r) rli[r] = __builtin_amdgcn_rcpf(li_l[crow(r, hi)]);
  unsigned char* Ow = Ob + (long)(wid * QBLK) * LDO;
  { const int qi = r32 & 3; const unsigned selA = (unsigned)qi | ((unsigned)(4 + qi) << 8);
#pragma unroll
    for (int R = 0; R < 4; ++R) {
#pragma unroll
      for (int d0 = 0; d0 < 4; ++d0) {
        const float v0 = __builtin_amdgcn_fmed3f(o[d0][4 * R + 0] * rli[4 * R + 0] * 16.0f, -440.f, 440.f), v1 = __builtin_amdgcn_fmed3f(o[d0][4 * R + 1] * rli[4 * R + 1] * 16.0f, -440.f, 440.f);
        const float v2 = __builtin_amdgcn_fmed3f(o[d0][4 * R + 2] * rli[4 * R + 2] * 16.0f, -440.f, 440.f), v3 = __builtin_amdgcn_fmed3f(o[d0][4 * R + 3] * rli[4 * R + 3] * 16.0f, -440.f, 440.f);
        int w = 0; w = __builtin_amdgcn_cvt_pk_fp8_f32(v0, v1, w, false); w = __builtin_amdgcn_cvt_pk_fp8_f32(v2, v3, w, true);
        const unsigned x0 = (unsigned)__builtin_amdgcn_update_dpp(0, w, 0x00, 0xF, 0xF, true), x1 = (unsigned)__builtin_amdgcn_update_dpp(0, w, 0x55, 0xF, 0xF, true);
        const unsigned x2 = (unsigned)__builtin_amdgcn_update_dpp(0, w, 0xAA, 0xF, 0xF, true), x3 = (unsigned)__builtin_amdgcn_update_dpp(0, w, 0xFF, 0xF, 0xF, true);
        const unsigned p01 = __builtin_amdgcn_perm(x1, x0, selA), p23 = __builtin_amdgcn_perm(x3, x2, selA);
        const unsigned dd = __builtin_amdgcn_perm(p23, p01, 0x05040100u);
        *(unsigned*)(Ow + (long)(8 * R + 4 * hi + qi) * LDO + d0 * 32 + (r32 & ~3)) = dd; } } }
#undef SLOAD
#undef SWRITE
#undef SWAIT
#undef RESC
}
#undef KSWZ
#undef SBAR
}

#define LAS __attribute__((address_space(3)))
typedef unsigned short bf16_t;
typedef short bf16x8 __attribute__((ext_vector_type(8)));
typedef float f32x4 __attribute__((ext_vector_type(4)));
typedef float f32x2 __attribute__((ext_vector_type(2)));
typedef float f32x16 __attribute__((ext_vector_type(16)));
typedef unsigned u32x4 __attribute__((ext_vector_type(4)));
typedef unsigned u32x2 __attribute__((ext_vector_type(2)));

constexpr int NTOK = 16384, DMODEL = 2048, SEQL = 8192;
constexpr size_t MiB = 1u << 20;
constexpr size_t WS_MOD = 0;
constexpr size_t WS_BAR = 512 * 1024;
constexpr size_t WS_S5A = 1 * MiB;
constexpr size_t WS_LNST = 296 * MiB;
constexpr size_t WS_ABT = 2 * MiB;
constexpr size_t WS_BIASQ = 2 * MiB + 64 * 1024;
constexpr size_t WS_ROWSQ = 336 * MiB;
constexpr size_t WS_BIASP = 340 * MiB;
constexpr size_t WS_WQF = 304 * MiB;
constexpr size_t WS_KEYS = 4 * MiB;
constexpr size_t WS_WSB = 5 * MiB;
constexpr size_t WS_WINE = 6 * MiB;
constexpr size_t WS_WOUTE = 16 * MiB;
constexpr size_t WS_WINO = 24 * MiB;
constexpr size_t WS_WOUTO = 56 * MiB;
constexpr size_t WS_WQ = 72 * MiB;
constexpr size_t WS_PU = 88 * MiB;
constexpr size_t WS_PV = 152 * MiB;
constexpr size_t WS_PSC = 5 * MiB + 512 * 1024;
constexpr int PEER_ROWB = 1536;
constexpr bool PEER_SLICE_U = true, PEER_SLICE_V = true;
typedef unsigned u32x6 __attribute__((ext_vector_type(6)));
typedef float f32x16 __attribute__((ext_vector_type(16)));
typedef float f32x32 __attribute__((ext_vector_type(32)));
typedef _Float16 h16x2 __attribute__((ext_vector_type(2)));
typedef _Float16 h16x32 __attribute__((ext_vector_type(32)));
constexpr size_t WS_WY = 216 * MiB;
constexpr size_t WS_WSUM = 232 * MiB;
constexpr size_t WS_H8 = 256 * MiB;
constexpr size_t WS_H = 344 * MiB;
constexpr size_t WS_XB = WS_H;
constexpr size_t WS_TMP = 408 * MiB;
constexpr size_t WS_AB = WS_TMP  , WS_Q = WS_TMP + 64 * MiB, WS_K = WS_TMP + 96 * MiB, WS_V = WS_TMP + 104 * MiB,
                 WS_SS = WS_TMP + 112 * MiB  , WS_CAT = WS_TMP + 176 * MiB;
constexpr size_t WS_Z = WS_TMP, WS_SG = WS_TMP + 256 * MiB;
constexpr size_t WS_QP = WS_TMP;
constexpr size_t WS_X8 = WS_TMP + 64 * MiB;
constexpr size_t WS_RSTD = WS_TMP + 64 * MiB;
constexpr size_t WS_EID = WS_TMP + 128 * MiB;
constexpr size_t WS_GATE = WS_TMP + 136 * MiB;
constexpr size_t WS_PW = WS_TMP + 144 * MiB;
constexpr size_t WS_PO = WS_TMP + 152 * MiB;
constexpr size_t WS_PACT = WS_TMP + 216 * MiB;
typedef unsigned u32x16 __attribute__((ext_vector_type(16)));
typedef __bf16 bf16x2v __attribute__((ext_vector_type(2)));
constexpr size_t WS_END = WS_TMP + 384 * MiB;
constexpr int LDS_BYTES = 147456;

struct P {
    const float *x, *c, *ada_w, *ada_b, *norm_g, *even_w_in, *even_w_out, *lam_re, *lam_im, *log_dt, *b_re, *b_im, *c_re, *c_im, *s5_d, *glu_w, *glu_b,
        *q_g, *k_g, *odd_w_in, *odd_w_out, *sgu_ln_g, *sgu_w, *sgu_b, *peer_wq, *peer_k1, *peer_k2, *peer_u, *peer_v, *final_g;
    float* out; unsigned char* ws;
};

__device__ __forceinline__ unsigned cvtpk(float lo, float hi) { unsigned r; asm("v_cvt_pk_bf16_f32 %0, %1, %2" : "=v"(r) : "v"(lo), "v"(hi)); return r; }
__device__ __forceinline__ unsigned pk_fp8x4(float a, float b, float c, float d) {
    a = __builtin_amdgcn_fmed3f(a, -440.f, 440.f); b = __builtin_amdgcn_fmed3f(b, -440.f, 440.f); c = __builtin_amdgcn_fmed3f(c, -440.f, 440.f); d = __builtin_amdgcn_fmed3f(d, -440.f, 440.f);
    int w = 0; w = __builtin_amdgcn_cvt_pk_fp8_f32(a, b, w, false); w = __builtin_amdgcn_cvt_pk_fp8_f32(c, d, w, true); return (unsigned)w; }
constexpr float F8_WS = 64.0f, F8_HS = 8.0f, F8_SGS = 8.0f, F8_CS = 16.0f, F8_XS = 8.0f;
__device__ __forceinline__ float bflo(unsigned w) { return __uint_as_float(w << 16); }
__device__ __forceinline__ float bfhi(unsigned w) { return __uint_as_float(w & 0xffff0000u); }
__device__ __forceinline__ float wave_sum(float v) {
    v += __uint_as_float(__builtin_amdgcn_update_dpp(0u, __float_as_uint(v), 0xB1, 0xF, 0xF, true));
    v += __uint_as_float(__builtin_amdgcn_update_dpp(0u, __float_as_uint(v), 0x4E, 0xF, 0xF, true));
    v += __uint_as_float(__builtin_amdgcn_update_dpp(0u, __float_as_uint(v), 0x141, 0xF, 0xF, true));
    v += __uint_as_float(__builtin_amdgcn_update_dpp(0u, __float_as_uint(v), 0x140, 0xF, 0xF, true));
    { const auto r = __builtin_amdgcn_permlane16_swap(__float_as_uint(v), __float_as_uint(v), false, false); v = __uint_as_float(r[0]) + __uint_as_float(r[1]); }
    { const auto r = __builtin_amdgcn_permlane32_swap(__float_as_uint(v), __float_as_uint(v), false, false); v = __uint_as_float(r[0]) + __uint_as_float(r[1]); }
    return v;
}
__device__ __forceinline__ float row16_sum(float v) {
    v += __uint_as_float(__builtin_amdgcn_update_dpp(0u, __float_as_uint(v), 0xB1, 0xF, 0xF, true));
    v += __uint_as_float(__builtin_amdgcn_update_dpp(0u, __float_as_uint(v), 0x4E, 0xF, 0xF, true));
    v += __uint_as_float(__builtin_amdgcn_update_dpp(0u, __float_as_uint(v), 0x141, 0xF, 0xF, true));
    v += __uint_as_float(__builtin_amdgcn_update_dpp(0u, __float_as_uint(v), 0x140, 0xF, 0xF, true));
    return v;
}
__device__ __forceinline__ float xrow_sum(float v) {
    { const auto r = __builtin_amdgcn_permlane16_swap(__float_as_uint(v), __float_as_uint(v), false, false); v = __uint_as_float(r[0]) + __uint_as_float(r[1]); }
    { const auto r = __builtin_amdgcn_permlane32_swap(__float_as_uint(v), __float_as_uint(v), false, false); v = __uint_as_float(r[0]) + __uint_as_float(r[1]); }
    return v;
}
__device__ __forceinline__ float sigmoid_f(float x) { return __builtin_amdgcn_rcpf(1.f + __expf(-x)); }
__device__ __forceinline__ float gelu_t(float x) { const float u = 0.7978845608028654f * (x + 0.044715f * x * x * x); return x * __builtin_amdgcn_rcpf(1.f + __expf(-2.f * u)); }
__device__ __forceinline__ void sincos_rad(float ang, float& sn, float& cs) {
    float rev = ang * 0.15915494309189535f; rev = rev - floorf(rev);
    sn = __builtin_amdgcn_sinf(rev); cs = __builtin_amdgcn_cosf(rev);
}
__device__ __forceinline__ float dot4(f32x4 a, f32x4 b) { return (a.x * b.x + a.y * b.y) + (a.z * b.z + a.w * b.w); }
#define LDS_WAIT() asm volatile("s_waitcnt lgkmcnt(0)" ::: "memory")

namespace pg8 {
constexpr int NTOK_ = 16384;
struct EpiEvenSplit {
    static constexpr bool PERM = true, AFTER_DRAIN = false;
    float ds; unsigned char* wsb;
    __device__ __forceinline__ void operator()(const f32x4 (&acc)[2][2][4][2], const Unit& u, int wr, int wc, int fr, int fq) const {
        { const int l_ = lane_id_v(); fr = l_ & 15; fq = l_ >> 4; }
        const int row0 = u.pm * BM + wr * 64 + fr; const int pn = u.pn;
        bf16_t* const UA = (bf16_t*)(wsb + WS_AB);
        if (pn < 4) {
#pragma unroll
            for (int ai = 0; ai < 2; ++ai)
#pragma unroll
                for (int m = 0; m < 4; ++m) { const int t = row0 + ai * HALF + m * 16;
#pragma unroll
                    for (int bj = 0; bj < 2; ++bj) { const int c = pn * 256 + bj * HALF + wc * 32 + 8 * fq; const f32x4 v0 = acc[ai][bj][m][0] * ds, v1 = acc[ai][bj][m][1] * ds;
                        u32x4 w; w.x = cvt_pk_bf16(v0[0], v0[1]); w.y = cvt_pk_bf16(v0[2], v0[3]); w.z = cvt_pk_bf16(v1[0], v1[1]); w.w = cvt_pk_bf16(v1[2], v1[3]);
                        *(u32x4*)(UA + ((size_t)(c >> 4) * 1024 + (t >> 4)) * 512 + (t & 15) * 16 + (c & 15)) = w; } }
            return;
        }
        bf16_t* base; int ldc, colt;
        if (pn < 8) { base = (bf16_t*)(wsb + WS_Q); ldc = 1024; colt = (pn - 4) * 256; } else { base = (bf16_t*)(wsb + (pn == 8 ? WS_K : WS_V)); ldc = 256; colt = 0; }
        const int col0 = colt + wc * 32 + 8 * fq;
#pragma unroll
        for (int ai = 0; ai < 2; ++ai)
#pragma unroll
            for (int m = 0; m < 4; ++m) { bf16_t* rowp = base + (size_t)(row0 + ai * HALF + m * 16) * ldc + col0;
#pragma unroll
                for (int bj = 0; bj < 2; ++bj) { const f32x4 v0 = acc[ai][bj][m][0] * ds, v1 = acc[ai][bj][m][1] * ds;
                    u32x4 w; w.x = cvt_pk_bf16(v0[0], v0[1]); w.y = cvt_pk_bf16(v0[2], v0[3]); w.z = cvt_pk_bf16(v1[0], v1[1]); w.w = cvt_pk_bf16(v1[2], v1[3]);
                    *(u32x4*)(rowp + bj * HALF) = w; } }
    }
};
template <int ACT> struct EpiBf16T {
    static constexpr bool PERM = true, AFTER_DRAIN = false;
    bf16_t* O; int ldc; float ds; float* lnst;
    __device__ __forceinline__ void operator()(const f32x4 (&acc)[2][2][4][2], const Unit& u, int wr, int wc, int fr, int fq) const {
        { const int l_ = lane_id_v(); fr = l_ & 15; fq = l_ >> 4; }
        const int row0 = u.pm * BM + wr * 64 + fr, col0 = u.pn * BM + wc * 32 + 8 * fq;
        const bool do_st = (ACT == 1) && lnst != nullptr && u.pn >= 16;
#pragma unroll
        for (int ai = 0; ai < 2; ++ai)
#pragma unroll
            for (int m = 0; m < 4; ++m) { const int trow = row0 + ai * HALF + m * 16;
                bf16_t* rowp = (ACT == 1) ? O + ((size_t)((trow >> 7) * 16 + (col0 >> 9)) * 128 + (trow & 127)) * 512 + (col0 & 511) : O + (size_t)trow * ldc + col0; float s1 = 0.f, s2 = 0.f;
#pragma unroll
                for (int bj = 0; bj < 2; ++bj) { f32x4 v0 = acc[ai][bj][m][0] * ds, v1 = acc[ai][bj][m][1] * ds;
                    if (ACT == 1) {
#pragma unroll
                        for (int e = 0; e < 4; ++e) { v0[e] = gelu_t(v0[e]); v1[e] = gelu_t(v1[e]); s1 += v0[e] + v1[e]; s2 += v0[e] * v0[e] + v1[e] * v1[e]; } }
                    u32x4 w; w.x = cvt_pk_bf16(v0[0], v0[1]); w.y = cvt_pk_bf16(v0[2], v0[3]); w.z = cvt_pk_bf16(v1[0], v1[1]); w.w = cvt_pk_bf16(v1[2], v1[3]);
                    *(u32x4*)(rowp + bj * HALF) = w; }
                if (ACT == 1) { if (do_st) {
                    s1 = xrow_sum(s1); s2 = xrow_sum(s2);
                    if (fq == 0) *(f32x2*)(lnst + ((size_t)((u.pn - 16) * 4 + wc) * NTOK_ + (row0 + ai * HALF + m * 16)) * 2) = (f32x2){s1, s2}; } }
            }
    }
};
struct EpiResid {
    static constexpr bool PERM = false, AFTER_DRAIN = false;
    const float* xin; float* xout; const float* gate; float ds;
    __device__ __forceinline__ void operator()(const f32x4 (&acc)[2][2][4][2], const Unit& u, int wr, int wc, int fr, int fq) const {
        { const int l_ = lane_id_v(); fr = l_ & 15; fq = l_ >> 4; }
        const int row0 = u.pm * BM + wr * 64 + fr, col0 = u.pn * BM + wc * 32 + 4 * fq;
        const float* gp = gate + (size_t)((u.pm * BM) >> 13) * 12288 + col0;
        f32x4 gv[2][2];
#pragma unroll
        for (int bj = 0; bj < 2; ++bj)
#pragma unroll
            for (int n = 0; n < 2; ++n) gv[bj][n] = *(const f32x4*)(gp + bj * HALF + n * 16) * ds;
#pragma unroll
        for (int ai = 0; ai < 2; ++ai)
#pragma unroll
            for (int m = 0; m < 4; ++m) { const size_t off = (size_t)(row0 + ai * HALF + m * 16) * 2048 + col0;
#pragma unroll
                for (int bj = 0; bj < 2; ++bj)
#pragma unroll
                    for (int n = 0; n < 2; ++n) { const f32x4 xi = *(const f32x4*)(xin + off + bj * HALF + n * 16);
                        *(f32x4*)(xout + off + bj * HALF + n * 16) = xi + gv[bj][n] * acc[ai][bj][m][n]; } }
    }
};
struct EpiF32B {
    static constexpr bool PERM = false, AFTER_DRAIN = false;
    float* C; int ldc; size_t bs;
    __device__ __forceinline__ void operator()(const f32x4 (&acc)[2][2][4][2], const Unit& u, int wr, int wc, int fr, int fq) const {
        { const int l_ = lane_id_v(); fr = l_ & 15; fq = l_ >> 4; }
        char* base = (char*)(C + (size_t)u.pb * bs + (size_t)(u.pm * BM) * ldc);
        const unsigned off0 = (unsigned)((wr * 64 + fr) * ldc + u.pn * BM + wc * 32 + 4 * fq) * 4u;
#pragma unroll
        for (int ai = 0; ai < 2; ++ai)
#pragma unroll
            for (int m = 0; m < 4; ++m) { const unsigned off = off0 + (unsigned)((ai * HALF + m * 16) * ldc) * 4u;
#pragma unroll
                for (int bj = 0; bj < 2; ++bj)
#pragma unroll
                    for (int n = 0; n < 2; ++n) *(f32x4*)(base + off + (bj * HALF + n * 16) * 4) = acc[ai][bj][m][n]; }
    }
};
struct EpiS5Glu {
    static constexpr bool PERM = false, AFTER_DRAIN = false;
    unsigned char* CAT; const PG8_LAS float* wl;
    __device__ __forceinline__ void operator()(const f32x4 (&acc)[2][2][4][2], const Unit& u, int wr, int wc, int fr, int fq) const {
        { const int l_ = lane_id_v(); fr = l_ & 15; fq = l_ >> 4; }
        const int g = u.pb;
#pragma unroll
        for (int ai = 0; ai < 2; ++ai)
#pragma unroll
            for (int m = 0; m < 4; ++m) {
                const int chunk = u.pm * BM + ai * HALF + wr * 64 + m * 16 + fr, token = chunk * 16 + wc * 4 + fq;
                float y[16];
#pragma unroll
                for (int bj = 0; bj < 2; ++bj)
#pragma unroll
                    for (int n = 0; n < 2; ++n)
#pragma unroll
                        for (int j = 0; j < 4; ++j) y[8 * bj + 4 * n + j] = gelu_t(acc[ai][bj][m][n][j]);
                f32x4 z[4];
#pragma unroll
                for (int kq = 0; kq < 4; ++kq) z[kq] = *(const PG8_LAS f32x4*)(wl + 256 + 4 * kq);
#pragma unroll
                for (int h = 0; h < 16; ++h)
#pragma unroll
                    for (int kq = 0; kq < 4; ++kq) z[kq] += *(const PG8_LAS f32x4*)(wl + h * 16 + 4 * kq) * y[h];
                float o[16];
#pragma unroll
                for (int k = 0; k < 16; ++k) o[k] = y[k] * sigmoid_f(z[k >> 2][k & 3]);
                u32x4 w; w.x = pk_fp8x4(o[0] * F8_CS, o[1] * F8_CS, o[2] * F8_CS, o[3] * F8_CS); w.y = pk_fp8x4(o[4] * F8_CS, o[5] * F8_CS, o[6] * F8_CS, o[7] * F8_CS);
                w.z = pk_fp8x4(o[8] * F8_CS, o[9] * F8_CS, o[10] * F8_CS, o[11] * F8_CS); w.w = pk_fp8x4(o[12] * F8_CS, o[13] * F8_CS, o[14] * F8_CS, o[15] * F8_CS);
                *(u32x4*)(CAT + (size_t)token * 2048 + g * 16) = w;
                asm volatile("" ::: "memory");
            }
    }
};
template <bool FIRST> struct EpiResidB {
    static constexpr bool PERM = true, AFTER_DRAIN = false;
    const float* xin; bf16_t* xb; const float* gate; float* rowsq; unsigned char* x8; float ds;
    __device__ __forceinline__ void operator()(const f32x4 (&acc)[2][2][4][2], const Unit& u, int wr, int wc, int fr, int fq) const {
        { const int l_ = lane_id_v(); fr = l_ & 15; fq = l_ >> 4; }
        const int row0 = u.pm * BM + wr * 64 + fr, col0 = u.pn * BM + wc * 32 + 8 * fq;
        const float* gp = gate + (size_t)((u.pm * BM) >> 13) * 12288 + col0; float* const rq = rowsq;
        f32x4 gv[2][2];
#pragma unroll
        for (int bj = 0; bj < 2; ++bj)
#pragma unroll
            for (int n = 0; n < 2; ++n) gv[bj][n] = *(const f32x4*)(gp + bj * HALF + n * 4) * ds;
#pragma unroll
        for (int ai = 0; ai < 2; ++ai) {
            f32x4 xi[4][2][2];
#pragma unroll
            for (int m = 0; m < 4; ++m) { const size_t off = (size_t)(row0 + ai * HALF + m * 16) * 2048 + col0;
#pragma unroll
                for (int bj = 0; bj < 2; ++bj) {
                    if (FIRST) { xi[m][bj][0] = *(const f32x4*)(xin + off + bj * HALF); xi[m][bj][1] = *(const f32x4*)(xin + off + bj * HALF + 4); }
                    else { const u32x4 w = *(const u32x4*)(xb + off + bj * HALF);
                        xi[m][bj][0] = (f32x4){__uint_as_float(w.x << 16), __uint_as_float(w.x & 0xffff0000u), __uint_as_float(w.y << 16), __uint_as_float(w.y & 0xffff0000u)};
                        xi[m][bj][1] = (f32x4){__uint_as_float(w.z << 16), __uint_as_float(w.z & 0xffff0000u), __uint_as_float(w.w << 16), __uint_as_float(w.w & 0xffff0000u)}; } } }
            asm volatile("" ::: "memory");
#pragma unroll
            for (int m = 0; m < 4; ++m) { const int row = row0 + ai * HALF + m * 16; const size_t off = (size_t)row * 2048 + col0; float ss = 0.f;
#pragma unroll
                for (int bj = 0; bj < 2; ++bj) { const f32x4 x0 = xi[m][bj][0] + gv[bj][0] * acc[ai][bj][m][0], x1 = xi[m][bj][1] + gv[bj][1] * acc[ai][bj][m][1];
                    ss += ((x0[0] * x0[0] + x0[1] * x0[1]) + (x0[2] * x0[2] + x0[3] * x0[3])) + ((x1[0] * x1[0] + x1[1] * x1[1]) + (x1[2] * x1[2] + x1[3] * x1[3]));
                    u32x4 o; o.x = cvt_pk_bf16(x0[0], x0[1]); o.y = cvt_pk_bf16(x0[2], x0[3]); o.z = cvt_pk_bf16(x1[0], x1[1]); o.w = cvt_pk_bf16(x1[2], x1[3]); *(u32x4*)(xb + off + bj * HALF) = o;
                    u32x2 o8; o8.x = pk_fp8x4(x0[0] * F8_XS, x0[1] * F8_XS, x0[2] * F8_XS, x0[3] * F8_XS); o8.y = pk_fp8x4(x1[0] * F8_XS, x1[1] * F8_XS, x1[2] * F8_XS, x1[3] * F8_XS); *(u32x2*)(x8 + off + bj * HALF) = o8; }
                ss = xrow_sum(ss);
                if (fq == 0) rq[(size_t)(u.pn * 4 + wc) * NTOK_ + row] = ss; }
        }
    }
};
struct EpiQ {
    static constexpr bool PERM = true, AFTER_DRAIN = false;
    bf16_t* O; const float* rowsq; const float* bias; float ds;
    __device__ __forceinline__ void operator()(const f32x4 (&acc)[2][2][4][2], const Unit& u, int wr, int wc, int fr, int fq) const {
        { const int l_ = lane_id_v(); fr = l_ & 15; fq = l_ >> 4; }
        const int row0 = u.pm * BM + wr * 64 + fr, col0 = u.pn * BM + wc * 32 + 8 * fq;
        const float* bp = bias + (size_t)((u.pm * BM) >> 13) * 2048 + col0;
        f32x4 bv[2][2];
#pragma unroll
        for (int bj = 0; bj < 2; ++bj)
#pragma unroll
            for (int n = 0; n < 2; ++n) bv[bj][n] = *(const f32x4*)(bp + bj * HALF + 4 * n);
        float rstd[2][4];
#pragma unroll
        for (int ai = 0; ai < 2; ++ai)
#pragma unroll
            for (int m = 0; m < 4; ++m) { const int row = row0 + ai * HALF + m * 16; float sq = 0.f;
#pragma unroll
                for (int t = 0; t < 8; ++t) sq += rowsq[(size_t)(fq * 8 + t) * NTOK_ + row];
                rstd[ai][m] = rsqrtf(xrow_sum(sq) * (1.0f / 2048.0f) + 1e-6f) * ds; }
#pragma unroll
        for (int ai = 0; ai < 2; ++ai)
#pragma unroll
            for (int m = 0; m < 4; ++m) { const int row = row0 + ai * HALF + m * 16; bf16_t* rowp = O + (size_t)row * 2048 + col0;
#pragma unroll
                for (int bj = 0; bj < 2; ++bj) { const f32x4 v0 = acc[ai][bj][m][0] * rstd[ai][m] + bv[bj][0], v1 = acc[ai][bj][m][1] * rstd[ai][m] + bv[bj][1];
                    u32x4 w; w.x = cvt_pk_bf16(v0[0], v0[1]); w.y = cvt_pk_bf16(v0[2], v0[3]); w.z = cvt_pk_bf16(v1[0], v1[1]); w.w = cvt_pk_bf16(v1[2], v1[3]);
                    *(u32x4*)(rowp + bj * HALF) = w; } }
    }
};
struct BatchOrder {
    int nM, nU, G, c;
    __device__ __forceinline__ bool next(int i, Unit& u) const { const int L = i * G + c; if (L >= nU) return false; u.pb = L / nM; u.pm = L % nM; u.pn = 0; return true; }
    __device__ __forceinline__ void a_ready(const Unit&) const {}
    __device__ __forceinline__ void done(const Unit&) const {}
};
}

__device__ __forceinline__ unsigned f2bf_rne(float f) { unsigned u = __builtin_bit_cast(unsigned, f); return (u + 0x7fffu + ((u >> 16) & 1u)) >> 16; }
__device__ __forceinline__ unsigned pk2(float lo, float hi) { return f2bf_rne(lo) | (f2bf_rne(hi) << 16); }
__device__ __forceinline__ void p0_transpose_item(const float* W, int K, int N, bf16_t* WT, LAS float* scr, int item, int lane) {
    const int nblk = N / 32, kb = item / nblk, nb = item % nblk, k0 = 64 * kb, n0 = 32 * nb;
#pragma unroll 8
    for (int i = 0; i < 32; ++i) { const int kk = 2 * i + (lane >> 5); scr[kk * 33 + (lane & 31)] = W[(size_t)(k0 + kk) * N + n0 + (lane & 31)]; }
    LDS_WAIT(); asm volatile("" ::: "memory");
    const int c = lane & 7;
#pragma unroll
    for (int j = 0; j < 4; ++j) { const int n = (lane >> 3) + 8 * j; const LAS float* s = scr + (8 * c) * 33 + n;
        u32x4 o; o.x = pk2(s[0 * 33], s[1 * 33]); o.y = pk2(s[2 * 33], s[3 * 33]); o.z = pk2(s[4 * 33], s[5 * 33]); o.w = pk2(s[6 * 33], s[7 * 33]);
        *(u32x4*)(WT + (size_t)(n0 + n) * K + k0 + 8 * c) = o; }
    LDS_WAIT(); asm volatile("" ::: "memory");
}

__device__ __forceinline__ void p0_transpose_item_f8(const float* W, int K, int N, unsigned char* WT, LAS float* scr, int item, int lane, float sc) {
    const int nblk = N / 32, kb = item / nblk, nb = item % nblk, k0 = 64 * kb, n0 = 32 * nb;
#pragma unroll 8
    for (int i = 0; i < 32; ++i) { const int kk = 2 * i + (lane >> 5); scr[kk * 33 + (lane & 31)] = W[(size_t)(k0 + kk) * N + n0 + (lane & 31)] * sc; }
    LDS_WAIT(); asm volatile("" ::: "memory");
    const int c = lane & 7;
#pragma unroll
    for (int j = 0; j < 4; ++j) { const int n = (lane >> 3) + 8 * j; const LAS float* s = scr + (8 * c) * 33 + n;
        u32x2 o; o.x = pk_fp8x4(s[0 * 33], s[1 * 33], s[2 * 33], s[3 * 33]); o.y = pk_fp8x4(s[4 * 33], s[5 * 33], s[6 * 33], s[7 * 33]);
        *(u32x2*)(WT + (size_t)(n0 + n) * K + k0 + 8 * c) = o; }
    LDS_WAIT(); asm volatile("" ::: "memory");
}

__device__ __forceinline__ void s5_gen_group(const P& p, LAS unsigned char* lds, int g, int tid) {
    LAS f32x2* pw = (LAS f32x2*)lds;
    LAS f32x2* Cc = (LAS f32x2*)(lds + 17408);
    LAS f32x2* Bb = (LAS f32x2*)(lds + 17408 + 16384);
    LAS float* Kt = (LAS float*)(lds + 17408 + 32768);
    LAS float* dsk = (LAS float*)(lds + 17408 + 65536);
    __syncthreads();
    if (tid < 128) {
        const int d = tid >> 6, pp = tid & 63, dgp = (d * 64 + g) * 64 + pp;
        const float lr = fminf(p.lam_re[dgp], -1e-4f), li = p.lam_im[dgp], dt = __expf(p.log_dt[d * 64 + g]);
        const float lrdt = lr * dt, ang = li * dt;
#pragma unroll 1
        for (int e = 0; e <= 16; ++e) { const float mag = __expf((float)e * lrdt); float sn, cs; sincos_rad((float)e * ang, sn, cs); pw[e * 128 + tid] = (f32x2){mag * cs, mag * sn}; }
        const f32x2 a1 = pw[128 + tid]; const float abr = a1.x, abi = a1.y;
        const float den = lr * lr + li * li, nr = abr - 1.0f;
        const float cre = (nr * lr + abi * li) / den, cim = (abi * lr - nr * li) / den;
        ((f32x2*)(p.ws + WS_S5A))[dgp] = pw[16 * 128 + tid];
#pragma unroll 4
        for (int h = 0; h < 16; ++h) { const float br = p.b_re[dgp * 16 + h], bi = p.b_im[dgp * 16 + h]; Bb[(d * 64 + pp) * 16 + h] = (f32x2){cre * br - cim * bi, cre * bi + cim * br}; }
    }
    for (int i = tid; i < 2048; i += 512) { const int d = i >> 10, h = (i >> 6) & 15, pp = i & 63; const size_t src = ((size_t)(d * 64 + g) * 16 + h) * 64 + pp; Cc[i] = (f32x2){p.c_re[src], p.c_im[src]}; }
    if (tid < 16) dsk[tid] = p.s5_d[g * 16 + tid];
    __syncthreads();
    {
        const int d = tid >> 8, tau = (tid >> 4) & 15, h = tid & 15; float acc[16];
#pragma unroll
        for (int hp = 0; hp < 16; ++hp) acc[hp] = 0.f;
#pragma unroll 2
        for (int pp = 0; pp < 64; ++pp) { const f32x2 c = Cc[(d * 16 + h) * 64 + pp], w = pw[tau * 128 + d * 64 + pp]; const float tx = c.x * w.x - c.y * w.y, ty = c.x * w.y + c.y * w.x;
#pragma unroll
            for (int hp = 0; hp < 16; ++hp) { const f32x2 bb = Bb[(d * 64 + pp) * 16 + hp]; acc[hp] += tx * bb.x - ty * bb.y; } }
#pragma unroll
        for (int hp = 0; hp < 16; ++hp) Kt[(d * 16 + tau) * 256 + h * 16 + hp] = acc[hp];
    }
    __syncthreads();
    bf16_t* Wy = (bf16_t*)(p.ws + WS_WY) + (size_t)g * 256 * 512;
#pragma unroll 1
    for (int idx = tid; idx < 256 * 256; idx += 512) {
        const int np = idx >> 8, k0 = (idx & 255) * 2;
        const int bj = (np >> 7) & 1, wc = (np >> 5) & 3, n = (np >> 4) & 1, fq = (np >> 2) & 3, j = np & 3, i = wc * 4 + fq, h = 8 * bj + 4 * n + j;
        float v[2];
#pragma unroll
        for (int kk = 0; kk < 2; ++kk) { const int k = k0 + kk;
            if (k < 256) { const int s = k >> 4, hp = k & 15;
                if (s < i) v[kk] = Kt[(i - s) * 256 + h * 16 + hp]; else if (s > i) v[kk] = Kt[(16 + (s - i)) * 256 + h * 16 + hp];
                else v[kk] = Kt[h * 16 + hp] + Kt[16 * 256 + h * 16 + hp] + (h == hp ? dsk[h] : 0.f);
            } else { const int kc = k - 256, d = kc >> 7, pp = (kc >> 1) & 63, ri = kc & 1, e = d ? 16 - i : i + 1;
                const f32x2 c = Cc[(d * 16 + h) * 64 + pp], w = pw[e * 128 + d * 64 + pp]; v[kk] = ri ? -(c.x * w.y + c.y * w.x) : (c.x * w.x - c.y * w.y); } }
        *(unsigned*)(Wy + (size_t)np * 512 + k0) = cvtpk(v[0], v[1]);
    }
    bf16_t* Wsum = (bf16_t*)(p.ws + WS_WSUM) + (size_t)g * 256 * 256;
#pragma unroll 1
    for (int idx = tid; idx < 256 * 128; idx += 512) {
        const int r = idx >> 7, k0 = (idx & 127) * 2, d = r >> 7, pp = (r >> 1) & 63, ri = r & 1;
        float v[2];
#pragma unroll
        for (int kk = 0; kk < 2; ++kk) { const int k = k0 + kk, s = k >> 4, hp = k & 15, e = d ? s : 15 - s;
            const f32x2 w = pw[e * 128 + d * 64 + pp], bb = Bb[(d * 64 + pp) * 16 + hp]; v[kk] = ri ? (w.x * bb.y + w.y * bb.x) : (w.x * bb.x - w.y * bb.y); }
        *(unsigned*)(Wsum + (size_t)r * 256 + k0) = cvtpk(v[0], v[1]);
    }
}

#ifndef PRO_DBL
#define PRO_DBL 0
#endif
#define PRO_REP(b) for (int _pr = 0; _pr < 1 + ((PRO_DBL >> (b)) & 1); ++_pr)
__device__ __forceinline__ void phase_prologue(const P& p, LAS unsigned char* lds, int tid, int lane, int wid) {
    unsigned char* ws = p.ws;
    LAS float* cact = (LAS float*)lds;
    LAS float* red = (LAS float*)(lds + 16384);
    for (int i = tid; i < 4096; i += 512) { const float cv = p.c[i]; cact[i] = cv * sigmoid_f(cv); }
    __syncthreads();
    float* mod = (float*)(ws + WS_MOD);
    PRO_REP(0) for (int item = blockIdx.x; item < 192; item += gridDim.x) {
        const int l = item / 96, cb = item % 96, cg4 = tid & 31, rl = tid >> 5;
        const float* W = p.ada_w + (size_t)l * 2048 * 12288 + cb * 128 + cg4 * 4;
        f32x4 a0 = {0.f, 0.f, 0.f, 0.f}, a1 = {0.f, 0.f, 0.f, 0.f};
#pragma unroll 8
        for (int r = rl; r < 2048; r += 16) { const f32x4 w = *(const f32x4*)(W + (size_t)r * 12288); const float c0 = cact[r], c1 = cact[2048 + r]; a0 += w * c0; a1 += w * c1; }
        *(LAS f32x4*)(red + (rl * 32 + cg4) * 8) = a0; *(LAS f32x4*)(red + (rl * 32 + cg4) * 8 + 4) = a1;
        __syncthreads();
        if (tid < 256) { const int col = tid & 127, b = tid >> 7; float s = 0.f;
#pragma unroll
            for (int r2 = 0; r2 < 16; ++r2) s += red[(r2 * 32 + (col >> 2)) * 8 + b * 4 + (col & 3)];
            s += p.ada_b[l * 12288 + cb * 128 + col]; mod[(l * 2 + b) * 12288 + cb * 128 + col] = s; }
        __syncthreads();
    }
    PRO_REP(1) {
        LAS float* scr = (LAS float*)(lds + 32768 + wid * 8448);
        const int gw = blockIdx.x * 8 + wid, ngw = gridDim.x * 8;
        constexpr int I0 = 32 * 80, I1 = 32 * 64, I2 = 32 * 256, I3 = 64 * 64, NIT = I0 + I1 + I2 + I3;
        for (int it = gw; it < NIT; it += ngw) {
            int r = it;
            if (r < I0) { p0_transpose_item_f8(p.even_w_in, 2048, 2560, ws + WS_WINE, scr, r, lane, F8_WS); continue; } r -= I0;
            if (r < I1) { p0_transpose_item_f8(p.even_w_out, 2048, 2048, ws + WS_WOUTE, scr, r, lane, F8_WS); continue; } r -= I1;
            if (r < I2) { p0_transpose_item_f8(p.odd_w_in, 2048, 8192, ws + WS_WINO, scr, r, lane, F8_WS); continue; } r -= I2;
            p0_transpose_item_f8(p.odd_w_out, 4096, 2048, ws + WS_WOUTO, scr, r, lane, F8_WS);
        }
    }
    const long gtid = (long)blockIdx.x * 512 + tid, ngt = (long)gridDim.x * 512;
    PRO_REP(2) {
        const int gw = blockIdx.x * 8 + wid, ngw = gridDim.x * 8;
        float* psc = (float*)(ws + WS_PSC);
        for (int row0 = 4 * gw; row0 < 4 * 16384; row0 += 4 * ngw) {
            f32x4 v[4][8]; float am[4]; const float* src[4]; unsigned char* dst[4];
#pragma unroll
            for (int rr = 0; rr < 4; ++rr) { const int row = row0 + rr; const bool tv = row >= 2 * 16384; const int r = tv ? row - 2 * 16384 : row;
                const bool sl = tv ? PEER_SLICE_V : PEER_SLICE_U;
                src[rr] = (tv ? p.peer_v : p.peer_u) + (size_t)r * 2048; dst[rr] = ws + (tv ? WS_PV : WS_PU) + (size_t)r * PEER_ROWB;
#pragma unroll
                for (int j = 0; j < 8; ++j) v[rr][j] = *(const f32x4*)(src[rr] + (sl ? 4 * (lane + 64 * j) : 16 * lane + 1024 * (j >> 2) + 4 * (j & 3))); }
#pragma unroll
            for (int rr = 0; rr < 4; ++rr) { am[rr] = 0.f;
#pragma unroll
                for (int j = 0; j < 8; ++j) am[rr] = fmaxf(am[rr], fmaxf(fmaxf(fabsf(v[rr][j].x), fabsf(v[rr][j].y)), fmaxf(fabsf(v[rr][j].z), fabsf(v[rr][j].w))));
#pragma unroll
                for (int o = 32; o > 0; o >>= 1) am[rr] = fmaxf(am[rr], __shfl_xor(am[rr], o)); }
#pragma unroll
            for (int rr = 0; rr < 4; ++rr) { const int row = row0 + rr;
                const float sc = am[rr] > 0.f ? 7.5f / am[rr] : 1.0f;
                if (lane == 0) psc[row] = am[rr] > 0.f ? am[rr] * (1.0f / 7.5f) : 1.0f;
                f32x16 ev, od;
#pragma unroll
                for (int j = 0; j < 8; ++j) { const f32x4 t = v[rr][j] * sc; ev[2 * j] = t.x; od[2 * j] = t.y; ev[2 * j + 1] = t.z; od[2 * j + 1] = t.w; }
                const u32x6 q = __builtin_amdgcn_cvt_scalef32_2xpk16_fp6_f32(ev, od, 1.0f);
                const bool tv = row >= 2 * 16384; const int r = tv ? row - 2 * 16384 : row;
                if (!(tv ? PEER_SLICE_V : PEER_SLICE_U)) {
                    *(u32x4*)(dst[rr] + 16 * lane) = (u32x4){q[0], q[1], q[2], q[3]};
                    *(u32x2*)(dst[rr] + 1024 + 8 * lane) = (u32x2){q[4], q[5]};
                } else {
                    unsigned char* sb = ws + (tv ? WS_PV : WS_PU) + (size_t)(r >> 14) * 16384 * PEER_ROWB + (size_t)(r & 16383) * 192 + 12 * (lane >> 2) + 4 * (lane & 3);
                    const unsigned pc[8] = {q[0] & 0xFFFFFFu, (q[0] >> 24) | ((q[1] & 0xFFFFu) << 8), (q[1] >> 16) | ((q[2] & 0xFFu) << 16), q[2] >> 8,
                                            q[3] & 0xFFFFFFu, (q[3] >> 24) | ((q[4] & 0xFFFFu) << 8), (q[4] >> 16) | ((q[5] & 0xFFu) << 16), q[5] >> 8};
                    const int i8 = 8 * (lane & 3);
#pragma unroll
                    for (int j = 0; j < 8; ++j) { const unsigned nx = __builtin_amdgcn_update_dpp(0u, pc[j], 0xF9, 0xF, 0xF, true);
                        const unsigned d = (pc[j] >> i8) | (nx << (24 - i8));
                        if ((lane & 3) < 3) *(unsigned*)(sb + (size_t)j * 16384 * 192) = d; }
                } }
        }
    }
    PRO_REP(3) for (int g = (int)gridDim.x - 1 - (int)blockIdx.x; g < 64; g += gridDim.x) s5_gen_group(p, lds, g, tid);
    for (long i = gtid; i < 65536; i += ngt) { const int layer = (int)(i >> 15), half = (int)(i >> 14) & 1, r = (int)(i & 16383);
        ((bf16_t*)(ws + WS_KEYS))[i] = (bf16_t)f2bf_rne((half ? p.peer_k2 : p.peer_k1)[layer * 16384 + r]); }
    for (long i = gtid; i < 131072; i += ngt) ((bf16_t*)(ws + WS_WSB))[i] = (bf16_t)f2bf_rne(p.sgu_w[i]);
}

template <bool OUT8>
__device__ __forceinline__ void phase_adaln(const float* xin, void* hout_, const float* g, const float* shift, const float* scale, int gw, int ngw, int lane) {
    for (int b = 0; b < 2; ++b) {
        f32x4 A[8], Bc[8];
#pragma unroll
        for (int j = 0; j < 8; ++j) { const int c = 8 * lane + 512 * (j >> 1) + 4 * (j & 1);
            const f32x4 gv = *(const f32x4*)(g + c), sc = *(const f32x4*)(scale + b * 12288 + c); A[j] = gv * (sc + 1.0f); Bc[j] = *(const f32x4*)(shift + b * 12288 + c); }
#pragma unroll 1
        for (int row0 = b * 8192 + gw; row0 < (b + 1) * 8192; row0 += 4 * ngw) {
            f32x4 v[4][8];
#pragma unroll
            for (int k = 0; k < 4; ++k) { const int row = row0 + k * ngw < (b + 1) * 8192 ? row0 + k * ngw : row0; const float* xr = xin + (size_t)row * 2048 + 8 * lane;
#pragma unroll
                for (int j = 0; j < 8; ++j) v[k][j] = *(const f32x4*)(xr + 512 * (j >> 1) + 4 * (j & 1)); }
#pragma unroll
            for (int k = 0; k < 4; ++k) { const int row = row0 + k * ngw < (b + 1) * 8192 ? row0 + k * ngw : row0; float ss = 0.f;
#pragma unroll
                for (int j = 0; j < 8; ++j) ss += dot4(v[k][j], v[k][j]);
                ss = wave_sum(ss); const float rstd = rsqrtf(ss * (1.0f / 2048.0f) + 1e-6f);
                bf16_t* hr = (bf16_t*)hout_ + (size_t)row * 2048 + 8 * lane; unsigned char* hr8 = (unsigned char*)hout_ + (size_t)row * 2048 + 8 * lane;
#pragma unroll
                for (int j = 0; j < 4; ++j) { const f32x4 y0 = v[k][2 * j] * rstd * A[2 * j] + Bc[2 * j], y1 = v[k][2 * j + 1] * rstd * A[2 * j + 1] + Bc[2 * j + 1];
                    if (OUT8) { u32x2 o; o.x = pk_fp8x4(y0.x * F8_HS, y0.y * F8_HS, y0.z * F8_HS, y0.w * F8_HS); o.y = pk_fp8x4(y1.x * F8_HS, y1.y * F8_HS, y1.z * F8_HS, y1.w * F8_HS); *(u32x2*)(hr8 + 512 * j) = o; }
                    else { u32x4 o; o.x = cvtpk(y0.x, y0.y); o.y = cvtpk(y0.z, y0.w); o.z = cvtpk(y1.x, y1.y); o.w = cvtpk(y1.z, y1.w);
                    *(u32x4*)(hr + 512 * j) = o; } } }
        }
    }
}

__device__ __forceinline__ void phase_fold_wq(const P& p, LAS unsigned char* lds, int tid, int lane, int wid) {
    unsigned char* ws = p.ws; const float* mod = (const float*)(ws + WS_MOD);
    for (long i = (long)blockIdx.x * 512 + tid; i < 2 * 2 * 2048; i += (long)gridDim.x * 512) { const int l = (int)(i >> 12), b = (int)(i >> 11) & 1, c = (int)(i & 2047);
        float* ab = (float*)(ws + WS_ABT) + (size_t)(l * 2 + b) * 4096;
        ab[c] = p.norm_g[(l * 2 + 1) * 2048 + c] * (1.0f + mod[(size_t)(l * 2 + b) * 12288 + 4 * 2048 + c]); ab[2048 + c] = mod[(size_t)(l * 2 + b) * 12288 + 3 * 2048 + c]; }
    LAS float* scr = (LAS float*)(lds + wid * 8448);
    const int gw = blockIdx.x * 8 + wid, ngw = gridDim.x * 8;
    for (int it = gw; it < 2 * 2048; it += ngw) {
        const int l = it >> 11, item = it & 2047, kb = item >> 6, nb = item & 63, k0 = 64 * kb, n0 = 32 * nb;
        const float* W = p.peer_wq + (size_t)l * 2048 * 2048;
#pragma unroll 8
        for (int i = 0; i < 32; ++i) { const int kk = 2 * i + (lane >> 5); scr[kk * 33 + (lane & 31)] = W[(size_t)(k0 + kk) * 2048 + n0 + (lane & 31)]; }
        LDS_WAIT(); asm volatile("" ::: "memory");
        const int c = lane & 7;
#pragma unroll
        for (int b = 0; b < 2; ++b) {
            const float* mb = mod + (size_t)(l * 2 + b) * 12288; const float* ng = p.norm_g + (l * 2 + 1) * 2048;
            float A[8];
#pragma unroll
            for (int t = 0; t < 8; ++t) A[t] = ng[k0 + 8 * c + t] * (1.0f + mb[4 * 2048 + k0 + 8 * c + t]);
            unsigned char* WT = ws + WS_WQF + (size_t)(l * 2 + b) * 2048 * 2048;
#pragma unroll
            for (int t = 0; t < 8; ++t) A[t] *= F8_WS;
#pragma unroll
            for (int j = 0; j < 4; ++j) { const int n = (lane >> 3) + 8 * j; const LAS float* s = scr + (8 * c) * 33 + n;
                u32x2 o; o.x = pk_fp8x4(s[0 * 33] * A[0], s[1 * 33] * A[1], s[2 * 33] * A[2], s[3 * 33] * A[3]); o.y = pk_fp8x4(s[4 * 33] * A[4], s[5 * 33] * A[5], s[6 * 33] * A[6], s[7 * 33] * A[7]);
                *(u32x2*)(WT + (size_t)(n0 + n) * 2048 + k0 + 8 * c) = o; }
            { const int n = lane & 31, kh = lane >> 5; float acc = 0.f;
#pragma unroll 8
              for (int t = 0; t < 32; ++t) acc += scr[(32 * kh + t) * 33 + n] * mb[3 * 2048 + k0 + 32 * kh + t];
              acc += __shfl_xor(acc, 32);
              if (lane < 32) ((float*)(ws + WS_BIASP))[((size_t)(l * 2 + b) * 32 + kb) * 2048 + n0 + n] = acc; }
        }
        LDS_WAIT(); asm volatile("" ::: "memory");
    }
}

__device__ __forceinline__ void phase_bias_reduce(const P& p, int tid) {
    for (long i = (long)blockIdx.x * 512 + tid; i < 2 * 2 * 2048; i += (long)gridDim.x * 512) { const int lb = (int)(i >> 11), n = (int)(i & 2047); float acc = 0.f;
#pragma unroll 8
        for (int kb = 0; kb < 32; ++kb) acc += ((const float*)(p.ws + WS_BIASP))[((size_t)lb * 32 + kb) * 2048 + n];
        ((float*)(p.ws + WS_BIASQ))[i] = acc; }
}
__device__ __forceinline__ void phase_qkprep(const P& p, int gw, int ngw, int lane) {
    bf16_t* Q = (bf16_t*)(p.ws + WS_Q); bf16_t* K = (bf16_t*)(p.ws + WS_K);
    const int sub = lane >> 4, ll = lane & 15;
    float inv[4], gq[8], gk[8];
#pragma unroll
    for (int e = 0; e < 4; ++e) inv[e] = __builtin_amdgcn_exp2f(-(float)((4 * ll + e) & 31) * 0.41524101186092029f);
#pragma unroll
    for (int e = 0; e < 8; ++e) { gq[e] = p.q_g[8 * ll + e]; gk[e] = p.k_g[8 * ll + e]; }
#pragma unroll 2
    for (int it = gw; it < NTOK * 10 / 4; it += ngw) {
        const int hr = 4 * it + sub, token = hr / 10, hh = hr - token * 10;
        u32x4* ptr = hh < 8 ? (u32x4*)(Q + (size_t)token * 1024 + hh * 128 + 8 * ll) : (u32x4*)(K + (size_t)token * 256 + (hh - 8) * 128 + 8 * ll);
        const u32x4 w = *ptr;
        float x[8] = {bflo(w.x), bfhi(w.x), bflo(w.y), bfhi(w.y), bflo(w.z), bfhi(w.z), bflo(w.w), bfhi(w.w)};
        float ss = 0.f;
#pragma unroll
        for (int e = 0; e < 8; ++e) ss += x[e] * x[e];
        ss = row16_sum(ss);
        const float r = rsqrtf(ss * (1.0f / 128.0f) + 1e-6f);
        const int s = token & 8191; const float pos = (float)(ll < 8 ? (s >> 6) : (s & 63));
        unsigned o[4];
#pragma unroll
        for (int e = 0; e < 4; ++e) { const float x1 = x[2 * e] * r * (hh < 8 ? gq[2 * e] : gk[2 * e]), x2 = x[2 * e + 1] * r * (hh < 8 ? gq[2 * e + 1] : gk[2 * e + 1]);
            float sn, cs; sincos_rad(pos * inv[e], sn, cs); o[e] = cvtpk(x1 * cs - x2 * sn, x1 * sn + x2 * cs); }
        *ptr = (u32x4){o[0], o[1], o[2], o[3]};
    }
}

__device__ __forceinline__ void phase_s5scan(const P& p, LAS unsigned char* lds, int lane, int wid) {
    const f32x2* A16 = (const f32x2*)(p.ws + WS_S5A);
    LAS f32x2* agg = (LAS f32x2*)lds;
    for (int item = blockIdx.x; item < 256; item += gridDim.x) {
        const int b = item >> 7, g = (item >> 1) & 63, d = item & 1;
        const f32x2 a = A16[(d * 64 + g) * 64 + lane];
        const float* S = (const float*)(p.ws + WS_SS) + ((size_t)g * 1024 + b * 512) * 256 + d * 128 + 2 * lane;
        bf16_t* HIN = (bf16_t*)(p.ws + WS_AB) + ((size_t)g * 1024 + b * 512) * 512 + 256 + d * 128 + 2 * lane;
        const int sA = 2 * wid + (d ? 1 : 0), sB = 2 * wid + (d ? 0 : 1), ordA = d ? 15 - sA : sA;
        float ar = 0.f, ai = 0.f, br = 0.f, bi = 0.f;
#pragma unroll 16
        for (int k = 0; k < 32; ++k) { const int o = d ? 31 - k : k; const f32x2 va = *(const f32x2*)(S + (size_t)(32 * sA + o) * 256), vb = *(const f32x2*)(S + (size_t)(32 * sB + o) * 256);
            const float nar = a.x * ar - a.y * ai + va.x, nai = a.x * ai + a.y * ar + va.y, nbr = a.x * br - a.y * bi + vb.x, nbi = a.x * bi + a.y * br + vb.y; ar = nar; ai = nai; br = nbr; bi = nbi; }
        __syncthreads();
        agg[ordA * 64 + lane] = (f32x2){ar, ai}; agg[(ordA + 1) * 64 + lane] = (f32x2){br, bi};
        __syncthreads();
        float pr = a.x, pi = a.y;
#pragma unroll
        for (int q = 0; q < 5; ++q) { const float nr = pr * pr - pi * pi, ni = 2.f * pr * pi; pr = nr; pi = ni; }
        float cr = 0.f, ci = 0.f;
        for (int s2 = 0; s2 < ordA; ++s2) { const f32x2 v = agg[s2 * 64 + lane]; const float nr = pr * cr - pi * ci + v.x, ni = pr * ci + pi * cr + v.y; cr = nr; ci = ni; }
        const float dr = pr * cr - pi * ci + ar, di = pr * ci + pi * cr + ai;
        ar = cr; ai = ci; br = dr; bi = di;
#pragma unroll 16
        for (int k = 0; k < 32; ++k) { const int o = d ? 31 - k : k; const size_t ca = (size_t)(32 * sA + o), cb = (size_t)(32 * sB + o);
            *(unsigned*)(HIN + ca * 512) = cvtpk(ar, ai); *(unsigned*)(HIN + cb * 512) = cvtpk(br, bi);
            const f32x2 va = *(const f32x2*)(S + ca * 256), vb = *(const f32x2*)(S + cb * 256);
            const float nar = a.x * ar - a.y * ai + va.x, nai = a.x * ai + a.y * ar + va.y, nbr = a.x * br - a.y * bi + vb.x, nbi = a.x * bi + a.y * br + vb.y; ar = nar; ai = nai; br = nbr; bi = nbi; }
    }
}

__device__ __forceinline__ void phase_attn(const P& p, char* lds) {
    const bf16_t* Q = (const bf16_t*)(p.ws + WS_Q); const bf16_t* K = (const bf16_t*)(p.ws + WS_K); const bf16_t* V = (const bf16_t*)(p.ws + WS_V);
    unsigned char* CAT = p.ws + WS_CAT;
    const int G = gridDim.x, bx = blockIdx.x, vcu = (G % 8 == 0) ? (bx % 8) * (G / 8) + bx / 8 : bx;
    for (int unit = vcu; unit < 512; unit += G) {
        const int bk = unit >> 7, rem = unit & 127, b = bk >> 1, kvh = bk & 1, h = kvh * 4 + (rem >> 5), qb = rem & 31;
        attn::attn_dense_body<attn::bf16>((const attn::bf16*)(Q + (size_t)(b * 8192 + qb * 256) * 1024 + h * 128),
                                          (const attn::bf16*)(K + (size_t)(b * 8192) * 256 + kvh * 128), (const attn::bf16*)(V + (size_t)(b * 8192) * 256 + kvh * 128),
                                          CAT + (size_t)(b * 8192 + qb * 256) * 2048 + 1024 + h * 128, 8192, lds);
        __syncthreads();
    }
}

constexpr int SGU_VS = 136;
constexpr int SGU_HB = 71680;
constexpr int SGU_VNT = 0, SGU_STG = 128 * SGU_VS * 2, SGU_STAT = 2 * 128 * SGU_VS * 2, SGU_BS = SGU_STAT + 1024;
static_assert(SGU_BS + 512 <= SGU_HB && 2 * SGU_HB <= LDS_BYTES - 64 && SGU_HB % 16 == 0, "SGU LDS map");
__device__ __forceinline__ void phase_sgu(const P& p, LAS unsigned char* lds, int tid, int lane, int wid) {
    const int hb = wid >> 2, w4 = wid & 3, t256 = tid & 255;
    LAS unsigned char* base = lds + hb * SGU_HB;
    LAS bf16_t* vnT = (LAS bf16_t*)(base + SGU_VNT);
    LAS bf16_t* stg = (LAS bf16_t*)(base + SGU_STG);
    LAS f32x2* stats = (LAS f32x2*)(base + SGU_STAT);
    LAS float* bs = (LAS float*)(base + SGU_BS);
    const bf16_t* Z = (const bf16_t*)(p.ws + WS_Z); unsigned char* SG = p.ws + WS_SG;
    const bf16_t* Wsb = (const bf16_t*)(p.ws + WS_WSB);
    const int fr = lane & 15, fq = lane >> 4, wi = w4 & 1, wc = w4 >> 1, i0 = 64 * wi, c0 = 64 * wc;
    for (int up = blockIdx.x; up < 512; up += gridDim.x) {
        const int unit = 2 * up + hb, n = unit >> 3, g = unit & 7;
        __syncthreads();
        if (t256 < 128) { const f32x2* part = (const f32x2*)(p.ws + WS_LNST) + (size_t)(2 * g * 4) * NTOK + (n * 128 + t256); float s1 = 0.f, s2 = 0.f;
#pragma unroll
            for (int q = 0; q < 8; ++q) { const f32x2 a2 = part[(size_t)q * NTOK]; s1 += a2.x; s2 += a2.y; }
            const float mean = s1 * (1.0f / 512.0f), var = fmaxf(s2 * (1.0f / 512.0f) - mean * mean, 0.f); stats[t256] = (f32x2){mean, rsqrtf(var + 1e-6f)};
            bs[t256] = p.sgu_b[g * 128 + t256]; }
        bf16x8 Af[4][4];
#pragma unroll
        for (int m = 0; m < 4; ++m)
#pragma unroll
            for (int ks = 0; ks < 4; ++ks) Af[m][ks] = *(const bf16x8*)(Wsb + (size_t)(g * 128 + i0 + 16 * m + fr) * 128 + 32 * ks + 8 * fq);
#pragma unroll 1
        for (int qt = 0; qt < 4; ++qt) {
            const int chb = g * 512 + qt * 128;
            __syncthreads();
            { u32x4 T[8];
#pragma unroll
              for (int q = 0; q < 8; ++q) { const int pc = t256 + 256 * q, j = pc >> 4, ch = (pc & 15) * 8; T[q] = *(const u32x4*)(Z + ((size_t)(n * 16 + 8 + g) * 128 + j) * 512 + qt * 128 + ch); }
#pragma unroll
              for (int q = 0; q < 8; ++q) { const int pc = t256 + 256 * q, j = pc >> 4, ch = (pc & 15) * 8; *(LAS u32x4*)(stg + j * SGU_VS + ch) = T[q]; } }
            __syncthreads();
#pragma unroll 1
            for (int slab = 0; slab < 2; ++slab) {
                const int cc = slab * 64 + lane; const float lng = p.sgu_ln_g[chb + cc];
                const int cl = cc & 63, rp = (cc & ~63) + ((cl >> 2) & 3) * 16 + (cl >> 4) * 4 + (cl & 3);
#pragma unroll
                for (int jg = 0; jg < 4; ++jg) {
                    const int j0 = 32 * w4 + 8 * jg; float y[8];
#pragma unroll
                    for (int k = 0; k < 8; ++k) { const float xv = bflo((unsigned)stg[(j0 + k) * SGU_VS + cc]); const f32x2 st = stats[j0 + k]; y[k] = (xv - st.x) * st.y * lng; }
                    u32x4 o; o.x = cvtpk(y[0], y[1]); o.y = cvtpk(y[2], y[3]); o.z = cvtpk(y[4], y[5]); o.w = cvtpk(y[6], y[7]);
                    *(LAS u32x4*)(vnT + rp * SGU_VS + j0) = o;
                }
            }
            __syncthreads();
#pragma unroll 1
            for (int np = 0; np < 2; ++np) {
                u32x4 U[4];
#pragma unroll
                for (int m = 0; m < 4; ++m) U[m] = *(const u32x4*)(Z + ((size_t)(n * 16 + g) * 128 + i0 + 16 * m + fr) * 512 + qt * 128 + c0 + 16 * fq + 8 * np);
                f32x4 acc[4][2];
#pragma unroll
                for (int m = 0; m < 4; ++m)
#pragma unroll
                    for (int nn = 0; nn < 2; ++nn) acc[m][nn] = (f32x4){0.f, 0.f, 0.f, 0.f};
#pragma unroll
                for (int ks = 0; ks < 4; ++ks) {
                    bf16x8 Bf[2];
#pragma unroll
                    for (int nn = 0; nn < 2; ++nn) Bf[nn] = *(const LAS bf16x8*)(vnT + (c0 + 16 * (2 * np + nn) + fr) * SGU_VS + 32 * ks + 8 * fq);
#pragma unroll
                    for (int m = 0; m < 4; ++m)
#pragma unroll
                        for (int nn = 0; nn < 2; ++nn) acc[m][nn] = __builtin_amdgcn_mfma_f32_16x16x32_bf16(Bf[nn], Af[m][ks], acc[m][nn], 0, 0, 0);
                }
#pragma unroll
                for (int m = 0; m < 4; ++m) { const int i = i0 + 16 * m + fr; const float bi = bs[i]; const size_t tok = (size_t)(n * 128 + i);
                    const int cch = chb + c0 + 16 * fq + 8 * np;
                    const u32x4 u0 = U[m];
                    const f32x4 s0 = acc[m][0] + bi, s1 = acc[m][1] + bi;
                    u32x2 o;
                    o.x = pk_fp8x4(bflo(u0.x) * s0.x * F8_SGS, bfhi(u0.x) * s0.y * F8_SGS, bflo(u0.y) * s0.z * F8_SGS, bfhi(u0.y) * s0.w * F8_SGS);
                    o.y = pk_fp8x4(bflo(u0.z) * s1.x * F8_SGS, bfhi(u0.z) * s1.y * F8_SGS, bflo(u0.w) * s1.z * F8_SGS, bfhi(u0.w) * s1.w * F8_SGS);
                    *(u32x2*)(SG + tok * 4096 + cch) = o; }
            }
        }
    }
}
#define XB_TMO      128
#define XB_XCNT(j)  (256  + 64 * (j))
#define XB_XSUB(j)  (1280 + 64 * (j))
#define XB_XGEN(j)  (2304 + 64 * (j))
#define XB_TOP      3328
#define XB_TOPGEN   3392
#define XCD_BAR_WORDS 3456
#define XB_SPIN_CAP (1u << 22)

__device__ __forceinline__ unsigned xb_ld(unsigned* p)              { return __hip_atomic_load(p, __ATOMIC_RELAXED, __HIP_MEMORY_SCOPE_AGENT); }
__device__ __forceinline__ unsigned xb_add(unsigned* p, unsigned v) { return __hip_atomic_fetch_add(p, v, __ATOMIC_RELAXED, __HIP_MEMORY_SCOPE_AGENT); }
__device__ __forceinline__ unsigned xb_xcc_id() { return (unsigned)__builtin_amdgcn_s_getreg((3 << 11) | 20) & 0xFu; }
#define XB_SPIN(cond, bar) do { unsigned _sp = 0; while (cond) { __builtin_amdgcn_s_sleep(1); \
    if ((++_sp & 255u) == 0u) { if (xb_ld(&(bar)[XB_TMO])) break; if (_sp > XB_SPIN_CAP) { atomicAdd(&(bar)[XB_TMO], 1u); break; } } } } while (0)

struct XcdBarrier {
    unsigned* bar; unsigned x;
    volatile LAS unsigned* st;
};

__device__ __forceinline__ XcdBarrier xcd_barrier_post(unsigned* bar, volatile LAS unsigned* st) {
    XcdBarrier b; b.bar = bar; b.x = xb_xcc_id(); b.st = st;
    if (threadIdx.x == 0) st[2] = xb_add(&bar[XB_XCNT(b.x)], 1u);
    return b;
}
__device__ __forceinline__ void xcd_barrier_complete(unsigned* bar, unsigned x, unsigned& nloc, unsigned& nx) {
    const unsigned G = gridDim.x * gridDim.y * gridDim.z;
    unsigned sum, cnt, mine, sp = 0u;
    for (;;) {
        sum = 0u; cnt = 0u; mine = 0u;
#pragma unroll
        for (unsigned j = 0; j < 16; ++j) { const unsigned c = xb_ld(&bar[XB_XCNT(j)]); sum += c; cnt += (c > 0u) ? 1u : 0u; mine = (j == x) ? c : mine; }
        if (sum == G) break;
        __builtin_amdgcn_s_sleep(1);
        if ((++sp & 255u) == 0u) { if (xb_ld(&bar[XB_TMO])) break; if (sp > XB_SPIN_CAP) { atomicAdd(&bar[XB_TMO], 1u); break; } }
    }
    nloc = mine > 0u ? mine : 1u; nx = cnt > 0u ? cnt : 1u;
}

__device__ __forceinline__ void xcd_barrier(const XcdBarrier& b) {
    asm volatile("s_waitcnt vmcnt(0)" ::: "memory");
    __syncthreads();
    if (threadIdx.x == 0) {
        unsigned* bar = b.bar;
        __builtin_amdgcn_s_waitcnt(0);
        unsigned nloc = b.st[0], nx = b.st[1];
        if (nloc == 0u) { xcd_barrier_complete(bar, b.x, nloc, nx); b.st[0] = nloc; b.st[1] = nx; }
        const unsigned old = xb_add(&bar[XB_XSUB(b.x)], 1u);
        const unsigned gen = old / nloc;
        if (old + 1u == (gen + 1u) * nloc) {
            __builtin_amdgcn_fence(__ATOMIC_RELEASE, "agent");
            asm volatile("s_waitcnt vmcnt(0)" ::: "memory");
            const unsigned og = xb_add(&bar[XB_TOP], 1u);
            const unsigned tg = og / nx;
            if (og + 1u == (tg + 1u) * nx) xb_add(&bar[XB_TOPGEN], 1u);
            else XB_SPIN(xb_ld(&bar[XB_TOPGEN]) == tg, bar);
            __builtin_amdgcn_fence(__ATOMIC_ACQUIRE, "agent");
            xb_add(&bar[XB_XGEN(b.x)], 1u);
            asm volatile("s_waitcnt vmcnt(0)" ::: "memory");
        } else {
            XB_SPIN(xb_ld(&bar[XB_XGEN(b.x)]) == gen, bar);
            __builtin_amdgcn_fence(__ATOMIC_ACQUIRE, "agent");
            asm volatile("s_waitcnt vmcnt(0)" ::: "memory");
        }
    }
    __syncthreads();
}

__device__ __forceinline__ void ce_desc(float& a, float& b) { const float mx = fmaxf(a, b), mn = fminf(a, b); a = mx; b = mn; }
__device__ __forceinline__ void bitonic_sort16_desc(float (&a)[16]) {
#pragma unroll
    for (int k = 2; k <= 16; k <<= 1)
#pragma unroll
        for (int j = k >> 1; j > 0; j >>= 1)
#pragma unroll
            for (int i = 0; i < 16; ++i) { const int l = i ^ j; if (l > i) { if ((i & k) == 0) ce_desc(a[i], a[l]); else ce_desc(a[l], a[i]); } }
}
__device__ __forceinline__ void merge_top16(float (&V)[16], const float (&S)[16]) {
#pragma unroll
    for (int i = 0; i < 16; ++i) V[i] = fmaxf(V[i], S[15 - i]);
#pragma unroll
    for (int j = 8; j > 0; j >>= 1)
#pragma unroll
        for (int i = 0; i < 16; ++i) { const int l = i ^ j; if (l > i) ce_desc(V[i], V[l]); }
}
__device__ __forceinline__ float with_payload(float v, unsigned mask, unsigned pay) { return __uint_as_float((__float_as_uint(v) & ~mask) | pay); }

__device__ __forceinline__ void peer_topk_half(const bf16_t* qrow, const bf16_t* keys, int r32, int hi, float (&V)[16]) {
    bf16x8 qf[8];
#pragma unroll
    for (int ks = 0; ks < 8; ++ks) qf[ks] = *(const bf16x8*)(qrow + 16 * ks + 8 * hi);
#pragma unroll
    for (int k = 0; k < 16; ++k) V[k] = -INFINITY;
#pragma unroll 1
    for (int t = 0; t < 4; ++t) {
        f32x16 s = (f32x16){0.f, 0.f, 0.f, 0.f, 0.f, 0.f, 0.f, 0.f, 0.f, 0.f, 0.f, 0.f, 0.f, 0.f, 0.f, 0.f};
#pragma unroll
        for (int ks = 0; ks < 8; ++ks) { const bf16x8 kf = *(const bf16x8*)(keys + (size_t)(t * 32 + r32) * 128 + 16 * ks + 8 * hi);
            s = __builtin_amdgcn_mfma_f32_32x32x16_bf16(kf, qf[ks], s, 0, 0, 0); }
        float S[16];
#pragma unroll
        for (int r = 0; r < 16; ++r) S[r] = with_payload(s[r], 0x7Fu, (unsigned)(t * 32 + (r & 3) + 8 * (r >> 2) + 4 * hi));
        bitonic_sort16_desc(S); merge_top16(V, S);
    }
    float PVv[16];
#pragma unroll
    for (int k = 0; k < 16; ++k) { const auto r = __builtin_amdgcn_permlane32_swap(__float_as_uint(V[k]), __float_as_uint(V[k]), false, false); PVv[k] = (hi ? __uint_as_float(r[0]) : __uint_as_float(r[1])); }
    merge_top16(V, PVv);
}

__device__ __forceinline__ void phase_peer_s1(const P& p, int layer, LAS unsigned char* lds, int lane, int wid) {
    LAS int* idxL = (LAS int*)(lds + 65536 + wid * 8192);
    const bf16_t* QP = (const bf16_t*)(p.ws + WS_QP);
    const bf16_t* keys = (const bf16_t*)(p.ws + WS_KEYS) + (size_t)layer * 2 * 16384;
    const float* rowsq = (const float*)(p.ws + WS_ROWSQ) + (size_t)layer * 32 * NTOK; float* RSTD = (float*)(p.ws + WS_RSTD);
    int* EID = (int*)(p.ws + WS_EID); float* GATE = (float*)(p.ws + WS_GATE);
    const int r32 = lane & 31, hi = lane >> 5, gw = blockIdx.x * 8 + wid, ngw = gridDim.x * 8;
#pragma unroll 1
    for (int tq = gw; tq < NTOK / 4; tq += ngw) {
        {
            const bf16_t* qrow = QP + (size_t)(4 * tq + (r32 >> 3)) * 2048 + (r32 & 7) * 256;
            float v1[16], v2[16];
            peer_topk_half(qrow, keys, r32, hi, v1);
            peer_topk_half(qrow + 128, keys + 16384, r32, hi, v2);
#pragma unroll
            for (int k = 0; k < 16; ++k) { idxL[k * 64 + lane] = (int)(__float_as_uint(v1[k]) & 0x7Fu); idxL[(16 + k) * 64 + lane] = (int)(__float_as_uint(v2[k]) & 0x7Fu); }
            float SC[16], S2[16];
#pragma unroll
            for (int b2 = 0; b2 < 16; ++b2) SC[b2] = with_payload(v1[0] + v2[b2], 0xFFu, (unsigned)b2);
#pragma unroll
            for (int a = 1; a <= 4; ++a) {
#pragma unroll
                for (int b2 = 0; b2 < 16; ++b2) S2[b2] = ((a + 1) * (b2 + 1) <= 16) ? with_payload(v1[a] + v2[b2], 0xFFu, (unsigned)(a * 16 + b2)) : -INFINITY;
                merge_top16(SC, S2); }
#pragma unroll
            for (int a = 5; a <= 7; ++a) { S2[2 * (a - 5)] = with_payload(v1[a] + v2[0], 0xFFu, (unsigned)(a * 16)); S2[2 * (a - 5) + 1] = with_payload(v1[a] + v2[1], 0xFFu, (unsigned)(a * 16 + 1)); }
#pragma unroll
            for (int a = 8; a <= 15; ++a) S2[6 + (a - 8)] = with_payload(v1[a] + v2[0], 0xFFu, (unsigned)(a * 16));
            S2[14] = -INFINITY; S2[15] = -INFINITY;
            bitonic_sort16_desc(S2); merge_top16(SC, S2);
            float e[16], sum = 0.f;
#pragma unroll
            for (int k = 0; k < 16; ++k) { e[k] = __expf(SC[k] - SC[0]); sum += e[k]; }
            const float inv = 1.0f / sum;
            if (hi == 0) {
                u32x4 iw[4]; f32x4 gv[4];
#pragma unroll
                for (int k = 0; k < 16; ++k) { const unsigned pay = __float_as_uint(SC[k]) & 0xFFu;
                    iw[k >> 2][k & 3] = (unsigned)(idxL[(pay >> 4) * 64 + lane] * 128 + idxL[(16 + (pay & 15)) * 64 + lane]); gv[k >> 2][k & 3] = e[k] * inv; }
                const size_t gbase = (size_t)(4 * tq + (r32 >> 3)) * 128 + (r32 & 7) * 16;
#pragma unroll
                for (int k4 = 0; k4 < 4; ++k4) { *(u32x4*)(EID + gbase + 4 * k4) = iw[k4]; *(f32x4*)(GATE + gbase + 4 * k4) = gv[k4]; } }
        }
        {
            const int token = 4 * tq + (lane >> 4), w = lane & 15;
            const float sq = row16_sum(rowsq[(size_t)w * NTOK + token] + rowsq[(size_t)(w + 16) * NTOK + token]);
            if (w == 0) RSTD[token] = rsqrtf(sq * (1.0f / 2048.0f) + 1e-6f); }
    }
}

__device__ __forceinline__ float dot2bf(unsigned a, unsigned b, float acc) { return __builtin_amdgcn_fdot2_f32_bf16(__builtin_bit_cast(bf16x2v, a), __builtin_bit_cast(bf16x2v, b), acc, false); }
__device__ __forceinline__ void peer_partition(const P& p, int myrank, int& part, int& rank, int& nwg) {
    unsigned* bar = (unsigned*)(p.ws + WS_BAR); const unsigned x = xb_xcc_id(); unsigned mine = 0u; bool ok = true;
#pragma unroll
    for (unsigned j = 0; j < 16; ++j) { const unsigned cj = xb_ld(&bar[XB_XCNT(j)]); ok = ok && ((j < 8u) ? (cj > 0u) : (cj == 0u)); mine = (j == x) ? cj : mine; }
    if (ok) { part = (int)x; rank = myrank; nwg = (int)mine; } else { part = (int)blockIdx.x & 7; rank = (int)blockIdx.x >> 3; nwg = (int)gridDim.x >> 3; }
    part = __builtin_amdgcn_readfirstlane(part); rank = __builtin_amdgcn_readfirstlane(rank); nwg = __builtin_amdgcn_readfirstlane(nwg);
}
__device__ __forceinline__ void phase_peer_u(const P& p, int layer, LAS unsigned char* lds, int lane, int wid, int myrank) {
    LAS unsigned char* wl = lds + wid * 16384;
    int part, rank, nwg; peer_partition(p, myrank, part, rank, nwg);
    const unsigned char* PUS = p.ws + WS_PU + (size_t)layer * 16384 * PEER_ROWB + (size_t)part * 16384 * 192;
    const int* EID = (const int*)(p.ws + WS_EID);
    const unsigned char* HB = p.ws + WS_XB + 512 * part;
    const float* RSTD = (const float*)(p.ws + WS_RSTD);
    const float* ABs = (const float*)(p.ws + WS_ABT) + (size_t)layer * 2 * 4096 + 256 * part + 4 * lane;
    float* PACT = (float*)(p.ws + WS_PACT) + (size_t)part * NTOK * 128;
    const int g = lane >> 2, s = lane & 3, nb = NTOK / 8, stride = nwg * 8;
    int tb = rank * 8 + wid;
    if (tb >= nb) return;
    int e0[8], e1[8]; u32x2 hs[8]; float rs[8]; f32x4 Av, Bv;
#define PB_LOAD(TB) { _Pragma("unroll") for (int j = 0; j < 8; ++j) { const size_t t = (size_t)(TB) * 8 + j; e0[j] = EID[t * 128 + lane]; e1[j] = EID[t * 128 + 64 + lane]; hs[j] = *(const u32x2*)(HB + t * 4096 + 8 * lane); rs[j] = RSTD[t]; } \
        Av = *(const f32x4*)(ABs + ((TB) >> 10) * 4096); Bv = *(const f32x4*)(ABs + ((TB) >> 10) * 4096 + 2048); }
#define PB_STORE(BUF) _Pragma("unroll") for (int j = 0; j < 8; ++j) { LAS int* il = (LAS int*)(wl + (BUF) * 8192); il[j * 128 + lane] = e0[j]; il[j * 128 + 64 + lane] = e1[j]; \
        u32x2 hw; hw.x = cvtpk(bflo(hs[j].x) * rs[j] * Av.x + Bv.x, bfhi(hs[j].x) * rs[j] * Av.y + Bv.y); hw.y = cvtpk(bflo(hs[j].y) * rs[j] * Av.z + Bv.z, bfhi(hs[j].y) * rs[j] * Av.w + Bv.w); \
        *(LAS u32x2*)(wl + (BUF) * 8192 + 4096 + j * 512 + 8 * lane) = hw; }
#define PR_LOAD(SLOT, ID) { const unsigned char* ur = PUS + (size_t)(ID) * 192 + 48 * s; R[SLOT][0] = *(const u32x4*)ur; R[SLOT][1] = *(const u32x4*)(ur + 16); R[SLOT][2] = *(const u32x4*)(ur + 32); }
    PB_LOAD(tb) PB_STORE(0)
    u32x4 R[8][3];
    { LAS int* il = (LAS int*)wl;
#pragma unroll
      for (int q = 0; q < 8; ++q) { const int id = il[16 * q + g]; PR_LOAD(q, id) } }
    int bi = 0;
#pragma unroll 1
    for (; tb < nb; tb += stride, bi ^= 1) {
        { const int tbn = tb + stride < nb ? tb + stride : tb; PB_LOAD(tbn) }
#pragma unroll 1
        for (int j = 0; j < 8; ++j) {
            if (j == 7) { PB_STORE(bi ^ 1) }
            LAS int* nid = (j < 7) ? (LAS int*)(wl + bi * 8192) + (j + 1) * 128 : (LAS int*)(wl + (bi ^ 1) * 8192);
            LAS u32x4* hp = (LAS u32x4*)(wl + bi * 8192 + 4096 + j * 512 + s * 128);
            const u32x4 h0 = hp[0], h1 = hp[1], h2 = hp[2], h3 = hp[3], h4 = hp[4], h5 = hp[5], h6 = hp[6], h7 = hp[7];
            float acc[8];
#pragma unroll
            for (int it = 0; it < 8; ++it) {
                const u32x16 dw = __builtin_bit_cast(u32x16, __builtin_amdgcn_cvt_scalef32_pk32_bf16_fp6((u32x6){R[it][0].x, R[it][0].y, R[it][0].z, R[it][0].w, R[it][1].x, R[it][1].y}, 1.0f));
                const u32x16 dx = __builtin_bit_cast(u32x16, __builtin_amdgcn_cvt_scalef32_pk32_bf16_fp6((u32x6){R[it][1].z, R[it][1].w, R[it][2].x, R[it][2].y, R[it][2].z, R[it][2].w}, 1.0f));
                { const int idn = nid[16 * it + g]; PR_LOAD(it, idn) }
                float a0 = 0.f, a1 = 0.f;
                a0 = dot2bf(dw[0], h0.x, a0); a1 = dot2bf(dw[1], h0.y, a1); a0 = dot2bf(dw[2], h0.z, a0); a1 = dot2bf(dw[3], h0.w, a1);
                a0 = dot2bf(dw[4], h1.x, a0); a1 = dot2bf(dw[5], h1.y, a1); a0 = dot2bf(dw[6], h1.z, a0); a1 = dot2bf(dw[7], h1.w, a1);
                a0 = dot2bf(dw[8], h2.x, a0); a1 = dot2bf(dw[9], h2.y, a1); a0 = dot2bf(dw[10], h2.z, a0); a1 = dot2bf(dw[11], h2.w, a1);
                a0 = dot2bf(dw[12], h3.x, a0); a1 = dot2bf(dw[13], h3.y, a1); a0 = dot2bf(dw[14], h3.z, a0); a1 = dot2bf(dw[15], h3.w, a1);
                a0 = dot2bf(dx[0], h4.x, a0); a1 = dot2bf(dx[1], h4.y, a1); a0 = dot2bf(dx[2], h4.z, a0); a1 = dot2bf(dx[3], h4.w, a1);
                a0 = dot2bf(dx[4], h5.x, a0); a1 = dot2bf(dx[5], h5.y, a1); a0 = dot2bf(dx[6], h5.z, a0); a1 = dot2bf(dx[7], h5.w, a1);
                a0 = dot2bf(dx[8], h6.x, a0); a1 = dot2bf(dx[9], h6.y, a1); a0 = dot2bf(dx[10], h6.z, a0); a1 = dot2bf(dx[11], h6.w, a1);
                a0 = dot2bf(dx[12], h7.x, a0); a1 = dot2bf(dx[13], h7.y, a1); a0 = dot2bf(dx[14], h7.z, a0); a1 = dot2bf(dx[15], h7.w, a1);
                float v = a0 + a1;
                v += __uint_as_float(__builtin_amdgcn_update_dpp(0u, __float_as_uint(v), 0xB1, 0xF, 0xF, true));
                v += __uint_as_float(__builtin_amdgcn_update_dpp(0u, __float_as_uint(v), 0x4E, 0xF, 0xF, true));
                acc[it] = v;
            }
            if (s == 0) { float* pa = PACT + ((size_t)tb * 8 + j) * 128 + g;
#pragma unroll
                for (int it = 0; it < 8; ++it) pa[16 * it] = acc[it]; }
        }
    }
#undef PB_LOAD
#undef PB_STORE
#undef PR_LOAD
}

__device__ __forceinline__ void phase_peer_w(const P& p, int layer, int tid) {
    const int* EID = (const int*)(p.ws + WS_EID); const float* GATE = (const float*)(p.ws + WS_GATE); const float* PACT = (const float*)(p.ws + WS_PACT); float* PW = (float*)(p.ws + WS_PW);
    const float* PSU = (const float*)(p.ws + WS_PSC) + layer * 16384; const float* PSV = PSU + 2 * 16384;
#pragma unroll 2
    for (int i4 = (int)blockIdx.x * 512 + tid; i4 < NTOK * 128 / 4; i4 += (int)gridDim.x * 512) {
        const size_t i = (size_t)i4 * 4;
        const u32x4 id4 = *(const u32x4*)(EID + i); const f32x4 g4 = *(const f32x4*)(GATE + i);
        f32x4 a = (f32x4){0.f, 0.f, 0.f, 0.f};
#pragma unroll
        for (int x = 0; x < 8; ++x) a += *(const f32x4*)(PACT + (size_t)x * NTOK * 128 + i);
        f32x4 w;
#pragma unroll
        for (int e = 0; e < 4; ++e) { const int id = (int)id4[e]; w[e] = gelu_t(a[e] * PSU[id]) * g4[e] * PSV[id]; }
        *(f32x4*)(PW + i) = w;
    }
}

__device__ __forceinline__ void phase_peer_vs(const P& p, int layer, LAS unsigned char* lds, int lane, int wid, int myrank) {
    LAS unsigned char* wl = lds + wid * 16384;
    int part, rank, nwg; peer_partition(p, myrank, part, rank, nwg);
    const unsigned char* PVS = p.ws + WS_PV + (size_t)layer * 16384 * PEER_ROWB + (size_t)part * 16384 * 192;
    const int* EID = (const int*)(p.ws + WS_EID); const float* PW = (const float*)(p.ws + WS_PW);
    unsigned char* PO = p.ws + WS_PO + 512 * part;
    const int g = lane >> 3, s = lane & 7, nb = NTOK / 8, stride = nwg * 8;
    const bool b3 = (lane & 8) != 0;
    int tb = rank * 8 + wid;
    if (tb >= nb) return;
    int e0[8], e1[8]; float w0[8], w1[8];
#define PB_LOAD(TB) _Pragma("unroll") for (int j = 0; j < 8; ++j) { const size_t t = (size_t)(TB) * 8 + j; e0[j] = EID[t * 128 + lane]; e1[j] = EID[t * 128 + 64 + lane]; w0[j] = PW[t * 128 + lane]; w1[j] = PW[t * 128 + 64 + lane]; }
#define PB_STORE(BUF) _Pragma("unroll") for (int j = 0; j < 8; ++j) { LAS int* il = (LAS int*)(wl + (BUF) * 8192); LAS float* fl = (LAS float*)(wl + (BUF) * 8192 + 4096); il[j * 128 + lane] = e0[j]; il[j * 128 + 64 + lane] = e1[j]; fl[j * 128 + lane] = w0[j]; fl[j * 128 + 64 + lane] = w1[j]; }
#define PR_LOAD(SLOT, ID) { const unsigned char* vr = PVS + (size_t)(ID) * 192 + 24 * s; R[SLOT][0] = *(const u32x2*)vr; R[SLOT][1] = *(const u32x2*)(vr + 8); R[SLOT][2] = *(const u32x2*)(vr + 16); }
    PB_LOAD(tb) PB_STORE(0)
    u32x2 R[8][3];
    { LAS int* il = (LAS int*)wl;
#pragma unroll
      for (int q = 0; q < 8; ++q) { const int id = il[8 * q + g]; PR_LOAD(q, id) } }
    int bi = 0;
#pragma unroll 1
    for (; tb < nb; tb += stride, bi ^= 1) {
        { const int tbn = tb + stride < nb ? tb + stride : tb; PB_LOAD(tbn) }
#pragma unroll 1
        for (int j = 0; j < 8; ++j) {
            if (j == 7) { PB_STORE(bi ^ 1) }
            LAS int* ids = (LAS int*)(wl + bi * 8192) + j * 128;
            LAS int* nid = (j < 7) ? ids + 128 : (LAS int*)(wl + (bi ^ 1) * 8192);
            LAS float* wv = (LAS float*)(wl + bi * 8192 + 4096) + j * 128;
            h16x2 o2[16];
#pragma unroll
            for (int k = 0; k < 16; ++k) o2[k] = (h16x2){(_Float16)0.f, (_Float16)0.f};
#pragma unroll
            for (int it = 0; it < 16; ++it) {
                const int sl = it & 7;
                const h16x32 d = __builtin_amdgcn_cvt_scalef32_pk32_f16_fp6((u32x6){R[sl][0].x, R[sl][0].y, R[sl][1].x, R[sl][1].y, R[sl][2].x, R[sl][2].y}, 1.0f);
                { const int idn = (it < 8) ? ids[8 * (it + 8) + g] : nid[8 * (it - 8) + g]; PR_LOAD(sl, idn) }
                const _Float16 wh = (_Float16)wv[8 * it + g]; const h16x2 w2 = (h16x2){wh, wh};
#pragma unroll
                for (int k = 0; k < 16; ++k) o2[k] = __builtin_elementwise_fma(w2, (h16x2){d[2 * k], d[2 * k + 1]}, o2[k]);
            }
            h16x2 t8[8], t4[4]; float res[4];
#pragma unroll
            for (int k = 0; k < 8; ++k) { const auto r = __builtin_amdgcn_permlane32_swap(__builtin_bit_cast(unsigned, o2[k]), __builtin_bit_cast(unsigned, o2[8 + k]), false, false);
                unsigned ra = r[0], rb = r[1]; asm volatile("" : "+v"(ra), "+v"(rb)); t8[k] = __builtin_bit_cast(h16x2, ra) + __builtin_bit_cast(h16x2, rb); }
#pragma unroll
            for (int k = 0; k < 4; ++k) { const auto r = __builtin_amdgcn_permlane16_swap(__builtin_bit_cast(unsigned, t8[k]), __builtin_bit_cast(unsigned, t8[4 + k]), false, false);
                unsigned ra = r[0], rb = r[1]; asm volatile("" : "+v"(ra), "+v"(rb)); t4[k] = __builtin_bit_cast(h16x2, ra) + __builtin_bit_cast(h16x2, rb); }
#pragma unroll
            for (int k = 0; k < 2; ++k) { const unsigned lo = __builtin_bit_cast(unsigned, t4[k]), hi = __builtin_bit_cast(unsigned, t4[2 + k]); const unsigned mine = b3 ? hi : lo, send = b3 ? lo : hi;
                const h16x2 rr = __builtin_bit_cast(h16x2, mine) + __builtin_bit_cast(h16x2, (unsigned)__builtin_amdgcn_update_dpp(0u, send, 0x128, 0xF, 0xF, true));
                res[2 * k] = (float)rr.x; res[2 * k + 1] = (float)rr.y; }
            u32x2 ow; ow.x = cvtpk(res[0], res[1]); ow.y = cvtpk(res[2], res[3]);
            *(u32x2*)(PO + ((size_t)tb * 8 + j) * 4096 + 64 * s + 8 * g) = ow;
        }
    }
#undef PB_LOAD
#undef PB_STORE
#undef PR_LOAD
}

template <bool FINAL>
__device__ __forceinline__ void phase_peer_norm(const P& p, int layer, int lane, int wid) {
    bf16_t* XB = (bf16_t*)(p.ws + WS_XB);
    const bf16_t* PO = (const bf16_t*)(p.ws + WS_PO);
    const float* mod = (const float*)(p.ws + WS_MOD);
    float* X = p.out;
    const int gw = blockIdx.x * 8 + wid, ngw = gridDim.x * 8;
    u32x4 pw[4], xw[4];
#define PN_LOAD(T, PWV, XWV) { const bf16_t* por = PO + (size_t)(T) * 2048 + 16 * lane; const bf16_t* xbl = XB + (size_t)(T) * 2048 + 16 * lane; \
        _Pragma("unroll") for (int j = 0; j < 4; ++j) { PWV[j] = *(const u32x4*)(por + 1024 * (j >> 1) + 8 * (j & 1)); XWV[j] = *(const u32x4*)(xbl + 1024 * (j >> 1) + 8 * (j & 1)); } }
    if (gw < NTOK) PN_LOAD(gw, pw, xw)
    float G2[32], PA[32], PB[32]; int bcur = -1;
#pragma unroll 1
    for (int token = gw; token < NTOK; token += ngw) {
        const int b = token >> 13;
        if (b != bcur) { bcur = b;
            const float* g2 = mod + (size_t)(layer * 2 + b) * 12288 + 5 * 2048 + 16 * lane;
#pragma unroll
            for (int j = 0; j < 8; ++j) { const int off = 1024 * (j >> 2) + 4 * (j & 3); const f32x4 gg = *(const f32x4*)(g2 + off);
                G2[4 * j] = gg.x; G2[4 * j + 1] = gg.y; G2[4 * j + 2] = gg.z; G2[4 * j + 3] = gg.w;
                if (FINAL) { const f32x4 fg = *(const f32x4*)(p.final_g + 16 * lane + off); PA[4 * j] = fg.x; PA[4 * j + 1] = fg.y; PA[4 * j + 2] = fg.z; PA[4 * j + 3] = fg.w; PB[4 * j] = 0.f; PB[4 * j + 1] = 0.f; PB[4 * j + 2] = 0.f; PB[4 * j + 3] = 0.f; }
                else { const float* ng = p.norm_g + (size_t)((layer + 1) * 2 + 0) * 2048 + 16 * lane; const float* sh = mod + (size_t)((layer + 1) * 2 + b) * 12288 + 16 * lane; const float* sc = sh + 2048;
                    const f32x4 gv = *(const f32x4*)(ng + off), sv = *(const f32x4*)(sc + off), hv = *(const f32x4*)(sh + off);
#pragma unroll
                    for (int e = 0; e < 4; ++e) { PA[4 * j + e] = gv[e] * (1.0f + sv[e]) * F8_HS; PB[4 * j + e] = hv[e] * F8_HS; } } } }
        u32x4 pwn[4], xwn[4];
        { const int tn = token + ngw < NTOK ? token + ngw : token; PN_LOAD(tn, pwn, xwn) }
        float o[32];
#pragma unroll
        for (int j = 0; j < 4; ++j) { const u32x4 w = pw[j];
            o[8 * j + 0] = bflo(w.x); o[8 * j + 1] = bfhi(w.x); o[8 * j + 2] = bflo(w.y); o[8 * j + 3] = bfhi(w.y);
            o[8 * j + 4] = bflo(w.z); o[8 * j + 5] = bfhi(w.z); o[8 * j + 6] = bflo(w.w); o[8 * j + 7] = bfhi(w.w); }
        {
            bf16_t* xbr = XB + (size_t)token * 2048 + 16 * lane; float* xr = X + (size_t)token * 2048 + 16 * lane;
            float xn[32], ss = 0.f;
#pragma unroll
            for (int jh = 0; jh < 2; ++jh) { const u32x4 w0 = xw[2 * jh], w1 = xw[2 * jh + 1];
                const float xi[16] = {bflo(w0.x), bfhi(w0.x), bflo(w0.y), bfhi(w0.y), bflo(w0.z), bfhi(w0.z), bflo(w0.w), bfhi(w0.w), bflo(w1.x), bfhi(w1.x), bflo(w1.y), bfhi(w1.y), bflo(w1.z), bfhi(w1.z), bflo(w1.w), bfhi(w1.w)};
#pragma unroll
                for (int q = 0; q < 16; ++q) { const float t = xi[q] + G2[16 * jh + q] * o[16 * jh + q]; xn[16 * jh + q] = t; ss += t * t; } }
            ss = wave_sum(ss); const float rstd = rsqrtf(ss * (1.0f / 2048.0f) + 1e-6f);
            if (FINAL) {
#pragma unroll
                for (int j = 0; j < 8; ++j) { const int off = 1024 * (j >> 2) + 4 * (j & 3);
                    f32x4 y;
#pragma unroll
                    for (int e = 0; e < 4; ++e) y[e] = xn[4 * j + e] * rstd * PA[4 * j + e];
                    *(f32x4*)(xr + off) = y; }
            } else {
                unsigned char* hrow8 = p.ws + WS_H8 + (size_t)token * 2048 + 16 * lane;
#pragma unroll
                for (int jh = 0; jh < 2; ++jh) { float y[16];
#pragma unroll
                    for (int q = 0; q < 16; ++q) y[q] = xn[16 * jh + q] * rstd * PA[16 * jh + q] + PB[16 * jh + q];
#pragma unroll
                    for (int h2 = 0; h2 < 2; ++h2) { u32x4 xo4; xo4.x = cvtpk(xn[16 * jh + 8 * h2], xn[16 * jh + 8 * h2 + 1]); xo4.y = cvtpk(xn[16 * jh + 8 * h2 + 2], xn[16 * jh + 8 * h2 + 3]); xo4.z = cvtpk(xn[16 * jh + 8 * h2 + 4], xn[16 * jh + 8 * h2 + 5]); xo4.w = cvtpk(xn[16 * jh + 8 * h2 + 6], xn[16 * jh + 8 * h2 + 7]);
                        *(u32x4*)(xbr + 1024 * jh + 8 * h2) = xo4; }
                    u32x4 w; w.x = pk_fp8x4(y[0], y[1], y[2], y[3]); w.y = pk_fp8x4(y[4], y[5], y[6], y[7]); w.z = pk_fp8x4(y[8], y[9], y[10], y[11]); w.w = pk_fp8x4(y[12], y[13], y[14], y[15]);
                    *(u32x4*)(hrow8 + 1024 * jh) = w; }
            }
        }
#pragma unroll
        for (int j = 0; j < 4; ++j) { pw[j] = pwn[j]; xw[j] = xwn[j]; }
    }
#undef PN_LOAD
}

#ifndef PH_MASK
#define PH_MASK 0xFFFF
#endif
#define PH(b) if constexpr ((PH_MASK >> (b)) & 1)
#ifndef DBL_MASK
#define DBL_MASK 0
#endif
#define REP(b) for (int _r = 0; _r < 1 + ((DBL_MASK >> (b)) & 1); ++_r)
__device__ __forceinline__ int fresh_tid() { int t = threadIdx.x; asm volatile("" : "+v"(t)); return t; }
__device__ __forceinline__ P load_p() {
    typedef __attribute__((address_space(1))) float* gp;
    typedef const gp __attribute__((address_space(4)))* cq;
    cq q = (cq)__builtin_amdgcn_kernarg_segment_ptr(); asm volatile("" : "+s"(q));
    P r; float** d = (float**)&r;
#pragma unroll
    for (int i = 0; i < (int)(sizeof(P) / 8); ++i) d[i] = (float*)q[i];
    return r;
}
#define LP (load_p())
#define WSB (load_p().ws)
#define MODP ((const float*)(load_p().ws + WS_MOD))
#define HP ((bf16_t*)(load_p().ws + WS_H))
__global__ void __launch_bounds__(512, 2) mk_fwd(P p_arg) {
    extern __shared__ __attribute__((aligned(16))) unsigned char lds_raw[];
    LAS unsigned char* lds = (LAS unsigned char*)lds_raw;
    cg::grid_group grid = cg::this_grid();
    const int wid = __builtin_amdgcn_readfirstlane((int)threadIdx.x >> 6);
    const int gw = blockIdx.x * 8 + wid, ngw = gridDim.x * 8, G = gridDim.x;
    volatile LAS unsigned* xst = (volatile LAS unsigned*)(lds + LDS_BYTES - 64);
    if (threadIdx.x < 16) xst[threadIdx.x] = 0u;
    __syncthreads();
    const XcdBarrier xb = xcd_barrier_post((unsigned*)(load_p().ws + WS_BAR), xst);
#define TID (fresh_tid())
#define LANE (fresh_tid() & 63)

    REP(0) { PH(0) phase_prologue(LP, lds, TID, LANE, wid);
    grid.sync(); }
    REP(1) { PH(1) phase_adaln<true>(LP.x, WSB + WS_H8, LP.norm_g, MODP, MODP + 2048, gw, ngw, LANE);
    xcd_barrier(xb); }
    REP(2) { PH(2) {   pg8::Gemm g{(const bf16_t*)(WSB + WS_H8), (const bf16_t*)(WSB + WS_WINE), NTOK, 2560, 1024, 1024, 1024, 0, 0}; pg8::StaticOrder S; S.init(NTOK, 2560, G, (int)blockIdx.x);
        pg8::EpiEvenSplit E{1.0f / (F8_HS * F8_WS), WSB};
        pg8::gemm_phase<pg8::EpiEvenSplit, pg8::StaticOrder, true, true, true>(lds, g, S, E); }
    xcd_barrier(xb); }
    PH(3) { phase_qkprep(LP, gw, ngw, LANE); phase_fold_wq(LP, lds, TID, LANE, wid); __syncthreads(); }
    REP(4) { PH(4) {
        pg8::Gemm g{(const bf16_t*)(WSB + WS_AB), (const bf16_t*)(WSB + WS_WSUM), 1024, 256, 256, 512, 256, (size_t)1024 * 512, (size_t)256 * 256};
        pg8::BatchOrder S{4, 256, G, (int)blockIdx.x}; pg8::EpiF32B E{(float*)(WSB + WS_SS), 256, (size_t)1024 * 256};
        pg8::gemm_phase<pg8::EpiF32B, pg8::BatchOrder, false, false>(lds, g, S, E); }
    xcd_barrier(xb); }
    REP(5) { PH(5) { phase_s5scan(LP, lds, LANE, wid); phase_bias_reduce(LP, TID); }
    xcd_barrier(xb); }
    REP(13) { PH(13) {
        pg8::Gemm g{(const bf16_t*)(WSB + WS_AB), (const bf16_t*)(WSB + WS_WY), 1024, 256, 512, 512, 512, (size_t)1024 * 512, (size_t)256 * 512};
        LAS float* wl = (LAS float*)(lds + 131072);
        { const int un = (int)blockIdx.x;
            const int tid = TID; __syncthreads();
            if (tid < 256) wl[tid] = LP.glu_w[(un >> 2) * 256 + tid]; else if (tid < 272) wl[tid] = LP.glu_b[(un >> 2) * 16 + tid - 256];
            __syncthreads();
            pg8::BatchOrder S{4, un + 1, 256, un}; pg8::EpiS5Glu E{WSB + WS_CAT, wl};
            pg8::gemm_phase<pg8::EpiS5Glu, pg8::BatchOrder, false, false>(lds, g, S, E); }
        __syncthreads(); } }
    REP(6) { PH(6) phase_attn(LP, (char*)lds_raw);
    xcd_barrier(xb); }
    REP(7) { PH(7) {   pg8::Gemm g{(const bf16_t*)(WSB + WS_CAT), (const bf16_t*)(WSB + WS_WOUTE), NTOK, 2048, 1024, 1024, 1024, 0, 0}; pg8::StaticOrder S; S.init(NTOK, 2048, G, (int)blockIdx.x);
        pg8::EpiResidB<true> E{LP.x, (bf16_t*)(WSB + WS_XB), MODP + 2 * 2048, (float*)(WSB + WS_ROWSQ), WSB + WS_X8, 1.0f / (F8_CS * F8_WS)};
        pg8::gemm_phase<pg8::EpiResidB<true>, pg8::StaticOrder, true, true, true>(lds, g, S, E); }
    xcd_barrier(xb); }
    REP(8) { PH(8) {   pg8::Gemm g{(const bf16_t*)(WSB + WS_X8), (const bf16_t*)(WSB + WS_WQF), NTOK, 2048, 1024, 1024, 1024, 0, (size_t)2048 * 1024}; pg8::StaticOrder S; S.init(NTOK, 2048, G, (int)blockIdx.x); S.pbs = 5;
        pg8::EpiQ E{(bf16_t*)(WSB + WS_QP), (const float*)(WSB + WS_ROWSQ), (const float*)(WSB + WS_BIASQ), 1.0f / (F8_XS * F8_WS)};
        pg8::gemm_phase<pg8::EpiQ, pg8::StaticOrder, true, true, true>(lds, g, S, E); }
    xcd_barrier(xb); }
    REP(16) { PH(9) phase_peer_s1(LP, 0, lds, LANE, wid); }
    xcd_barrier(xb);
    REP(17) { PH(9) phase_peer_u(LP, 0, lds, LANE, wid, (int)xst[2]); }
    xcd_barrier(xb);
    REP(18) { PH(9) phase_peer_w(LP, 0, TID); }
    xcd_barrier(xb);
    REP(19) { PH(9) phase_peer_vs(LP, 0, lds, LANE, wid, (int)xst[2]); }
    xcd_barrier(xb);
    PH(9) phase_peer_norm<false>(LP, 0, LANE, wid);
    xcd_barrier(xb);
    REP(10) { PH(10) {   pg8::Gemm g{(const bf16_t*)(WSB + WS_H8), (const bf16_t*)(WSB + WS_WINO), NTOK, 8192, 1024, 1024, 1024, 0, 0}; pg8::StaticOrder S; S.init(NTOK, 8192, G, (int)blockIdx.x);
        pg8::EpiBf16T<1> E{(bf16_t*)(WSB + WS_Z), 8192, 1.0f / (F8_HS * F8_WS), (float*)(WSB + WS_LNST)};
        pg8::gemm_phase<pg8::EpiBf16T<1>, pg8::StaticOrder, true, true, true>(lds, g, S, E); }
    xcd_barrier(xb); }
    REP(11) { PH(11) phase_sgu(LP, lds, TID, LANE, wid);
    xcd_barrier(xb); }
    PH(12) {   pg8::Gemm g{(const bf16_t*)(WSB + WS_SG), (const bf16_t*)(WSB + WS_WOUTO), NTOK, 2048, 2048, 2048, 2048, 0, 0}; pg8::StaticOrder S; S.init(NTOK, 2048, G, (int)blockIdx.x);
        pg8::EpiResidB<false> E{nullptr, (bf16_t*)(WSB + WS_XB), MODP + 2 * 12288 + 2 * 2048, (float*)(WSB + WS_ROWSQ) + (size_t)32 * NTOK, WSB + WS_X8, 1.0f / (F8_SGS * F8_WS)};
        pg8::gemm_phase<pg8::EpiResidB<false>, pg8::StaticOrder, true, true, true>(lds, g, S, E); }
    xcd_barrier(xb);
    REP(8) { PH(8) {   pg8::Gemm g{(const bf16_t*)(WSB + WS_X8), (const bf16_t*)(WSB + WS_WQF) + (size_t)2 * 2048 * 1024, NTOK, 2048, 1024, 1024, 1024, 0, (size_t)2048 * 1024}; pg8::StaticOrder S; S.init(NTOK, 2048, G, (int)blockIdx.x); S.pbs = 5;
        pg8::EpiQ E{(bf16_t*)(WSB + WS_QP), (const float*)(WSB + WS_ROWSQ) + (size_t)32 * NTOK, (const float*)(WSB + WS_BIASQ) + 2 * 2048, 1.0f / (F8_XS * F8_WS)};
        pg8::gemm_phase<pg8::EpiQ, pg8::StaticOrder, true, true, true>(lds, g, S, E); }
    xcd_barrier(xb); }
    REP(16) { PH(9) phase_peer_s1(LP, 1, lds, LANE, wid); }
    xcd_barrier(xb);
    REP(17) { PH(9) phase_peer_u(LP, 1, lds, LANE, wid, (int)xst[2]); }
    xcd_barrier(xb);
    REP(18) { PH(9) phase_peer_w(LP, 1, TID); }
    xcd_barrier(xb);
    REP(19) { PH(9) phase_peer_vs(LP, 1, lds, LANE, wid, (int)xst[2]); }
    xcd_barrier(xb);
    PH(9) phase_peer_norm<true>(LP, 1, LANE, wid);
}

#undef LP
#undef WSB
#undef MODP
#undef HP
extern "C" void kernel_launch(void* const* d_in, const int* in_sizes, int n_in, void* d_out, int out_size, void* d_ws, size_t ws_size, hipStream_t stream) {
    static int grid = 0;
    if (grid == 0) {
        if (n_in != 30 || out_size != NTOK * DMODEL || ws_size < WS_END) { fprintf(stderr, "kernel_launch: unexpected shapes (n_in %d out %d ws %zu, need ws >= %zu)\n", n_in, out_size, ws_size, (size_t)WS_END); grid = -1; return; }
        int dev = 0, cus = 0, per_cu = 0;
        (void)hipGetDevice(&dev); (void)hipDeviceGetAttribute(&cus, hipDeviceAttributeMultiprocessorCount, dev);
        if (hipFuncSetAttribute((const void*)mk_fwd, hipFuncAttributeMaxDynamicSharedMemorySize, LDS_BYTES) != hipSuccess) { fprintf(stderr, "kernel_launch: hipFuncSetAttribute failed\n"); grid = -1; return; }
        if (hipOccupancyMaxActiveBlocksPerMultiprocessor(&per_cu, (const void*)mk_fwd, 512, LDS_BYTES) != hipSuccess || per_cu < 1) { fprintf(stderr, "kernel_launch: occupancy query says %d\n", per_cu); (void)hipGetLastError(); per_cu = 1; }
        grid = cus;
        if (grid > cus * per_cu) grid = cus * per_cu;
        if (grid != 256) { fprintf(stderr, "kernel_launch: this kernel is laid out for a 256-CU device (got %d workgroups)\n", grid); grid = -1; return; }
    }
    if (grid < 0) return;
    if (hipMemsetAsync((char*)d_ws + WS_BAR, 0, 16384, stream) != hipSuccess) { fprintf(stderr, "kernel_launch: hipMemsetAsync failed\n"); return; }
    P p{};
    const float** pf = (const float**)&p;
    for (int i = 0; i < 30; ++i) pf[i] = (const float*)d_in[i];
    p.out = (float*)d_out; p.ws = (unsigned char*)d_ws;
    void* args[] = {&p};
    hipError_t e = hipLaunchCooperativeKernel((const void*)mk_fwd, dim3(grid), dim3(512), args, LDS_BYTES, stream);
    if (e != hipSuccess) fprintf(stderr, "kernel_launch: cooperative launch failed: %s (grid %d)\n", hipGetErrorString(e), grid);
}
```
